# Optimizing an MI355X kernel written in HIP

```python
import math
import jax
import jax.numpy as jnp
from jax import lax
import numpy as np

D_MODEL = 1024
BATCH = 8
SEQ = 4096
DEPTH = 2

A_HEADS = 4
A_DK = 64
A_DV = 64
B_HEADS = 8
B_GROUPS = 2
B_HPG = B_HEADS // B_GROUPS
B_DH = 64
C_HEADS = 4
C_DH = 64
MIX_WIDTH = A_HEADS * A_DV + B_HEADS * B_DH + C_HEADS * C_DH
D_FF = 4 * D_MODEL
ROPE_THETA = 500000.0
ROT_DIM = B_DH // 4
EPS = 1e-6
NEG_BIG = -1e30
POS_BIG = 1e30
TINY = 1e-30
HGRN_CHUNK = 64
CMP_BLOCK = 32
CMP_STRIDE = 16
CMP_HIDDEN = 128
SEL_BLOCK = 64
SEL_TOPK = 16
WINDOW = 512
NSA_QBLOCK = 64
FOX_QBLOCK = 128

IN_SPLIT = (
    A_HEADS * A_DK, A_HEADS * A_DK, A_HEADS * A_DV, A_HEADS * A_DV,
    B_HEADS * B_DH,
    B_GROUPS * B_DH, B_GROUPS * B_DH,
    B_GROUPS * B_DH, B_GROUPS * B_DH,
    B_GROUPS * B_DH, B_GROUPS * B_DH,
    3 * B_HEADS,
    C_HEADS * C_DH, C_HEADS * C_DH, C_HEADS * C_DH, C_HEADS,
)
IN_WIDTH = sum(IN_SPLIT)

kernel_name = "hybrid_hgrn2_nsa_fox_block"


def _rmsnorm(x, g):
    xf = x.astype(jnp.float32)
    var = jnp.mean(xf * xf, axis=-1, keepdims=True)
    return xf * lax.rsqrt(var + EPS) * g.astype(jnp.float32)


def _rope_partial(x, pos):
    half = ROT_DIM // 2
    inv_freq = jnp.power(jnp.float32(ROPE_THETA), -jnp.arange(0, ROT_DIM, 2, dtype=jnp.float32) / ROT_DIM)
    ang = pos.astype(jnp.float32)[:, None] * inv_freq[None, :]
    ang = ang.reshape((1, pos.shape[0]) + (1,) * (x.ndim - 3) + (half,))
    cos, sin = jnp.cos(ang), jnp.sin(ang)
    x1 = x[..., :half]
    x2 = x[..., half:ROT_DIM]
    return jnp.concatenate([x1 * cos - x2 * sin, x2 * cos + x1 * sin, x[..., ROT_DIM:]], axis=-1)


def _masked_softmax(logits, mask):
    logits = jnp.where(mask, logits.astype(jnp.float32), NEG_BIG)
    m = jnp.max(logits, axis=-1, keepdims=True)
    p = jnp.where(mask, jnp.exp(logits - m), 0.0)
    return p / jnp.maximum(jnp.sum(p, axis=-1, keepdims=True), TINY)


def _hgrn2(q, f_logit, i_val, g_out, lb, onorm_g):
    bsz, seq = q.shape[0], q.shape[1]
    lb = lb.reshape(A_HEADS, A_DK)
    z = f_logit.astype(jnp.float32).reshape(bsz, seq, A_HEADS, A_DK)
    f = lb + (1.0 - lb) * jax.nn.sigmoid(z)
    log_f = jnp.log(jnp.maximum(f, TINY))
    k = (1.0 - lb) * jax.nn.sigmoid(-z)
    qf = q.astype(jnp.float32).reshape(bsz, seq, A_HEADS, A_DK) * (A_DK ** -0.5)
    v = i_val.astype(jnp.float32).reshape(bsz, seq, A_HEADS, A_DV)
    n_chunks = seq // HGRN_CHUNK

    def to_chunks(t):
        return t.reshape(bsz, n_chunks, HGRN_CHUNK, A_HEADS, -1).transpose(1, 0, 3, 2, 4)

    causal = jnp.tril(jnp.ones((HGRN_CHUNK, HGRN_CHUNK), dtype=bool))

    def step(state, inp):
        qc, kc, vc, gc = inp
        G = jnp.cumsum(gc, axis=2)
        o_inter = jnp.einsum('bhtk,bhkv->bhtv', qc * jnp.exp(G), state)
        diff = G[:, :, :, None, :] - G[:, :, None, :, :]
        decay = jnp.exp(jnp.where(causal[:, :, None], diff, NEG_BIG))
        scores = jnp.einsum('bhtk,bhsk,bhtsk->bhts', qc, kc, decay)
        o_intra = jnp.einsum('bhts,bhsv->bhtv', scores, vc)
        g_last = G[:, :, -1:, :]
        k_dec = kc * jnp.exp(g_last - G)
        state = state * jnp.exp(g_last[:, :, 0, :])[..., None] + jnp.einsum('bhsk,bhsv->bhkv', k_dec, vc)
        return state, o_inter + o_intra

    state0 = jnp.zeros((bsz, A_HEADS, A_DK, A_DV), jnp.float32)
    _, o = lax.scan(step, state0, (to_chunks(qf), to_chunks(k), to_chunks(v), to_chunks(log_f)))
    o = o.transpose(1, 0, 3, 2, 4).reshape(bsz, seq, A_HEADS, A_DV)
    gate = jax.nn.silu(g_out.astype(jnp.float32)).reshape(bsz, seq, A_HEADS, A_DV)
    o = _rmsnorm(o, onorm_g) * gate
    return o.reshape(bsz, seq, A_HEADS * A_DV)


def _nsa(q, k_cmp, v_cmp, k_slc, v_slc, k_win, v_win, gates, qn_g, kn_g, cmp_pos, cmp_w1, cmp_w2):
    bsz, seq = q.shape[0], q.shape[1]
    pos = jnp.arange(seq)
    qh = _rope_partial(_rmsnorm(q.reshape(bsz, seq, B_GROUPS, B_HPG, B_DH), qn_g), pos) * (B_DH ** -0.5)
    ks = _rope_partial(_rmsnorm(k_slc.reshape(bsz, seq, B_GROUPS, B_DH), kn_g), pos)
    kw = _rope_partial(_rmsnorm(k_win.reshape(bsz, seq, B_GROUPS, B_DH), kn_g), pos)
    vs = v_slc.astype(jnp.float32).reshape(bsz, seq, B_GROUPS, B_DH)
    vw = v_win.astype(jnp.float32).reshape(bsz, seq, B_GROUPS, B_DH)

    n_sub = CMP_BLOCK // CMP_STRIDE
    n_cmp = seq // CMP_STRIDE - n_sub + 1

    def compress(t, which):
        sub = t.astype(jnp.float32).reshape(bsz, seq // CMP_STRIDE, CMP_STRIDE, B_GROUPS, B_DH)
        blocks = jnp.concatenate([sub[:, m:m + n_cmp] for m in range(n_sub)], axis=2)
        blocks = blocks + cmp_pos[which][None, None, :, None, :]
        flat = blocks.transpose(0, 1, 3, 2, 4).reshape(bsz, n_cmp, B_GROUPS, CMP_BLOCK * B_DH)
        hidden = jax.nn.gelu(flat @ cmp_w1[which])
        return hidden @ cmp_w2[which]

    cmp_end = jnp.arange(n_cmp) * CMP_STRIDE + CMP_BLOCK - 1
    kc = _rope_partial(_rmsnorm(compress(k_cmp.reshape(bsz, seq, B_GROUPS, B_DH), 0), kn_g), cmp_end)
    vc = compress(v_cmp.reshape(bsz, seq, B_GROUPS, B_DH), 1)

    n_sel = seq // SEL_BLOCK
    ci = np.arange(n_cmp)[:, None]
    sj = np.arange(n_sel)[None, :]
    c_start = ci * CMP_STRIDE
    overlap = jnp.asarray(((c_start <= sj * SEL_BLOCK + SEL_BLOCK - 1)
                           & (c_start + CMP_BLOCK - 1 >= sj * SEL_BLOCK)).astype(np.float32))
    topk = min(SEL_TOPK, n_sel)
    kb = ks.reshape(bsz, n_sel, SEL_BLOCK, B_GROUPS, B_DH).transpose(0, 3, 1, 2, 4)
    vb = vs.reshape(bsz, n_sel, SEL_BLOCK, B_GROUPS, B_DH).transpose(0, 3, 1, 2, 4)
    kw_pad = jnp.pad(kw, ((0, 0), (WINDOW, 0), (0, 0), (0, 0)))
    vw_pad = jnp.pad(vw, ((0, 0), (WINDOW, 0), (0, 0), (0, 0)))
    gate = jax.nn.sigmoid(gates.astype(jnp.float32)).reshape(bsz, seq, 3, B_GROUPS, B_HPG)
    b_idx = jnp.arange(bsz)[:, None, None, None]
    g_idx = jnp.arange(B_GROUPS)[None, :, None, None]
    sel_off = jnp.arange(SEL_BLOCK)
    win_off = jnp.arange(WINDOW + NSA_QBLOCK)
    blk_ids = jnp.arange(n_sel)

    def block_fn(blk):
        q0 = blk * NSA_QBLOCK
        t = q0 + jnp.arange(NSA_QBLOCK)
        qb = lax.dynamic_slice_in_dim(qh, q0, NSA_QBLOCK, axis=1)
        s_c = jnp.einsum('bqghd,bngd->bghqn', qb, kc)
        p_c = _masked_softmax(s_c, cmp_end[None, :] <= t[:, None])
        o_c = jnp.einsum('bghqn,bngd->bqghd', p_c, vc)
        imp = jnp.einsum('bghqn,nj->bgqj', p_c, overlap)
        cur = (t // SEL_BLOCK)[:, None]
        forced = (blk_ids[None, :] == 0) | (blk_ids[None, :] == cur) | (blk_ids[None, :] == cur - 1)
        imp = jnp.where(forced, POS_BIG, imp)
        imp = jnp.where(blk_ids[None, :] * SEL_BLOCK > t[:, None], NEG_BIG, imp)
        vals, idx = lax.top_k(imp, topk)
        k_sel = kb[b_idx, g_idx, idx]
        v_sel = vb[b_idx, g_idx, idx]
        s_s = jnp.einsum('bqghd,bgqkld->bghqkl', qb, k_sel).reshape(bsz, B_GROUPS, B_HPG, NSA_QBLOCK, topk * SEL_BLOCK)
        key_pos = idx[..., None] * SEL_BLOCK + sel_off
        m_s = (key_pos <= t[None, None, :, None, None]) & (vals > NEG_BIG * 0.5)[..., None]
        m_s = m_s.reshape(bsz, B_GROUPS, 1, NSA_QBLOCK, topk * SEL_BLOCK)
        p_s = _masked_softmax(s_s, m_s).reshape(bsz, B_GROUPS, B_HPG, NSA_QBLOCK, topk, SEL_BLOCK)
        o_s = jnp.einsum('bghqkl,bgqkld->bqghd', p_s, v_sel)
        kwb = lax.dynamic_slice_in_dim(kw_pad, q0, WINDOW + NSA_QBLOCK, axis=1)
        vwb = lax.dynamic_slice_in_dim(vw_pad, q0, WINDOW + NSA_QBLOCK, axis=1)
        kpos = q0 - WINDOW + win_off
        m_w = (kpos[None, :] >= 0) & (kpos[None, :] <= t[:, None]) & (kpos[None, :] > t[:, None] - WINDOW)
        s_w = jnp.einsum('bqghd,bkgd->bghqk', qb, kwb)
        p_w = _masked_softmax(s_w, m_w)
        o_w = jnp.einsum('bghqk,bkgd->bqghd', p_w, vwb)
        gb = lax.dynamic_slice_in_dim(gate, q0, NSA_QBLOCK, axis=1)
        return gb[:, :, 0, :, :, None] * o_c + gb[:, :, 1, :, :, None] * o_s + gb[:, :, 2, :, :, None] * o_w

    out = lax.map(block_fn, jnp.arange(seq // NSA_QBLOCK))
    return out.transpose(1, 0, 2, 3, 4, 5).reshape(bsz, seq, B_HEADS * B_DH)


def _fox(q, k, v, f_logit, qn_g, kn_g, fb):
    bsz, seq = q.shape[0], q.shape[1]
    qh = _rmsnorm(q.reshape(bsz, seq, C_HEADS, C_DH), qn_g) * (C_DH ** -0.5)
    kh = _rmsnorm(k.reshape(bsz, seq, C_HEADS, C_DH), kn_g)
    vh = v.astype(jnp.float32).reshape(bsz, seq, C_HEADS, C_DH)
    log_f = jax.nn.log_sigmoid(f_logit.astype(jnp.float32) + fb.astype(jnp.float32))
    c = jnp.cumsum(log_f, axis=1).transpose(0, 2, 1)
    kpos = jnp.arange(seq)

    def block_fn(blk):
        q0 = blk * FOX_QBLOCK
        t = q0 + jnp.arange(FOX_QBLOCK)
        qb = lax.dynamic_slice_in_dim(qh, q0, FOX_QBLOCK, axis=1)
        cq = lax.dynamic_slice_in_dim(c, q0, FOX_QBLOCK, axis=2)
        s = jnp.einsum('bqhd,bkhd->bhqk', qb, kh) + cq[..., None] - c[:, :, None, :]
        p = _masked_softmax(s, kpos[None, :] <= t[:, None])
        return jnp.einsum('bhqk,bkhd->bqhd', p, vh)

    out = lax.map(block_fn, jnp.arange(seq // FOX_QBLOCK))
    return out.transpose(1, 0, 2, 3, 4).reshape(bsz, seq, C_HEADS * C_DH)


def setup_inputs(seed: int = 0) -> dict:
    key = jax.random.key(seed)
    ks = jax.random.split(key, 17)

    def nrm(k, shape, scale):
        return jax.random.normal(k, shape, jnp.float32) * scale

    return {
        'x': nrm(ks[0], (BATCH, SEQ, D_MODEL), 1.0),
        'norm1_g': 1.0 + nrm(ks[1], (DEPTH, D_MODEL), 0.02),
        'w_in': nrm(ks[2], (DEPTH, D_MODEL, IN_WIDTH), D_MODEL ** -0.5),
        'hgrn_lb_logits': nrm(ks[3], (DEPTH, A_HEADS * A_DK), 0.1),
        'hgrn_onorm_g': 1.0 + nrm(ks[4], (DEPTH, A_DV), 0.02),
        'nsa_qn_g': 1.0 + nrm(ks[5], (DEPTH, B_DH), 0.02),
        'nsa_kn_g': 1.0 + nrm(ks[6], (DEPTH, B_DH), 0.02),
        'nsa_cmp_pos': nrm(ks[7], (DEPTH, 2, CMP_BLOCK, B_DH), 0.02),
        'nsa_cmp_w1': nrm(ks[8], (DEPTH, 2, CMP_BLOCK * B_DH, CMP_HIDDEN), (CMP_BLOCK * B_DH) ** -0.5),
        'nsa_cmp_w2': nrm(ks[9], (DEPTH, 2, CMP_HIDDEN, B_DH), CMP_HIDDEN ** -0.5),
        'fox_qn_g': 1.0 + nrm(ks[10], (DEPTH, C_DH), 0.02),
        'fox_kn_g': 1.0 + nrm(ks[11], (DEPTH, C_DH), 0.02),
        'fox_fb': 2.0 + nrm(ks[12], (DEPTH, C_HEADS), 0.1),
        'w_o': nrm(ks[13], (DEPTH, MIX_WIDTH, D_MODEL), MIX_WIDTH ** -0.5),
        'norm2_g': 1.0 + nrm(ks[14], (DEPTH, D_MODEL), 0.02),
        'w_up': nrm(ks[15], (DEPTH, D_MODEL, D_FF), D_MODEL ** -0.5),
        'w_down': nrm(ks[16], (DEPTH, D_FF, D_MODEL), D_FF ** -0.5),
    }


def reference(x, norm1_g, w_in, hgrn_lb_logits, hgrn_onorm_g, nsa_qn_g, nsa_kn_g, nsa_cmp_pos,
              nsa_cmp_w1, nsa_cmp_w2, fox_qn_g, fox_kn_g, fox_fb, w_o, norm2_g, w_up, w_down):
    lb_p = jax.nn.softmax(hgrn_lb_logits.astype(jnp.float32), axis=0)
    lb_all = jnp.cumsum(lb_p, axis=0) - lb_p[0:1]
    split_at = [int(v) for v in np.cumsum(IN_SPLIT)[:-1]]
    for layer in range(DEPTH):
        h = _rmsnorm(x, norm1_g[layer]).astype(x.dtype)
        proj = h @ w_in[layer]
        (aq, af, ai, ag, bq, bkc, bvc, bks, bvs, bkw, bvw, bg,
         cq, ck, cv, cf) = jnp.split(proj, split_at, axis=-1)
        o_a = _hgrn2(aq, af, ai, ag, lb_all[layer], hgrn_onorm_g[layer])
        o_b = _nsa(bq, bkc, bvc, bks, bvs, bkw, bvw, bg, nsa_qn_g[layer], nsa_kn_g[layer],
                   nsa_cmp_pos[layer], nsa_cmp_w1[layer], nsa_cmp_w2[layer])
        o_c = _fox(cq, ck, cv, cf, fox_qn_g[layer], fox_kn_g[layer], fox_fb[layer])
        mix = jnp.concatenate([o_a, o_b, o_c], axis=-1).astype(x.dtype)
        x = x + (mix @ w_o[layer]).astype(x.dtype)
        h2 = _rmsnorm(x, norm2_g[layer]).astype(x.dtype)
        x = x + (jnp.square(jax.nn.relu(h2 @ w_up[layer])) @ w_down[layer]).astype(x.dtype)
    return x
```

```cpp
#include <hip/hip_runtime.h>
#include <hip/hip_cooperative_groups.h>
#include <stdint.h>
#include <cstdio>
namespace cg = cooperative_groups;

#ifndef MULTI_LAUNCH
#define MULTI_LAUNCH 0
#endif

typedef unsigned short bf16_t;
typedef short bf16x8 __attribute__((ext_vector_type(8)));
typedef float f32x4 __attribute__((ext_vector_type(4)));
typedef unsigned long long u64;
#define DEVI __device__ __forceinline__

constexpr int T_TOK = 32768, SEQ = 4096, DM = 1024, DFF = 4096;
constexpr int PJ_LD = 3072;
constexpr int NW_IN = 3100, NW_IN_PAD = 3200;
constexpr int NPHASE = 18;

constexpr size_t OFF_WIN = 0;
constexpr size_t OFF_WO = OFF_WIN + (size_t)2 * NW_IN_PAD * 1024 * 2;
constexpr size_t OFF_WUP = OFF_WO + (size_t)2 * 1024 * 1024 * 2;
constexpr size_t OFF_WDN = OFF_WUP + (size_t)2 * 4096 * 1024 * 2;
constexpr size_t OFF_W1T = OFF_WDN + (size_t)2 * 4096 * 1024 * 2;
constexpr size_t OFF_W2T = OFF_W1T + (size_t)2 * 2 * 128 * 2048 * 2;
constexpr size_t OFF_CBIAS = OFF_W2T + (size_t)2 * 2 * 64 * 128 * 2;
constexpr size_t OFF_ROPE = OFF_CBIAS + 2048;
constexpr size_t OFF_GATES = OFF_ROPE + (size_t)4096 * 16 * 4;
constexpr size_t OFF_FOXC = OFF_GATES + (size_t)T_TOK * 32 * 4;
constexpr size_t OFF_KC = OFF_FOXC + (size_t)8 * 4 * 4096 * 4;
constexpr size_t OFF_VCT = OFF_KC + (size_t)8 * 2 * 256 * 64 * 2;
constexpr size_t OFF_DECAY = OFF_VCT + (size_t)8 * 2 * 256 * 64 * 2;
constexpr size_t OFF_KVT = OFF_DECAY + (size_t)2048 * 64 * 4;
constexpr size_t OFF_ST = OFF_KVT + (size_t)2048 * 4096 * 4;
constexpr size_t OFF_ACT = OFF_ST + (size_t)2048 * 4096 * 2;
constexpr size_t OFF_BIG = OFF_ACT + (size_t)T_TOK * 1024 * 2;
constexpr size_t OFF_VT_IN_BIG = (size_t)T_TOK * PJ_LD * 2;
constexpr size_t WS_NEED = OFF_BIG + (size_t)T_TOK * 4096 * 2;

constexpr int LDS_BYTES = 67584;

struct Params {
    const float *x, *norm1_g, *w_in, *lb_logits, *onorm_g, *nsa_qn_g, *nsa_kn_g, *cmp_pos, *cmp_w1, *cmp_w2,
        *fox_qn_g, *fox_kn_g, *fox_fb, *w_o, *norm2_g, *w_up, *w_down;
    float* out;
    char* ws;
};

DEVI unsigned pk2(float lo, float hi) { unsigned r; asm("v_cvt_pk_bf16_f32 %0, %1, %2" : "=v"(r) : "v"(lo), "v"(hi)); return r; }
DEVI bf16_t f2bf(float f) { return (bf16_t)(pk2(f, 0.f) & 0xffffu); }
DEVI float bf2f(bf16_t h) { return __uint_as_float(((unsigned)h) << 16); }
DEVI float bflo(unsigned u) { return __uint_as_float(u << 16); }
DEVI float bfhi(unsigned u) { return __uint_as_float(u & 0xffff0000u); }
DEVI f32x4 mfma(bf16x8 a, bf16x8 b, f32x4 c) { return __builtin_amdgcn_mfma_f32_16x16x32_bf16(a, b, c, 0, 0, 0); }
DEVI int otid() { int t; asm volatile("v_mov_b32 %0, %1" : "=v"(t) : "v"(threadIdx.x)); return t; }
DEVI float wave_sum(float v) {
#pragma unroll
    for (int o = 32; o >= 1; o >>= 1) v += __shfl_xor(v, o);
    return v;
}
DEVI bf16x8 mk8(unsigned a, unsigned b, unsigned c, unsigned d) {
    uint4 u = make_uint4(a, b, c, d);
    return *(bf16x8*)&u;
}
DEVI bf16x8 ld8(const bf16_t* p) { uint4 u = *(const uint4*)p; return *(bf16x8*)&u; }
DEVI bf16x8 ld4x2(const bf16_t* p0, const bf16_t* p1) {
    uint2 a = *(const uint2*)p0, b = *(const uint2*)p1;
    return mk8(a.x, a.y, b.x, b.y);
}

DEVI int win_colmap(int n) {
    if (n < 2304) return n;
    if (n < 3072) return n + 24;
    if (n < 3096) return n - 768;
    return n;
}
__device__ void transpose_tile(const float* __restrict__ src, int ld_src, bf16_t* __restrict__ dst, int ld_dst, int k0, int n0, int nvalid,
                               int colmode, float* tile) {
    const int tid = otid();
    for (int idx = tid; idx < 4096; idx += 256) {
        const int i = idx >> 6, j = idx & 63, n = n0 + j;
        float v = 0.f;
        if (n < nvalid) v = src[(size_t)(k0 + i) * ld_src + (colmode ? win_colmap(n) : n)];
        tile[i * 65 + j] = v;
    }
    __syncthreads();
    for (int idx = tid; idx < 4096; idx += 256) {
        const int j = idx >> 6, i = idx & 63;
        dst[(size_t)(n0 + j) * ld_dst + k0 + i] = f2bf(tile[i * 65 + j]);
    }
    __syncthreads();
}

__device__ void norm_phase(const float* __restrict__ xin, const float* __restrict__ g, bf16_t* __restrict__ hout) {
    const int tid = otid(); const int lane = tid & 63, w = tid >> 6;
    for (int row = blockIdx.x * 4 + w; row < T_TOK; row += gridDim.x * 4) {
        const float4* xr = (const float4*)(xin + (size_t)row * DM);
        float4 v[4]; float ss = 0.f;
#pragma unroll
        for (int i = 0; i < 4; ++i) { v[i] = xr[lane + 64 * i]; ss += v[i].x * v[i].x + v[i].y * v[i].y + v[i].z * v[i].z + v[i].w * v[i].w; }
        ss = wave_sum(ss);
        const float r = rsqrtf(ss * (1.0f / 1024.0f) + 1e-6f);
#pragma unroll
        for (int i = 0; i < 4; ++i) {
            const float4 gg = ((const float4*)g)[lane + 64 * i];
            uint2 o; o.x = pk2(v[i].x * r * gg.x, v[i].y * r * gg.y); o.y = pk2(v[i].z * r * gg.z, v[i].w * r * gg.w);
            *(uint2*)(hout + (size_t)row * DM + (lane + 64 * i) * 4) = o;
        }
    }
}

__device__ void prep_phase(const Params& p, char* lds) {
    float* tile = (float*)lds;
    bf16_t* win_t = (bf16_t*)(p.ws + OFF_WIN); bf16_t* wo_t = (bf16_t*)(p.ws + OFF_WO);
    bf16_t* wup_t = (bf16_t*)(p.ws + OFF_WUP); bf16_t* wdn_t = (bf16_t*)(p.ws + OFF_WDN);
    bf16_t* w1t = (bf16_t*)(p.ws + OFF_W1T); bf16_t* w2t = (bf16_t*)(p.ws + OFF_W2T);
    const int J0 = 1600, J1 = J0 + 512, J2 = J1 + 2048, J3 = J2 + 2048, J4 = J3 + 256, J5 = J4 + 8, J6 = J5 + 128, J7 = J6 + 128;
    for (int job = blockIdx.x; job < J7; job += gridDim.x) {
        if (job < J0) { const int L = job / 800, r = job % 800, kt = r / 50, nt = r % 50;
            transpose_tile(p.w_in + (size_t)L * 1024 * NW_IN, NW_IN, win_t + (size_t)L * NW_IN_PAD * 1024, 1024, kt * 64, nt * 64, NW_IN, 1, tile);
        } else if (job < J1) { const int j = job - J0, L = j / 256, r = j % 256, kt = r / 16, nt = r % 16;
            transpose_tile(p.w_o + (size_t)L * 1024 * 1024, 1024, wo_t + (size_t)L * 1024 * 1024, 1024, kt * 64, nt * 64, 1024, 0, tile);
        } else if (job < J2) { const int j = job - J1, L = j / 1024, r = j % 1024, kt = r / 64, nt = r % 64;
            transpose_tile(p.w_up + (size_t)L * 1024 * 4096, 4096, wup_t + (size_t)L * 4096 * 1024, 1024, kt * 64, nt * 64, 4096, 0, tile);
        } else if (job < J3) { const int j = job - J2, L = j / 1024, r = j % 1024, kt = r / 16, nt = r % 16;
            transpose_tile(p.w_down + (size_t)L * 4096 * 1024, 1024, wdn_t + (size_t)L * 1024 * 4096, 4096, kt * 64, nt * 64, 1024, 0, tile);
        } else if (job < J4) { const int j = job - J3, lw = j / 64, r = j % 64, kt = r / 2, nt = r % 2;
            transpose_tile(p.cmp_w1 + (size_t)lw * 2048 * 128, 128, w1t + (size_t)lw * 128 * 2048, 2048, kt * 64, nt * 64, 128, 0, tile);
        } else if (job < J5) { const int j = job - J4, lw = j / 2, kt = j % 2;
            transpose_tile(p.cmp_w2 + (size_t)lw * 128 * 64, 64, w2t + (size_t)lw * 64 * 128, 128, kt * 64, 0, 64, 0, tile);
        } else if (job < J6) {
            const int o = (job - J5) * 4 + (threadIdx.x >> 6), lane = threadIdx.x & 63, lw = o >> 7, hid = o & 127;
            const float* pos = p.cmp_pos + (size_t)lw * 2048; const float* w1 = p.cmp_w1 + (size_t)lw * 2048 * 128 + hid;
            float s = 0.f;
            for (int k = lane; k < 2048; k += 64) s += pos[k] * w1[(size_t)k * 128];
            s = wave_sum(s);
            if (lane == 0) ((float*)(p.ws + OFF_CBIAS))[o] = s;
        } else {
            const int e = (job - J6) * 256 + threadIdx.x, pos = e >> 3, i = e & 7;
            const float invf[8] = {1.0f, 0.1939227432012558f, 0.03760603070259094f, 0.007292664609849453f, 0.0014142135623842478f,
                                   0.00027424818836152554f, 5.318296098266728e-05f, 1.0313386155758053e-05f};
            float fr = 1.0f;
#pragma unroll
            for (int q = 0; q < 8; ++q) if (i == q) fr = invf[q];
            const float ang = (float)pos * fr;
            const double a = (double)ang; const double n = rint(a * 0.15915494309189535); const float rr = (float)(a - n * 6.283185307179586);
            float* rt = (float*)(p.ws + OFF_ROPE);
            rt[pos * 16 + i] = __cosf(rr); rt[pos * 16 + 8 + i] = __sinf(rr);
        }
    }
    norm_phase(p.x, p.norm1_g, (bf16_t*)(p.ws + OFF_ACT));
}

enum { EPI_PROJ = 0, EPI_WO = 1, EPI_UP = 2, EPI_DOWN = 3 };

DEVI void proj_epilogue(const Params& p, int L, const f32x4 (&acc)[4][4], int m0w, int cc, int lane) {
    const int quad = lane >> 4, l15 = lane & 15;
    bf16_t* proj = (bf16_t*)(p.ws + OFF_BIG); bf16_t* VT = (bf16_t*)(p.ws + OFF_BIG + OFF_VT_IN_BIG);
    float* gates = (float*)(p.ws + OFF_GATES); const float* rope = (const float*)(p.ws + OFF_ROPE);
    if (cc > 48) return;
    int kind = 0, vidx = 0; const float* gain = nullptr; float scale = 1.f; bool dorope = false;
    if (cc >= 8 && cc < 12) { kind = 5; vidx = cc - 8; }
    else if (cc >= 16 && cc < 24) { kind = 1; gain = p.nsa_qn_g + L * 64; scale = 0.125f; dorope = true; }
    else if (cc == 28 || cc == 29 || cc == 32 || cc == 33) { kind = 1; gain = p.nsa_kn_g + L * 64; dorope = true; }
    else if (cc == 30 || cc == 31) { kind = 5; vidx = 4 + (cc - 30); }
    else if (cc == 34 || cc == 35) { kind = 5; vidx = 6 + (cc - 34); }
    else if (cc >= 36 && cc < 40) { kind = 1; gain = p.fox_qn_g + L * 64; scale = 0.125f; }
    else if (cc >= 40 && cc < 44) { kind = 1; gain = p.fox_kn_g + L * 64; }
    else if (cc >= 44 && cc < 48) { kind = 5; vidx = 8 + (cc - 44); }
    else if (cc == 48) kind = 6;
#pragma unroll
    for (int mi = 0; mi < 4; ++mi) {
        const int token = m0w + mi * 16 + l15, pos = token & 4095, bb = token >> 12;
        float v[4][4];
#pragma unroll
        for (int ni = 0; ni < 4; ++ni)
#pragma unroll
            for (int j = 0; j < 4; ++j) v[ni][j] = acc[mi][ni][j];
        if (kind == 6) {
#pragma unroll
            for (int ni = 0; ni < 2; ++ni)
#pragma unroll
                for (int j = 0; j < 4; ++j) { const int d = ni * 16 + quad * 4 + j;
                    if (d < 24) gates[(size_t)token * 32 + d] = 1.0f / (1.0f + __expf(-v[ni][j]));
                    else if (d < 28) gates[(size_t)token * 32 + d] = v[ni][j]; }
            continue;
        }
        if (kind == 1) {
            float ss = 0.f;
#pragma unroll
            for (int ni = 0; ni < 4; ++ni)
#pragma unroll
                for (int j = 0; j < 4; ++j) ss += v[ni][j] * v[ni][j];
            ss += __shfl_xor(ss, 16); ss += __shfl_xor(ss, 32);
            const float r = rsqrtf(ss * (1.0f / 64.0f) + 1e-6f);
#pragma unroll
            for (int ni = 0; ni < 4; ++ni) { const float4 gg = *(const float4*)(gain + ni * 16 + quad * 4);
                v[ni][0] *= r * gg.x; v[ni][1] *= r * gg.y; v[ni][2] *= r * gg.z; v[ni][3] *= r * gg.w; }
            if (dorope) {
                const float4 cs = *(const float4*)(rope + pos * 16 + (quad & 1) * 4), sn = *(const float4*)(rope + pos * 16 + 8 + (quad & 1) * 4);
                const float cv[4] = {cs.x, cs.y, cs.z, cs.w}, sv[4] = {sn.x, sn.y, sn.z, sn.w};
#pragma unroll
                for (int j = 0; j < 4; ++j) { const float xx = v[0][j], pp = __shfl_xor(xx, 32);
                    v[0][j] = (quad < 2) ? (xx * cv[j] - pp * sv[j]) : (xx * cv[j] + pp * sv[j]); }
            }
#pragma unroll
            for (int ni = 0; ni < 4; ++ni)
#pragma unroll
                for (int j = 0; j < 4; ++j) v[ni][j] *= scale;
        }
        if (kind == 5) {
#pragma unroll
            for (int ni = 0; ni < 4; ++ni)
#pragma unroll
                for (int j = 0; j < 4; ++j) { const int d = ni * 16 + quad * 4 + j;
                    VT[((size_t)(vidx * 8 + bb) * 64 + d) * 4096 + pos] = f2bf(v[ni][j]); }
        } else {
#pragma unroll
            for (int ni = 0; ni < 4; ++ni) { uint2 o; o.x = pk2(v[ni][0], v[ni][1]); o.y = pk2(v[ni][2], v[ni][3]);
                *(uint2*)(proj + (size_t)token * PJ_LD + cc * 64 + ni * 16 + quad * 4) = o; }
        }
    }
}

template <int EPI>
__device__ void gemm_phase(const Params& p, int L, char* lds) {
    const bf16_t* A; const bf16_t* Bt; int K, nNt;
    if (EPI == EPI_PROJ) { A = (const bf16_t*)(p.ws + OFF_ACT); Bt = (const bf16_t*)(p.ws + OFF_WIN) + (size_t)L * NW_IN_PAD * 1024; K = 1024; nNt = 25; }
    else if (EPI == EPI_WO) { A = (const bf16_t*)(p.ws + OFF_ACT); Bt = (const bf16_t*)(p.ws + OFF_WO) + (size_t)L * 1024 * 1024; K = 1024; nNt = 8; }
    else if (EPI == EPI_UP) { A = (const bf16_t*)(p.ws + OFF_ACT); Bt = (const bf16_t*)(p.ws + OFF_WUP) + (size_t)L * 4096 * 1024; K = 1024; nNt = 32; }
    else { A = (const bf16_t*)(p.ws + OFF_BIG); Bt = (const bf16_t*)(p.ws + OFF_WDN) + (size_t)L * 1024 * 4096; K = 4096; nNt = 8; }
    const int tid = otid(), lane = tid & 63, w = tid >> 6, quad = lane >> 4, l15 = lane & 15, wm = w >> 1, wn = w & 1;
    const int xcd = blockIdx.x & 7, loc = blockIdx.x >> 3, nloc = gridDim.x >> 3;
    const int nk = K / 64;
    for (int it = loc; it < 32 * nNt; it += nloc) {
        const int m0 = (xcd + 8 * (it / nNt)) * 128, n0 = (it % nNt) * 128;
        f32x4 acc[4][4];
#pragma unroll
        for (int a = 0; a < 4; ++a)
#pragma unroll
            for (int b = 0; b < 4; ++b) acc[a][b] = (f32x4){0.f, 0.f, 0.f, 0.f};
        uint4 ra[4], rb[4];
        const int lrow = tid >> 3, lc = tid & 7;
        const bf16_t* Ap = A + (size_t)(m0 + lrow) * K + lc * 8;
        const bf16_t* Bp = Bt + (size_t)(n0 + lrow) * K + lc * 8;
#pragma unroll
        for (int i = 0; i < 4; ++i) { ra[i] = *(const uint4*)(Ap + (size_t)(32 * i) * K); rb[i] = *(const uint4*)(Bp + (size_t)(32 * i) * K); }
#pragma unroll
        for (int i = 0; i < 4; ++i) { const int row = lrow + 32 * i; const int off = row * 128 + ((lc ^ (row & 7)) << 4);
            *(uint4*)(lds + off) = ra[i]; *(uint4*)(lds + 16384 + off) = rb[i]; }
        __syncthreads();
        for (int kt = 0; kt < nk; ++kt) {
            char* sA = lds + (kt & 1) * 32768; char* sB = sA + 16384;
            if (kt + 1 < nk) {
#pragma unroll
                for (int i = 0; i < 4; ++i) { ra[i] = *(const uint4*)(Ap + (size_t)(32 * i) * K + (kt + 1) * 64); rb[i] = *(const uint4*)(Bp + (size_t)(32 * i) * K + (kt + 1) * 64); }
            }
#pragma unroll
            for (int ks = 0; ks < 2; ++ks) {
                bf16x8 af[4], bfr[4];
                const int ch = ks * 4 + quad;
#pragma unroll
                for (int mi = 0; mi < 4; ++mi) { const int row = wm * 64 + mi * 16 + l15; af[mi] = *(const bf16x8*)(sA + row * 128 + ((ch ^ (row & 7)) << 4)); }
#pragma unroll
                for (int ni = 0; ni < 4; ++ni) { const int row = wn * 64 + ni * 16 + l15; bfr[ni] = *(const bf16x8*)(sB + row * 128 + ((ch ^ (row & 7)) << 4)); }
#pragma unroll
                for (int mi = 0; mi < 4; ++mi)
#pragma unroll
                    for (int ni = 0; ni < 4; ++ni) acc[mi][ni] = mfma(bfr[ni], af[mi], acc[mi][ni]);
            }
            if (kt + 1 < nk) {
                char* dA = lds + ((kt + 1) & 1) * 32768;
#pragma unroll
                for (int i = 0; i < 4; ++i) { const int row = lrow + 32 * i; const int off = row * 128 + ((lc ^ (row & 7)) << 4);
                    *(uint4*)(dA + off) = ra[i]; *(uint4*)(dA + 16384 + off) = rb[i]; }
            }
            __syncthreads();
        }
        if (EPI == EPI_PROJ) {
            proj_epilogue(p, L, acc, m0 + wm * 64, (n0 + wn * 64) >> 6, lane);
        } else if (EPI == EPI_UP) {
            bf16_t* hid = (bf16_t*)(p.ws + OFF_BIG);
#pragma unroll
            for (int mi = 0; mi < 4; ++mi)
#pragma unroll
                for (int ni = 0; ni < 4; ++ni) { const int m = m0 + wm * 64 + mi * 16 + l15, n = n0 + wn * 64 + ni * 16 + quad * 4;
                    float a0 = fmaxf(acc[mi][ni][0], 0.f), a1 = fmaxf(acc[mi][ni][1], 0.f), a2 = fmaxf(acc[mi][ni][2], 0.f), a3 = fmaxf(acc[mi][ni][3], 0.f);
                    uint2 o; o.x = pk2(a0 * a0, a1 * a1); o.y = pk2(a2 * a2, a3 * a3);
                    *(uint2*)(hid + (size_t)m * DFF + n) = o; }
        } else {
            const float* xin = (EPI == EPI_WO && L == 0) ? p.x : p.out;
#pragma unroll
            for (int mi = 0; mi < 4; ++mi)
#pragma unroll
                for (int ni = 0; ni < 4; ++ni) { const int m = m0 + wm * 64 + mi * 16 + l15, n = n0 + wn * 64 + ni * 16 + quad * 4;
                    float4 xv = *(const float4*)(xin + (size_t)m * DM + n);
                    xv.x += acc[mi][ni][0]; xv.y += acc[mi][ni][1]; xv.z += acc[mi][ni][2]; xv.w += acc[mi][ni][3];
                    *(float4*)(p.out + (size_t)m * DM + n) = xv; }
        }
    }
}

DEVI float hgrn_lb(const Params& p, int L, int hk) {
    if (L == 0) return 0.f;
    const float l0 = p.lb_logits[hk], l1 = p.lb_logits[256 + hk];
    return 1.0f / (1.0f + __expf(l0 - l1));
}

__device__ void hgrn_a_unit(const Params& p, int L, int u, char* lds) {
    const int tid = otid(), lane = tid & 63, w = tid >> 6, quad = lane >> 4, l15 = lane & 15;
    const int c = u & 63, h = (u >> 6) & 3, b = u >> 8;
    const bf16_t* proj = (const bf16_t*)(p.ws + OFF_BIG); const bf16_t* VT = (const bf16_t*)(p.ws + OFF_BIG + OFF_VT_IN_BIG);
    float* segtot = (float*)lds;
    bf16_t* KDt = (bf16_t*)(lds + 1024);
    const int k = tid & 63, seg = tid >> 6;
    const float lb = hgrn_lb(p, L, h * 64 + k);
    float gl[16], kkv[16]; float run = 0.f;
    const bf16_t* zp = proj + (size_t)(b * 4096 + c * 64 + seg * 16) * PJ_LD + 256 + h * 64 + k;
#pragma unroll
    for (int i = 0; i < 16; ++i) {
        const float z = bf2f(zp[(size_t)i * PJ_LD]);
        const float sg = 1.0f / (1.0f + __expf(-z)), sn = 1.0f / (1.0f + __expf(z));
        const float f = lb + (1.0f - lb) * sg;
        run += __logf(fmaxf(f, 1e-30f)); gl[i] = run; kkv[i] = (1.0f - lb) * sn;
    }
    segtot[seg * 64 + k] = run;
    __syncthreads();
    float off = 0.f, tot = 0.f;
#pragma unroll
    for (int s = 0; s < 4; ++s) { const float t = segtot[s * 64 + k]; tot += t; if (s < seg) off += t; }
    unsigned pkd[8];
#pragma unroll
    for (int i = 0; i < 8; ++i) {
        const float a0 = kkv[2 * i] * __expf(tot - (off + gl[2 * i])), a1 = kkv[2 * i + 1] * __expf(tot - (off + gl[2 * i + 1]));
        pkd[i] = pk2(a0, a1);
    }
    *(uint4*)(KDt + k * 72 + seg * 16) = make_uint4(pkd[0], pkd[1], pkd[2], pkd[3]);
    *(uint4*)(KDt + k * 72 + seg * 16 + 8) = make_uint4(pkd[4], pkd[5], pkd[6], pkd[7]);
    if (seg == 0) ((float*)(p.ws + OFF_DECAY))[u * 64 + k] = __expf(tot);
    __syncthreads();
    const bf16_t* vt = VT + ((size_t)(h * 8 + b) * 64) * 4096 + c * 64;
    float* kvt = (float*)(p.ws + OFF_KVT) + (size_t)u * 4096;
    bf16x8 af[2];
#pragma unroll
    for (int ks = 0; ks < 2; ++ks) af[ks] = ld8(vt + (size_t)(w * 16 + l15) * 4096 + ks * 32 + quad * 8);
#pragma unroll
    for (int kt = 0; kt < 4; ++kt) {
        f32x4 acc = (f32x4){0.f, 0.f, 0.f, 0.f};
#pragma unroll
        for (int ks = 0; ks < 2; ++ks) { const bf16x8 bfr = *(const bf16x8*)(KDt + (kt * 16 + l15) * 72 + ks * 32 + quad * 8); acc = mfma(af[ks], bfr, acc); }
#pragma unroll
        for (int j = 0; j < 4; ++j) kvt[(w * 16 + quad * 4 + j) * 64 + kt * 16 + l15] = acc[j];
    }
    __syncthreads();
}

__device__ void hgrn_scan_phase(const Params& p) {
    const float* kvt = (const float*)(p.ws + OFF_KVT); const float* dec = (const float*)(p.ws + OFF_DECAY);
    bf16_t* st = (bf16_t*)(p.ws + OFF_ST);
    for (int e = blockIdx.x * 256 + otid(); e < 32 * 4096; e += gridDim.x * 256) {
        const int bh = e >> 12, vk = e & 4095, k = vk & 63;
        float S = 0.f;
#pragma unroll 8
        for (int c = 0; c < 64; ++c) {
            const int u = bh * 64 + c;
            st[(size_t)u * 4096 + vk] = f2bf(S);
            S = S * dec[u * 64 + k] + kvt[(size_t)u * 4096 + vk];
        }
    }
}

__device__ void hgrn_c_unit(const Params& p, int L, int u, char* lds) {
    const int tid = otid(), lane = tid & 63, w = tid >> 6, quad = lane >> 4, l15 = lane & 15;
    const int c = u & 63, h = (u >> 6) & 3, b = u >> 8;
    const bf16_t* proj = (const bf16_t*)(p.ws + OFF_BIG); const bf16_t* VT = (const bf16_t*)(p.ws + OFF_BIG + OFF_VT_IN_BIG);
    float* Gs = (float*)lds; float* KKs = Gs + 64 * 65; float* Qs = KKs + 64 * 65; float* segtot = Qs + 64 * 65;
    {
        const int k = tid & 63, seg = tid >> 6;
        const float lb = hgrn_lb(p, L, h * 64 + k);
        float gl[16], kkv[16]; float run = 0.f;
        const bf16_t* zp = proj + (size_t)(b * 4096 + c * 64 + seg * 16) * PJ_LD + 256 + h * 64 + k;
#pragma unroll
        for (int i = 0; i < 16; ++i) {
            const float z = bf2f(zp[(size_t)i * PJ_LD]);
            const float sg = 1.0f / (1.0f + __expf(-z)), sn = 1.0f / (1.0f + __expf(z));
            const float f = lb + (1.0f - lb) * sg;
            run += __logf(fmaxf(f, 1e-30f)); gl[i] = run; kkv[i] = (1.0f - lb) * sn;
            Qs[(seg * 16 + i) * 65 + k] = bf2f(zp[(size_t)i * PJ_LD - 256]) * 0.125f;
        }
        segtot[seg * 64 + k] = run;
        __syncthreads();
        float off = 0.f;
#pragma unroll
        for (int s = 0; s < 4; ++s) { const float t = segtot[s * 64 + k]; if (s < seg) off += t; }
#pragma unroll
        for (int i = 0; i < 16; ++i) { Gs[(seg * 16 + i) * 65 + k] = off + gl[i]; KKs[(seg * 16 + i) * 65 + k] = kkv[i]; }
        __syncthreads();
    }
    const int I = w;
    const int tq = 16 * I + l15;
    bf16x8 qt[2], qg[2];
#pragma unroll
    for (int ks = 0; ks < 2; ++ks) {
        float a[8], g8[8];
#pragma unroll
        for (int j = 0; j < 8; ++j) {
            const int k = ks * 32 + quad * 8 + j;
            const float G = Gs[tq * 65 + k], q = Qs[tq * 65 + k];
            const float gref = (I == 0) ? 0.f : Gs[(16 * I - 1) * 65 + k];
            a[j] = q * __expf(G - gref); g8[j] = q * __expf(G);
        }
        qt[ks] = mk8(pk2(a[0], a[1]), pk2(a[2], a[3]), pk2(a[4], a[5]), pk2(a[6], a[7]));
        qg[ks] = mk8(pk2(g8[0], g8[1]), pk2(g8[2], g8[3]), pk2(g8[4], g8[5]), pk2(g8[6], g8[7]));
    }
    f32x4 O[4];
#pragma unroll
    for (int vt = 0; vt < 4; ++vt) O[vt] = (f32x4){0.f, 0.f, 0.f, 0.f};
    const bf16_t* st = (const bf16_t*)(p.ws + OFF_ST) + (size_t)u * 4096;
#pragma unroll
    for (int vt = 0; vt < 4; ++vt)
#pragma unroll
        for (int ks = 0; ks < 2; ++ks) O[vt] = mfma(ld8(st + (vt * 16 + l15) * 64 + ks * 32 + quad * 8), qg[ks], O[vt]);
    const bf16_t* vtp = VT + ((size_t)(h * 8 + b) * 64) * 4096 + c * 64;
    for (int Jp = 0; Jp <= (I >> 1); ++Jp) {
        f32x4 sc[2];
#pragma unroll
        for (int jj = 0; jj < 2; ++jj) {
            const int J = 2 * Jp + jj;
            sc[jj] = (f32x4){0.f, 0.f, 0.f, 0.f};
            if (J <= I) {
                const int s = 16 * J + l15;
#pragma unroll
                for (int ks = 0; ks < 2; ++ks) {
                    float a[8];
#pragma unroll
                    for (int j = 0; j < 8; ++j) {
                        const int k = ks * 32 + quad * 8 + j;
                        const float gref = (I == 0) ? 0.f : Gs[(16 * I - 1) * 65 + k];
                        a[j] = KKs[s * 65 + k] * __expf(gref - Gs[s * 65 + k]);
                    }
                    sc[jj] = mfma(mk8(pk2(a[0], a[1]), pk2(a[2], a[3]), pk2(a[4], a[5]), pk2(a[6], a[7])), qt[ks], sc[jj]);
                }
#pragma unroll
                for (int j = 0; j < 4; ++j) { const int s2 = 16 * J + quad * 4 + j; if (s2 > tq) sc[jj][j] = 0.f; }
            }
        }
        const bf16x8 P = mk8(pk2(sc[0][0], sc[0][1]), pk2(sc[0][2], sc[0][3]), pk2(sc[1][0], sc[1][1]), pk2(sc[1][2], sc[1][3]));
#pragma unroll
        for (int vt = 0; vt < 4; ++vt) {
            const bf16_t* r = vtp + (size_t)(vt * 16 + l15) * 4096 + 32 * Jp + quad * 4;
            O[vt] = mfma(ld4x2(r, r + 16), P, O[vt]);
        }
    }
    float ss = 0.f;
#pragma unroll
    for (int vt = 0; vt < 4; ++vt)
#pragma unroll
        for (int j = 0; j < 4; ++j) ss += O[vt][j] * O[vt][j];
    ss += __shfl_xor(ss, 16); ss += __shfl_xor(ss, 32);
    const float r = rsqrtf(ss * (1.0f / 64.0f) + 1e-6f);
    const size_t token = (size_t)b * 4096 + c * 64 + tq;
    bf16_t* mix = (bf16_t*)(p.ws + OFF_ACT);
#pragma unroll
    for (int vt = 0; vt < 4; ++vt) {
        const int v0 = vt * 16 + quad * 4;
        const float4 og = *(const float4*)(p.onorm_g + L * 64 + v0);
        const uint2 gz = *(const uint2*)(proj + token * PJ_LD + 768 + h * 64 + v0);
        const float g0 = bflo(gz.x), g1 = bfhi(gz.x), g2 = bflo(gz.y), g3 = bfhi(gz.y);
        const float o0 = O[vt][0] * r * og.x * (g0 / (1.0f + __expf(-g0))), o1 = O[vt][1] * r * og.y * (g1 / (1.0f + __expf(-g1)));
        const float o2 = O[vt][2] * r * og.z * (g2 / (1.0f + __expf(-g2))), o3 = O[vt][3] * r * og.w * (g3 / (1.0f + __expf(-g3)));
        uint2 o; o.x = pk2(o0, o1); o.y = pk2(o2, o3);
        *(uint2*)(mix + token * DM + h * 64 + v0) = o;
    }
    __syncthreads();
}

__device__ void compress_unit(const Params& p, int L, int u, char* lds) {
    const int tid = otid(), lane = tid & 63, w = tid >> 6, quad = lane >> 4, l15 = lane & 15;
    const int which = u & 1, g = (u >> 1) & 1, b = (u >> 2) & 7, ntile = u >> 5;
    const bf16_t* proj = (const bf16_t*)(p.ws + OFF_BIG);
    const bf16_t* w1t = (const bf16_t*)(p.ws + OFF_W1T) + (size_t)(L * 2 + which) * 128 * 2048;
    const bf16_t* w2t = (const bf16_t*)(p.ws + OFF_W2T) + (size_t)(L * 2 + which) * 64 * 128;
    const float* cbias = (const float*)(p.ws + OFF_CBIAS) + (L * 2 + which) * 128;
    bf16_t* Hs = (bf16_t*)lds + w * 16 * 136;
    const int nrow = ntile * 64 + w * 16 + l15;
    int tokbase = 16 * nrow; if (tokbase > 4096 - 32) tokbase = 4096 - 32;
    const bf16_t* xa = proj + ((size_t)b * 4096 + tokbase) * PJ_LD + (which ? 1664 : 1536) + g * 64;
    f32x4 acc[8];
#pragma unroll
    for (int i = 0; i < 8; ++i) acc[i] = (f32x4){0.f, 0.f, 0.f, 0.f};
    for (int kk = 0; kk < 64; ++kk) {
        const int l = kk >> 1, d = (kk & 1) * 32 + quad * 8;
        const bf16x8 a = ld8(xa + (size_t)l * PJ_LD + d);
#pragma unroll
        for (int ni = 0; ni < 8; ++ni) acc[ni] = mfma(a, ld8(w1t + (size_t)(ni * 16 + l15) * 2048 + kk * 32 + quad * 8), acc[ni]);
    }
#pragma unroll
    for (int ni = 0; ni < 8; ++ni) { const float bsv = cbias[ni * 16 + l15];
#pragma unroll
        for (int j = 0; j < 4; ++j) { const float x = acc[ni][j] + bsv;
            const float uu = 0.7978845608028654f * (x + 0.044715f * x * x * x);
            const float th = 1.0f - 2.0f / (1.0f + __expf(2.0f * uu));
            Hs[(quad * 4 + j) * 136 + ni * 16 + l15] = f2bf(0.5f * x * (1.0f + th)); } }
    __syncthreads();
    f32x4 o[4];
#pragma unroll
    for (int i = 0; i < 4; ++i) o[i] = (f32x4){0.f, 0.f, 0.f, 0.f};
#pragma unroll
    for (int ks = 0; ks < 4; ++ks) { const bf16x8 a = *(const bf16x8*)(Hs + l15 * 136 + ks * 32 + quad * 8);
#pragma unroll
        for (int ni = 0; ni < 4; ++ni) o[ni] = mfma(a, ld8(w2t + (size_t)(ni * 16 + l15) * 128 + ks * 32 + quad * 8), o[ni]); }
    const int nb = ntile * 64 + w * 16 + quad * 4;
    if (which == 0) {
        bf16_t* kc = (bf16_t*)(p.ws + OFF_KC) + (size_t)(b * 2 + g) * 256 * 64;
        const float* rope = (const float*)(p.ws + OFF_ROPE);
#pragma unroll
        for (int j = 0; j < 4; ++j) {
            const int n = nb + j;
            float ss = o[0][j] * o[0][j] + o[1][j] * o[1][j] + o[2][j] * o[2][j] + o[3][j] * o[3][j];
            ss += __shfl_xor(ss, 1); ss += __shfl_xor(ss, 2); ss += __shfl_xor(ss, 4); ss += __shfl_xor(ss, 8);
            const float r = rsqrtf(ss * (1.0f / 64.0f) + 1e-6f);
            float v[4];
#pragma unroll
            for (int ni = 0; ni < 4; ++ni) v[ni] = o[ni][j] * r * p.nsa_kn_g[L * 64 + ni * 16 + l15];
            int pos = 16 * n + 31; if (pos > 4095) pos = 4095;
            const float cs = rope[pos * 16 + (l15 & 7)], sn = rope[pos * 16 + 8 + (l15 & 7)];
            const float pp = __shfl_xor(v[0], 8);
            v[0] = (l15 < 8) ? (v[0] * cs - pp * sn) : (v[0] * cs + pp * sn);
#pragma unroll
            for (int ni = 0; ni < 4; ++ni) kc[(size_t)n * 64 + ni * 16 + l15] = (n < 255) ? f2bf(v[ni]) : (bf16_t)0;
        }
    } else {
        bf16_t* vct = (bf16_t*)(p.ws + OFF_VCT) + (size_t)(b * 2 + g) * 64 * 256;
#pragma unroll
        for (int ni = 0; ni < 4; ++ni) {
            float v0 = o[ni][0], v1 = o[ni][1], v2 = o[ni][2], v3 = o[ni][3];
            if (nb + 3 >= 255) v3 = 0.f;
            uint2 ov; ov.x = pk2(v0, v1); ov.y = pk2(v2, v3);
            *(uint2*)(vct + (size_t)(ni * 16 + l15) * 256 + nb) = ov;
        }
    }
    __syncthreads();
}

__device__ void foxc_job(const Params& p, int L, int bh) {
    const int lane = otid() & 63, b = bh >> 2, h = bh & 3;
    const float* gates = (const float*)(p.ws + OFF_GATES);
    float* cc = (float*)(p.ws + OFF_FOXC) + (size_t)bh * 4096;
    const float fb = p.fox_fb[L * 4 + h];
    float run = 0.f;
    for (int i = 0; i < 64; ++i) {
        const float x = gates[((size_t)b * 4096 + lane * 64 + i) * 32 + 24 + h] + fb;
        run += (x >= 0.f) ? -log1pf(__expf(-x)) : (x - log1pf(__expf(x)));
    }
    float incl = run;
#pragma unroll
    for (int o = 1; o < 64; o <<= 1) { const float t = __shfl_up(incl, o); if (lane >= o) incl += t; }
    float acc = incl - run;
    for (int i = 0; i < 64; ++i) {
        const float x = gates[((size_t)b * 4096 + lane * 64 + i) * 32 + 24 + h] + fb;
        acc += (x >= 0.f) ? -log1pf(__expf(-x)) : (x - log1pf(__expf(x)));
        cc[lane * 64 + i] = acc;
    }
}

DEVI void load_kf(const bf16_t* Kp, int ldk, int kb, int lane, bf16x8 (&kf)[2][2]) {
    const int quad = lane >> 4, l15 = lane & 15;
#pragma unroll
    for (int t2 = 0; t2 < 2; ++t2)
#pragma unroll
        for (int ks = 0; ks < 2; ++ks) kf[t2][ks] = ld8(Kp + (size_t)(kb + t2 * 16 + l15) * ldk + ks * 32 + quad * 8);
}
DEVI void load_vf(const bf16_t* VTp, int ldv, int kb, int lane, bf16x8 (&vf)[4]) {
    const int quad = lane >> 4, l15 = lane & 15;
#pragma unroll
    for (int dt = 0; dt < 4; ++dt) { const bf16_t* r = VTp + (size_t)(dt * 16 + l15) * ldv + kb + quad * 4; vf[dt] = ld4x2(r, r + 16); }
}

template <int NT, class MaskF>
DEVI void attn_step32(const bf16_t* Kp, int ldk, const bf16_t* VTp, int ldv, int kb, const bf16x8 (&qf)[NT][2], f32x4 (&O)[4][NT], float (&m)[NT], float (&l)[NT],
                      int lane, MaskF maskf) {
    const int quad = lane >> 4;
    bf16x8 kf[2][2], vf[4];
    load_kf(Kp, ldk, kb, lane, kf);
    load_vf(VTp, ldv, kb, lane, vf);
#pragma unroll
    for (int nt = 0; nt < NT; ++nt) {
        f32x4 s0 = (f32x4){0.f, 0.f, 0.f, 0.f}, s1 = s0;
#pragma unroll
        for (int ks = 0; ks < 2; ++ks) { s0 = mfma(kf[0][ks], qf[nt][ks], s0); s1 = mfma(kf[1][ks], qf[nt][ks], s1); }
        float sv[8]; bool ok[8]; float mx = -1e30f;
#pragma unroll
        for (int e = 0; e < 8; ++e) { sv[e] = (e < 4) ? s0[e & 3] : s1[e & 3]; const int key = kb + (e >> 2) * 16 + quad * 4 + (e & 3);
            ok[e] = maskf(nt, e, key, sv[e]); if (ok[e]) mx = fmaxf(mx, sv[e]); }
        mx = fmaxf(mx, __shfl_xor(mx, 16)); mx = fmaxf(mx, __shfl_xor(mx, 32));
        const float mn = fmaxf(m[nt], mx), alpha = __expf(m[nt] - mn);
        float pv[8]; float rs = 0.f;
#pragma unroll
        for (int e = 0; e < 8; ++e) { pv[e] = ok[e] ? __expf(sv[e] - mn) : 0.f; rs += pv[e]; }
        rs += __shfl_xor(rs, 16); rs += __shfl_xor(rs, 32);
        l[nt] = l[nt] * alpha + rs; m[nt] = mn;
        const bf16x8 P = mk8(pk2(pv[0], pv[1]), pk2(pv[2], pv[3]), pk2(pv[4], pv[5]), pk2(pv[6], pv[7]));
#pragma unroll
        for (int dt = 0; dt < 4; ++dt) { O[dt][nt] = O[dt][nt] * alpha; O[dt][nt] = mfma(vf[dt], P, O[dt][nt]); }
    }
}

template <int NT>
DEVI void attn_store(bf16_t* mix, size_t token0, int col0, const f32x4 (&O)[4][NT], const float (&sc)[NT], int lane, bool accum) {
    const int quad = lane >> 4, l15 = lane & 15;
#pragma unroll
    for (int nt = 0; nt < NT; ++nt)
#pragma unroll
        for (int dt = 0; dt < 4; ++dt) {
            bf16_t* dst = mix + (token0 + nt * 16 + l15) * DM + col0 + dt * 16 + quad * 4;
            float a0 = O[dt][nt][0] * sc[nt], a1 = O[dt][nt][1] * sc[nt], a2 = O[dt][nt][2] * sc[nt], a3 = O[dt][nt][3] * sc[nt];
            if (accum) { const uint2 old = *(const uint2*)dst; a0 += bflo(old.x); a1 += bfhi(old.x); a2 += bflo(old.y); a3 += bfhi(old.y); }
            uint2 o; o.x = pk2(a0, a1); o.y = pk2(a2, a3);
            *(uint2*)dst = o;
        }
}

__device__ void nsa_unit(const Params& p, int L, int b, int g, int blk, char* lds) {
    const int tid = otid(), lane = tid & 63, w = tid >> 6, quad = lane >> 4, l15 = lane & 15;
    const bf16_t* proj = (const bf16_t*)(p.ws + OFF_BIG); const bf16_t* VT = (const bf16_t*)(p.ws + OFF_BIG + OFF_VT_IN_BIG);
    const float* gates = (const float*)(p.ws + OFF_GATES);
    bf16_t* mix = (bf16_t*)(p.ws + OFF_ACT);
    float* impL = (float*)lds; u64* selm = (u64*)(lds + 65536);
    const int q0 = blk * 64; const size_t token0 = (size_t)b * 4096 + q0;
    const int head = g * 4 + w, mixcol = 256 + head * 64;
    const bf16_t* Kc = (const bf16_t*)(p.ws + OFF_KC) + (size_t)(b * 2 + g) * 256 * 64;
    const bf16_t* VcT = (const bf16_t*)(p.ws + OFF_VCT) + (size_t)(b * 2 + g) * 64 * 256;
    const int nsteps = (4 * blk + 3 + 31) >> 5;
#pragma unroll 1
    for (int hq = 0; hq < 2; ++hq) {
        const int qoff = hq * 32;
        bf16x8 qf[2][2]; int tq[2]; f32x4 O[4][2]; float m[2], l[2];
#pragma unroll
        for (int nt = 0; nt < 2; ++nt) { tq[nt] = q0 + qoff + nt * 16 + l15;
#pragma unroll
            for (int ks = 0; ks < 2; ++ks) qf[nt][ks] = ld8(proj + (token0 + qoff + nt * 16 + l15) * PJ_LD + 1024 + head * 64 + ks * 32 + quad * 8); }
#pragma unroll
        for (int nt = 0; nt < 2; ++nt) { m[nt] = -1e30f; l[nt] = 0.f; }
#pragma unroll 1
        for (int st = 0; st < nsteps; ++st) {
            const int kb = st * 32; bf16x8 kf[2][2]; load_kf(Kc, 64, kb, lane, kf);
#pragma unroll
            for (int nt = 0; nt < 2; ++nt) {
                f32x4 s0 = (f32x4){0.f, 0.f, 0.f, 0.f}, s1 = s0;
#pragma unroll
                for (int ks = 0; ks < 2; ++ks) { s0 = mfma(kf[0][ks], qf[nt][ks], s0); s1 = mfma(kf[1][ks], qf[nt][ks], s1); }
                float sv[8]; bool ok[8]; float mx = -1e30f;
#pragma unroll
                for (int e = 0; e < 8; ++e) { sv[e] = (e < 4) ? s0[e & 3] : s1[e & 3]; const int n = kb + (e >> 2) * 16 + quad * 4 + (e & 3);
                    ok[e] = (16 * n + 31 <= tq[nt]); if (ok[e]) mx = fmaxf(mx, sv[e]); }
                mx = fmaxf(mx, __shfl_xor(mx, 16)); mx = fmaxf(mx, __shfl_xor(mx, 32));
                const float mn = fmaxf(m[nt], mx), alpha = __expf(m[nt] - mn);
                float rs = 0.f;
#pragma unroll
                for (int e = 0; e < 8; ++e) rs += ok[e] ? __expf(sv[e] - mn) : 0.f;
                rs += __shfl_xor(rs, 16); rs += __shfl_xor(rs, 32);
                l[nt] = l[nt] * alpha + rs; m[nt] = mn;
            }
        }
        float inv[2], prevr[2];
#pragma unroll
        for (int nt = 0; nt < 2; ++nt) { inv[nt] = 1.0f / fmaxf(l[nt], 1e-30f); prevr[nt] = 0.f; }
#pragma unroll
        for (int dt = 0; dt < 4; ++dt)
#pragma unroll
            for (int nt = 0; nt < 2; ++nt) O[dt][nt] = (f32x4){0.f, 0.f, 0.f, 0.f};
#pragma unroll 1
        for (int st = 0; st < nsteps; ++st) {
            const int kb = st * 32; bf16x8 kf[2][2], vf[4]; load_kf(Kc, 64, kb, lane, kf); load_vf(VcT, 256, kb, lane, vf);
#pragma unroll
            for (int nt = 0; nt < 2; ++nt) {
                f32x4 s0 = (f32x4){0.f, 0.f, 0.f, 0.f}, s1 = s0;
#pragma unroll
                for (int ks = 0; ks < 2; ++ks) { s0 = mfma(kf[0][ks], qf[nt][ks], s0); s1 = mfma(kf[1][ks], qf[nt][ks], s1); }
                float pv[8];
#pragma unroll
                for (int e = 0; e < 8; ++e) { const float s = (e < 4) ? s0[e & 3] : s1[e & 3]; const int n = kb + (e >> 2) * 16 + quad * 4 + (e & 3);
                    pv[e] = (16 * n + 31 <= tq[nt]) ? __expf(s - m[nt]) * inv[nt] : 0.f; }
                const int qq = qoff + nt * 16 + l15;
#pragma unroll
                for (int t2 = 0; t2 < 2; ++t2) {
                    const float A = (pv[t2 * 4] + pv[t2 * 4 + 1]) + (pv[t2 * 4 + 2] + pv[t2 * 4 + 3]);
                    const float r = __shfl(pv[t2 * 4 + 3], (lane + 48) & 63);
                    const float carry = (quad == 0) ? prevr[nt] : r; prevr[nt] = r;
                    const int jb = st * 8 + t2 * 4 + quad;
                    impL[(w * 64 + jb) * 64 + ((qq ^ jb) & 63)] = A + carry;
                }
                const bf16x8 P = mk8(pk2(pv[0], pv[1]), pk2(pv[2], pv[3]), pk2(pv[4], pv[5]), pk2(pv[6], pv[7]));
#pragma unroll
                for (int dt = 0; dt < 4; ++dt) O[dt][nt] = mfma(vf[dt], P, O[dt][nt]);
            }
        }
        float sc[2];
#pragma unroll
        for (int nt = 0; nt < 2; ++nt) sc[nt] = gates[(token0 + qoff + nt * 16 + l15) * 32 + 0 * 8 + head];
        attn_store<2>(mix, token0 + qoff, mixcol, O, sc, lane, false);
    }
    __syncthreads();
#pragma unroll 1
    for (int qi = 0; qi < 16; ++qi) {
        const int q = w * 16 + qi, jb = lane;
        const int col = (q ^ jb) & 63;
        float val = (impL[(0 * 64 + jb) * 64 + col] + impL[(1 * 64 + jb) * 64 + col]) + (impL[(2 * 64 + jb) * 64 + col] + impL[(3 * 64 + jb) * 64 + col]);
        if (jb > blk) val = -1e30f;
        else if (jb == 0 || jb == blk || jb == blk - 1) val = 1e30f;
        int rank = 0;
        for (int jp = 0; jp < 64; ++jp) { const float vj = __shfl(val, jp); rank += ((vj > val) || (vj == val && jp < jb)) ? 1 : 0; }
        const bool sel = (rank < 16) && (val > -5e29f);
        const u64 mask = __ballot(sel);
        if (lane == 0) selm[q] = mask;
    }
    __syncthreads();
    u64 uni = 0;
    for (int q = 0; q < 64; ++q) uni |= selm[q];
#pragma unroll 1
    for (int hq = 0; hq < 2; ++hq) {
        const int qoff = hq * 32;
        bf16x8 qf[2][2]; int tq[2]; f32x4 O[4][2]; float m[2], l[2]; u64 sm[2];
#pragma unroll
        for (int nt = 0; nt < 2; ++nt) { tq[nt] = q0 + qoff + nt * 16 + l15; sm[nt] = selm[qoff + nt * 16 + l15];
#pragma unroll
            for (int ks = 0; ks < 2; ++ks) qf[nt][ks] = ld8(proj + (token0 + qoff + nt * 16 + l15) * PJ_LD + 1024 + head * 64 + ks * 32 + quad * 8); }
        {
            const bf16_t* Ks = proj + (size_t)b * 4096 * PJ_LD + 1792 + g * 64;
            const bf16_t* VsT = VT + ((size_t)((4 + g) * 8 + b) * 64) * 4096;
#pragma unroll
            for (int nt = 0; nt < 2; ++nt) { m[nt] = -1e30f; l[nt] = 0.f; }
#pragma unroll
            for (int dt = 0; dt < 4; ++dt)
#pragma unroll
                for (int nt = 0; nt < 2; ++nt) O[dt][nt] = (f32x4){0.f, 0.f, 0.f, 0.f};
#pragma unroll 1
            for (int jb = 0; jb <= blk; ++jb) {
                if (!((uni >> jb) & 1ull)) continue;
#pragma unroll 1
                for (int hf = 0; hf < 2; ++hf)
                    attn_step32<2>(Ks, PJ_LD, VsT, 4096, jb * 64 + hf * 32, qf, O, m, l, lane,
                                   [&](int nt, int e, int key, float& s) { return (((sm[nt] >> jb) & 1ull) != 0) && (key <= tq[nt]); });
            }
            float sc[2];
#pragma unroll
            for (int nt = 0; nt < 2; ++nt) sc[nt] = gates[(token0 + qoff + nt * 16 + l15) * 32 + 1 * 8 + head] / fmaxf(l[nt], 1e-30f);
            attn_store<2>(mix, token0 + qoff, mixcol, O, sc, lane, true);
        }
        {
            const bf16_t* Kw = proj + (size_t)b * 4096 * PJ_LD + 2048 + g * 64;
            const bf16_t* VwT = VT + ((size_t)((6 + g) * 8 + b) * 64) * 4096;
#pragma unroll
            for (int nt = 0; nt < 2; ++nt) { m[nt] = -1e30f; l[nt] = 0.f; }
#pragma unroll
            for (int dt = 0; dt < 4; ++dt)
#pragma unroll
                for (int nt = 0; nt < 2; ++nt) O[dt][nt] = (f32x4){0.f, 0.f, 0.f, 0.f};
#pragma unroll 1
            for (int jb = (blk > 8 ? blk - 8 : 0); jb <= blk; ++jb)
#pragma unroll 1
                for (int hf = 0; hf < 2; ++hf)
                    attn_step32<2>(Kw, PJ_LD, VwT, 4096, jb * 64 + hf * 32, qf, O, m, l, lane,
                                   [&](int nt, int e, int key, float& s) { return (key <= tq[nt]) && (key + 512 > tq[nt]); });
            float sc[2];
#pragma unroll
            for (int nt = 0; nt < 2; ++nt) sc[nt] = gates[(token0 + qoff + nt * 16 + l15) * 32 + 2 * 8 + head] / fmaxf(l[nt], 1e-30f);
            attn_store<2>(mix, token0 + qoff, mixcol, O, sc, lane, true);
        }
    }
    __syncthreads();
}

__device__ void fox_unit(const Params& p, int L, int b, int h, int qb) {
    const int tid = otid(), lane = tid & 63, w = tid >> 6, quad = lane >> 4, l15 = lane & 15;
    const bf16_t* proj = (const bf16_t*)(p.ws + OFF_BIG); const bf16_t* VT = (const bf16_t*)(p.ws + OFF_BIG + OFF_VT_IN_BIG);
    bf16_t* mix = (bf16_t*)(p.ws + OFF_ACT);
    const float* cc = (const float*)(p.ws + OFF_FOXC) + (size_t)(b * 4 + h) * 4096;
    const int q0 = qb * 256 + w * 64; const size_t token0 = (size_t)b * 4096 + q0;
    bf16x8 qf[4][2]; int tq[4]; float cq[4];
#pragma unroll
    for (int nt = 0; nt < 4; ++nt) { tq[nt] = q0 + nt * 16 + l15; cq[nt] = cc[tq[nt]];
#pragma unroll
        for (int ks = 0; ks < 2; ++ks) qf[nt][ks] = ld8(proj + (token0 + nt * 16 + l15) * PJ_LD + 2304 + h * 64 + ks * 32 + quad * 8); }
    const bf16_t* Kp = proj + (size_t)b * 4096 * PJ_LD + 2560 + h * 64;
    const bf16_t* VTp = VT + ((size_t)((8 + h) * 8 + b) * 64) * 4096;
    f32x4 O[4][4]; float m[4], l[4];
#pragma unroll
    for (int nt = 0; nt < 4; ++nt) { m[nt] = -1e30f; l[nt] = 0.f; }
#pragma unroll
    for (int dt = 0; dt < 4; ++dt)
#pragma unroll
        for (int nt = 0; nt < 4; ++nt) O[dt][nt] = (f32x4){0.f, 0.f, 0.f, 0.f};
#pragma unroll 1
    for (int kb = 0; kb < q0 + 64; kb += 32) {
        const float4 c0 = *(const float4*)(cc + kb + quad * 4), c1 = *(const float4*)(cc + kb + 16 + quad * 4);
        const float ck[8] = {c0.x, c0.y, c0.z, c0.w, c1.x, c1.y, c1.z, c1.w};
        attn_step32<4>(Kp, PJ_LD, VTp, 4096, kb, qf, O, m, l, lane,
                       [&](int nt, int e, int key, float& s) { s += cq[nt] - ck[e]; return key <= tq[nt]; });
    }
    float sc[4];
#pragma unroll
    for (int nt = 0; nt < 4; ++nt) sc[nt] = 1.0f / fmaxf(l[nt], 1e-30f);
    attn_store<4>(mix, token0, 768 + h * 64, O, sc, lane, false);
}

__device__ void mixA_phase(const Params& p, int L, char* lds) {
    for (int job = blockIdx.x; job < 136 + 2048; job += gridDim.x) {
        if (job < 128) compress_unit(p, L, job, lds);
        else if (job < 136) foxc_job(p, L, (job - 128) * 4 + (threadIdx.x >> 6));
        else hgrn_a_unit(p, L, job - 136, lds);
    }
}
__device__ void mixB_phase(const Params& p, int L, char* lds) {
    for (int idx = blockIdx.x; idx < 1536 + 2048; idx += gridDim.x) {
        if (idx < 1536) {
            const int r = idx % 3, qd = idx / 3;
            if (r < 2) { const int n = qd * 2 + r, blk = 63 - (n >> 4), bg = n & 15; nsa_unit(p, L, bg >> 1, bg & 1, blk, lds); }
            else { const int f = qd, qb = 15 - (f >> 5), bh = f & 31; fox_unit(p, L, bh >> 2, bh & 3, qb); }
        } else hgrn_c_unit(p, L, idx - 1536, lds);
    }
}

__device__ void run_phase(const Params& p, int ph, char* lds) {
    if (ph == 0) { prep_phase(p, lds); return; }
    const int L = (ph - 1) / 9, s = (ph - 1) % 9;
    switch (s) {
        case 0: gemm_phase<EPI_PROJ>(p, L, lds); break;
        case 1: mixA_phase(p, L, lds); break;
        case 2: hgrn_scan_phase(p); break;
        case 3: mixB_phase(p, L, lds); break;
        case 4: gemm_phase<EPI_WO>(p, L, lds); break;
        case 5: norm_phase(p.out, p.norm2_g + L * 1024, (bf16_t*)(p.ws + OFF_ACT)); break;
        case 6: gemm_phase<EPI_UP>(p, L, lds); break;
        case 7: gemm_phase<EPI_DOWN>(p, L, lds); break;
        default: norm_phase(p.out, p.norm1_g + (L + 1) * 1024, (bf16_t*)(p.ws + OFF_ACT)); break;
    }
}

__global__ void __launch_bounds__(256, 2) fwd_kernel(Params p, int ph_lo, int ph_hi) {
    __shared__ __attribute__((aligned(16))) char lds[LDS_BYTES];
    for (int ph = ph_lo; ph < ph_hi; ++ph) {
        run_phase(p, ph, lds);
        if (ph + 1 < ph_hi) { cg::this_grid().sync(); }
    }
}

extern "C" void kernel_launch(void* const* d_in, const int* in_sizes, int n_in, void* d_out, int out_size, void* d_ws, size_t ws_size,
                              hipStream_t stream) {
    if (ws_size < WS_NEED) { fprintf(stderr, "workspace too small: %zu < %zu\n", ws_size, (size_t)WS_NEED); return; }
    Params p{};
    p.x = (const float*)d_in[0]; p.norm1_g = (const float*)d_in[1]; p.w_in = (const float*)d_in[2]; p.lb_logits = (const float*)d_in[3];
    p.onorm_g = (const float*)d_in[4]; p.nsa_qn_g = (const float*)d_in[5]; p.nsa_kn_g = (const float*)d_in[6]; p.cmp_pos = (const float*)d_in[7];
    p.cmp_w1 = (const float*)d_in[8]; p.cmp_w2 = (const float*)d_in[9]; p.fox_qn_g = (const float*)d_in[10]; p.fox_kn_g = (const float*)d_in[11];
    p.fox_fb = (const float*)d_in[12]; p.w_o = (const float*)d_in[13]; p.norm2_g = (const float*)d_in[14]; p.w_up = (const float*)d_in[15];
    p.w_down = (const float*)d_in[16];
    p.out = (float*)d_out; p.ws = (char*)d_ws;
#if MULTI_LAUNCH
    for (int ph = 0; ph < NPHASE; ++ph) hipLaunchKernelGGL(fwd_kernel, dim3(512), dim3(256), 0, stream, p, ph, ph + 1);
#else
    static int grid_blocks = 0;
    if (!grid_blocks) {
        int dev = 0, cus = 0, per_cu = 0;
        hipGetDevice(&dev);
        hipDeviceGetAttribute(&cus, hipDeviceAttributeMultiprocessorCount, dev);
        hipOccupancyMaxActiveBlocksPerMultiprocessor(&per_cu, fwd_kernel, 256, 0);
        if (per_cu > 2) per_cu = 2;
        grid_blocks = cus * per_cu;
        grid_blocks &= ~7;
    }
    int lo = 0, hi = NPHASE;
    void* args[] = {&p, &lo, &hi};
    hipError_t e = hipLaunchCooperativeKernel((void*)fwd_kernel, dim3(grid_blocks), dim3(256), args, 0, stream);
    if (e != hipSuccess) fprintf(stderr, "cooperative launch failed: %s (grid %d)\n", hipGetErrorString(e), grid_blocks);
#endif
}
```

```cpp
#include <hip/hip_runtime.h>
#include <hip/hip_cooperative_groups.h>
#include <stdint.h>
#include <cstdio>
namespace cg = cooperative_groups;

#ifndef MULTI_LAUNCH
#define MULTI_LAUNCH 0
#endif

typedef unsigned short bf16_t;
typedef short bf16x8 __attribute__((ext_vector_type(8)));
typedef float f32x4 __attribute__((ext_vector_type(4)));
typedef unsigned long long u64;
typedef unsigned u32x16 __attribute__((ext_vector_type(16)));
#define DEVI __device__ __forceinline__

constexpr int T_TOK = 32768, SEQ = 4096, DM = 1024, DFF = 4096;
constexpr int PJ_LD = 3072;
constexpr int NW_IN = 3100, NW_IN_PAD = 3200;
constexpr int NPHASE = 18;

constexpr size_t OFF_WIN = 0;
constexpr size_t OFF_WO = OFF_WIN + (size_t)2 * NW_IN_PAD * 1024 * 2;
constexpr size_t OFF_WUP = OFF_WO + (size_t)2 * 1024 * 1024 * 2;
constexpr size_t OFF_WDN = OFF_WUP + (size_t)2 * 4096 * 1024 * 2;
constexpr size_t OFF_W1T = OFF_WDN + (size_t)2 * 4096 * 1024 * 2;
constexpr size_t OFF_W2T = OFF_W1T + (size_t)2 * 2 * 128 * 2048 * 2;
constexpr size_t OFF_CBIAS = OFF_W2T + (size_t)2 * 2 * 64 * 128 * 2;
constexpr size_t OFF_ROPE = OFF_CBIAS + 2048;
constexpr size_t OFF_GATES = OFF_ROPE + (size_t)4096 * 16 * 4;
constexpr size_t OFF_FOXC = OFF_GATES + (size_t)T_TOK * 32 * 4;
constexpr size_t OFF_KC = OFF_FOXC + (size_t)8 * 4 * 4096 * 4;
constexpr size_t OFF_VCT = OFF_KC + (size_t)8 * 2 * 256 * 64 * 2;
constexpr size_t OFF_DECAY = OFF_VCT + (size_t)8 * 2 * 256 * 64 * 2;
constexpr size_t OFF_KVT = OFF_DECAY + (size_t)2048 * 64 * 4;
constexpr size_t OFF_ST = OFF_KVT + (size_t)2048 * 4096 * 4;
constexpr size_t OFF_ACT = OFF_ST + (size_t)2048 * 4096 * 2;
constexpr size_t OFF_BIG = OFF_ACT + (size_t)T_TOK * 1024 * 2;
constexpr size_t OFF_VT_IN_BIG = (size_t)T_TOK * PJ_LD * 2;
constexpr size_t WS_NEED = OFF_BIG + (size_t)T_TOK * 4096 * 2;

constexpr int LDS_BYTES = 67584;

struct Params {
    const float *x, *norm1_g, *w_in, *lb_logits, *onorm_g, *nsa_qn_g, *nsa_kn_g, *cmp_pos, *cmp_w1, *cmp_w2,
        *fox_qn_g, *fox_kn_g, *fox_fb, *w_o, *norm2_g, *w_up, *w_down;
    float* out;
    char* ws;
};

DEVI unsigned pk2(float lo, float hi) { unsigned r; asm("v_cvt_pk_bf16_f32 %0, %1, %2" : "=v"(r) : "v"(lo), "v"(hi)); return r; }
DEVI bf16_t f2bf(float f) { return (bf16_t)(pk2(f, 0.f) & 0xffffu); }
DEVI float bf2f(bf16_t h) { return __uint_as_float(((unsigned)h) << 16); }
DEVI float bflo(unsigned u) { return __uint_as_float(u << 16); }
DEVI float bfhi(unsigned u) { return __uint_as_float(u & 0xffff0000u); }
DEVI f32x4 mfma(bf16x8 a, bf16x8 b, f32x4 c) { return __builtin_amdgcn_mfma_f32_16x16x32_bf16(a, b, c, 0, 0, 0); }
DEVI int otid() { int t; asm volatile("v_mov_b32 %0, %1" : "=v"(t) : "v"(threadIdx.x)); return t; }
DEVI float wave_sum(float v) {
#pragma unroll
    for (int o = 32; o >= 1; o >>= 1) v += __shfl_xor(v, o);
    return v;
}
DEVI bf16x8 mk8(unsigned a, unsigned b, unsigned c, unsigned d) {
    uint4 u = make_uint4(a, b, c, d);
    return *(bf16x8*)&u;
}
DEVI bf16x8 ld8(const bf16_t* p) { uint4 u = *(const uint4*)p; return *(bf16x8*)&u; }
DEVI bf16x8 ld4x2(const bf16_t* p0, const bf16_t* p1) {
    uint2 a = *(const uint2*)p0, b = *(const uint2*)p1;
    return mk8(a.x, a.y, b.x, b.y);
}

DEVI int win_colmap(int n) {
    if (n < 2304) return n;
    if (n < 3072) return n + 24;
    if (n < 3096) return n - 768;
    return n;
}
__device__ void transpose_tile(const float* __restrict__ src, int ld_src, bf16_t* __restrict__ dst, int ld_dst, int k0, int n0, int nvalid,
                               int colmode, float* tile) {
    const int tid = otid();
    for (int idx = tid; idx < 4096; idx += 256) {
        const int i = idx >> 6, j = idx & 63, n = n0 + j;
        float v = 0.f;
        if (n < nvalid) v = src[(size_t)(k0 + i) * ld_src + (colmode ? win_colmap(n) : n)];
        tile[i * 65 + j] = v;
    }
    __syncthreads();
    for (int idx = tid; idx < 4096; idx += 256) {
        const int j = idx >> 6, i = idx & 63;
        dst[(size_t)(n0 + j) * ld_dst + k0 + i] = f2bf(tile[i * 65 + j]);
    }
    __syncthreads();
}

__device__ void norm_phase(const float* __restrict__ xin, const float* __restrict__ g, bf16_t* __restrict__ hout) {
    const int tid = otid(); const int lane = tid & 63, w = tid >> 6;
    for (int row = blockIdx.x * 4 + w; row < T_TOK; row += gridDim.x * 4) {
        const float4* xr = (const float4*)(xin + (size_t)row * DM);
        float4 v[4]; float ss = 0.f;
#pragma unroll
        for (int i = 0; i < 4; ++i) { v[i] = xr[lane + 64 * i]; ss += v[i].x * v[i].x + v[i].y * v[i].y + v[i].z * v[i].z + v[i].w * v[i].w; }
        ss = wave_sum(ss);
        const float r = rsqrtf(ss * (1.0f / 1024.0f) + 1e-6f);
#pragma unroll
        for (int i = 0; i < 4; ++i) {
            const float4 gg = ((const float4*)g)[lane + 64 * i];
            uint2 o; o.x = pk2(v[i].x * r * gg.x, v[i].y * r * gg.y); o.y = pk2(v[i].z * r * gg.z, v[i].w * r * gg.w);
            *(uint2*)(hout + (size_t)row * DM + (lane + 64 * i) * 4) = o;
        }
    }
}

__device__ void prep_phase(const Params& p, char* lds) {
    float* tile = (float*)lds;
    bf16_t* win_t = (bf16_t*)(p.ws + OFF_WIN); bf16_t* wo_t = (bf16_t*)(p.ws + OFF_WO);
    bf16_t* wup_t = (bf16_t*)(p.ws + OFF_WUP); bf16_t* wdn_t = (bf16_t*)(p.ws + OFF_WDN);
    bf16_t* w1t = (bf16_t*)(p.ws + OFF_W1T); bf16_t* w2t = (bf16_t*)(p.ws + OFF_W2T);
    const int J0 = 1600, J1 = J0 + 512, J2 = J1 + 2048, J3 = J2 + 2048, J4 = J3 + 256, J5 = J4 + 8, J6 = J5 + 128, J7 = J6 + 128;
    for (int job = blockIdx.x; job < J7; job += gridDim.x) {
        if (job < J0) { const int L = job / 800, r = job % 800, kt = r / 50, nt = r % 50;
            transpose_tile(p.w_in + (size_t)L * 1024 * NW_IN, NW_IN, win_t + (size_t)L * NW_IN_PAD * 1024, 1024, kt * 64, nt * 64, NW_IN, 1, tile);
        } else if (job < J1) { const int j = job - J0, L = j / 256, r = j % 256, kt = r / 16, nt = r % 16;
            transpose_tile(p.w_o + (size_t)L * 1024 * 1024, 1024, wo_t + (size_t)L * 1024 * 1024, 1024, kt * 64, nt * 64, 1024, 0, tile);
        } else if (job < J2) { const int j = job - J1, L = j / 1024, r = j % 1024, kt = r / 64, nt = r % 64;
            transpose_tile(p.w_up + (size_t)L * 1024 * 4096, 4096, wup_t + (size_t)L * 4096 * 1024, 1024, kt * 64, nt * 64, 4096, 0, tile);
        } else if (job < J3) { const int j = job - J2, L = j / 1024, r = j % 1024, kt = r / 16, nt = r % 16;
            transpose_tile(p.w_down + (size_t)L * 4096 * 1024, 1024, wdn_t + (size_t)L * 1024 * 4096, 4096, kt * 64, nt * 64, 1024, 0, tile);
        } else if (job < J4) { const int j = job - J3, lw = j / 64, r = j % 64, kt = r / 2, nt = r % 2;
            transpose_tile(p.cmp_w1 + (size_t)lw * 2048 * 128, 128, w1t + (size_t)lw * 128 * 2048, 2048, kt * 64, nt * 64, 128, 0, tile);
        } else if (job < J5) { const int j = job - J4, lw = j / 2, kt = j % 2;
            transpose_tile(p.cmp_w2 + (size_t)lw * 128 * 64, 64, w2t + (size_t)lw * 64 * 128, 128, kt * 64, 0, 64, 0, tile);
        } else if (job < J6) {
            const int t_ = otid(); const int o = (job - J5) * 4 + (t_ >> 6), lane = t_ & 63, lw = o >> 7, hid = o & 127;
            const float* pos = p.cmp_pos + (size_t)lw * 2048; const float* w1 = p.cmp_w1 + (size_t)lw * 2048 * 128 + hid;
            float s = 0.f;
            for (int k = lane; k < 2048; k += 64) s += pos[k] * w1[(size_t)k * 128];
            s = wave_sum(s);
            if (lane == 0) ((float*)(p.ws + OFF_CBIAS))[o] = s;
        } else {
            const int e = (job - J6) * 256 + otid(), pos = e >> 3, i = e & 7;
            const float invf[8] = {1.0f, 0.1939227432012558f, 0.03760603070259094f, 0.007292664609849453f, 0.0014142135623842478f,
                                   0.00027424818836152554f, 5.318296098266728e-05f, 1.0313386155758053e-05f};
            float fr = 1.0f;
#pragma unroll
            for (int q = 0; q < 8; ++q) if (i == q) fr = invf[q];
            const float ang = (float)pos * fr;
            const double a = (double)ang; const double n = rint(a * 0.15915494309189535); const float rr = (float)(a - n * 6.283185307179586);
            float* rt = (float*)(p.ws + OFF_ROPE);
            rt[pos * 16 + i] = __cosf(rr); rt[pos * 16 + 8 + i] = __sinf(rr);
        }
    }
    norm_phase(p.x, p.norm1_g, (bf16_t*)(p.ws + OFF_ACT));
}

enum { EPI_PROJ = 0, EPI_WO = 1, EPI_UP = 2, EPI_DOWN = 3 };

DEVI void proj_epilogue(const Params& p, int L, const f32x4 (&acc)[4][4], int m0w, int cc, int lane) {
    const int quad = lane >> 4, l15 = lane & 15;
    bf16_t* proj = (bf16_t*)(p.ws + OFF_BIG); bf16_t* VT = (bf16_t*)(p.ws + OFF_BIG + OFF_VT_IN_BIG);
    float* gates = (float*)(p.ws + OFF_GATES); const float* rope = (const float*)(p.ws + OFF_ROPE);
    if (cc > 48) return;
    int kind = 0, vidx = 0; const float* gain = nullptr; float scale = 1.f; bool dorope = false;
    if (cc >= 8 && cc < 12) { kind = 5; vidx = cc - 8; }
    else if (cc >= 16 && cc < 24) { kind = 1; gain = p.nsa_qn_g + L * 64; scale = 0.125f; dorope = true; }
    else if (cc == 28 || cc == 29 || cc == 32 || cc == 33) { kind = 1; gain = p.nsa_kn_g + L * 64; dorope = true; }
    else if (cc == 30 || cc == 31) { kind = 5; vidx = 4 + (cc - 30); }
    else if (cc == 34 || cc == 35) { kind = 5; vidx = 6 + (cc - 34); }
    else if (cc >= 36 && cc < 40) { kind = 1; gain = p.fox_qn_g + L * 64; scale = 0.125f; }
    else if (cc >= 40 && cc < 44) { kind = 1; gain = p.fox_kn_g + L * 64; }
    else if (cc >= 44 && cc < 48) { kind = 5; vidx = 8 + (cc - 44); }
    else if (cc == 48) kind = 6;
#pragma unroll
    for (int mi = 0; mi < 4; ++mi) {
        const int token = m0w + mi * 16 + l15, pos = token & 4095, bb = token >> 12;
        float v[4][4];
#pragma unroll
        for (int ni = 0; ni < 4; ++ni)
#pragma unroll
            for (int j = 0; j < 4; ++j) v[ni][j] = acc[mi][ni][j];
        if (kind == 6) {
#pragma unroll
            for (int ni = 0; ni < 2; ++ni)
#pragma unroll
                for (int j = 0; j < 4; ++j) { const int d = ni * 16 + quad * 4 + j;
                    if (d < 24) gates[(size_t)token * 32 + d] = 1.0f / (1.0f + __expf(-v[ni][j]));
                    else if (d < 28) gates[(size_t)token * 32 + d] = v[ni][j]; }
            continue;
        }
        if (kind == 1) {
            float ss = 0.f;
#pragma unroll
            for (int ni = 0; ni < 4; ++ni)
#pragma unroll
                for (int j = 0; j < 4; ++j) ss += v[ni][j] * v[ni][j];
            ss += __shfl_xor(ss, 16); ss += __shfl_xor(ss, 32);
            const float r = rsqrtf(ss * (1.0f / 64.0f) + 1e-6f);
#pragma unroll
            for (int ni = 0; ni < 4; ++ni) { const float4 gg = *(const float4*)(gain + ni * 16 + quad * 4);
                v[ni][0] *= r * gg.x; v[ni][1] *= r * gg.y; v[ni][2] *= r * gg.z; v[ni][3] *= r * gg.w; }
            if (dorope) {
                const float4 cs = *(const float4*)(rope + pos * 16 + (quad & 1) * 4), sn = *(const float4*)(rope + pos * 16 + 8 + (quad & 1) * 4);
                const float cv[4] = {cs.x, cs.y, cs.z, cs.w}, sv[4] = {sn.x, sn.y, sn.z, sn.w};
#pragma unroll
                for (int j = 0; j < 4; ++j) { const float xx = v[0][j], pp = __shfl_xor(xx, 32);
                    v[0][j] = (quad < 2) ? (xx * cv[j] - pp * sv[j]) : (xx * cv[j] + pp * sv[j]); }
            }
#pragma unroll
            for (int ni = 0; ni < 4; ++ni)
#pragma unroll
                for (int j = 0; j < 4; ++j) v[ni][j] *= scale;
        }
        if (kind == 5) {
#pragma unroll
            for (int ni = 0; ni < 4; ++ni)
#pragma unroll
                for (int j = 0; j < 4; ++j) { const int d = ni * 16 + quad * 4 + j;
                    VT[((size_t)(vidx * 8 + bb) * 64 + d) * 4096 + pos] = f2bf(v[ni][j]); }
        } else {
#pragma unroll
            for (int ni = 0; ni < 4; ++ni) { uint2 o; o.x = pk2(v[ni][0], v[ni][1]); o.y = pk2(v[ni][2], v[ni][3]);
                *(uint2*)(proj + (size_t)token * PJ_LD + cc * 64 + ni * 16 + quad * 4) = o; }
        }
    }
}

DEVI void g_load(uint4 (&RA)[4], uint4 (&RB)[4], const bf16_t* Ap, const bf16_t* Bp, int K, int KT) {
#pragma unroll
    for (int i = 0; i < 4; ++i) { RA[i] = *(const uint4*)(Ap + (size_t)(32 * i) * K + KT * 64); RB[i] = *(const uint4*)(Bp + (size_t)(32 * i) * K + KT * 64); }
}
DEVI void g_swrite(const uint4 (&RA)[4], const uint4 (&RB)[4], char* d_) {
#pragma unroll
    for (int i = 0; i < 4; ++i) { *(uint4*)(d_ + i * 4096) = RA[i]; *(uint4*)(d_ + 16384 + i * 4096) = RB[i]; }
}
DEVI void g_compute(const char* sA, f32x4 (&acc)[4][4], int wm, int wn, int quad, int l15) {
    const char* sB = sA + 16384;
#pragma unroll
    for (int ks = 0; ks < 2; ++ks) {
        bf16x8 af[4], bfr[4]; const int ch = ks * 4 + quad;
#pragma unroll
        for (int mi = 0; mi < 4; ++mi) { const int row = wm * 64 + mi * 16 + l15; af[mi] = *(const bf16x8*)(sA + row * 128 + ((ch ^ (row & 7)) << 4)); }
#pragma unroll
        for (int ni = 0; ni < 4; ++ni) { const int row = wn * 64 + ni * 16 + l15; bfr[ni] = *(const bf16x8*)(sB + row * 128 + ((ch ^ (row & 7)) << 4)); }
#pragma unroll
        for (int mi = 0; mi < 4; ++mi)
#pragma unroll
            for (int ni = 0; ni < 4; ++ni) acc[mi][ni] = mfma(bfr[ni], af[mi], acc[mi][ni]);
    }
}

template <int EPI>
__device__ void gemm_phase(const Params& p, int L, char* lds) {
    const bf16_t* A; const bf16_t* Bt; int K, nNt;
    if (EPI == EPI_PROJ) { A = (const bf16_t*)(p.ws + OFF_ACT); Bt = (const bf16_t*)(p.ws + OFF_WIN) + (size_t)L * NW_IN_PAD * 1024; K = 1024; nNt = 25; }
    else if (EPI == EPI_WO) { A = (const bf16_t*)(p.ws + OFF_ACT); Bt = (const bf16_t*)(p.ws + OFF_WO) + (size_t)L * 1024 * 1024; K = 1024; nNt = 8; }
    else if (EPI == EPI_UP) { A = (const bf16_t*)(p.ws + OFF_ACT); Bt = (const bf16_t*)(p.ws + OFF_WUP) + (size_t)L * 4096 * 1024; K = 1024; nNt = 32; }
    else { A = (const bf16_t*)(p.ws + OFF_BIG); Bt = (const bf16_t*)(p.ws + OFF_WDN) + (size_t)L * 1024 * 4096; K = 4096; nNt = 8; }
    const int tid = otid(), lane = tid & 63, w = tid >> 6, quad = lane >> 4, l15 = lane & 15, wm = w >> 1, wn = w & 1;
    const int xcd = blockIdx.x & 7, loc = blockIdx.x >> 3, nloc = gridDim.x >> 3;
    const int nk = K / 64;
    for (int it = loc; it < 32 * nNt; it += nloc) {
        const int m0 = (xcd + 8 * (it / nNt)) * 128, n0 = (it % nNt) * 128;
        f32x4 acc[4][4];
#pragma unroll
        for (int a = 0; a < 4; ++a)
#pragma unroll
            for (int b = 0; b < 4; ++b) acc[a][b] = (f32x4){0.f, 0.f, 0.f, 0.f};
        u32x16 ra0, rb0, ra1, rb1;
        const int lrow = tid >> 3, lc = tid & 7;
        const bf16_t* Ap = A + (size_t)(m0 + lrow) * K + lc * 8;
        const bf16_t* Bp = Bt + (size_t)(n0 + lrow) * K + lc * 8;
        const int woff = lrow * 128 + ((lc ^ (lrow & 7)) << 4);
#define G_LD1(R, P, I, KT) { const uint4 t_ = *(const uint4*)((P) + (size_t)(32 * I) * K + (KT) * 64); R[4 * I] = t_.x; R[4 * I + 1] = t_.y; R[4 * I + 2] = t_.z; R[4 * I + 3] = t_.w; }
#define G_LOAD(RA, RB, KT) { G_LD1(RA, Ap, 0, KT) G_LD1(RB, Bp, 0, KT) G_LD1(RA, Ap, 1, KT) G_LD1(RB, Bp, 1, KT) G_LD1(RA, Ap, 2, KT) G_LD1(RB, Bp, 2, KT) G_LD1(RA, Ap, 3, KT) G_LD1(RB, Bp, 3, KT) }
#define G_SW1(R, D, I) *(uint4*)((D) + I * 4096) = make_uint4(R[4 * I], R[4 * I + 1], R[4 * I + 2], R[4 * I + 3]);
#define G_SWRITE(RA, RB, DST) { G_SW1(RA, DST, 0) G_SW1(RB, (DST) + 16384, 0) G_SW1(RA, DST, 1) G_SW1(RB, (DST) + 16384, 1) G_SW1(RA, DST, 2) G_SW1(RB, (DST) + 16384, 2) G_SW1(RA, DST, 3) G_SW1(RB, (DST) + 16384, 3) }
        G_LOAD(ra0, rb0, 0)
        G_LOAD(ra1, rb1, 1)
        G_SWRITE(ra0, rb0, lds + woff)
        __syncthreads();
#pragma unroll 1
        for (int kt = 0; kt < nk; kt += 2) {
            if (kt + 2 < nk) { G_LOAD(ra0, rb0, kt + 2) }
            g_compute(lds, acc, wm, wn, quad, l15);
            G_SWRITE(ra1, rb1, lds + 32768 + woff)
            __syncthreads();
            if (kt + 3 < nk) { G_LOAD(ra1, rb1, kt + 3) }
            g_compute(lds + 32768, acc, wm, wn, quad, l15);
            if (kt + 2 < nk) { G_SWRITE(ra0, rb0, lds + woff) }
            __syncthreads();
        }
#undef G_LOAD
#undef G_SWRITE
#undef G_LD1
#undef G_SW1
        if (EPI == EPI_PROJ) {
            proj_epilogue(p, L, acc, m0 + wm * 64, (n0 + wn * 64) >> 6, lane);
        } else if (EPI == EPI_UP) {
            bf16_t* hid = (bf16_t*)(p.ws + OFF_BIG);
#pragma unroll
            for (int mi = 0; mi < 4; ++mi)
#pragma unroll
                for (int ni = 0; ni < 4; ++ni) { const int m = m0 + wm * 64 + mi * 16 + l15, n = n0 + wn * 64 + ni * 16 + quad * 4;
                    float a0 = fmaxf(acc[mi][ni][0], 0.f), a1 = fmaxf(acc[mi][ni][1], 0.f), a2 = fmaxf(acc[mi][ni][2], 0.f), a3 = fmaxf(acc[mi][ni][3], 0.f);
                    uint2 o; o.x = pk2(a0 * a0, a1 * a1); o.y = pk2(a2 * a2, a3 * a3);
                    *(uint2*)(hid + (size_t)m * DFF + n) = o; }
        } else {
            const float* xin = (EPI == EPI_WO && L == 0) ? p.x : p.out;
#pragma unroll
            for (int mi = 0; mi < 4; ++mi)
#pragma unroll
                for (int ni = 0; ni < 4; ++ni) { const int m = m0 + wm * 64 + mi * 16 + l15, n = n0 + wn * 64 + ni * 16 + quad * 4;
                    float4 xv = *(const float4*)(xin + (size_t)m * DM + n);
                    xv.x += acc[mi][ni][0]; xv.y += acc[mi][ni][1]; xv.z += acc[mi][ni][2]; xv.w += acc[mi][ni][3];
                    *(float4*)(p.out + (size_t)m * DM + n) = xv; }
        }
    }
}

DEVI float hgrn_lb(const Params& p, int L, int hk) {
    if (L == 0) return 0.f;
    const float l0 = p.lb_logits[hk], l1 = p.lb_logits[256 + hk];
    return 1.0f / (1.0f + __expf(l0 - l1));
}

__device__ void hgrn_a_unit(const Params& p, int L, int u, char* lds) {
    const int tid = otid(), lane = tid & 63, w = tid >> 6, quad = lane >> 4, l15 = lane & 15;
    const int c = u & 63, h = (u >> 6) & 3, b = u >> 8;
    const bf16_t* proj = (const bf16_t*)(p.ws + OFF_BIG); const bf16_t* VT = (const bf16_t*)(p.ws + OFF_BIG + OFF_VT_IN_BIG);
    float* segtot = (float*)lds;
    bf16_t* KDt = (bf16_t*)(lds + 1024);
    const int k = tid & 63, seg = tid >> 6;
    const float lb = hgrn_lb(p, L, h * 64 + k);
    float gl[16], kkv[16]; float run = 0.f;
    const bf16_t* zp = proj + (size_t)(b * 4096 + c * 64 + seg * 16) * PJ_LD + 256 + h * 64 + k;
#pragma unroll
    for (int i = 0; i < 16; ++i) {
        const float z = bf2f(zp[(size_t)i * PJ_LD]);
        const float sg = 1.0f / (1.0f + __expf(-z)), sn = 1.0f / (1.0f + __expf(z));
        const float f = lb + (1.0f - lb) * sg;
        run += __logf(fmaxf(f, 1e-30f)); gl[i] = run; kkv[i] = (1.0f - lb) * sn;
    }
    segtot[seg * 64 + k] = run;
    __syncthreads();
    float off = 0.f, tot = 0.f;
#pragma unroll
    for (int s = 0; s < 4; ++s) { const float t = segtot[s * 64 + k]; tot += t; if (s < seg) off += t; }
    unsigned pkd[8];
#pragma unroll
    for (int i = 0; i < 8; ++i) {
        const float a0 = kkv[2 * i] * __expf(tot - (off + gl[2 * i])), a1 = kkv[2 * i + 1] * __expf(tot - (off + gl[2 * i + 1]));
        pkd[i] = pk2(a0, a1);
    }
    *(uint4*)(KDt + k * 72 + seg * 16) = make_uint4(pkd[0], pkd[1], pkd[2], pkd[3]);
    *(uint4*)(KDt + k * 72 + seg * 16 + 8) = make_uint4(pkd[4], pkd[5], pkd[6], pkd[7]);
    if (seg == 0) ((float*)(p.ws + OFF_DECAY))[u * 64 + k] = __expf(tot);
    __syncthreads();
    const bf16_t* vt = VT + ((size_t)(h * 8 + b) * 64) * 4096 + c * 64;
    float* kvt = (float*)(p.ws + OFF_KVT) + (size_t)u * 4096;
    bf16x8 af[2];
#pragma unroll
    for (int ks = 0; ks < 2; ++ks) af[ks] = ld8(vt + (size_t)(w * 16 + l15) * 4096 + ks * 32 + quad * 8);
#pragma unroll
    for (int kt = 0; kt < 4; ++kt) {
        f32x4 acc = (f32x4){0.f, 0.f, 0.f, 0.f};
#pragma unroll
        for (int ks = 0; ks < 2; ++ks) { const bf16x8 bfr = *(const bf16x8*)(KDt + (kt * 16 + l15) * 72 + ks * 32 + quad * 8); acc = mfma(af[ks], bfr, acc); }
#pragma unroll
        for (int j = 0; j < 4; ++j) kvt[(w * 16 + quad * 4 + j) * 64 + kt * 16 + l15] = acc[j];
    }
    __syncthreads();
}

__device__ void hgrn_scan_phase(const Params& p) {
    const float* kvt = (const float*)(p.ws + OFF_KVT); const float* dec = (const float*)(p.ws + OFF_DECAY);
    bf16_t* st = (bf16_t*)(p.ws + OFF_ST);
    for (int e = blockIdx.x * 256 + otid(); e < 32 * 4096; e += gridDim.x * 256) {
        const int bh = e >> 12, vk = e & 4095, k = vk & 63;
        float S = 0.f;
#pragma unroll 8
        for (int c = 0; c < 64; ++c) {
            const int u = bh * 64 + c;
            st[(size_t)u * 4096 + vk] = f2bf(S);
            S = S * dec[u * 64 + k] + kvt[(size_t)u * 4096 + vk];
        }
    }
}

__device__ void hgrn_c_unit(const Params& p, int L, int u, char* lds) {
    const int tid = otid(), lane = tid & 63, w = tid >> 6, quad = lane >> 4, l15 = lane & 15;
    const int c = u & 63, h = (u >> 6) & 3, b = u >> 8;
    const bf16_t* proj = (const bf16_t*)(p.ws + OFF_BIG); const bf16_t* VT = (const bf16_t*)(p.ws + OFF_BIG + OFF_VT_IN_BIG);
    float* Gs = (float*)lds; float* KKs = Gs + 64 * 65; float* Qs = KKs + 64 * 65; float* segtot = Qs + 64 * 65;
    {
        const int k = tid & 63, seg = tid >> 6;
        const float lb = hgrn_lb(p, L, h * 64 + k);
        float gl[16], kkv[16]; float run = 0.f;
        const bf16_t* zp = proj + (size_t)(b * 4096 + c * 64 + seg * 16) * PJ_LD + 256 + h * 64 + k;
#pragma unroll
        for (int i = 0; i < 16; ++i) {
            const float z = bf2f(zp[(size_t)i * PJ_LD]);
            const float sg = 1.0f / (1.0f + __expf(-z)), sn = 1.0f / (1.0f + __expf(z));
            const float f = lb + (1.0f - lb) * sg;
            run += __logf(fmaxf(f, 1e-30f)); gl[i] = run; kkv[i] = (1.0f - lb) * sn;
            Qs[(seg * 16 + i) * 65 + k] = bf2f(zp[(size_t)i * PJ_LD - 256]) * 0.125f;
        }
        segtot[seg * 64 + k] = run;
        __syncthreads();
        float off = 0.f;
#pragma unroll
        for (int s = 0; s < 4; ++s) { const float t = segtot[s * 64 + k]; if (s < seg) off += t; }
#pragma unroll
        for (int i = 0; i < 16; ++i) { Gs[(seg * 16 + i) * 65 + k] = off + gl[i]; KKs[(seg * 16 + i) * 65 + k] = kkv[i]; }
        __syncthreads();
    }
    const int I = w;
    const int tq = 16 * I + l15;
    bf16x8 qt[2], qg[2];
#pragma unroll
    for (int ks = 0; ks < 2; ++ks) {
        float a[8], g8[8];
#pragma unroll
        for (int j = 0; j < 8; ++j) {
            const int k = ks * 32 + quad * 8 + j;
            const float G = Gs[tq * 65 + k], q = Qs[tq * 65 + k];
            const float gref = (I == 0) ? 0.f : Gs[(16 * I - 1) * 65 + k];
            a[j] = q * __expf(G - gref); g8[j] = q * __expf(G);
        }
        qt[ks] = mk8(pk2(a[0], a[1]), pk2(a[2], a[3]), pk2(a[4], a[5]), pk2(a[6], a[7]));
        qg[ks] = mk8(pk2(g8[0], g8[1]), pk2(g8[2], g8[3]), pk2(g8[4], g8[5]), pk2(g8[6], g8[7]));
    }
    f32x4 O[4];
#pragma unroll
    for (int vt = 0; vt < 4; ++vt) O[vt] = (f32x4){0.f, 0.f, 0.f, 0.f};
    const bf16_t* st = (const bf16_t*)(p.ws + OFF_ST) + (size_t)u * 4096;
#pragma unroll
    for (int vt = 0; vt < 4; ++vt)
#pragma unroll
        for (int ks = 0; ks < 2; ++ks) O[vt] = mfma(ld8(st + (vt * 16 + l15) * 64 + ks * 32 + quad * 8), qg[ks], O[vt]);
    const bf16_t* vtp = VT + ((size_t)(h * 8 + b) * 64) * 4096 + c * 64;
    for (int Jp = 0; Jp <= (I >> 1); ++Jp) {
        f32x4 sc[2];
#pragma unroll
        for (int jj = 0; jj < 2; ++jj) {
            const int J = 2 * Jp + jj;
            sc[jj] = (f32x4){0.f, 0.f, 0.f, 0.f};
            if (J <= I) {
                const int s = 16 * J + l15;
#pragma unroll
                for (int ks = 0; ks < 2; ++ks) {
                    float a[8];
#pragma unroll
                    for (int j = 0; j < 8; ++j) {
                        const int k = ks * 32 + quad * 8 + j;
                        const float gref = (I == 0) ? 0.f : Gs[(16 * I - 1) * 65 + k];
                        a[j] = KKs[s * 65 + k] * __expf(gref - Gs[s * 65 + k]);
                    }
                    sc[jj] = mfma(mk8(pk2(a[0], a[1]), pk2(a[2], a[3]), pk2(a[4], a[5]), pk2(a[6], a[7])), qt[ks], sc[jj]);
                }
#pragma unroll
                for (int j = 0; j < 4; ++j) { const int s2 = 16 * J + quad * 4 + j; if (s2 > tq) sc[jj][j] = 0.f; }
            }
        }
        const bf16x8 P = mk8(pk2(sc[0][0], sc[0][1]), pk2(sc[0][2], sc[0][3]), pk2(sc[1][0], sc[1][1]), pk2(sc[1][2], sc[1][3]));
#pragma unroll
        for (int vt = 0; vt < 4; ++vt) {
            const bf16_t* r = vtp + (size_t)(vt * 16 + l15) * 4096 + 32 * Jp + quad * 4;
            O[vt] = mfma(ld4x2(r, r + 16), P, O[vt]);
        }
    }
    float ss = 0.f;
#pragma unroll
    for (int vt = 0; vt < 4; ++vt)
#pragma unroll
        for (int j = 0; j < 4; ++j) ss += O[vt][j] * O[vt][j];
    ss += __shfl_xor(ss, 16); ss += __shfl_xor(ss, 32);
    const float r = rsqrtf(ss * (1.0f / 64.0f) + 1e-6f);
    const size_t token = (size_t)b * 4096 + c * 64 + tq;
    bf16_t* mix = (bf16_t*)(p.ws + OFF_ACT);
#pragma unroll
    for (int vt = 0; vt < 4; ++vt) {
        const int v0 = vt * 16 + quad * 4;
        const float4 og = *(const float4*)(p.onorm_g + L * 64 + v0);
        const uint2 gz = *(const uint2*)(proj + token * PJ_LD + 768 + h * 64 + v0);
        const float g0 = bflo(gz.x), g1 = bfhi(gz.x), g2 = bflo(gz.y), g3 = bfhi(gz.y);
        const float o0 = O[vt][0] * r * og.x * (g0 / (1.0f + __expf(-g0))), o1 = O[vt][1] * r * og.y * (g1 / (1.0f + __expf(-g1)));
        const float o2 = O[vt][2] * r * og.z * (g2 / (1.0f + __expf(-g2))), o3 = O[vt][3] * r * og.w * (g3 / (1.0f + __expf(-g3)));
        uint2 o; o.x = pk2(o0, o1); o.y = pk2(o2, o3);
        *(uint2*)(mix + token * DM + h * 64 + v0) = o;
    }
    __syncthreads();
}

__device__ void compress_unit(const Params& p, int L, int u, char* lds) {
    const int tid = otid(), lane = tid & 63, w = tid >> 6, quad = lane >> 4, l15 = lane & 15;
    const int which = u & 1, g = (u >> 1) & 1, b = (u >> 2) & 7, ntile = u >> 5;
    const bf16_t* proj = (const bf16_t*)(p.ws + OFF_BIG);
    const bf16_t* w1t = (const bf16_t*)(p.ws + OFF_W1T) + (size_t)(L * 2 + which) * 128 * 2048;
    const bf16_t* w2t = (const bf16_t*)(p.ws + OFF_W2T) + (size_t)(L * 2 + which) * 64 * 128;
    const float* cbias = (const float*)(p.ws + OFF_CBIAS) + (L * 2 + which) * 128;
    bf16_t* Hs = (bf16_t*)lds + w * 16 * 136;
    const int nrow = ntile * 64 + w * 16 + l15;
    int tokbase = 16 * nrow; if (tokbase > 4096 - 32) tokbase = 4096 - 32;
    const bf16_t* xa = proj + ((size_t)b * 4096 + tokbase) * PJ_LD + (which ? 1664 : 1536) + g * 64;
    f32x4 acc[8];
#pragma unroll
    for (int i = 0; i < 8; ++i) acc[i] = (f32x4){0.f, 0.f, 0.f, 0.f};
    for (int kk = 0; kk < 64; ++kk) {
        const int l = kk >> 1, d = (kk & 1) * 32 + quad * 8;
        const bf16x8 a = ld8(xa + (size_t)l * PJ_LD + d);
#pragma unroll
        for (int ni = 0; ni < 8; ++ni) acc[ni] = mfma(a, ld8(w1t + (size_t)(ni * 16 + l15) * 2048 + kk * 32 + quad * 8), acc[ni]);
    }
#pragma unroll
    for (int ni = 0; ni < 8; ++ni) { const float bsv = cbias[ni * 16 + l15];
#pragma unroll
        for (int j = 0; j < 4; ++j) { const float x = acc[ni][j] + bsv;
            const float uu = 0.7978845608028654f * (x + 0.044715f * x * x * x);
            const float th = 1.0f - 2.0f / (1.0f + __expf(2.0f * uu));
            Hs[(quad * 4 + j) * 136 + ni * 16 + l15] = f2bf(0.5f * x * (1.0f + th)); } }
    __syncthreads();
    f32x4 o[4];
#pragma unroll
    for (int i = 0; i < 4; ++i) o[i] = (f32x4){0.f, 0.f, 0.f, 0.f};
#pragma unroll
    for (int ks = 0; ks < 4; ++ks) { const bf16x8 a = *(const bf16x8*)(Hs + l15 * 136 + ks * 32 + quad * 8);
#pragma unroll
        for (int ni = 0; ni < 4; ++ni) o[ni] = mfma(a, ld8(w2t + (size_t)(ni * 16 + l15) * 128 + ks * 32 + quad * 8), o[ni]); }
    const int nb = ntile * 64 + w * 16 + quad * 4;
    if (which == 0) {
        bf16_t* kc = (bf16_t*)(p.ws + OFF_KC) + (size_t)(b * 2 + g) * 256 * 64;
        const float* rope = (const float*)(p.ws + OFF_ROPE);
#pragma unroll
        for (int j = 0; j < 4; ++j) {
            const int n = nb + j;
            float ss = o[0][j] * o[0][j] + o[1][j] * o[1][j] + o[2][j] * o[2][j] + o[3][j] * o[3][j];
            ss += __shfl_xor(ss, 1); ss += __shfl_xor(ss, 2); ss += __shfl_xor(ss, 4); ss += __shfl_xor(ss, 8);
            const float r = rsqrtf(ss * (1.0f / 64.0f) + 1e-6f);
            float v[4];
#pragma unroll
            for (int ni = 0; ni < 4; ++ni) v[ni] = o[ni][j] * r * p.nsa_kn_g[L * 64 + ni * 16 + l15];
            int pos = 16 * n + 31; if (pos > 4095) pos = 4095;
            const float cs = rope[pos * 16 + (l15 & 7)], sn = rope[pos * 16 + 8 + (l15 & 7)];
            const float pp = __shfl_xor(v[0], 8);
            v[0] = (l15 < 8) ? (v[0] * cs - pp * sn) : (v[0] * cs + pp * sn);
#pragma unroll
            for (int ni = 0; ni < 4; ++ni) kc[(size_t)n * 64 + ni * 16 + l15] = (n < 255) ? f2bf(v[ni]) : (bf16_t)0;
        }
    } else {
        bf16_t* vct = (bf16_t*)(p.ws + OFF_VCT) + (size_t)(b * 2 + g) * 64 * 256;
#pragma unroll
        for (int ni = 0; ni < 4; ++ni) {
            float v0 = o[ni][0], v1 = o[ni][1], v2 = o[ni][2], v3 = o[ni][3];
            if (nb + 3 >= 255) v3 = 0.f;
            uint2 ov; ov.x = pk2(v0, v1); ov.y = pk2(v2, v3);
            *(uint2*)(vct + (size_t)(ni * 16 + l15) * 256 + nb) = ov;
        }
    }
    __syncthreads();
}

__device__ void foxc_job(const Params& p, int L, int bh) {
    const int lane = otid() & 63, b = bh >> 2, h = bh & 3;
    const float* gates = (const float*)(p.ws + OFF_GATES);
    float* cc = (float*)(p.ws + OFF_FOXC) + (size_t)bh * 4096;
    const float fb = p.fox_fb[L * 4 + h];
    float run = 0.f;
    for (int i = 0; i < 64; ++i) {
        const float x = gates[((size_t)b * 4096 + lane * 64 + i) * 32 + 24 + h] + fb;
        run += (x >= 0.f) ? -log1pf(__expf(-x)) : (x - log1pf(__expf(x)));
    }
    float incl = run;
#pragma unroll
    for (int o = 1; o < 64; o <<= 1) { const float t = __shfl_up(incl, o); if (lane >= o) incl += t; }
    float acc = incl - run;
    for (int i = 0; i < 64; ++i) {
        const float x = gates[((size_t)b * 4096 + lane * 64 + i) * 32 + 24 + h] + fb;
        acc += (x >= 0.f) ? -log1pf(__expf(-x)) : (x - log1pf(__expf(x)));
        cc[lane * 64 + i] = acc;
    }
}

DEVI void load_kf(const bf16_t* Kp, int ldk, int kb, int lane, bf16x8 (&kf)[2][2]) {
    const int quad = lane >> 4, l15 = lane & 15;
#pragma unroll
    for (int t2 = 0; t2 < 2; ++t2)
#pragma unroll
        for (int ks = 0; ks < 2; ++ks) kf[t2][ks] = ld8(Kp + (size_t)(kb + t2 * 16 + l15) * ldk + ks * 32 + quad * 8);
}
DEVI void load_vf(const bf16_t* VTp, int ldv, int kb, int lane, bf16x8 (&vf)[4]) {
    const int quad = lane >> 4, l15 = lane & 15;
#pragma unroll
    for (int dt = 0; dt < 4; ++dt) { const bf16_t* r = VTp + (size_t)(dt * 16 + l15) * ldv + kb + quad * 4; vf[dt] = ld4x2(r, r + 16); }
}

template <int NT, class MaskF>
DEVI void attn_step32(const bf16_t* Kp, int ldk, const bf16_t* VTp, int ldv, int kb, const bf16x8 (&qf)[NT][2], f32x4 (&O)[4][NT], float (&m)[NT], float (&l)[NT],
                      int lane, MaskF maskf) {
    const int quad = lane >> 4;
    bf16x8 kf[2][2], vf[4];
    load_kf(Kp, ldk, kb, lane, kf);
    load_vf(VTp, ldv, kb, lane, vf);
#pragma unroll
    for (int nt = 0; nt < NT; ++nt) {
        f32x4 s0 = (f32x4){0.f, 0.f, 0.f, 0.f}, s1 = s0;
#pragma unroll
        for (int ks = 0; ks < 2; ++ks) { s0 = mfma(kf[0][ks], qf[nt][ks], s0); s1 = mfma(kf[1][ks], qf[nt][ks], s1); }
        float sv[8]; bool ok[8]; float mx = -1e30f;
#pragma unroll
        for (int e = 0; e < 8; ++e) { sv[e] = (e < 4) ? s0[e & 3] : s1[e & 3]; const int key = kb + (e >> 2) * 16 + quad * 4 + (e & 3);
            ok[e] = maskf(nt, e, key, sv[e]); if (ok[e]) mx = fmaxf(mx, sv[e]); }
        mx = fmaxf(mx, __shfl_xor(mx, 16)); mx = fmaxf(mx, __shfl_xor(mx, 32));
        const float mn = fmaxf(m[nt], mx), alpha = __expf(m[nt] - mn);
        float pv[8]; float rs = 0.f;
#pragma unroll
        for (int e = 0; e < 8; ++e) { pv[e] = ok[e] ? __expf(sv[e] - mn) : 0.f; rs += pv[e]; }
        rs += __shfl_xor(rs, 16); rs += __shfl_xor(rs, 32);
        l[nt] = l[nt] * alpha + rs; m[nt] = mn;
        const bf16x8 P = mk8(pk2(pv[0], pv[1]), pk2(pv[2], pv[3]), pk2(pv[4], pv[5]), pk2(pv[6], pv[7]));
#pragma unroll
        for (int dt = 0; dt < 4; ++dt) { O[dt][nt] = O[dt][nt] * alpha; O[dt][nt] = mfma(vf[dt], P, O[dt][nt]); }
    }
}

template <int NT>
DEVI void attn_store(bf16_t* mix, size_t token0, int col0, const f32x4 (&O)[4][NT], const float (&sc)[NT], int lane, bool accum) {
    const int quad = lane >> 4, l15 = lane & 15;
#pragma unroll
    for (int nt = 0; nt < NT; ++nt)
#pragma unroll
        for (int dt = 0; dt < 4; ++dt) {
            bf16_t* dst = mix + (token0 + nt * 16 + l15) * DM + col0 + dt * 16 + quad * 4;
            float a0 = O[dt][nt][0] * sc[nt], a1 = O[dt][nt][1] * sc[nt], a2 = O[dt][nt][2] * sc[nt], a3 = O[dt][nt][3] * sc[nt];
            if (accum) { const uint2 old = *(const uint2*)dst; a0 += bflo(old.x); a1 += bfhi(old.x); a2 += bflo(old.y); a3 += bfhi(old.y); }
            uint2 o; o.x = pk2(a0, a1); o.y = pk2(a2, a3);
            *(uint2*)dst = o;
        }
}

__device__ void nsa_unit(const Params& p, int L, int b, int g, int blk, char* lds) {
    const int tid = otid(), lane = tid & 63, w = tid >> 6, quad = lane >> 4, l15 = lane & 15;
    const bf16_t* proj = (const bf16_t*)(p.ws + OFF_BIG); const bf16_t* VT = (const bf16_t*)(p.ws + OFF_BIG + OFF_VT_IN_BIG);
    const float* gates = (const float*)(p.ws + OFF_GATES);
    bf16_t* mix = (bf16_t*)(p.ws + OFF_ACT);
    float* impL = (float*)lds; u64* selm = (u64*)(lds + 65536);
    const int q0 = blk * 64; const size_t token0 = (size_t)b * 4096 + q0;
    const int head = g * 4 + w, mixcol = 256 + head * 64;
    const bf16_t* Kc = (const bf16_t*)(p.ws + OFF_KC) + (size_t)(b * 2 + g) * 256 * 64;
    const bf16_t* VcT = (const bf16_t*)(p.ws + OFF_VCT) + (size_t)(b * 2 + g) * 64 * 256;
    const int nsteps = (4 * blk + 3 + 31) >> 5;
#pragma unroll 1
    for (int hq = 0; hq < 2; ++hq) {
        const int qoff = hq * 32;
        bf16x8 qf[2][2]; int tq[2]; f32x4 O[4][2]; float m[2], l[2];
#pragma unroll
        for (int nt = 0; nt < 2; ++nt) { tq[nt] = q0 + qoff + nt * 16 + l15;
#pragma unroll
            for (int ks = 0; ks < 2; ++ks) qf[nt][ks] = ld8(proj + (token0 + qoff + nt * 16 + l15) * PJ_LD + 1024 + head * 64 + ks * 32 + quad * 8); }
#pragma unroll
        for (int nt = 0; nt < 2; ++nt) { m[nt] = -1e30f; l[nt] = 0.f; }
#pragma unroll 1
        for (int st = 0; st < nsteps; ++st) {
            const int kb = st * 32; bf16x8 kf[2][2]; load_kf(Kc, 64, kb, lane, kf);
#pragma unroll
            for (int nt = 0; nt < 2; ++nt) {
                f32x4 s0 = (f32x4){0.f, 0.f, 0.f, 0.f}, s1 = s0;
#pragma unroll
                for (int ks = 0; ks < 2; ++ks) { s0 = mfma(kf[0][ks], qf[nt][ks], s0); s1 = mfma(kf[1][ks], qf[nt][ks], s1); }
                float sv[8]; bool ok[8]; float mx = -1e30f;
#pragma unroll
                for (int e = 0; e < 8; ++e) { sv[e] = (e < 4) ? s0[e & 3] : s1[e & 3]; const int n = kb + (e >> 2) * 16 + quad * 4 + (e & 3);
                    ok[e] = (16 * n + 31 <= tq[nt]); if (ok[e]) mx = fmaxf(mx, sv[e]); }
                mx = fmaxf(mx, __shfl_xor(mx, 16)); mx = fmaxf(mx, __shfl_xor(mx, 32));
                const float mn = fmaxf(m[nt], mx), alpha = __expf(m[nt] - mn);
                float rs = 0.f;
#pragma unroll
                for (int e = 0; e < 8; ++e) rs += ok[e] ? __expf(sv[e] - mn) : 0.f;
                rs += __shfl_xor(rs, 16); rs += __shfl_xor(rs, 32);
                l[nt] = l[nt] * alpha + rs; m[nt] = mn;
            }
        }
        float inv[2], prevr[2];
#pragma unroll
        for (int nt = 0; nt < 2; ++nt) { inv[nt] = 1.0f / fmaxf(l[nt], 1e-30f); prevr[nt] = 0.f; }
#pragma unroll
        for (int dt = 0; dt < 4; ++dt)
#pragma unroll
            for (int nt = 0; nt < 2; ++nt) O[dt][nt] = (f32x4){0.f, 0.f, 0.f, 0.f};
#pragma unroll 1
        for (int st = 0; st < nsteps; ++st) {
            const int kb = st * 32; bf16x8 kf[2][2], vf[4]; load_kf(Kc, 64, kb, lane, kf); load_vf(VcT, 256, kb, lane, vf);
#pragma unroll
            for (int nt = 0; nt < 2; ++nt) {
                f32x4 s0 = (f32x4){0.f, 0.f, 0.f, 0.f}, s1 = s0;
#pragma unroll
                for (int ks = 0; ks < 2; ++ks) { s0 = mfma(kf[0][ks], qf[nt][ks], s0); s1 = mfma(kf[1][ks], qf[nt][ks], s1); }
                float pv[8];
#pragma unroll
                for (int e = 0; e < 8; ++e) { const float s = (e < 4) ? s0[e & 3] : s1[e & 3]; const int n = kb + (e >> 2) * 16 + quad * 4 + (e & 3);
                    pv[e] = (16 * n + 31 <= tq[nt]) ? __expf(s - m[nt]) * inv[nt] : 0.f; }
                const int qq = qoff + nt * 16 + l15;
#pragma unroll
                for (int t2 = 0; t2 < 2; ++t2) {
                    const float A = (pv[t2 * 4] + pv[t2 * 4 + 1]) + (pv[t2 * 4 + 2] + pv[t2 * 4 + 3]);
                    const float r = __shfl(pv[t2 * 4 + 3], (lane + 48) & 63);
                    const float carry = (quad == 0) ? prevr[nt] : r; prevr[nt] = r;
                    const int jb = st * 8 + t2 * 4 + quad;
                    impL[(w * 64 + jb) * 64 + ((qq ^ jb) & 63)] = A + carry;
                }
                const bf16x8 P = mk8(pk2(pv[0], pv[1]), pk2(pv[2], pv[3]), pk2(pv[4], pv[5]), pk2(pv[6], pv[7]));
#pragma unroll
                for (int dt = 0; dt < 4; ++dt) O[dt][nt] = mfma(vf[dt], P, O[dt][nt]);
            }
        }
        float sc[2];
#pragma unroll
        for (int nt = 0; nt < 2; ++nt) sc[nt] = gates[(token0 + qoff + nt * 16 + l15) * 32 + 0 * 8 + head];
        attn_store<2>(mix, token0 + qoff, mixcol, O, sc, lane, false);
    }
    __syncthreads();
#pragma unroll 1
    for (int qi = 0; qi < 16; ++qi) {
        const int q = w * 16 + qi, jb = lane;
        const int col = (q ^ jb) & 63;
        float val = (impL[(0 * 64 + jb) * 64 + col] + impL[(1 * 64 + jb) * 64 + col]) + (impL[(2 * 64 + jb) * 64 + col] + impL[(3 * 64 + jb) * 64 + col]);
        if (jb > blk) val = -1e30f;
        else if (jb == 0 || jb == blk || jb == blk - 1) val = 1e30f;
        int rank = 0;
        for (int jp = 0; jp < 64; ++jp) { const float vj = __shfl(val, jp); rank += ((vj > val) || (vj == val && jp < jb)) ? 1 : 0; }
        const bool sel = (rank < 16) && (val > -5e29f);
        const u64 mask = __ballot(sel);
        if (lane == 0) selm[q] = mask;
    }
    __syncthreads();
    u64 uni = 0;
    for (int q = 0; q < 64; ++q) uni |= selm[q];
#pragma unroll 1
    for (int hq = 0; hq < 2; ++hq) {
        const int qoff = hq * 32;
        bf16x8 qf[2][2]; int tq[2]; f32x4 O[4][2]; float m[2], l[2]; u64 sm[2];
#pragma unroll
        for (int nt = 0; nt < 2; ++nt) { tq[nt] = q0 + qoff + nt * 16 + l15; sm[nt] = selm[qoff + nt * 16 + l15];
#pragma unroll
            for (int ks = 0; ks < 2; ++ks) qf[nt][ks] = ld8(proj + (token0 + qoff + nt * 16 + l15) * PJ_LD + 1024 + head * 64 + ks * 32 + quad * 8); }
        {
            const bf16_t* Ks = proj + (size_t)b * 4096 * PJ_LD + 1792 + g * 64;
            const bf16_t* VsT = VT + ((size_t)((4 + g) * 8 + b) * 64) * 4096;
#pragma unroll
            for (int nt = 0; nt < 2; ++nt) { m[nt] = -1e30f; l[nt] = 0.f; }
#pragma unroll
            for (int dt = 0; dt < 4; ++dt)
#pragma unroll
                for (int nt = 0; nt < 2; ++nt) O[dt][nt] = (f32x4){0.f, 0.f, 0.f, 0.f};
#pragma unroll 1
            for (int jb = 0; jb <= blk; ++jb) {
                if (!((uni >> jb) & 1ull)) continue;
#pragma unroll 1
                for (int hf = 0; hf < 2; ++hf)
                    attn_step32<2>(Ks, PJ_LD, VsT, 4096, jb * 64 + hf * 32, qf, O, m, l, lane,
                                   [&](int nt, int e, int key, float& s) { return (((sm[nt] >> jb) & 1ull) != 0) && (key <= tq[nt]); });
            }
            float sc[2];
#pragma unroll
            for (int nt = 0; nt < 2; ++nt) sc[nt] = gates[(token0 + qoff + nt * 16 + l15) * 32 + 1 * 8 + head] / fmaxf(l[nt], 1e-30f);
            attn_store<2>(mix, token0 + qoff, mixcol, O, sc, lane, true);
        }
        {
            const bf16_t* Kw = proj + (size_t)b * 4096 * PJ_LD + 2048 + g * 64;
            const bf16_t* VwT = VT + ((size_t)((6 + g) * 8 + b) * 64) * 4096;
#pragma unroll
            for (int nt = 0; nt < 2; ++nt) { m[nt] = -1e30f; l[nt] = 0.f; }
#pragma unroll
            for (int dt = 0; dt < 4; ++dt)
#pragma unroll
                for (int nt = 0; nt < 2; ++nt) O[dt][nt] = (f32x4){0.f, 0.f, 0.f, 0.f};
#pragma unroll 1
            for (int jb = (blk > 8 ? blk - 8 : 0); jb <= blk; ++jb)
#pragma unroll 1
                for (int hf = 0; hf < 2; ++hf)
                    attn_step32<2>(Kw, PJ_LD, VwT, 4096, jb * 64 + hf * 32, qf, O, m, l, lane,
                                   [&](int nt, int e, int key, float& s) { return (key <= tq[nt]) && (key + 512 > tq[nt]); });
            float sc[2];
#pragma unroll
            for (int nt = 0; nt < 2; ++nt) sc[nt] = gates[(token0 + qoff + nt * 16 + l15) * 32 + 2 * 8 + head] / fmaxf(l[nt], 1e-30f);
            attn_store<2>(mix, token0 + qoff, mixcol, O, sc, lane, true);
        }
    }
    __syncthreads();
}

__device__ void fox_unit(const Params& p, int L, int b, int h, int qb) {
    const int tid = otid(), lane = tid & 63, w = tid >> 6, quad = lane >> 4, l15 = lane & 15;
    const bf16_t* proj = (const bf16_t*)(p.ws + OFF_BIG); const bf16_t* VT = (const bf16_t*)(p.ws + OFF_BIG + OFF_VT_IN_BIG);
    bf16_t* mix = (bf16_t*)(p.ws + OFF_ACT);
    const float* cc = (const float*)(p.ws + OFF_FOXC) + (size_t)(b * 4 + h) * 4096;
    const int q0 = qb * 128 + w * 32; const size_t token0 = (size_t)b * 4096 + q0;
    bf16x8 qf[2][2]; int tq[2]; float cq[2];
#pragma unroll
    for (int nt = 0; nt < 2; ++nt) { tq[nt] = q0 + nt * 16 + l15; cq[nt] = cc[tq[nt]];
#pragma unroll
        for (int ks = 0; ks < 2; ++ks) qf[nt][ks] = ld8(proj + (token0 + nt * 16 + l15) * PJ_LD + 2304 + h * 64 + ks * 32 + quad * 8); }
    const bf16_t* Kp = proj + (size_t)b * 4096 * PJ_LD + 2560 + h * 64;
    const bf16_t* VTp = VT + ((size_t)((8 + h) * 8 + b) * 64) * 4096;
    f32x4 O[4][2]; float m[2], l[2];
#pragma unroll
    for (int nt = 0; nt < 2; ++nt) { m[nt] = -1e30f; l[nt] = 0.f; }
#pragma unroll
    for (int dt = 0; dt < 4; ++dt)
#pragma unroll
        for (int nt = 0; nt < 2; ++nt) O[dt][nt] = (f32x4){0.f, 0.f, 0.f, 0.f};
#pragma unroll 1
    for (int kb = 0; kb < q0 + 32; kb += 32) {
        const float4 c0 = *(const float4*)(cc + kb + quad * 4), c1 = *(const float4*)(cc + kb + 16 + quad * 4);
        const float ck[8] = {c0.x, c0.y, c0.z, c0.w, c1.x, c1.y, c1.z, c1.w};
        attn_step32<2>(Kp, PJ_LD, VTp, 4096, kb, qf, O, m, l, lane,
                       [&](int nt, int e, int key, float& s) { s += cq[nt] - ck[e]; return key <= tq[nt]; });
    }
    float sc[2];
#pragma unroll
    for (int nt = 0; nt < 2; ++nt) sc[nt] = 1.0f / fmaxf(l[nt], 1e-30f);
    attn_store<2>(mix, token0, 768 + h * 64, O, sc, lane, false);
}

__device__ void mixA_phase(const Params& p, int L, char* lds) {
    for (int job = blockIdx.x; job < 136 + 2048; job += gridDim.x) {
        if (job < 128) compress_unit(p, L, job, lds);
        else if (job < 136) foxc_job(p, L, (job - 128) * 4 + (otid() >> 6));
        else hgrn_a_unit(p, L, job - 136, lds);
    }
}
__device__ void mixB_phase(const Params& p, int L, char* lds) {
#pragma unroll 1
    for (int n = blockIdx.x; n < 1024; n += gridDim.x) { const int blk = 63 - (n >> 4), bg = n & 15; nsa_unit(p, L, bg >> 1, bg & 1, blk, lds); }
#pragma unroll 1
    for (int i = blockIdx.x; i < 1024; i += gridDim.x) { const int f = (i < 512) ? i : (1535 - i);
        const int qb = f >> 5, bh = f & 31; fox_unit(p, L, bh >> 2, bh & 3, qb); }
#pragma unroll 1
    for (int u = blockIdx.x; u < 2048; u += gridDim.x) hgrn_c_unit(p, L, u, lds);
}

__device__ void run_phase(const Params& p, int ph, char* lds) {
    if (ph == 0) { prep_phase(p, lds); return; }
    const int L = (ph - 1) / 9, s = (ph - 1) % 9;
    switch (s) {
        case 0: gemm_phase<EPI_PROJ>(p, L, lds); break;
        case 1: mixA_phase(p, L, lds); break;
        case 2: hgrn_scan_phase(p); break;
        case 3: mixB_phase(p, L, lds); break;
        case 4: gemm_phase<EPI_WO>(p, L, lds); break;
        case 5: norm_phase(p.out, p.norm2_g + L * 1024, (bf16_t*)(p.ws + OFF_ACT)); break;
        case 6: gemm_phase<EPI_UP>(p, L, lds); break;
        case 7: gemm_phase<EPI_DOWN>(p, L, lds); break;
        default: norm_phase(p.out, p.norm1_g + (L + 1) * 1024, (bf16_t*)(p.ws + OFF_ACT)); break;
    }
}

__global__ void __launch_bounds__(256, 2) fwd_kernel(Params p, int ph_lo, int ph_hi) {
    __shared__ __attribute__((aligned(16))) char lds[LDS_BYTES];
    for (int ph = ph_lo; ph < ph_hi; ++ph) {
#ifdef REPEAT_MASK
        const int nrep = (ph >= 1 && ((REPEAT_MASK >> ((ph - 1) % 9)) & 1)) ? 2 : 1;
#pragma unroll 1
        for (int rep = 0; rep < nrep; ++rep) {
            if (rep) cg::this_grid().sync();
            run_phase(p, ph, lds);
        }
#else
        run_phase(p, ph, lds);
#endif
        if (ph + 1 < ph_hi) { cg::this_grid().sync(); }
    }
}

extern "C" void kernel_launch(void* const* d_in, const int* in_sizes, int n_in, void* d_out, int out_size, void* d_ws, size_t ws_size,
                              hipStream_t stream) {
    if (ws_size < WS_NEED) { fprintf(stderr, "workspace too small: %zu < %zu\n", ws_size, (size_t)WS_NEED); return; }
    Params p{};
    p.x = (const float*)d_in[0]; p.norm1_g = (const float*)d_in[1]; p.w_in = (const float*)d_in[2]; p.lb_logits = (const float*)d_in[3];
    p.onorm_g = (const float*)d_in[4]; p.nsa_qn_g = (const float*)d_in[5]; p.nsa_kn_g = (const float*)d_in[6]; p.cmp_pos = (const float*)d_in[7];
    p.cmp_w1 = (const float*)d_in[8]; p.cmp_w2 = (const float*)d_in[9]; p.fox_qn_g = (const float*)d_in[10]; p.fox_kn_g = (const float*)d_in[11];
    p.fox_fb = (const float*)d_in[12]; p.w_o = (const float*)d_in[13]; p.norm2_g = (const float*)d_in[14]; p.w_up = (const float*)d_in[15];
    p.w_down = (const float*)d_in[16];
    p.out = (float*)d_out; p.ws = (char*)d_ws;
#if MULTI_LAUNCH
    for (int ph = 0; ph < NPHASE; ++ph) hipLaunchKernelGGL(fwd_kernel, dim3(512), dim3(256), 0, stream, p, ph, ph + 1);
#else
    static int grid_blocks = 0;
    if (!grid_blocks) {
        int dev = 0, cus = 0, per_cu = 0;
        hipGetDevice(&dev);
        hipDeviceGetAttribute(&cus, hipDeviceAttributeMultiprocessorCount, dev);
        hipOccupancyMaxActiveBlocksPerMultiprocessor(&per_cu, fwd_kernel, 256, 0);
        if (per_cu > 2) per_cu = 2;
        grid_blocks = cus * per_cu;
        grid_blocks &= ~7;
    }
    int lo = 0, hi = NPHASE;
    void* args[] = {&p, &lo, &hi};
    hipError_t e = hipLaunchCooperativeKernel((void*)fwd_kernel, dim3(grid_blocks), dim3(256), args, 0, stream);
    if (e != hipSuccess) fprintf(stderr, "cooperative launch failed: %s (grid %d)\n", hipGetErrorString(e), grid_blocks);
#endif
}
```

```cpp
#include <hip/hip_runtime.h>
#include <hip/hip_cooperative_groups.h>
#include <stdint.h>
#include <cstdio>
namespace cg = cooperative_groups;

#ifndef MULTI_LAUNCH
#define MULTI_LAUNCH 0
#endif

typedef unsigned short bf16_t;
typedef short bf16x8 __attribute__((ext_vector_type(8)));
typedef float f32x4 __attribute__((ext_vector_type(4)));
typedef unsigned long long u64;
typedef unsigned u32x16 __attribute__((ext_vector_type(16)));
#define DEVI __device__ __forceinline__

constexpr int T_TOK = 32768, SEQ = 4096, DM = 1024, DFF = 4096;
constexpr int PJ_LD = 3072;
constexpr int NW_IN = 3100, NW_IN_PAD = 3200;
constexpr int NPHASE = 18;

constexpr size_t OFF_WIN = 0;
constexpr size_t OFF_WO = OFF_WIN + (size_t)2 * NW_IN_PAD * 1024 * 2;
constexpr size_t OFF_WUP = OFF_WO + (size_t)2 * 1024 * 1024 * 2;
constexpr size_t OFF_WDN = OFF_WUP + (size_t)2 * 4096 * 1024 * 2;
constexpr size_t OFF_W1T = OFF_WDN + (size_t)2 * 4096 * 1024 * 2;
constexpr size_t OFF_W2T = OFF_W1T + (size_t)2 * 2 * 128 * 2048 * 2;
constexpr size_t OFF_CBIAS = OFF_W2T + (size_t)2 * 2 * 64 * 128 * 2;
constexpr size_t OFF_CTR = OFF_CBIAS + 2048;
constexpr size_t OFF_ROPE = OFF_CTR + 256;
constexpr size_t OFF_GATES = OFF_ROPE + (size_t)4096 * 16 * 4;
constexpr size_t OFF_FOXC = OFF_GATES + (size_t)T_TOK * 32 * 4;
constexpr size_t OFF_KC = OFF_FOXC + (size_t)8 * 4 * 4096 * 4;
constexpr size_t OFF_VCT = OFF_KC + (size_t)8 * 2 * 256 * 64 * 2;
constexpr size_t OFF_DECAY = OFF_VCT + (size_t)8 * 2 * 256 * 64 * 2;
constexpr size_t OFF_KVT = OFF_DECAY + (size_t)2048 * 64 * 4;
constexpr size_t OFF_ST = OFF_KVT + (size_t)2048 * 4096 * 4;
constexpr size_t OFF_ACT = OFF_ST + (size_t)2048 * 4096 * 2;
constexpr size_t OFF_BIG = OFF_ACT + (size_t)T_TOK * 1024 * 2;
constexpr size_t OFF_VT_IN_BIG = (size_t)T_TOK * PJ_LD * 2;
constexpr size_t WS_NEED = OFF_BIG + (size_t)T_TOK * 4096 * 2;

constexpr int LDS_BYTES = 67584;

struct Params {
    const float *x, *norm1_g, *w_in, *lb_logits, *onorm_g, *nsa_qn_g, *nsa_kn_g, *cmp_pos, *cmp_w1, *cmp_w2,
        *fox_qn_g, *fox_kn_g, *fox_fb, *w_o, *norm2_g, *w_up, *w_down;
    float* out;
    char* ws;
};

DEVI unsigned pk2(float lo, float hi) { unsigned r; asm("v_cvt_pk_bf16_f32 %0, %1, %2" : "=v"(r) : "v"(lo), "v"(hi)); return r; }
DEVI bf16_t f2bf(float f) { return (bf16_t)(pk2(f, 0.f) & 0xffffu); }
DEVI float bf2f(bf16_t h) { return __uint_as_float(((unsigned)h) << 16); }
DEVI float bflo(unsigned u) { return __uint_as_float(u << 16); }
DEVI float bfhi(unsigned u) { return __uint_as_float(u & 0xffff0000u); }
DEVI f32x4 mfma(bf16x8 a, bf16x8 b, f32x4 c) { return __builtin_amdgcn_mfma_f32_16x16x32_bf16(a, b, c, 0, 0, 0); }
DEVI int otid() { int t; asm volatile("v_mov_b32 %0, %1" : "=v"(t) : "v"(threadIdx.x)); return t; }
DEVI float wave_sum(float v) {
#pragma unroll
    for (int o = 32; o >= 1; o >>= 1) v += __shfl_xor(v, o);
    return v;
}
DEVI bf16x8 mk8(unsigned a, unsigned b, unsigned c, unsigned d) {
    uint4 u = make_uint4(a, b, c, d);
    return *(bf16x8*)&u;
}
DEVI bf16x8 ld8(const bf16_t* p) { uint4 u = *(const uint4*)p; return *(bf16x8*)&u; }
DEVI bf16x8 ld4x2(const bf16_t* p0, const bf16_t* p1) {
    uint2 a = *(const uint2*)p0, b = *(const uint2*)p1;
    return mk8(a.x, a.y, b.x, b.y);
}

DEVI int win_colmap(int n) {
    if (n < 2304) return n;
    if (n < 3072) return n + 24;
    if (n < 3096) return n - 768;
    return n;
}
__device__ void transpose_tile(const float* __restrict__ src, int ld_src, bf16_t* __restrict__ dst, int ld_dst, int k0, int n0, int nvalid,
                               int colmode, float* tile) {
    const int tid = otid();
    for (int idx = tid; idx < 4096; idx += 256) {
        const int i = idx >> 6, j = idx & 63, n = n0 + j;
        float v = 0.f;
        if (n < nvalid) v = src[(size_t)(k0 + i) * ld_src + (colmode ? win_colmap(n) : n)];
        tile[i * 65 + j] = v;
    }
    __syncthreads();
    for (int idx = tid; idx < 4096; idx += 256) {
        const int j = idx >> 6, i = idx & 63;
        dst[(size_t)(n0 + j) * ld_dst + k0 + i] = f2bf(tile[i * 65 + j]);
    }
    __syncthreads();
}

__device__ void norm_phase(const float* __restrict__ xin, const float* __restrict__ g, bf16_t* __restrict__ hout) {
    const int tid = otid(); const int lane = tid & 63, w = tid >> 6;
    for (int row = blockIdx.x * 4 + w; row < T_TOK; row += gridDim.x * 4) {
        const float4* xr = (const float4*)(xin + (size_t)row * DM);
        float4 v[4]; float ss = 0.f;
#pragma unroll
        for (int i = 0; i < 4; ++i) { v[i] = xr[lane + 64 * i]; ss += v[i].x * v[i].x + v[i].y * v[i].y + v[i].z * v[i].z + v[i].w * v[i].w; }
        ss = wave_sum(ss);
        const float r = rsqrtf(ss * (1.0f / 1024.0f) + 1e-6f);
#pragma unroll
        for (int i = 0; i < 4; ++i) {
            const float4 gg = ((const float4*)g)[lane + 64 * i];
            uint2 o; o.x = pk2(v[i].x * r * gg.x, v[i].y * r * gg.y); o.y = pk2(v[i].z * r * gg.z, v[i].w * r * gg.w);
            *(uint2*)(hout + (size_t)row * DM + (lane + 64 * i) * 4) = o;
        }
    }
}

__device__ void prep_phase(const Params& p, char* lds) {
    float* tile = (float*)lds;
    if (blockIdx.x == 0 && otid() < 64) ((unsigned*)(p.ws + OFF_CTR))[otid()] = 0u;
    bf16_t* win_t = (bf16_t*)(p.ws + OFF_WIN); bf16_t* wo_t = (bf16_t*)(p.ws + OFF_WO);
    bf16_t* wup_t = (bf16_t*)(p.ws + OFF_WUP); bf16_t* wdn_t = (bf16_t*)(p.ws + OFF_WDN);
    bf16_t* w1t = (bf16_t*)(p.ws + OFF_W1T); bf16_t* w2t = (bf16_t*)(p.ws + OFF_W2T);
    const int J0 = 1600, J1 = J0 + 512, J2 = J1 + 2048, J3 = J2 + 2048, J4 = J3 + 256, J5 = J4 + 8, J6 = J5 + 128, J7 = J6 + 128;
    for (int job = blockIdx.x; job < J7; job += gridDim.x) {
        if (job < J0) { const int L = job / 800, r = job % 800, kt = r / 50, nt = r % 50;
            transpose_tile(p.w_in + (size_t)L * 1024 * NW_IN, NW_IN, win_t + (size_t)L * NW_IN_PAD * 1024, 1024, kt * 64, nt * 64, NW_IN, 1, tile);
        } else if (job < J1) { const int j = job - J0, L = j / 256, r = j % 256, kt = r / 16, nt = r % 16;
            transpose_tile(p.w_o + (size_t)L * 1024 * 1024, 1024, wo_t + (size_t)L * 1024 * 1024, 1024, kt * 64, nt * 64, 1024, 0, tile);
        } else if (job < J2) { const int j = job - J1, L = j / 1024, r = j % 1024, kt = r / 64, nt = r % 64;
            transpose_tile(p.w_up + (size_t)L * 1024 * 4096, 4096, wup_t + (size_t)L * 4096 * 1024, 1024, kt * 64, nt * 64, 4096, 0, tile);
        } else if (job < J3) { const int j = job - J2, L = j / 1024, r = j % 1024, kt = r / 16, nt = r % 16;
            transpose_tile(p.w_down + (size_t)L * 4096 * 1024, 1024, wdn_t + (size_t)L * 1024 * 4096, 4096, kt * 64, nt * 64, 1024, 0, tile);
        } else if (job < J4) { const int j = job - J3, lw = j / 64, r = j % 64, kt = r / 2, nt = r % 2;
            transpose_tile(p.cmp_w1 + (size_t)lw * 2048 * 128, 128, w1t + (size_t)lw * 128 * 2048, 2048, kt * 64, nt * 64, 128, 0, tile);
        } else if (job < J5) { const int j = job - J4, lw = j / 2, kt = j % 2;
            transpose_tile(p.cmp_w2 + (size_t)lw * 128 * 64, 64, w2t + (size_t)lw * 64 * 128, 128, kt * 64, 0, 64, 0, tile);
        } else if (job < J6) {
            const int t_ = otid(); const int o = (job - J5) * 4 + (t_ >> 6), lane = t_ & 63, lw = o >> 7, hid = o & 127;
            const float* pos = p.cmp_pos + (size_t)lw * 2048; const float* w1 = p.cmp_w1 + (size_t)lw * 2048 * 128 + hid;
            float s = 0.f;
            for (int k = lane; k < 2048; k += 64) s += pos[k] * w1[(size_t)k * 128];
            s = wave_sum(s);
            if (lane == 0) ((float*)(p.ws + OFF_CBIAS))[o] = s;
        } else {
            const int e = (job - J6) * 256 + otid(), pos = e >> 3, i = e & 7;
            const float invf[8] = {1.0f, 0.1939227432012558f, 0.03760603070259094f, 0.007292664609849453f, 0.0014142135623842478f,
                                   0.00027424818836152554f, 5.318296098266728e-05f, 1.0313386155758053e-05f};
            float fr = 1.0f;
#pragma unroll
            for (int q = 0; q < 8; ++q) if (i == q) fr = invf[q];
            const float ang = (float)pos * fr;
            const double a = (double)ang; const double n = rint(a * 0.15915494309189535); const float rr = (float)(a - n * 6.283185307179586);
            float* rt = (float*)(p.ws + OFF_ROPE);
            rt[pos * 16 + i] = __cosf(rr); rt[pos * 16 + 8 + i] = __sinf(rr);
        }
    }
    norm_phase(p.x, p.norm1_g, (bf16_t*)(p.ws + OFF_ACT));
}

enum { EPI_PROJ = 0, EPI_WO = 1, EPI_UP = 2, EPI_DOWN = 3 };

DEVI void proj_epilogue(const Params& p, int L, const f32x4 (&acc)[4][4], int m0w, int cc, int lane) {
    const int quad = lane >> 4, l15 = lane & 15;
    bf16_t* proj = (bf16_t*)(p.ws + OFF_BIG); bf16_t* VT = (bf16_t*)(p.ws + OFF_BIG + OFF_VT_IN_BIG);
    float* gates = (float*)(p.ws + OFF_GATES); const float* rope = (const float*)(p.ws + OFF_ROPE);
    if (cc > 48) return;
    int kind = 0, vidx = 0; const float* gain = nullptr; float scale = 1.f; bool dorope = false;
    if (cc >= 8 && cc < 12) { kind = 5; vidx = cc - 8; }
    else if (cc >= 16 && cc < 24) { kind = 1; gain = p.nsa_qn_g + L * 64; scale = 0.125f; dorope = true; }
    else if (cc == 28 || cc == 29 || cc == 32 || cc == 33) { kind = 1; gain = p.nsa_kn_g + L * 64; dorope = true; }
    else if (cc == 30 || cc == 31) { kind = 5; vidx = 4 + (cc - 30); }
    else if (cc == 34 || cc == 35) { kind = 5; vidx = 6 + (cc - 34); }
    else if (cc >= 36 && cc < 40) { kind = 1; gain = p.fox_qn_g + L * 64; scale = 0.125f; }
    else if (cc >= 40 && cc < 44) { kind = 1; gain = p.fox_kn_g + L * 64; }
    else if (cc >= 44 && cc < 48) { kind = 5; vidx = 8 + (cc - 44); }
    else if (cc == 48) kind = 6;
#pragma unroll
    for (int mi = 0; mi < 4; ++mi) {
        const int token = m0w + mi * 16 + l15, pos = token & 4095, bb = token >> 12;
        float v[4][4];
#pragma unroll
        for (int ni = 0; ni < 4; ++ni)
#pragma unroll
            for (int j = 0; j < 4; ++j) v[ni][j] = acc[mi][ni][j];
        if (kind == 6) {
#pragma unroll
            for (int ni = 0; ni < 2; ++ni)
#pragma unroll
                for (int j = 0; j < 4; ++j) { const int d = ni * 16 + quad * 4 + j;
                    if (d < 24) gates[(size_t)token * 32 + d] = 1.0f / (1.0f + __expf(-v[ni][j]));
                    else if (d < 28) gates[(size_t)token * 32 + d] = v[ni][j]; }
            continue;
        }
        if (kind == 1) {
            float ss = 0.f;
#pragma unroll
            for (int ni = 0; ni < 4; ++ni)
#pragma unroll
                for (int j = 0; j < 4; ++j) ss += v[ni][j] * v[ni][j];
            ss += __shfl_xor(ss, 16); ss += __shfl_xor(ss, 32);
            const float r = rsqrtf(ss * (1.0f / 64.0f) + 1e-6f);
#pragma unroll
            for (int ni = 0; ni < 4; ++ni) { const float4 gg = *(const float4*)(gain + ni * 16 + quad * 4);
                v[ni][0] *= r * gg.x; v[ni][1] *= r * gg.y; v[ni][2] *= r * gg.z; v[ni][3] *= r * gg.w; }
            if (dorope) {
                const float4 cs = *(const float4*)(rope + pos * 16 + (quad & 1) * 4), sn = *(const float4*)(rope + pos * 16 + 8 + (quad & 1) * 4);
                const float cv[4] = {cs.x, cs.y, cs.z, cs.w}, sv[4] = {sn.x, sn.y, sn.z, sn.w};
#pragma unroll
                for (int j = 0; j < 4; ++j) { const float xx = v[0][j], pp = __shfl_xor(xx, 32);
                    v[0][j] = (quad < 2) ? (xx * cv[j] - pp * sv[j]) : (xx * cv[j] + pp * sv[j]); }
            }
#pragma unroll
            for (int ni = 0; ni < 4; ++ni)
#pragma unroll
                for (int j = 0; j < 4; ++j) v[ni][j] *= scale;
        }
        if (kind == 5) {
#pragma unroll
            for (int ni = 0; ni < 4; ++ni)
#pragma unroll
                for (int j = 0; j < 4; ++j) { const int d = ni * 16 + quad * 4 + j;
                    VT[((size_t)(vidx * 8 + bb) * 64 + d) * 4096 + pos] = f2bf(v[ni][j]); }
        } else {
#pragma unroll
            for (int ni = 0; ni < 4; ++ni) { uint2 o; o.x = pk2(v[ni][0], v[ni][1]); o.y = pk2(v[ni][2], v[ni][3]);
                *(uint2*)(proj + (size_t)token * PJ_LD + cc * 64 + ni * 16 + quad * 4) = o; }
        }
    }
}

DEVI void g_load(uint4 (&RA)[4], uint4 (&RB)[4], const bf16_t* Ap, const bf16_t* Bp, int K, int KT) {
#pragma unroll
    for (int i = 0; i < 4; ++i) { RA[i] = *(const uint4*)(Ap + (size_t)(32 * i) * K + KT * 64); RB[i] = *(const uint4*)(Bp + (size_t)(32 * i) * K + KT * 64); }
}
DEVI void g_swrite(const uint4 (&RA)[4], const uint4 (&RB)[4], char* d_) {
#pragma unroll
    for (int i = 0; i < 4; ++i) { *(uint4*)(d_ + i * 4096) = RA[i]; *(uint4*)(d_ + 16384 + i * 4096) = RB[i]; }
}
DEVI void g_compute(const char* sA, f32x4 (&acc)[4][4], int wm, int wn, int quad, int l15) {
    const char* sB = sA + 16384;
#pragma unroll
    for (int ks = 0; ks < 2; ++ks) {
        bf16x8 af[4], bfr[4]; const int ch = ks * 4 + quad;
#pragma unroll
        for (int mi = 0; mi < 4; ++mi) { const int row = wm * 64 + mi * 16 + l15; af[mi] = *(const bf16x8*)(sA + row * 128 + ((ch ^ (row & 7)) << 4)); }
#pragma unroll
        for (int ni = 0; ni < 4; ++ni) { const int row = wn * 64 + ni * 16 + l15; bfr[ni] = *(const bf16x8*)(sB + row * 128 + ((ch ^ (row & 7)) << 4)); }
#pragma unroll
        for (int mi = 0; mi < 4; ++mi)
#pragma unroll
            for (int ni = 0; ni < 4; ++ni) acc[mi][ni] = mfma(bfr[ni], af[mi], acc[mi][ni]);
    }
}

template <int EPI>
__device__ void gemm_phase(const Params& p, int L, char* lds) {
    const bf16_t* A; const bf16_t* Bt; int K, nNt;
    if (EPI == EPI_PROJ) { A = (const bf16_t*)(p.ws + OFF_ACT); Bt = (const bf16_t*)(p.ws + OFF_WIN) + (size_t)L * NW_IN_PAD * 1024; K = 1024; nNt = 25; }
    else if (EPI == EPI_WO) { A = (const bf16_t*)(p.ws + OFF_ACT); Bt = (const bf16_t*)(p.ws + OFF_WO) + (size_t)L * 1024 * 1024; K = 1024; nNt = 8; }
    else if (EPI == EPI_UP) { A = (const bf16_t*)(p.ws + OFF_ACT); Bt = (const bf16_t*)(p.ws + OFF_WUP) + (size_t)L * 4096 * 1024; K = 1024; nNt = 32; }
    else { A = (const bf16_t*)(p.ws + OFF_BIG); Bt = (const bf16_t*)(p.ws + OFF_WDN) + (size_t)L * 1024 * 4096; K = 4096; nNt = 8; }
    const int tid = otid(), lane = tid & 63, w = tid >> 6, quad = lane >> 4, l15 = lane & 15, wm = w >> 1, wn = w & 1;
    const int xcd = blockIdx.x & 7, loc = blockIdx.x >> 3, nloc = gridDim.x >> 3;
    const int nk = K / 64;
    for (int it = loc; it < 32 * nNt; it += nloc) {
        const int m0 = (xcd + 8 * (it / nNt)) * 128, n0 = (it % nNt) * 128;
        f32x4 acc[4][4];
#pragma unroll
        for (int a = 0; a < 4; ++a)
#pragma unroll
            for (int b = 0; b < 4; ++b) acc[a][b] = (f32x4){0.f, 0.f, 0.f, 0.f};
        u32x16 ra0, rb0, ra1, rb1;
        const int lrow = tid >> 3, lc = tid & 7;
        const bf16_t* Ap = A + (size_t)(m0 + lrow) * K + lc * 8;
        const bf16_t* Bp = Bt + (size_t)(n0 + lrow) * K + lc * 8;
        const int woff = lrow * 128 + ((lc ^ (lrow & 7)) << 4);
#define G_LD1(R, P, I, KT) { const uint4 t_ = *(const uint4*)((P) + (size_t)(32 * I) * K + (KT) * 64); R[4 * I] = t_.x; R[4 * I + 1] = t_.y; R[4 * I + 2] = t_.z; R[4 * I + 3] = t_.w; }
#define G_LOAD(RA, RB, KT) { G_LD1(RA, Ap, 0, KT) G_LD1(RB, Bp, 0, KT) G_LD1(RA, Ap, 1, KT) G_LD1(RB, Bp, 1, KT) G_LD1(RA, Ap, 2, KT) G_LD1(RB, Bp, 2, KT) G_LD1(RA, Ap, 3, KT) G_LD1(RB, Bp, 3, KT) }
#define G_SW1(R, D, I) *(uint4*)((D) + I * 4096) = make_uint4(R[4 * I], R[4 * I + 1], R[4 * I + 2], R[4 * I + 3]);
#define G_SWRITE(RA, RB, DST) { G_SW1(RA, DST, 0) G_SW1(RB, (DST) + 16384, 0) G_SW1(RA, DST, 1) G_SW1(RB, (DST) + 16384, 1) G_SW1(RA, DST, 2) G_SW1(RB, (DST) + 16384, 2) G_SW1(RA, DST, 3) G_SW1(RB, (DST) + 16384, 3) }
        G_LOAD(ra0, rb0, 0)
        G_LOAD(ra1, rb1, 1)
        G_SWRITE(ra0, rb0, lds + woff)
        __syncthreads();
#pragma unroll 1
        for (int kt = 0; kt < nk - 2; kt += 2) {
            G_LOAD(ra0, rb0, kt + 2)
            __builtin_amdgcn_sched_barrier(0);
            g_compute(lds, acc, wm, wn, quad, l15);
            G_SWRITE(ra1, rb1, lds + 32768 + woff)
            __syncthreads();
            G_LOAD(ra1, rb1, kt + 3)
            __builtin_amdgcn_sched_barrier(0);
            g_compute(lds + 32768, acc, wm, wn, quad, l15);
            G_SWRITE(ra0, rb0, lds + woff)
            __syncthreads();
        }
        g_compute(lds, acc, wm, wn, quad, l15);
        G_SWRITE(ra1, rb1, lds + 32768 + woff)
        __syncthreads();
        g_compute(lds + 32768, acc, wm, wn, quad, l15);
        __syncthreads();
#undef G_LOAD
#undef G_SWRITE
#undef G_LD1
#undef G_SW1
        if (EPI == EPI_PROJ) {
            proj_epilogue(p, L, acc, m0 + wm * 64, (n0 + wn * 64) >> 6, lane);
        } else if (EPI == EPI_UP) {
            bf16_t* hid = (bf16_t*)(p.ws + OFF_BIG);
#pragma unroll
            for (int mi = 0; mi < 4; ++mi)
#pragma unroll
                for (int ni = 0; ni < 4; ++ni) { const int m = m0 + wm * 64 + mi * 16 + l15, n = n0 + wn * 64 + ni * 16 + quad * 4;
                    float a0 = fmaxf(acc[mi][ni][0], 0.f), a1 = fmaxf(acc[mi][ni][1], 0.f), a2 = fmaxf(acc[mi][ni][2], 0.f), a3 = fmaxf(acc[mi][ni][3], 0.f);
                    uint2 o; o.x = pk2(a0 * a0, a1 * a1); o.y = pk2(a2 * a2, a3 * a3);
                    *(uint2*)(hid + (size_t)m * DFF + n) = o; }
        } else {
            const float* xin = (EPI == EPI_WO && L == 0) ? p.x : p.out;
#pragma unroll
            for (int mi = 0; mi < 4; ++mi)
#pragma unroll
                for (int ni = 0; ni < 4; ++ni) { const int m = m0 + wm * 64 + mi * 16 + l15, n = n0 + wn * 64 + ni * 16 + quad * 4;
                    float4 xv = *(const float4*)(xin + (size_t)m * DM + n);
                    xv.x += acc[mi][ni][0]; xv.y += acc[mi][ni][1]; xv.z += acc[mi][ni][2]; xv.w += acc[mi][ni][3];
                    *(float4*)(p.out + (size_t)m * DM + n) = xv; }
        }
    }
}

DEVI float hgrn_lb(const Params& p, int L, int hk) {
    if (L == 0) return 0.f;
    const float l0 = p.lb_logits[hk], l1 = p.lb_logits[256 + hk];
    return 1.0f / (1.0f + __expf(l0 - l1));
}

__device__ void hgrn_a_unit(const Params& p, int L, int u, char* lds) {
    const int tid = otid(), lane = tid & 63, w = tid >> 6, quad = lane >> 4, l15 = lane & 15;
    const int c = u & 63, h = (u >> 6) & 3, b = u >> 8;
    const bf16_t* proj = (const bf16_t*)(p.ws + OFF_BIG); const bf16_t* VT = (const bf16_t*)(p.ws + OFF_BIG + OFF_VT_IN_BIG);
    float* segtot = (float*)lds;
    bf16_t* KDt = (bf16_t*)(lds + 1024);
    const int k = tid & 63, seg = tid >> 6;
    const float lb = hgrn_lb(p, L, h * 64 + k);
    float gl[16], kkv[16]; float run = 0.f;
    const bf16_t* zp = proj + (size_t)(b * 4096 + c * 64 + seg * 16) * PJ_LD + 256 + h * 64 + k;
#pragma unroll
    for (int i = 0; i < 16; ++i) {
        const float z = bf2f(zp[(size_t)i * PJ_LD]);
        const float sg = 1.0f / (1.0f + __expf(-z)), sn = 1.0f / (1.0f + __expf(z));
        const float f = lb + (1.0f - lb) * sg;
        run += __logf(fmaxf(f, 1e-30f)); gl[i] = run; kkv[i] = (1.0f - lb) * sn;
    }
    segtot[seg * 64 + k] = run;
    __syncthreads();
    float off = 0.f, tot = 0.f;
#pragma unroll
    for (int s = 0; s < 4; ++s) { const float t = segtot[s * 64 + k]; tot += t; if (s < seg) off += t; }
    unsigned pkd[8];
#pragma unroll
    for (int i = 0; i < 8; ++i) {
        const float a0 = kkv[2 * i] * __expf(tot - (off + gl[2 * i])), a1 = kkv[2 * i + 1] * __expf(tot - (off + gl[2 * i + 1]));
        pkd[i] = pk2(a0, a1);
    }
    *(uint4*)(KDt + k * 72 + seg * 16) = make_uint4(pkd[0], pkd[1], pkd[2], pkd[3]);
    *(uint4*)(KDt + k * 72 + seg * 16 + 8) = make_uint4(pkd[4], pkd[5], pkd[6], pkd[7]);
    if (seg == 0) ((float*)(p.ws + OFF_DECAY))[u * 64 + k] = __expf(tot);
    __syncthreads();
    const bf16_t* vt = VT + ((size_t)(h * 8 + b) * 64) * 4096 + c * 64;
    float* kvt = (float*)(p.ws + OFF_KVT) + (size_t)u * 4096;
    bf16x8 af[2];
#pragma unroll
    for (int ks = 0; ks < 2; ++ks) af[ks] = ld8(vt + (size_t)(w * 16 + l15) * 4096 + ks * 32 + quad * 8);
#pragma unroll
    for (int kt = 0; kt < 4; ++kt) {
        f32x4 acc = (f32x4){0.f, 0.f, 0.f, 0.f};
#pragma unroll
        for (int ks = 0; ks < 2; ++ks) { const bf16x8 bfr = *(const bf16x8*)(KDt + (kt * 16 + l15) * 72 + ks * 32 + quad * 8); acc = mfma(af[ks], bfr, acc); }
#pragma unroll
        for (int j = 0; j < 4; ++j) kvt[(w * 16 + quad * 4 + j) * 64 + kt * 16 + l15] = acc[j];
    }
    __syncthreads();
}

__device__ void hgrn_scan_phase(const Params& p) {
    const float* kvt = (const float*)(p.ws + OFF_KVT); const float* dec = (const float*)(p.ws + OFF_DECAY);
    bf16_t* st = (bf16_t*)(p.ws + OFF_ST);
    for (int e = blockIdx.x * 256 + otid(); e < 32 * 4096; e += gridDim.x * 256) {
        const int bh = e >> 12, vk = e & 4095, k = vk & 63;
        float S = 0.f;
#pragma unroll 8
        for (int c = 0; c < 64; ++c) {
            const int u = bh * 64 + c;
            st[(size_t)u * 4096 + vk] = f2bf(S);
            S = S * dec[u * 64 + k] + kvt[(size_t)u * 4096 + vk];
        }
    }
}

__device__ void hgrn_c_unit(const Params& p, int L, int u, char* lds) {
    const int tid = otid(), lane = tid & 63, w = tid >> 6, quad = lane >> 4, l15 = lane & 15;
    const int c = u & 63, h = (u >> 6) & 3, b = u >> 8;
    const bf16_t* proj = (const bf16_t*)(p.ws + OFF_BIG); const bf16_t* VT = (const bf16_t*)(p.ws + OFF_BIG + OFF_VT_IN_BIG);
    float* Gs = (float*)lds; float* KKs = Gs + 64 * 65; float* Qs = KKs + 64 * 65; float* segtot = Qs + 64 * 65;
    {
        const int k = tid & 63, seg = tid >> 6;
        const float lb = hgrn_lb(p, L, h * 64 + k);
        float gl[16], kkv[16]; float run = 0.f;
        const bf16_t* zp = proj + (size_t)(b * 4096 + c * 64 + seg * 16) * PJ_LD + 256 + h * 64 + k;
#pragma unroll
        for (int i = 0; i < 16; ++i) {
            const float z = bf2f(zp[(size_t)i * PJ_LD]);
            const float sg = 1.0f / (1.0f + __expf(-z)), sn = 1.0f / (1.0f + __expf(z));
            const float f = lb + (1.0f - lb) * sg;
            run += __logf(fmaxf(f, 1e-30f)); gl[i] = run; kkv[i] = (1.0f - lb) * sn;
            Qs[(seg * 16 + i) * 65 + k] = bf2f(zp[(size_t)i * PJ_LD - 256]) * 0.125f;
        }
        segtot[seg * 64 + k] = run;
        __syncthreads();
        float off = 0.f;
#pragma unroll
        for (int s = 0; s < 4; ++s) { const float t = segtot[s * 64 + k]; if (s < seg) off += t; }
#pragma unroll
        for (int i = 0; i < 16; ++i) { Gs[(seg * 16 + i) * 65 + k] = off + gl[i]; KKs[(seg * 16 + i) * 65 + k] = kkv[i]; }
        __syncthreads();
    }
    const int I = w;
    const int tq = 16 * I + l15;
    bf16x8 qt[2], qg[2];
#pragma unroll
    for (int ks = 0; ks < 2; ++ks) {
        float a[8], g8[8];
#pragma unroll
        for (int j = 0; j < 8; ++j) {
            const int k = ks * 32 + quad * 8 + j;
            const float G = Gs[tq * 65 + k], q = Qs[tq * 65 + k];
            const float gref = (I == 0) ? 0.f : Gs[(16 * I - 1) * 65 + k];
            a[j] = q * __expf(G - gref); g8[j] = q * __expf(G);
        }
        qt[ks] = mk8(pk2(a[0], a[1]), pk2(a[2], a[3]), pk2(a[4], a[5]), pk2(a[6], a[7]));
        qg[ks] = mk8(pk2(g8[0], g8[1]), pk2(g8[2], g8[3]), pk2(g8[4], g8[5]), pk2(g8[6], g8[7]));
    }
    f32x4 O[4];
#pragma unroll
    for (int vt = 0; vt < 4; ++vt) O[vt] = (f32x4){0.f, 0.f, 0.f, 0.f};
    const bf16_t* st = (const bf16_t*)(p.ws + OFF_ST) + (size_t)u * 4096;
#pragma unroll
    for (int vt = 0; vt < 4; ++vt)
#pragma unroll
        for (int ks = 0; ks < 2; ++ks) O[vt] = mfma(ld8(st + (vt * 16 + l15) * 64 + ks * 32 + quad * 8), qg[ks], O[vt]);
    const bf16_t* vtp = VT + ((size_t)(h * 8 + b) * 64) * 4096 + c * 64;
    for (int Jp = 0; Jp <= (I >> 1); ++Jp) {
        f32x4 sc[2];
#pragma unroll
        for (int jj = 0; jj < 2; ++jj) {
            const int J = 2 * Jp + jj;
            sc[jj] = (f32x4){0.f, 0.f, 0.f, 0.f};
            if (J <= I) {
                const int s = 16 * J + l15;
#pragma unroll
                for (int ks = 0; ks < 2; ++ks) {
                    float a[8];
#pragma unroll
                    for (int j = 0; j < 8; ++j) {
                        const int k = ks * 32 + quad * 8 + j;
                        const float gref = (I == 0) ? 0.f : Gs[(16 * I - 1) * 65 + k];
                        a[j] = KKs[s * 65 + k] * __expf(gref - Gs[s * 65 + k]);
                    }
                    sc[jj] = mfma(mk8(pk2(a[0], a[1]), pk2(a[2], a[3]), pk2(a[4], a[5]), pk2(a[6], a[7])), qt[ks], sc[jj]);
                }
#pragma unroll
                for (int j = 0; j < 4; ++j) { const int s2 = 16 * J + quad * 4 + j; if (s2 > tq) sc[jj][j] = 0.f; }
            }
        }
        const bf16x8 P = mk8(pk2(sc[0][0], sc[0][1]), pk2(sc[0][2], sc[0][3]), pk2(sc[1][0], sc[1][1]), pk2(sc[1][2], sc[1][3]));
#pragma unroll
        for (int vt = 0; vt < 4; ++vt) {
            const bf16_t* r = vtp + (size_t)(vt * 16 + l15) * 4096 + 32 * Jp + quad * 4;
            O[vt] = mfma(ld4x2(r, r + 16), P, O[vt]);
        }
    }
    float ss = 0.f;
#pragma unroll
    for (int vt = 0; vt < 4; ++vt)
#pragma unroll
        for (int j = 0; j < 4; ++j) ss += O[vt][j] * O[vt][j];
    ss += __shfl_xor(ss, 16); ss += __shfl_xor(ss, 32);
    const float r = rsqrtf(ss * (1.0f / 64.0f) + 1e-6f);
    const size_t token = (size_t)b * 4096 + c * 64 + tq;
    bf16_t* mix = (bf16_t*)(p.ws + OFF_ACT);
#pragma unroll
    for (int vt = 0; vt < 4; ++vt) {
        const int v0 = vt * 16 + quad * 4;
        const float4 og = *(const float4*)(p.onorm_g + L * 64 + v0);
        const uint2 gz = *(const uint2*)(proj + token * PJ_LD + 768 + h * 64 + v0);
        const float g0 = bflo(gz.x), g1 = bfhi(gz.x), g2 = bflo(gz.y), g3 = bfhi(gz.y);
        const float o0 = O[vt][0] * r * og.x * (g0 / (1.0f + __expf(-g0))), o1 = O[vt][1] * r * og.y * (g1 / (1.0f + __expf(-g1)));
        const float o2 = O[vt][2] * r * og.z * (g2 / (1.0f + __expf(-g2))), o3 = O[vt][3] * r * og.w * (g3 / (1.0f + __expf(-g3)));
        uint2 o; o.x = pk2(o0, o1); o.y = pk2(o2, o3);
        *(uint2*)(mix + token * DM + h * 64 + v0) = o;
    }
    __syncthreads();
}

__device__ void compress_unit(const Params& p, int L, int u, char* lds) {
    const int tid = otid(), lane = tid & 63, w = tid >> 6, quad = lane >> 4, l15 = lane & 15;
    const int which = u & 1, g = (u >> 1) & 1, b = (u >> 2) & 7, ntile = u >> 5;
    const bf16_t* proj = (const bf16_t*)(p.ws + OFF_BIG);
    const bf16_t* w1t = (const bf16_t*)(p.ws + OFF_W1T) + (size_t)(L * 2 + which) * 128 * 2048;
    const bf16_t* w2t = (const bf16_t*)(p.ws + OFF_W2T) + (size_t)(L * 2 + which) * 64 * 128;
    const float* cbias = (const float*)(p.ws + OFF_CBIAS) + (L * 2 + which) * 128;
    bf16_t* Hs = (bf16_t*)lds + w * 16 * 136;
    const int nrow = ntile * 64 + w * 16 + l15;
    int tokbase = 16 * nrow; if (tokbase > 4096 - 32) tokbase = 4096 - 32;
    const bf16_t* xa = proj + ((size_t)b * 4096 + tokbase) * PJ_LD + (which ? 1664 : 1536) + g * 64;
    f32x4 acc[8];
#pragma unroll
    for (int i = 0; i < 8; ++i) acc[i] = (f32x4){0.f, 0.f, 0.f, 0.f};
    for (int kk = 0; kk < 64; ++kk) {
        const int l = kk >> 1, d = (kk & 1) * 32 + quad * 8;
        const bf16x8 a = ld8(xa + (size_t)l * PJ_LD + d);
#pragma unroll
        for (int ni = 0; ni < 8; ++ni) acc[ni] = mfma(a, ld8(w1t + (size_t)(ni * 16 + l15) * 2048 + kk * 32 + quad * 8), acc[ni]);
    }
#pragma unroll
    for (int ni = 0; ni < 8; ++ni) { const float bsv = cbias[ni * 16 + l15];
#pragma unroll
        for (int j = 0; j < 4; ++j) { const float x = acc[ni][j] + bsv;
            const float uu = 0.7978845608028654f * (x + 0.044715f * x * x * x);
            const float th = 1.0f - 2.0f / (1.0f + __expf(2.0f * uu));
            Hs[(quad * 4 + j) * 136 + ni * 16 + l15] = f2bf(0.5f * x * (1.0f + th)); } }
    __syncthreads();
    f32x4 o[4];
#pragma unroll
    for (int i = 0; i < 4; ++i) o[i] = (f32x4){0.f, 0.f, 0.f, 0.f};
#pragma unroll
    for (int ks = 0; ks < 4; ++ks) { const bf16x8 a = *(const bf16x8*)(Hs + l15 * 136 + ks * 32 + quad * 8);
#pragma unroll
        for (int ni = 0; ni < 4; ++ni) o[ni] = mfma(a, ld8(w2t + (size_t)(ni * 16 + l15) * 128 + ks * 32 + quad * 8), o[ni]); }
    const int nb = ntile * 64 + w * 16 + quad * 4;
    if (which == 0) {
        bf16_t* kc = (bf16_t*)(p.ws + OFF_KC) + (size_t)(b * 2 + g) * 256 * 64;
        const float* rope = (const float*)(p.ws + OFF_ROPE);
#pragma unroll
        for (int j = 0; j < 4; ++j) {
            const int n = nb + j;
            float ss = o[0][j] * o[0][j] + o[1][j] * o[1][j] + o[2][j] * o[2][j] + o[3][j] * o[3][j];
            ss += __shfl_xor(ss, 1); ss += __shfl_xor(ss, 2); ss += __shfl_xor(ss, 4); ss += __shfl_xor(ss, 8);
            const float r = rsqrtf(ss * (1.0f / 64.0f) + 1e-6f);
            float v[4];
#pragma unroll
            for (int ni = 0; ni < 4; ++ni) v[ni] = o[ni][j] * r * p.nsa_kn_g[L * 64 + ni * 16 + l15];
            int pos = 16 * n + 31; if (pos > 4095) pos = 4095;
            const float cs = rope[pos * 16 + (l15 & 7)], sn = rope[pos * 16 + 8 + (l15 & 7)];
            const float pp = __shfl_xor(v[0], 8);
            v[0] = (l15 < 8) ? (v[0] * cs - pp * sn) : (v[0] * cs + pp * sn);
#pragma unroll
            for (int ni = 0; ni < 4; ++ni) kc[(size_t)n * 64 + ni * 16 + l15] = (n < 255) ? f2bf(v[ni]) : (bf16_t)0;
        }
    } else {
        bf16_t* vct = (bf16_t*)(p.ws + OFF_VCT) + (size_t)(b * 2 + g) * 64 * 256;
#pragma unroll
        for (int ni = 0; ni < 4; ++ni) {
            float v0 = o[ni][0], v1 = o[ni][1], v2 = o[ni][2], v3 = o[ni][3];
            if (nb + 3 >= 255) v3 = 0.f;
            uint2 ov; ov.x = pk2(v0, v1); ov.y = pk2(v2, v3);
            *(uint2*)(vct + (size_t)(ni * 16 + l15) * 256 + nb) = ov;
        }
    }
    __syncthreads();
}

__device__ void foxc_job(const Params& p, int L, int bh) {
    const int lane = otid() & 63, b = bh >> 2, h = bh & 3;
    const float* gates = (const float*)(p.ws + OFF_GATES);
    float* cc = (float*)(p.ws + OFF_FOXC) + (size_t)bh * 4096;
    const float fb = p.fox_fb[L * 4 + h];
    float run = 0.f;
    for (int i = 0; i < 64; ++i) {
        const float x = gates[((size_t)b * 4096 + lane * 64 + i) * 32 + 24 + h] + fb;
        run += (x >= 0.f) ? -log1pf(__expf(-x)) : (x - log1pf(__expf(x)));
    }
    float incl = run;
#pragma unroll
    for (int o = 1; o < 64; o <<= 1) { const float t = __shfl_up(incl, o); if (lane >= o) incl += t; }
    float acc = incl - run;
    for (int i = 0; i < 64; ++i) {
        const float x = gates[((size_t)b * 4096 + lane * 64 + i) * 32 + 24 + h] + fb;
        acc += (x >= 0.f) ? -log1pf(__expf(-x)) : (x - log1pf(__expf(x)));
        cc[lane * 64 + i] = acc;
    }
}

constexpr int KV_BUF = 16384;
typedef __attribute__((address_space(3))) unsigned* ldsp_t;
DEVI void tile_glds(const bf16_t* Kg, int ldk, const bf16_t* Vg, int ldv, char* buf, int tid) {
    const int w = tid >> 6, i = tid & 63;
#pragma unroll
    for (int jj = 0; jj < 2; ++jj) {
        const int j = w * 2 + jj, row = 8 * j + (i >> 3), slot = i & 7;
        const bf16_t* kp = Kg + (size_t)row * ldk + ((slot ^ (row & 7)) << 3);
        const bf16_t* vp = Vg + (size_t)row * ldv + ((slot ^ ((row >> 1) & 7)) << 3);
        __builtin_amdgcn_global_load_lds((const unsigned*)kp, (ldsp_t)(unsigned)(size_t)(buf + j * 1024), 16, 0, 0);
        __builtin_amdgcn_global_load_lds((const unsigned*)vp, (ldsp_t)(unsigned)(size_t)(buf + 8192 + j * 1024), 16, 0, 0);
    }
}
DEVI void lds_kf(const char* buf, int kh, int lane, bf16x8 (&kf)[2][2]) {
    const int quad = lane >> 4, l15 = lane & 15;
#pragma unroll
    for (int t2 = 0; t2 < 2; ++t2)
#pragma unroll
        for (int ks = 0; ks < 2; ++ks) { const int row = kh * 32 + t2 * 16 + l15, ch = ks * 4 + quad; kf[t2][ks] = *(const bf16x8*)(buf + row * 128 + ((ch ^ (row & 7)) << 4)); }
}
DEVI void lds_vf(const char* buf, int kh, int lane, bf16x8 (&vf)[4]) {
    const int quad = lane >> 4, l15 = lane & 15;
#pragma unroll
    for (int dt = 0; dt < 4; ++dt) { const int d = dt * 16 + l15, u0 = kh * 8 + quad, u1 = u0 + 4;
        const uint2 a = *(const uint2*)(buf + 8192 + d * 128 + ((u0 ^ (d & 14)) << 3)), b = *(const uint2*)(buf + 8192 + d * 128 + ((u1 ^ (d & 14)) << 3));
        vf[dt] = mk8(a.x, a.y, b.x, b.y); }
}

template <class MaskF>
DEVI void attn_block64(const char* buf, int kbase, const char* ql, int q0o, int q1o, int qstride, const float* cb, f32x4 (&O)[4][4], float (&m)[4], float (&l)[4], int lane, MaskF maskf) {
    const int quad = lane >> 4;
#pragma unroll
    for (int kh = 0; kh < 2; ++kh) {
        bf16x8 kf[2][2], vf[4];
        lds_kf(buf, kh, lane, kf); lds_vf(buf, kh, lane, vf);
        float ck[8] = {0.f, 0.f, 0.f, 0.f, 0.f, 0.f, 0.f, 0.f};
        if (cb) { const float4 c0 = *(const float4*)(cb + kbase + kh * 32 + quad * 4), c1 = *(const float4*)(cb + kbase + kh * 32 + 16 + quad * 4);
            ck[0] = c0.x; ck[1] = c0.y; ck[2] = c0.z; ck[3] = c0.w; ck[4] = c1.x; ck[5] = c1.y; ck[6] = c1.z; ck[7] = c1.w; }
#pragma unroll
        for (int nt = 0; nt < 4; ++nt) {
            f32x4 s0 = (f32x4){0.f, 0.f, 0.f, 0.f}, s1 = s0;
            { const bf16x8 qa = *(const bf16x8*)(ql + nt * qstride + q0o), qb_ = *(const bf16x8*)(ql + nt * qstride + q1o);
              s0 = mfma(kf[0][0], qa, s0); s1 = mfma(kf[1][0], qa, s1); s0 = mfma(kf[0][1], qb_, s0); s1 = mfma(kf[1][1], qb_, s1); }
            float sv[8]; bool ok[8]; float mx = -1e30f;
#pragma unroll
            for (int e = 0; e < 8; ++e) { sv[e] = (e < 4) ? s0[e & 3] : s1[e & 3]; const int key = kbase + kh * 32 + (e >> 2) * 16 + quad * 4 + (e & 3);
                ok[e] = maskf(nt, ck[e], key, sv[e]); if (ok[e]) mx = fmaxf(mx, sv[e]); }
            mx = fmaxf(mx, __shfl_xor(mx, 16)); mx = fmaxf(mx, __shfl_xor(mx, 32));
            const float mn = fmaxf(m[nt], mx), alpha = __expf(m[nt] - mn);
            float pv[8]; float rs = 0.f;
#pragma unroll
            for (int e = 0; e < 8; ++e) { pv[e] = ok[e] ? __expf(sv[e] - mn) : 0.f; rs += pv[e]; }
            rs += __shfl_xor(rs, 16); rs += __shfl_xor(rs, 32);
            l[nt] = l[nt] * alpha + rs; m[nt] = mn;
            const bf16x8 P = mk8(pk2(pv[0], pv[1]), pk2(pv[2], pv[3]), pk2(pv[4], pv[5]), pk2(pv[6], pv[7]));
#pragma unroll
            for (int dt = 0; dt < 4; ++dt) { O[dt][nt] = O[dt][nt] * alpha; O[dt][nt] = mfma(vf[dt], P, O[dt][nt]); }
        }
    }
}

template <class MaskF>
DEVI void attn_stream(u64 tiles, const bf16_t* Kbase, int ldk, const bf16_t* Vbase, int ldv, char* kvbuf, int jb_wave_max,
                      const char* ql, int q0o, int q1o, int qstride, const float* cb, f32x4 (&O)[4][4], float (&m)[4], float (&l)[4], int tid, int lane, MaskF maskf) {
    if (tiles == 0ull) return;
    int jb = __ffsll((long long)tiles) - 1; tiles &= tiles - 1;
    tile_glds(Kbase + (size_t)jb * 64 * ldk, ldk, Vbase + jb * 64, ldv, kvbuf, tid);
    __syncthreads();
    int cur = 0;
#pragma unroll 1
    for (;;) {
        const bool more = tiles != 0ull;
        int jbn = 0;
        if (more) { jbn = __ffsll((long long)tiles) - 1; tiles &= tiles - 1; tile_glds(Kbase + (size_t)jbn * 64 * ldk, ldk, Vbase + jbn * 64, ldv, kvbuf + (cur ^ 1) * KV_BUF, tid); }
        if (jb <= jb_wave_max) attn_block64(kvbuf + cur * KV_BUF, jb * 64, ql, q0o, q1o, qstride, cb, O, m, l, lane, [&](int nt, float ckv, int key, float& s) { return maskf(nt, ckv, key, jb, s); });
        __syncthreads();
        if (!more) break;
        jb = jbn; cur ^= 1;
    }
}

DEVI void attn_store2(bf16_t* mix, size_t token0, int tokstride, int col0, int colstride, const f32x4 (&O)[4][4], const float (&sc)[4], int lane, bool accum) {
    const int quad = lane >> 4, l15 = lane & 15;
#pragma unroll
    for (int nt = 0; nt < 4; ++nt)
#pragma unroll
        for (int dt = 0; dt < 4; ++dt) {
            bf16_t* dst = mix + (token0 + nt * tokstride + l15) * DM + col0 + nt * colstride + dt * 16 + quad * 4;
            float a0 = O[dt][nt][0] * sc[nt], a1 = O[dt][nt][1] * sc[nt], a2 = O[dt][nt][2] * sc[nt], a3 = O[dt][nt][3] * sc[nt];
            if (accum) { const uint2 old = *(const uint2*)dst; a0 += bflo(old.x); a1 += bfhi(old.x); a2 += bflo(old.y); a3 += bfhi(old.y); }
            uint2 o; o.x = pk2(a0, a1); o.y = pk2(a2, a3);
            *(uint2*)dst = o;
        }
}

__device__ void nsa_unit(const Params& p, int L, int b, int g, int blk, char* lds) {
    const int tid = otid(), lane = tid & 63, w = tid >> 6, quad = lane >> 4, l15 = lane & 15;
    const bf16_t* proj = (const bf16_t*)(p.ws + OFF_BIG); const bf16_t* VT = (const bf16_t*)(p.ws + OFF_BIG + OFF_VT_IN_BIG);
    const float* gates = (const float*)(p.ws + OFF_GATES);
    bf16_t* mix = (bf16_t*)(p.ws + OFF_ACT);
    char* kvbuf = lds; float* impL = (float*)(lds + KV_BUF)  ; char* Qs = lds + 32768; u64* selm = (u64*)(lds + 65536);
    const int q0 = blk * 64; const int tq = q0 + w * 16 + l15; const size_t token = (size_t)b * 4096 + tq;
    const size_t token0 = (size_t)b * 4096 + q0 + w * 16;
    const int mixcol = 256 + g * 256;
#pragma unroll
    for (int t = 0; t < 8; ++t) { const int idx = t * 64 + lane, rr = idx >> 3, c = idx & 7, hh = rr >> 4, r16 = rr & 15;
        const uint4 v = *(const uint4*)(proj + (token0 + r16) * PJ_LD + 1024 + (g * 4 + hh) * 64 + c * 8);
        *(uint4*)(Qs + (hh * 64 + w * 16 + r16) * 128 + ((c ^ (r16 & 7)) << 4)) = v; }
    const char* ql = Qs + (w * 16 + l15) * 128; const int q0o = ((quad) ^ (l15 & 7)) << 4, q1o = ((4 + quad) ^ (l15 & 7)) << 4; const int qstride = 8192;
    __syncthreads();
    f32x4 O[4][4]; float m[4], l[4];
    const bf16_t* Kc = (const bf16_t*)(p.ws + OFF_KC) + (size_t)(b * 2 + g) * 256 * 64;
    const bf16_t* VcT = (const bf16_t*)(p.ws + OFF_VCT) + (size_t)(b * 2 + g) * 64 * 256;
    const int ncb = (4 * blk + 3 + 63) >> 6;
#pragma unroll
    for (int nt = 0; nt < 4; ++nt) { m[nt] = -1e30f; l[nt] = 0.f; }
    {
#pragma unroll 1
        for (int pass = 0; pass < 2; ++pass) {
            float inv[4]; float prevr = 0.f;
            if (pass == 1) {
#pragma unroll
                for (int nt = 0; nt < 4; ++nt) inv[nt] = 1.0f / fmaxf(l[nt], 1e-30f);
#pragma unroll
                for (int dt = 0; dt < 4; ++dt)
#pragma unroll
                    for (int nt = 0; nt < 4; ++nt) O[dt][nt] = (f32x4){0.f, 0.f, 0.f, 0.f};
            }
#pragma unroll 1
            for (int ct = 0; ct < ncb; ++ct) {
                tile_glds(Kc + (size_t)ct * 64 * 64, 64, VcT + ct * 64, 256, kvbuf, tid);
                __syncthreads();
                const char* buf = kvbuf;
#pragma unroll
                for (int kh = 0; kh < 2; ++kh) {
                    bf16x8 kf[2][2]; lds_kf(buf, kh, lane, kf);
                    if (pass == 0) {
#pragma unroll
                        for (int nt = 0; nt < 4; ++nt) {
                            f32x4 s0 = (f32x4){0.f, 0.f, 0.f, 0.f}, s1 = s0;
                            { const bf16x8 qa = *(const bf16x8*)(ql + nt * qstride + q0o), qb_ = *(const bf16x8*)(ql + nt * qstride + q1o);
                              s0 = mfma(kf[0][0], qa, s0); s1 = mfma(kf[1][0], qa, s1); s0 = mfma(kf[0][1], qb_, s0); s1 = mfma(kf[1][1], qb_, s1); }
                            float sv[8]; bool ok[8]; float mx = -1e30f;
#pragma unroll
                            for (int e = 0; e < 8; ++e) { sv[e] = (e < 4) ? s0[e & 3] : s1[e & 3]; const int n = ct * 64 + kh * 32 + (e >> 2) * 16 + quad * 4 + (e & 3);
                                ok[e] = (16 * n + 31 <= tq); if (ok[e]) mx = fmaxf(mx, sv[e]); }
                            mx = fmaxf(mx, __shfl_xor(mx, 16)); mx = fmaxf(mx, __shfl_xor(mx, 32));
                            const float mn = fmaxf(m[nt], mx), alpha = __expf(m[nt] - mn);
                            float rs = 0.f;
#pragma unroll
                            for (int e = 0; e < 8; ++e) rs += ok[e] ? __expf(sv[e] - mn) : 0.f;
                            rs += __shfl_xor(rs, 16); rs += __shfl_xor(rs, 32);
                            l[nt] = l[nt] * alpha + rs; m[nt] = mn;
                        }
                    } else {
                        bf16x8 vf[4]; lds_vf(buf, kh, lane, vf);
                        float As[2] = {0.f, 0.f}, p3[2] = {0.f, 0.f};
#pragma unroll
                        for (int nt = 0; nt < 4; ++nt) {
                            f32x4 s0 = (f32x4){0.f, 0.f, 0.f, 0.f}, s1 = s0;
                            { const bf16x8 qa = *(const bf16x8*)(ql + nt * qstride + q0o), qb_ = *(const bf16x8*)(ql + nt * qstride + q1o);
                              s0 = mfma(kf[0][0], qa, s0); s1 = mfma(kf[1][0], qa, s1); s0 = mfma(kf[0][1], qb_, s0); s1 = mfma(kf[1][1], qb_, s1); }
                            float pv[8];
#pragma unroll
                            for (int e = 0; e < 8; ++e) { const float s = (e < 4) ? s0[e & 3] : s1[e & 3]; const int n = ct * 64 + kh * 32 + (e >> 2) * 16 + quad * 4 + (e & 3);
                                pv[e] = (16 * n + 31 <= tq) ? __expf(s - m[nt]) * inv[nt] : 0.f; }
                            As[0] += (pv[0] + pv[1]) + (pv[2] + pv[3]); As[1] += (pv[4] + pv[5]) + (pv[6] + pv[7]); p3[0] += pv[3]; p3[1] += pv[7];
                            const bf16x8 P = mk8(pk2(pv[0], pv[1]), pk2(pv[2], pv[3]), pk2(pv[4], pv[5]), pk2(pv[6], pv[7]));
#pragma unroll
                            for (int dt = 0; dt < 4; ++dt) O[dt][nt] = mfma(vf[dt], P, O[dt][nt]);
                        }
                        const int qq = w * 16 + l15;
#pragma unroll
                        for (int t2 = 0; t2 < 2; ++t2) {
                            const float rr = __shfl(p3[t2], (lane + 48) & 63);
                            const float carry = (quad == 0) ? prevr : rr; prevr = rr;
                            const int jb = ct * 16 + kh * 8 + t2 * 4 + quad;
                            impL[jb * 64 + ((qq ^ jb) & 63)] = As[t2] + carry;
                        }
                    }
                }
                __syncthreads();
            }
        }
    }
    {
        const float4 gv = *(const float4*)(gates + token * 32 + 0 * 8 + g * 4);
        const float sc[4] = {gv.x, gv.y, gv.z, gv.w};
        attn_store2(mix, token0, 0, mixcol, 64, O, sc, lane, false);
    }
#pragma unroll 1
    for (int qi = 0; qi < 16; ++qi) {
        const int q = w * 16 + qi, jb = lane;
        float val = impL[jb * 64 + ((q ^ jb) & 63)];
        if (jb > blk) val = -1e30f;
        else if (jb == 0 || jb == blk || jb == blk - 1) val = 1e30f;
        int rank = 0;
        for (int jp = 0; jp < 64; ++jp) { const float vj = __shfl(val, jp); rank += ((vj > val) || (vj == val && jp < jb)) ? 1 : 0; }
        const bool sel = (rank < 16) && (val > -5e29f);
        const u64 mask = __ballot(sel);
        if (lane == 0) selm[q] = mask;
    }
    __syncthreads();
    u64 uni = 0;
    for (int q = 0; q < 64; ++q) uni |= selm[q];
    const u64 sm = selm[w * 16 + l15];
    {
#pragma unroll
        for (int nt = 0; nt < 4; ++nt) { m[nt] = -1e30f; l[nt] = 0.f; }
#pragma unroll
        for (int dt = 0; dt < 4; ++dt)
#pragma unroll
            for (int nt = 0; nt < 4; ++nt) O[dt][nt] = (f32x4){0.f, 0.f, 0.f, 0.f};
        const u64 tiles = uni & ((blk == 63) ? ~0ull : ((2ull << blk) - 1ull));
        attn_stream(tiles, proj + (size_t)b * 4096 * PJ_LD + 1792 + g * 64, PJ_LD, VT + ((size_t)((4 + g) * 8 + b) * 64) * 4096, 4096, kvbuf, 63, ql, q0o, q1o, qstride, nullptr, O, m, l, tid, lane,
                    [&](int nt, float ckv, int key, int jb, float& s) { return (((sm >> jb) & 1ull) != 0) && (key <= tq); });
        const float4 gv = *(const float4*)(gates + token * 32 + 1 * 8 + g * 4);
        const float sc[4] = {gv.x / fmaxf(l[0], 1e-30f), gv.y / fmaxf(l[1], 1e-30f), gv.z / fmaxf(l[2], 1e-30f), gv.w / fmaxf(l[3], 1e-30f)};
        attn_store2(mix, token0, 0, mixcol, 64, O, sc, lane, true);
    }
    {
#pragma unroll
        for (int nt = 0; nt < 4; ++nt) { m[nt] = -1e30f; l[nt] = 0.f; }
#pragma unroll
        for (int dt = 0; dt < 4; ++dt)
#pragma unroll
            for (int nt = 0; nt < 4; ++nt) O[dt][nt] = (f32x4){0.f, 0.f, 0.f, 0.f};
        const int jlo = blk > 8 ? blk - 8 : 0;
        const u64 upto = (blk == 63) ? ~0ull : ((2ull << blk) - 1ull);
        const u64 tiles = upto & ~((1ull << jlo) - 1ull);
        attn_stream(tiles, proj + (size_t)b * 4096 * PJ_LD + 2048 + g * 64, PJ_LD, VT + ((size_t)((6 + g) * 8 + b) * 64) * 4096, 4096, kvbuf, 63, ql, q0o, q1o, qstride, nullptr, O, m, l, tid, lane,
                    [&](int nt, float ckv, int key, int jb, float& s) { return (key <= tq) && (key + 512 > tq); });
        const float4 gv = *(const float4*)(gates + token * 32 + 2 * 8 + g * 4);
        const float sc[4] = {gv.x / fmaxf(l[0], 1e-30f), gv.y / fmaxf(l[1], 1e-30f), gv.z / fmaxf(l[2], 1e-30f), gv.w / fmaxf(l[3], 1e-30f)};
        attn_store2(mix, token0, 0, mixcol, 64, O, sc, lane, true);
    }
    __syncthreads();
}

__device__ void fox_unit(const Params& p, int L, int b, int h, int qb, char* lds) {
    const int tid = otid(), lane = tid & 63, w = tid >> 6, quad = lane >> 4, l15 = lane & 15;
    const bf16_t* proj = (const bf16_t*)(p.ws + OFF_BIG); const bf16_t* VT = (const bf16_t*)(p.ws + OFF_BIG + OFF_VT_IN_BIG);
    bf16_t* mix = (bf16_t*)(p.ws + OFF_ACT);
    const float* cc = (const float*)(p.ws + OFF_FOXC) + (size_t)(b * 4 + h) * 4096;
    const int q0 = qb * 256 + w * 64; const size_t token0 = (size_t)b * 4096 + q0;
    int tq[4]; float cq[4];
#pragma unroll
    for (int nt = 0; nt < 4; ++nt) { tq[nt] = q0 + nt * 16 + l15; cq[nt] = cc[tq[nt]]; }
    char* Qs = lds + 32768;
#pragma unroll
    for (int t = 0; t < 8; ++t) { const int idx = t * 64 + lane, rr = idx >> 3, c = idx & 7;
        const uint4 v = *(const uint4*)(proj + (token0 + rr) * PJ_LD + 2304 + h * 64 + c * 8);
        *(uint4*)(Qs + (w * 64 + rr) * 128 + ((c ^ (rr & 7)) << 4)) = v; }
    const char* ql = Qs + (w * 64 + l15) * 128; const int q0o = ((quad) ^ (l15 & 7)) << 4, q1o = ((4 + quad) ^ (l15 & 7)) << 4; const int qstride = 2048;
    __syncthreads();
    f32x4 O[4][4]; float m[4], l[4];
#pragma unroll
    for (int nt = 0; nt < 4; ++nt) { m[nt] = -1e30f; l[nt] = 0.f; }
#pragma unroll
    for (int dt = 0; dt < 4; ++dt)
#pragma unroll
        for (int nt = 0; nt < 4; ++nt) O[dt][nt] = (f32x4){0.f, 0.f, 0.f, 0.f};
    const int jmax = qb * 4 + 3;
    const u64 tiles = (jmax == 63) ? ~0ull : ((2ull << jmax) - 1ull);
    attn_stream(tiles, proj + (size_t)b * 4096 * PJ_LD + 2560 + h * 64, PJ_LD, VT + ((size_t)((8 + h) * 8 + b) * 64) * 4096, 4096, lds, qb * 4 + w, ql, q0o, q1o, qstride, cc, O, m, l, tid, lane,
                [&](int nt, float ckv, int key, int jb, float& s) { s += cq[nt] - ckv; return key <= tq[nt]; });
    float sc[4];
#pragma unroll
    for (int nt = 0; nt < 4; ++nt) sc[nt] = 1.0f / fmaxf(l[nt], 1e-30f);
    attn_store2(mix, token0, 16, 768 + h * 64, 0, O, sc, lane, false);
}

__device__ void mixA_phase(const Params& p, int L, char* lds) {
    for (int job = blockIdx.x; job < 136 + 2048; job += gridDim.x) {
        if (job < 128) compress_unit(p, L, job, lds);
        else if (job < 136) foxc_job(p, L, (job - 128) * 4 + (otid() >> 6));
        else hgrn_a_unit(p, L, job - 136, lds);
    }
}
DEVI int next_unit(unsigned* ctr, char* lds) {
    int* slot = (int*)(lds + LDS_BYTES - 16);
    __syncthreads();
    if (otid() == 0) *slot = (int)atomicAdd(ctr, 1u);
    __syncthreads();
    return *slot;
}
__device__ void mixB_phase(const Params& p, int L, char* lds) {
    unsigned* ctr = (unsigned*)(p.ws + OFF_CTR) + L * 4;
#pragma unroll 1
    for (;;) { const int f = next_unit(ctr + 0, lds); if (f >= 512) break; const int qb = 15 - (f >> 5), bh = f & 31; fox_unit(p, L, bh >> 2, bh & 3, qb, lds); }
#pragma unroll 1
    for (;;) { const int n = next_unit(ctr + 1, lds); if (n >= 1024) break; const int blk = 63 - (n >> 4), bg = n & 15; nsa_unit(p, L, bg >> 1, bg & 1, blk, lds); }
#pragma unroll 1
    for (;;) { const int u = next_unit(ctr + 2, lds); if (u >= 2048) break; hgrn_c_unit(p, L, u, lds); }
}

__device__ void run_phase(const Params& p, int ph, char* lds) {
    if (ph == 0) { prep_phase(p, lds); return; }
    const int L = (ph - 1) / 9, s = (ph - 1) % 9;
    switch (s) {
        case 0: gemm_phase<EPI_PROJ>(p, L, lds); break;
        case 1: mixA_phase(p, L, lds); break;
        case 2: hgrn_scan_phase(p); break;
        case 3: mixB_phase(p, L, lds); break;
        case 4: gemm_phase<EPI_WO>(p, L, lds); break;
        case 5: norm_phase(p.out, p.norm2_g + L * 1024, (bf16_t*)(p.ws + OFF_ACT)); break;
        case 6: gemm_phase<EPI_UP>(p, L, lds); break;
        case 7: gemm_phase<EPI_DOWN>(p, L, lds); break;
        default: norm_phase(p.out, p.norm1_g + (L + 1) * 1024, (bf16_t*)(p.ws + OFF_ACT)); break;
    }
}

__global__ void __launch_bounds__(256, 2) fwd_kernel(Params p, int ph_lo, int ph_hi) {
    __shared__ __attribute__((aligned(16))) char lds[LDS_BYTES];
    for (int ph = ph_lo; ph < ph_hi; ++ph) {
#ifdef REPEAT_MASK
        const int nrep = (ph >= 1 && ((REPEAT_MASK >> ((ph - 1) % 9)) & 1)) ? 2 : 1;
#pragma unroll 1
        for (int rep = 0; rep < nrep; ++rep) {
            if (rep) cg::this_grid().sync();
            run_phase(p, ph, lds);
        }
#else
        run_phase(p, ph, lds);
#endif
        if (ph + 1 < ph_hi) { cg::this_grid().sync(); }
    }
}

extern "C" void kernel_launch(void* const* d_in, const int* in_sizes, int n_in, void* d_out, int out_size, void* d_ws, size_t ws_size,
                              hipStream_t stream) {
    if (ws_size < WS_NEED) { fprintf(stderr, "workspace too small: %zu < %zu\n", ws_size, (size_t)WS_NEED); return; }
    Params p{};
    p.x = (const float*)d_in[0]; p.norm1_g = (const float*)d_in[1]; p.w_in = (const float*)d_in[2]; p.lb_logits = (const float*)d_in[3];
    p.onorm_g = (const float*)d_in[4]; p.nsa_qn_g = (const float*)d_in[5]; p.nsa_kn_g = (const float*)d_in[6]; p.cmp_pos = (const float*)d_in[7];
    p.cmp_w1 = (const float*)d_in[8]; p.cmp_w2 = (const float*)d_in[9]; p.fox_qn_g = (const float*)d_in[10]; p.fox_kn_g = (const float*)d_in[11];
    p.fox_fb = (const float*)d_in[12]; p.w_o = (const float*)d_in[13]; p.norm2_g = (const float*)d_in[14]; p.w_up = (const float*)d_in[15];
    p.w_down = (const float*)d_in[16];
    p.out = (float*)d_out; p.ws = (char*)d_ws;
#if MULTI_LAUNCH
    for (int ph = 0; ph < NPHASE; ++ph) hipLaunchKernelGGL(fwd_kernel, dim3(512), dim3(256), 0, stream, p, ph, ph + 1);
#else
    static int grid_blocks = 0;
    if (!grid_blocks) {
        int dev = 0, cus = 0, per_cu = 0;
        hipGetDevice(&dev);
        hipDeviceGetAttribute(&cus, hipDeviceAttributeMultiprocessorCount, dev);
        hipOccupancyMaxActiveBlocksPerMultiprocessor(&per_cu, fwd_kernel, 256, 0);
        if (per_cu > 2) per_cu = 2;
        grid_blocks = cus * per_cu;
        grid_blocks &= ~7;
    }
    int lo = 0, hi = NPHASE;
    void* args[] = {&p, &lo, &hi};
    hipError_t e = hipLaunchCooperativeKernel((void*)fwd_kernel, dim3(grid_blocks), dim3(256), args, 0, stream);
    if (e != hipSuccess) fprintf(stderr, "cooperative launch failed: %s (grid %d)\n", hipGetErrorString(e), grid_blocks);
#endif
}
```

```cpp
#include <hip/hip_runtime.h>
#include <hip/hip_cooperative_groups.h>
#include <stdint.h>
#include <cstdio>
namespace cg = cooperative_groups;

#ifndef MULTI_LAUNCH
#define MULTI_LAUNCH 0
#endif

typedef unsigned short bf16_t;
typedef short bf16x8 __attribute__((ext_vector_type(8)));
typedef float f32x4 __attribute__((ext_vector_type(4)));
typedef unsigned long long u64;
typedef __attribute__((address_space(3))) unsigned* ldsp_t;
typedef unsigned u32x16 __attribute__((ext_vector_type(16)));
#define DEVI __device__ __forceinline__

constexpr int T_TOK = 32768, SEQ = 4096, DM = 1024, DFF = 4096;
constexpr int PJ_LD = 3072;
constexpr int NW_IN = 3100, NW_IN_PAD = 3200;
constexpr int NPHASE = 18;

constexpr size_t OFF_WIN = 0;
constexpr size_t OFF_WO = OFF_WIN + (size_t)2 * NW_IN_PAD * 1024 * 2;
constexpr size_t OFF_WUP = OFF_WO + (size_t)2 * 1024 * 1024 * 2;
constexpr size_t OFF_WDN = OFF_WUP + (size_t)2 * 4096 * 1024 * 2;
constexpr size_t OFF_W1T = OFF_WDN + (size_t)2 * 4096 * 1024 * 2;
constexpr size_t OFF_W2T = OFF_W1T + (size_t)2 * 2 * 128 * 2048 * 2;
constexpr size_t OFF_CBIAS = OFF_W2T + (size_t)2 * 2 * 64 * 128 * 2;
constexpr size_t OFF_CTR = OFF_CBIAS + 2048;
constexpr size_t OFF_ROPE = OFF_CTR + 256;
constexpr size_t OFF_GATES = OFF_ROPE + (size_t)4096 * 16 * 4;
constexpr size_t OFF_FOXC = OFF_GATES + (size_t)T_TOK * 32 * 4;
constexpr size_t OFF_KC = OFF_FOXC + (size_t)8 * 4 * 4096 * 4;
constexpr size_t OFF_VCT = OFF_KC + (size_t)8 * 2 * 256 * 64 * 2;
constexpr size_t OFF_DECAY = OFF_VCT + (size_t)8 * 2 * 256 * 64 * 2;
constexpr size_t OFF_KVT = OFF_DECAY + (size_t)2048 * 64 * 4;
constexpr size_t OFF_ST = OFF_KVT + (size_t)2048 * 4096 * 4;
constexpr size_t OFF_ACT = OFF_ST + (size_t)2048 * 4096 * 2;
constexpr size_t OFF_BIG = OFF_ACT + (size_t)T_TOK * 1024 * 2;
constexpr size_t OFF_VT_IN_BIG = (size_t)T_TOK * PJ_LD * 2;
constexpr size_t WS_NEED = OFF_BIG + (size_t)T_TOK * 4096 * 2;

constexpr int LDS_BYTES = 67584;

struct Params {
    const float *x, *norm1_g, *w_in, *lb_logits, *onorm_g, *nsa_qn_g, *nsa_kn_g, *cmp_pos, *cmp_w1, *cmp_w2,
        *fox_qn_g, *fox_kn_g, *fox_fb, *w_o, *norm2_g, *w_up, *w_down;
    float* out;
    char* ws;
};

DEVI unsigned pk2(float lo, float hi) { unsigned r; asm("v_cvt_pk_bf16_f32 %0, %1, %2" : "=v"(r) : "v"(lo), "v"(hi)); return r; }
DEVI bf16_t f2bf(float f) { return (bf16_t)(pk2(f, 0.f) & 0xffffu); }
DEVI float bf2f(bf16_t h) { return __uint_as_float(((unsigned)h) << 16); }
DEVI float bflo(unsigned u) { return __uint_as_float(u << 16); }
DEVI float bfhi(unsigned u) { return __uint_as_float(u & 0xffff0000u); }
DEVI f32x4 mfma(bf16x8 a, bf16x8 b, f32x4 c) { return __builtin_amdgcn_mfma_f32_16x16x32_bf16(a, b, c, 0, 0, 0); }
DEVI int otid() { int t; asm volatile("v_mov_b32 %0, %1" : "=v"(t) : "v"(threadIdx.x)); return t; }
DEVI float wave_sum(float v) {
#pragma unroll
    for (int o = 32; o >= 1; o >>= 1) v += __shfl_xor(v, o);
    return v;
}
DEVI bf16x8 mk8(unsigned a, unsigned b, unsigned c, unsigned d) {
    uint4 u = make_uint4(a, b, c, d);
    return *(bf16x8*)&u;
}
DEVI bf16x8 ld8(const bf16_t* p) { uint4 u = *(const uint4*)p; return *(bf16x8*)&u; }
DEVI bf16x8 ld4x2(const bf16_t* p0, const bf16_t* p1) {
    uint2 a = *(const uint2*)p0, b = *(const uint2*)p1;
    return mk8(a.x, a.y, b.x, b.y);
}

DEVI int win_colmap(int n) {
    if (n < 2304) return n;
    if (n < 3072) return n + 24;
    if (n < 3096) return n - 768;
    return n;
}
__device__ void transpose_tile(const float* __restrict__ src, int ld_src, bf16_t* __restrict__ dst, int ld_dst, int k0, int n0, int nvalid,
                               int colmode, float* tile) {
    const int tid = otid();
    for (int idx = tid; idx < 4096; idx += 256) {
        const int i = idx >> 6, j = idx & 63, n = n0 + j;
        float v = 0.f;
        if (n < nvalid) v = src[(size_t)(k0 + i) * ld_src + (colmode ? win_colmap(n) : n)];
        tile[i * 65 + j] = v;
    }
    __syncthreads();
    for (int idx = tid; idx < 4096; idx += 256) {
        const int j = idx >> 6, i = idx & 63;
        dst[(size_t)(n0 + j) * ld_dst + k0 + i] = f2bf(tile[i * 65 + j]);
    }
    __syncthreads();
}

__device__ void norm_phase(const float* __restrict__ xin, const float* __restrict__ g, bf16_t* __restrict__ hout) {
    const int tid = otid(); const int lane = tid & 63, w = tid >> 6;
    for (int row = blockIdx.x * 4 + w; row < T_TOK; row += gridDim.x * 4) {
        const float4* xr = (const float4*)(xin + (size_t)row * DM);
        float4 v[4]; float ss = 0.f;
#pragma unroll
        for (int i = 0; i < 4; ++i) { v[i] = xr[lane + 64 * i]; ss += v[i].x * v[i].x + v[i].y * v[i].y + v[i].z * v[i].z + v[i].w * v[i].w; }
        ss = wave_sum(ss);
        const float r = rsqrtf(ss * (1.0f / 1024.0f) + 1e-6f);
#pragma unroll
        for (int i = 0; i < 4; ++i) {
            const float4 gg = ((const float4*)g)[lane + 64 * i];
            uint2 o; o.x = pk2(v[i].x * r * gg.x, v[i].y * r * gg.y); o.y = pk2(v[i].z * r * gg.z, v[i].w * r * gg.w);
            *(uint2*)(hout + (size_t)row * DM + (lane + 64 * i) * 4) = o;
        }
    }
}

__device__ void prep_phase(const Params& p, char* lds) {
    float* tile = (float*)lds;
    if (blockIdx.x == 0 && otid() < 64) ((unsigned*)(p.ws + OFF_CTR))[otid()] = 0u;
    bf16_t* win_t = (bf16_t*)(p.ws + OFF_WIN); bf16_t* wo_t = (bf16_t*)(p.ws + OFF_WO);
    bf16_t* wup_t = (bf16_t*)(p.ws + OFF_WUP); bf16_t* wdn_t = (bf16_t*)(p.ws + OFF_WDN);
    bf16_t* w1t = (bf16_t*)(p.ws + OFF_W1T); bf16_t* w2t = (bf16_t*)(p.ws + OFF_W2T);
    const int J0 = 1600, J1 = J0 + 512, J2 = J1 + 2048, J3 = J2 + 2048, J4 = J3 + 256, J5 = J4 + 8, J6 = J5 + 128, J7 = J6 + 128;
    for (int job = blockIdx.x; job < J7; job += gridDim.x) {
        if (job < J0) { const int L = job / 800, r = job % 800, kt = r / 50, nt = r % 50;
            transpose_tile(p.w_in + (size_t)L * 1024 * NW_IN, NW_IN, win_t + (size_t)L * NW_IN_PAD * 1024, 1024, kt * 64, nt * 64, NW_IN, 1, tile);
        } else if (job < J1) { const int j = job - J0, L = j / 256, r = j % 256, kt = r / 16, nt = r % 16;
            transpose_tile(p.w_o + (size_t)L * 1024 * 1024, 1024, wo_t + (size_t)L * 1024 * 1024, 1024, kt * 64, nt * 64, 1024, 0, tile);
        } else if (job < J2) { const int j = job - J1, L = j / 1024, r = j % 1024, kt = r / 64, nt = r % 64;
            transpose_tile(p.w_up + (size_t)L * 1024 * 4096, 4096, wup_t + (size_t)L * 4096 * 1024, 1024, kt * 64, nt * 64, 4096, 0, tile);
        } else if (job < J3) { const int j = job - J2, L = j / 1024, r = j % 1024, kt = r / 16, nt = r % 16;
            transpose_tile(p.w_down + (size_t)L * 4096 * 1024, 1024, wdn_t + (size_t)L * 1024 * 4096, 4096, kt * 64, nt * 64, 1024, 0, tile);
        } else if (job < J4) { const int j = job - J3, lw = j / 64, r = j % 64, kt = r / 2, nt = r % 2;
            transpose_tile(p.cmp_w1 + (size_t)lw * 2048 * 128, 128, w1t + (size_t)lw * 128 * 2048, 2048, kt * 64, nt * 64, 128, 0, tile);
        } else if (job < J5) { const int j = job - J4, lw = j / 2, kt = j % 2;
            transpose_tile(p.cmp_w2 + (size_t)lw * 128 * 64, 64, w2t + (size_t)lw * 64 * 128, 128, kt * 64, 0, 64, 0, tile);
        } else if (job < J6) {
            const int t_ = otid(); const int o = (job - J5) * 4 + (t_ >> 6), lane = t_ & 63, lw = o >> 7, hid = o & 127;
            const float* pos = p.cmp_pos + (size_t)lw * 2048; const float* w1 = p.cmp_w1 + (size_t)lw * 2048 * 128 + hid;
            float s = 0.f;
            for (int k = lane; k < 2048; k += 64) s += pos[k] * w1[(size_t)k * 128];
            s = wave_sum(s);
            if (lane == 0) ((float*)(p.ws + OFF_CBIAS))[o] = s;
        } else {
            const int e = (job - J6) * 256 + otid(), pos = e >> 3, i = e & 7;
            const float invf[8] = {1.0f, 0.1939227432012558f, 0.03760603070259094f, 0.007292664609849453f, 0.0014142135623842478f,
                                   0.00027424818836152554f, 5.318296098266728e-05f, 1.0313386155758053e-05f};
            float fr = 1.0f;
#pragma unroll
            for (int q = 0; q < 8; ++q) if (i == q) fr = invf[q];
            const float ang = (float)pos * fr;
            const double a = (double)ang; const double n = rint(a * 0.15915494309189535); const float rr = (float)(a - n * 6.283185307179586);
            float* rt = (float*)(p.ws + OFF_ROPE);
            rt[pos * 16 + i] = __cosf(rr); rt[pos * 16 + 8 + i] = __sinf(rr);
        }
    }
    norm_phase(p.x, p.norm1_g, (bf16_t*)(p.ws + OFF_ACT));
}

enum { EPI_PROJ = 0, EPI_WO = 1, EPI_UP = 2, EPI_DOWN = 3 };

DEVI void proj_epilogue(const Params& p, int L, const f32x4 (&acc)[4][4], int m0w, int cc, int lane) {
    const int quad = lane >> 4, l15 = lane & 15;
    bf16_t* proj = (bf16_t*)(p.ws + OFF_BIG); bf16_t* VT = (bf16_t*)(p.ws + OFF_BIG + OFF_VT_IN_BIG);
    float* gates = (float*)(p.ws + OFF_GATES); const float* rope = (const float*)(p.ws + OFF_ROPE);
    if (cc > 48) return;
    int kind = 0, vidx = 0; const float* gain = nullptr; float scale = 1.f; bool dorope = false;
    if (cc >= 8 && cc < 12) { kind = 5; vidx = cc - 8; }
    else if (cc >= 16 && cc < 24) { kind = 1; gain = p.nsa_qn_g + L * 64; scale = 0.125f; dorope = true; }
    else if (cc == 28 || cc == 29 || cc == 32 || cc == 33) { kind = 1; gain = p.nsa_kn_g + L * 64; dorope = true; }
    else if (cc == 30 || cc == 31) { kind = 5; vidx = 4 + (cc - 30); }
    else if (cc == 34 || cc == 35) { kind = 5; vidx = 6 + (cc - 34); }
    else if (cc >= 36 && cc < 40) { kind = 1; gain = p.fox_qn_g + L * 64; scale = 0.125f; }
    else if (cc >= 40 && cc < 44) { kind = 1; gain = p.fox_kn_g + L * 64; }
    else if (cc >= 44 && cc < 48) { kind = 5; vidx = 8 + (cc - 44); }
    else if (cc == 48) kind = 6;
#pragma unroll
    for (int mi = 0; mi < 4; ++mi) {
        const int token = m0w + mi * 16 + l15, pos = token & 4095, bb = token >> 12;
        float v[4][4];
#pragma unroll
        for (int ni = 0; ni < 4; ++ni)
#pragma unroll
            for (int j = 0; j < 4; ++j) v[ni][j] = acc[mi][ni][j];
        if (kind == 6) {
#pragma unroll
            for (int ni = 0; ni < 2; ++ni)
#pragma unroll
                for (int j = 0; j < 4; ++j) { const int d = ni * 16 + quad * 4 + j;
                    if (d < 24) gates[(size_t)token * 32 + d] = 1.0f / (1.0f + __expf(-v[ni][j]));
                    else if (d < 28) gates[(size_t)token * 32 + d] = v[ni][j]; }
            continue;
        }
        if (kind == 1) {
            float ss = 0.f;
#pragma unroll
            for (int ni = 0; ni < 4; ++ni)
#pragma unroll
                for (int j = 0; j < 4; ++j) ss += v[ni][j] * v[ni][j];
            ss += __shfl_xor(ss, 16); ss += __shfl_xor(ss, 32);
            const float r = rsqrtf(ss * (1.0f / 64.0f) + 1e-6f);
#pragma unroll
            for (int ni = 0; ni < 4; ++ni) { const float4 gg = *(const float4*)(gain + ni * 16 + quad * 4);
                v[ni][0] *= r * gg.x; v[ni][1] *= r * gg.y; v[ni][2] *= r * gg.z; v[ni][3] *= r * gg.w; }
            if (dorope) {
                const float4 cs = *(const float4*)(rope + pos * 16 + (quad & 1) * 4), sn = *(const float4*)(rope + pos * 16 + 8 + (quad & 1) * 4);
                const float cv[4] = {cs.x, cs.y, cs.z, cs.w}, sv[4] = {sn.x, sn.y, sn.z, sn.w};
#pragma unroll
                for (int j = 0; j < 4; ++j) { const float xx = v[0][j], pp = __shfl_xor(xx, 32);
                    v[0][j] = (quad < 2) ? (xx * cv[j] - pp * sv[j]) : (xx * cv[j] + pp * sv[j]); }
            }
#pragma unroll
            for (int ni = 0; ni < 4; ++ni)
#pragma unroll
                for (int j = 0; j < 4; ++j) v[ni][j] *= scale;
        }
        if (kind == 5) {
#pragma unroll
            for (int ni = 0; ni < 4; ++ni)
#pragma unroll
                for (int j = 0; j < 4; ++j) { const int d = ni * 16 + quad * 4 + j;
                    VT[((size_t)(vidx * 8 + bb) * 64 + d) * 4096 + pos] = f2bf(v[ni][j]); }
        } else {
#pragma unroll
            for (int ni = 0; ni < 4; ++ni) { uint2 o; o.x = pk2(v[ni][0], v[ni][1]); o.y = pk2(v[ni][2], v[ni][3]);
                *(uint2*)(proj + (size_t)token * PJ_LD + cc * 64 + ni * 16 + quad * 4) = o; }
        }
    }
}

DEVI void g_load(uint4 (&RA)[4], uint4 (&RB)[4], const bf16_t* Ap, const bf16_t* Bp, int K, int KT) {
#pragma unroll
    for (int i = 0; i < 4; ++i) { RA[i] = *(const uint4*)(Ap + (size_t)(32 * i) * K + KT * 64); RB[i] = *(const uint4*)(Bp + (size_t)(32 * i) * K + KT * 64); }
}
DEVI void g_swrite(const uint4 (&RA)[4], const uint4 (&RB)[4], char* d_) {
#pragma unroll
    for (int i = 0; i < 4; ++i) { *(uint4*)(d_ + i * 4096) = RA[i]; *(uint4*)(d_ + 16384 + i * 4096) = RB[i]; }
}
DEVI void g_compute(const char* sA, f32x4 (&acc)[4][4], int wm, int wn, int quad, int l15) {
    const char* sB = sA + 16384;
#pragma unroll
    for (int ks = 0; ks < 2; ++ks) {
        bf16x8 af[4], bfr[4]; const int ch = ks * 4 + quad;
#pragma unroll
        for (int mi = 0; mi < 4; ++mi) { const int row = wm * 64 + mi * 16 + l15; af[mi] = *(const bf16x8*)(sA + row * 128 + ((ch ^ (row & 7)) << 4)); }
#pragma unroll
        for (int ni = 0; ni < 4; ++ni) { const int row = wn * 64 + ni * 16 + l15; bfr[ni] = *(const bf16x8*)(sB + row * 128 + ((ch ^ (row & 7)) << 4)); }
#pragma unroll
        for (int mi = 0; mi < 4; ++mi)
#pragma unroll
            for (int ni = 0; ni < 4; ++ni) acc[mi][ni] = mfma(bfr[ni], af[mi], acc[mi][ni]);
    }
}

template <int EPI>
__device__ void gemm_phase(const Params& p, int L, char* lds) {
    const bf16_t* A; const bf16_t* Bt; int K, nNt;
    if (EPI == EPI_PROJ) { A = (const bf16_t*)(p.ws + OFF_ACT); Bt = (const bf16_t*)(p.ws + OFF_WIN) + (size_t)L * NW_IN_PAD * 1024; K = 1024; nNt = 25; }
    else if (EPI == EPI_WO) { A = (const bf16_t*)(p.ws + OFF_ACT); Bt = (const bf16_t*)(p.ws + OFF_WO) + (size_t)L * 1024 * 1024; K = 1024; nNt = 8; }
    else if (EPI == EPI_UP) { A = (const bf16_t*)(p.ws + OFF_ACT); Bt = (const bf16_t*)(p.ws + OFF_WUP) + (size_t)L * 4096 * 1024; K = 1024; nNt = 32; }
    else { A = (const bf16_t*)(p.ws + OFF_BIG); Bt = (const bf16_t*)(p.ws + OFF_WDN) + (size_t)L * 1024 * 4096; K = 4096; nNt = 8; }
    const int tid = otid(), lane = tid & 63, w = tid >> 6, quad = lane >> 4, l15 = lane & 15, wm = w >> 1, wn = w & 1;
    const int xcd = blockIdx.x & 7, loc = blockIdx.x >> 3, nloc = gridDim.x >> 3;
    const int nk = K / 64;
    for (int it = loc; it < 32 * nNt; it += nloc) {
        const int gsz = 8 * nNt, mloc = (it / gsz) * 8 + (it & 7), nloc_t = (it % gsz) >> 3;
        const int m0 = (xcd + 8 * mloc) * 128, n0 = nloc_t * 128;
        f32x4 acc[4][4];
#pragma unroll
        for (int a = 0; a < 4; ++a)
#pragma unroll
            for (int b = 0; b < 4; ++b) acc[a][b] = (f32x4){0.f, 0.f, 0.f, 0.f};
        u32x16 ra0, rb0, ra1, rb1;
        const int lrow = tid >> 3, lc = tid & 7;
        const bf16_t* Ap = A + (size_t)(m0 + lrow) * K + lc * 8;
        const bf16_t* Bp = Bt + (size_t)(n0 + lrow) * K + lc * 8;
        const int woff = lrow * 128 + ((lc ^ (lrow & 7)) << 4);
#define G_LD1(R, P, I, KT) { const uint4 t_ = *(const uint4*)((P) + (size_t)(32 * I) * K + (KT) * 64); R[4 * I] = t_.x; R[4 * I + 1] = t_.y; R[4 * I + 2] = t_.z; R[4 * I + 3] = t_.w; }
#define G_LOAD(RA, RB, KT) { G_LD1(RA, Ap, 0, KT) G_LD1(RB, Bp, 0, KT) G_LD1(RA, Ap, 1, KT) G_LD1(RB, Bp, 1, KT) G_LD1(RA, Ap, 2, KT) G_LD1(RB, Bp, 2, KT) G_LD1(RA, Ap, 3, KT) G_LD1(RB, Bp, 3, KT) }
#define G_SW1(R, D, I) *(uint4*)((D) + I * 4096) = make_uint4(R[4 * I], R[4 * I + 1], R[4 * I + 2], R[4 * I + 3]);
#define G_SWRITE(RA, RB, DST) { G_SW1(RA, DST, 0) G_SW1(RB, (DST) + 16384, 0) G_SW1(RA, DST, 1) G_SW1(RB, (DST) + 16384, 1) G_SW1(RA, DST, 2) G_SW1(RB, (DST) + 16384, 2) G_SW1(RA, DST, 3) G_SW1(RB, (DST) + 16384, 3) }
        G_LOAD(ra0, rb0, 0)
        G_LOAD(ra1, rb1, 1)
        G_SWRITE(ra0, rb0, lds + woff)
        __syncthreads();
#pragma unroll 1
        for (int kt = 0; kt < nk - 2; kt += 2) {
            G_LOAD(ra0, rb0, kt + 2)
            __builtin_amdgcn_sched_barrier(0);
            g_compute(lds, acc, wm, wn, quad, l15);
            G_SWRITE(ra1, rb1, lds + 32768 + woff)
            __syncthreads();
            G_LOAD(ra1, rb1, kt + 3)
            __builtin_amdgcn_sched_barrier(0);
            g_compute(lds + 32768, acc, wm, wn, quad, l15);
            G_SWRITE(ra0, rb0, lds + woff)
            __syncthreads();
        }
        g_compute(lds, acc, wm, wn, quad, l15);
        G_SWRITE(ra1, rb1, lds + 32768 + woff)
        __syncthreads();
        g_compute(lds + 32768, acc, wm, wn, quad, l15);
        __syncthreads();
#undef G_LOAD
#undef G_SWRITE
#undef G_LD1
#undef G_SW1
        if (EPI == EPI_PROJ) {
            proj_epilogue(p, L, acc, m0 + wm * 64, (n0 + wn * 64) >> 6, lane);
        } else if (EPI == EPI_UP) {
            bf16_t* hid = (bf16_t*)(p.ws + OFF_BIG);
#pragma unroll
            for (int mi = 0; mi < 4; ++mi)
#pragma unroll
                for (int ni = 0; ni < 4; ++ni) { const int m = m0 + wm * 64 + mi * 16 + l15, n = n0 + wn * 64 + ni * 16 + quad * 4;
                    float a0 = fmaxf(acc[mi][ni][0], 0.f), a1 = fmaxf(acc[mi][ni][1], 0.f), a2 = fmaxf(acc[mi][ni][2], 0.f), a3 = fmaxf(acc[mi][ni][3], 0.f);
                    uint2 o; o.x = pk2(a0 * a0, a1 * a1); o.y = pk2(a2 * a2, a3 * a3);
                    *(uint2*)(hid + (size_t)m * DFF + n) = o; }
        } else {
            const float* xin = (EPI == EPI_WO && L == 0) ? p.x : p.out;
#pragma unroll
            for (int mi = 0; mi < 4; ++mi)
#pragma unroll
                for (int ni = 0; ni < 4; ++ni) { const int m = m0 + wm * 64 + mi * 16 + l15, n = n0 + wn * 64 + ni * 16 + quad * 4;
                    float4 xv = *(const float4*)(xin + (size_t)m * DM + n);
                    xv.x += acc[mi][ni][0]; xv.y += acc[mi][ni][1]; xv.z += acc[mi][ni][2]; xv.w += acc[mi][ni][3];
                    *(float4*)(p.out + (size_t)m * DM + n) = xv; }
        }
    }
}

DEVI float hgrn_lb(const Params& p, int L, int hk) {
    if (L == 0) return 0.f;
    const float l0 = p.lb_logits[hk], l1 = p.lb_logits[256 + hk];
    return 1.0f / (1.0f + __expf(l0 - l1));
}

__device__ void hgrn_a_unit(const Params& p, int L, int u, char* lds) {
    const int tid = otid(), lane = tid & 63, w = tid >> 6, quad = lane >> 4, l15 = lane & 15;
    const int c = u & 63, h = (u >> 6) & 3, b = u >> 8;
    const bf16_t* proj = (const bf16_t*)(p.ws + OFF_BIG); const bf16_t* VT = (const bf16_t*)(p.ws + OFF_BIG + OFF_VT_IN_BIG);
    float* segtot = (float*)lds;
    bf16_t* KDt = (bf16_t*)(lds + 1024);
    const int k = tid & 63, seg = tid >> 6;
    const float lb = hgrn_lb(p, L, h * 64 + k);
    float gl[16], kkv[16]; float run = 0.f;
    const bf16_t* zp = proj + (size_t)(b * 4096 + c * 64 + seg * 16) * PJ_LD + 256 + h * 64 + k;
#pragma unroll
    for (int i = 0; i < 16; ++i) {
        const float z = bf2f(zp[(size_t)i * PJ_LD]);
        const float sg = 1.0f / (1.0f + __expf(-z)), sn = 1.0f / (1.0f + __expf(z));
        const float f = lb + (1.0f - lb) * sg;
        run += __logf(fmaxf(f, 1e-30f)); gl[i] = run; kkv[i] = (1.0f - lb) * sn;
    }
    segtot[seg * 64 + k] = run;
    __syncthreads();
    float off = 0.f, tot = 0.f;
#pragma unroll
    for (int s = 0; s < 4; ++s) { const float t = segtot[s * 64 + k]; tot += t; if (s < seg) off += t; }
    unsigned pkd[8];
#pragma unroll
    for (int i = 0; i < 8; ++i) {
        const float a0 = kkv[2 * i] * __expf(tot - (off + gl[2 * i])), a1 = kkv[2 * i + 1] * __expf(tot - (off + gl[2 * i + 1]));
        pkd[i] = pk2(a0, a1);
    }
    *(uint4*)(KDt + k * 72 + seg * 16) = make_uint4(pkd[0], pkd[1], pkd[2], pkd[3]);
    *(uint4*)(KDt + k * 72 + seg * 16 + 8) = make_uint4(pkd[4], pkd[5], pkd[6], pkd[7]);
    if (seg == 0) ((float*)(p.ws + OFF_DECAY))[u * 64 + k] = __expf(tot);
    __syncthreads();
    const bf16_t* vt = VT + ((size_t)(h * 8 + b) * 64) * 4096 + c * 64;
    float* kvt = (float*)(p.ws + OFF_KVT) + (size_t)u * 4096;
    bf16x8 af[2];
#pragma unroll
    for (int ks = 0; ks < 2; ++ks) af[ks] = ld8(vt + (size_t)(w * 16 + l15) * 4096 + ks * 32 + quad * 8);
#pragma unroll
    for (int kt = 0; kt < 4; ++kt) {
        f32x4 acc = (f32x4){0.f, 0.f, 0.f, 0.f};
#pragma unroll
        for (int ks = 0; ks < 2; ++ks) { const bf16x8 bfr = *(const bf16x8*)(KDt + (kt * 16 + l15) * 72 + ks * 32 + quad * 8); acc = mfma(af[ks], bfr, acc); }
#pragma unroll
        for (int j = 0; j < 4; ++j) kvt[(w * 16 + quad * 4 + j) * 64 + kt * 16 + l15] = acc[j];
    }
    __syncthreads();
}

__device__ void hgrn_scan_phase(const Params& p) {
    const float* kvt = (const float*)(p.ws + OFF_KVT); const float* dec = (const float*)(p.ws + OFF_DECAY);
    bf16_t* st = (bf16_t*)(p.ws + OFF_ST);
    for (int e = blockIdx.x * 256 + otid(); e < 32 * 4096; e += gridDim.x * 256) {
        const int bh = e >> 12, vk = e & 4095, k = vk & 63;
        float S = 0.f;
#pragma unroll 8
        for (int c = 0; c < 64; ++c) {
            const int u = bh * 64 + c;
            st[(size_t)u * 4096 + vk] = f2bf(S);
            S = S * dec[u * 64 + k] + kvt[(size_t)u * 4096 + vk];
        }
    }
}

__device__ void hgrn_c_unit(const Params& p, int L, int u, char* lds) {
    const int tid = otid(), lane = tid & 63, w = tid >> 6, quad = lane >> 4, l15 = lane & 15;
    const int c = u & 63, h = (u >> 6) & 3, b = u >> 8;
    const bf16_t* proj = (const bf16_t*)(p.ws + OFF_BIG); const bf16_t* VT = (const bf16_t*)(p.ws + OFF_BIG + OFF_VT_IN_BIG);
    float* Gs = (float*)lds; float* KKs = Gs + 64 * 65; float* Qs = KKs + 64 * 65; float* segtot = Qs + 64 * 65;
    {
        const int k = tid & 63, seg = tid >> 6;
        const float lb = hgrn_lb(p, L, h * 64 + k);
        float gl[16], kkv[16]; float run = 0.f;
        const bf16_t* zp = proj + (size_t)(b * 4096 + c * 64 + seg * 16) * PJ_LD + 256 + h * 64 + k;
#pragma unroll
        for (int i = 0; i < 16; ++i) {
            const float z = bf2f(zp[(size_t)i * PJ_LD]);
            const float sg = 1.0f / (1.0f + __expf(-z)), sn = 1.0f / (1.0f + __expf(z));
            const float f = lb + (1.0f - lb) * sg;
            run += __logf(fmaxf(f, 1e-30f)); gl[i] = run; kkv[i] = (1.0f - lb) * sn;
            Qs[(seg * 16 + i) * 65 + k] = bf2f(zp[(size_t)i * PJ_LD - 256]) * 0.125f;
        }
        segtot[seg * 64 + k] = run;
        __syncthreads();
        float off = 0.f;
#pragma unroll
        for (int s = 0; s < 4; ++s) { const float t = segtot[s * 64 + k]; if (s < seg) off += t; }
#pragma unroll
        for (int i = 0; i < 16; ++i) { Gs[(seg * 16 + i) * 65 + k] = off + gl[i]; KKs[(seg * 16 + i) * 65 + k] = kkv[i]; }
        __syncthreads();
    }
    const int I = w;
    const int tq = 16 * I + l15;
    bf16x8 qt[2], qg[2];
#pragma unroll
    for (int ks = 0; ks < 2; ++ks) {
        float a[8], g8[8];
#pragma unroll
        for (int j = 0; j < 8; ++j) {
            const int k = ks * 32 + quad * 8 + j;
            const float G = Gs[tq * 65 + k], q = Qs[tq * 65 + k];
            const float gref = (I == 0) ? 0.f : Gs[(16 * I - 1) * 65 + k];
            a[j] = q * __expf(G - gref); g8[j] = q * __expf(G);
        }
        qt[ks] = mk8(pk2(a[0], a[1]), pk2(a[2], a[3]), pk2(a[4], a[5]), pk2(a[6], a[7]));
        qg[ks] = mk8(pk2(g8[0], g8[1]), pk2(g8[2], g8[3]), pk2(g8[4], g8[5]), pk2(g8[6], g8[7]));
    }
    f32x4 O[4];
#pragma unroll
    for (int vt = 0; vt < 4; ++vt) O[vt] = (f32x4){0.f, 0.f, 0.f, 0.f};
    const bf16_t* st = (const bf16_t*)(p.ws + OFF_ST) + (size_t)u * 4096;
#pragma unroll
    for (int vt = 0; vt < 4; ++vt)
#pragma unroll
        for (int ks = 0; ks < 2; ++ks) O[vt] = mfma(ld8(st + (vt * 16 + l15) * 64 + ks * 32 + quad * 8), qg[ks], O[vt]);
    const bf16_t* vtp = VT + ((size_t)(h * 8 + b) * 64) * 4096 + c * 64;
    for (int Jp = 0; Jp <= (I >> 1); ++Jp) {
        f32x4 sc[2];
#pragma unroll
        for (int jj = 0; jj < 2; ++jj) {
            const int J = 2 * Jp + jj;
            sc[jj] = (f32x4){0.f, 0.f, 0.f, 0.f};
            if (J <= I) {
                const int s = 16 * J + l15;
#pragma unroll
                for (int ks = 0; ks < 2; ++ks) {
                    float a[8];
#pragma unroll
                    for (int j = 0; j < 8; ++j) {
                        const int k = ks * 32 + quad * 8 + j;
                        const float gref = (I == 0) ? 0.f : Gs[(16 * I - 1) * 65 + k];
                        a[j] = KKs[s * 65 + k] * __expf(gref - Gs[s * 65 + k]);
                    }
                    sc[jj] = mfma(mk8(pk2(a[0], a[1]), pk2(a[2], a[3]), pk2(a[4], a[5]), pk2(a[6], a[7])), qt[ks], sc[jj]);
                }
#pragma unroll
                for (int j = 0; j < 4; ++j) { const int s2 = 16 * J + quad * 4 + j; if (s2 > tq) sc[jj][j] = 0.f; }
            }
        }
        const bf16x8 P = mk8(pk2(sc[0][0], sc[0][1]), pk2(sc[0][2], sc[0][3]), pk2(sc[1][0], sc[1][1]), pk2(sc[1][2], sc[1][3]));
#pragma unroll
        for (int vt = 0; vt < 4; ++vt) {
            const bf16_t* r = vtp + (size_t)(vt * 16 + l15) * 4096 + 32 * Jp + quad * 4;
            O[vt] = mfma(ld4x2(r, r + 16), P, O[vt]);
        }
    }
    float ss = 0.f;
#pragma unroll
    for (int vt = 0; vt < 4; ++vt)
#pragma unroll
        for (int j = 0; j < 4; ++j) ss += O[vt][j] * O[vt][j];
    ss += __shfl_xor(ss, 16); ss += __shfl_xor(ss, 32);
    const float r = rsqrtf(ss * (1.0f / 64.0f) + 1e-6f);
    const size_t token = (size_t)b * 4096 + c * 64 + tq;
    bf16_t* mix = (bf16_t*)(p.ws + OFF_ACT);
#pragma unroll
    for (int vt = 0; vt < 4; ++vt) {
        const int v0 = vt * 16 + quad * 4;
        const float4 og = *(const float4*)(p.onorm_g + L * 64 + v0);
        const uint2 gz = *(const uint2*)(proj + token * PJ_LD + 768 + h * 64 + v0);
        const float g0 = bflo(gz.x), g1 = bfhi(gz.x), g2 = bflo(gz.y), g3 = bfhi(gz.y);
        const float o0 = O[vt][0] * r * og.x * (g0 / (1.0f + __expf(-g0))), o1 = O[vt][1] * r * og.y * (g1 / (1.0f + __expf(-g1)));
        const float o2 = O[vt][2] * r * og.z * (g2 / (1.0f + __expf(-g2))), o3 = O[vt][3] * r * og.w * (g3 / (1.0f + __expf(-g3)));
        uint2 o; o.x = pk2(o0, o1); o.y = pk2(o2, o3);
        *(uint2*)(mix + token * DM + h * 64 + v0) = o;
    }
    __syncthreads();
}

__device__ void compress_unit(const Params& p, int L, int u, char* lds) {
    const int tid = otid(), lane = tid & 63, w = tid >> 6, quad = lane >> 4, l15 = lane & 15;
    const int which = u & 1, g = (u >> 1) & 1, b = (u >> 2) & 7, ntile = u >> 5;
    const bf16_t* proj = (const bf16_t*)(p.ws + OFF_BIG);
    const bf16_t* w1t = (const bf16_t*)(p.ws + OFF_W1T) + (size_t)(L * 2 + which) * 128 * 2048;
    const bf16_t* w2t = (const bf16_t*)(p.ws + OFF_W2T) + (size_t)(L * 2 + which) * 64 * 128;
    const float* cbias = (const float*)(p.ws + OFF_CBIAS) + (L * 2 + which) * 128;
    bf16_t* Hs = (bf16_t*)lds + w * 16 * 136;
    const int nrow = ntile * 64 + w * 16 + l15;
    int tokbase = 16 * nrow; if (tokbase > 4096 - 32) tokbase = 4096 - 32;
    const bf16_t* xa = proj + ((size_t)b * 4096 + tokbase) * PJ_LD + (which ? 1664 : 1536) + g * 64;
    f32x4 acc[8];
#pragma unroll
    for (int i = 0; i < 8; ++i) acc[i] = (f32x4){0.f, 0.f, 0.f, 0.f};
#pragma unroll 2
    for (int kk = 0; kk < 64; ++kk) {
        const int l = kk >> 1, d = (kk & 1) * 32 + quad * 8;
        const bf16x8 a = ld8(xa + (size_t)l * PJ_LD + d);
#pragma unroll
        for (int ni = 0; ni < 8; ++ni) acc[ni] = mfma(a, ld8(w1t + (size_t)(ni * 16 + l15) * 2048 + kk * 32 + quad * 8), acc[ni]);
    }
#pragma unroll
    for (int ni = 0; ni < 8; ++ni) { const float bsv = cbias[ni * 16 + l15];
#pragma unroll
        for (int j = 0; j < 4; ++j) { const float x = acc[ni][j] + bsv;
            const float uu = 0.7978845608028654f * (x + 0.044715f * x * x * x);
            const float th = 1.0f - 2.0f / (1.0f + __expf(2.0f * uu));
            Hs[(quad * 4 + j) * 136 + ni * 16 + l15] = f2bf(0.5f * x * (1.0f + th)); } }
    __syncthreads();
    f32x4 o[4];
#pragma unroll
    for (int i = 0; i < 4; ++i) o[i] = (f32x4){0.f, 0.f, 0.f, 0.f};
#pragma unroll
    for (int ks = 0; ks < 4; ++ks) { const bf16x8 a = *(const bf16x8*)(Hs + l15 * 136 + ks * 32 + quad * 8);
#pragma unroll
        for (int ni = 0; ni < 4; ++ni) o[ni] = mfma(a, ld8(w2t + (size_t)(ni * 16 + l15) * 128 + ks * 32 + quad * 8), o[ni]); }
    const int nb = ntile * 64 + w * 16 + quad * 4;
    if (which == 0) {
        bf16_t* kc = (bf16_t*)(p.ws + OFF_KC) + (size_t)(b * 2 + g) * 256 * 64;
        const float* rope = (const float*)(p.ws + OFF_ROPE);
#pragma unroll
        for (int j = 0; j < 4; ++j) {
            const int n = nb + j;
            float ss = o[0][j] * o[0][j] + o[1][j] * o[1][j] + o[2][j] * o[2][j] + o[3][j] * o[3][j];
            ss += __shfl_xor(ss, 1); ss += __shfl_xor(ss, 2); ss += __shfl_xor(ss, 4); ss += __shfl_xor(ss, 8);
            const float r = rsqrtf(ss * (1.0f / 64.0f) + 1e-6f);
            float v[4];
#pragma unroll
            for (int ni = 0; ni < 4; ++ni) v[ni] = o[ni][j] * r * p.nsa_kn_g[L * 64 + ni * 16 + l15];
            int pos = 16 * n + 31; if (pos > 4095) pos = 4095;
            const float cs = rope[pos * 16 + (l15 & 7)], sn = rope[pos * 16 + 8 + (l15 & 7)];
            const float pp = __shfl_xor(v[0], 8);
            v[0] = (l15 < 8) ? (v[0] * cs - pp * sn) : (v[0] * cs + pp * sn);
#pragma unroll
            for (int ni = 0; ni < 4; ++ni) kc[(size_t)n * 64 + ni * 16 + l15] = (n < 255) ? f2bf(v[ni]) : (bf16_t)0;
        }
    } else {
        bf16_t* vct = (bf16_t*)(p.ws + OFF_VCT) + (size_t)(b * 2 + g) * 64 * 256;
#pragma unroll
        for (int ni = 0; ni < 4; ++ni) {
            float v0 = o[ni][0], v1 = o[ni][1], v2 = o[ni][2], v3 = o[ni][3];
            if (nb + 3 >= 255) v3 = 0.f;
            uint2 ov; ov.x = pk2(v0, v1); ov.y = pk2(v2, v3);
            *(uint2*)(vct + (size_t)(ni * 16 + l15) * 256 + nb) = ov;
        }
    }
    __syncthreads();
}

__device__ void foxc_job(const Params& p, int L, int bh, char* lds) {
    const int tid = otid(), lane = tid & 63, w = tid >> 6, b = bh >> 2, h = bh & 3;
    const float* gates = (const float*)(p.ws + OFF_GATES);
    float* cc = (float*)(p.ws + OFF_FOXC) + (size_t)bh * 4096;
    float* wtot = (float*)lds;
    const float fb = p.fox_fb[L * 4 + h];
    float v[16];
#pragma unroll
    for (int i = 0; i < 16; ++i) v[i] = gates[((size_t)b * 4096 + tid * 16 + i) * 32 + 24 + h] + fb;
    float run = 0.f;
#pragma unroll
    for (int i = 0; i < 16; ++i) { const float x = v[i]; run += (x >= 0.f) ? -log1pf(__expf(-x)) : (x - log1pf(__expf(x))); v[i] = run; }
    float incl = run;
#pragma unroll
    for (int o = 1; o < 64; o <<= 1) { const float t = __shfl_up(incl, o); if (lane >= o) incl += t; }
    if (lane == 63) wtot[w] = incl;
    __syncthreads();
    float pre = incl - run;
#pragma unroll
    for (int s = 0; s < 4; ++s) if (s < w) pre += wtot[s];
#pragma unroll
    for (int i = 0; i < 4; ++i) *(float4*)(cc + tid * 16 + i * 4) = make_float4(pre + v[4 * i], pre + v[4 * i + 1], pre + v[4 * i + 2], pre + v[4 * i + 3]);
    __syncthreads();
}

constexpr int KV_BUF = 16384;
DEVI void tile_glds(const bf16_t* Kg, int ldk, const bf16_t* Vg, int ldv, char* buf, int tid) {
    const int w = tid >> 6, i = tid & 63;
#pragma unroll
    for (int jj = 0; jj < 2; ++jj) {
        const int j = w * 2 + jj, row = 8 * j + (i >> 3), slot = i & 7;
        const bf16_t* kp = Kg + (size_t)row * ldk + ((slot ^ (row & 7)) << 3);
        const bf16_t* vp = Vg + (size_t)row * ldv + ((slot ^ ((row >> 1) & 7)) << 3);
        __builtin_amdgcn_global_load_lds((const unsigned*)kp, (ldsp_t)(unsigned)(size_t)(buf + j * 1024), 16, 0, 0);
        __builtin_amdgcn_global_load_lds((const unsigned*)vp, (ldsp_t)(unsigned)(size_t)(buf + 8192 + j * 1024), 16, 0, 0);
    }
}
DEVI void lds_kf(const char* buf, int kh, int lane, bf16x8 (&kf)[2][2]) {
    const int quad = lane >> 4, l15 = lane & 15;
#pragma unroll
    for (int t2 = 0; t2 < 2; ++t2)
#pragma unroll
        for (int ks = 0; ks < 2; ++ks) { const int row = kh * 32 + t2 * 16 + l15, ch = ks * 4 + quad; kf[t2][ks] = *(const bf16x8*)(buf + row * 128 + ((ch ^ (row & 7)) << 4)); }
}
DEVI void lds_vf(const char* buf, int kh, int lane, bf16x8 (&vf)[4]) {
    const int quad = lane >> 4, l15 = lane & 15;
#pragma unroll
    for (int dt = 0; dt < 4; ++dt) { const int d = dt * 16 + l15, u0 = kh * 8 + quad, u1 = u0 + 4;
        const uint2 a = *(const uint2*)(buf + 8192 + d * 128 + ((u0 ^ (d & 14)) << 3)), b = *(const uint2*)(buf + 8192 + d * 128 + ((u1 ^ (d & 14)) << 3));
        vf[dt] = mk8(a.x, a.y, b.x, b.y); }
}

template <class MaskF>
DEVI void attn_block64(const char* buf, int kbase, const char* ql, int q0o, int q1o, int qstride, const float* cb, f32x4 (&O)[4][4], float (&m)[4], float (&l)[4], int lane, MaskF maskf) {
    const int quad = lane >> 4;
#pragma unroll
    for (int kh = 0; kh < 2; ++kh) {
        bf16x8 kf[2][2], vf[4];
        lds_kf(buf, kh, lane, kf); lds_vf(buf, kh, lane, vf);
        float ck[8] = {0.f, 0.f, 0.f, 0.f, 0.f, 0.f, 0.f, 0.f};
        if (cb) { const float4 c0 = *(const float4*)(cb + kbase + kh * 32 + quad * 4), c1 = *(const float4*)(cb + kbase + kh * 32 + 16 + quad * 4);
            ck[0] = c0.x; ck[1] = c0.y; ck[2] = c0.z; ck[3] = c0.w; ck[4] = c1.x; ck[5] = c1.y; ck[6] = c1.z; ck[7] = c1.w; }
#pragma unroll
        for (int nt = 0; nt < 4; ++nt) {
            f32x4 s0 = (f32x4){0.f, 0.f, 0.f, 0.f}, s1 = s0;
            { const bf16x8 qa = *(const bf16x8*)(ql + nt * qstride + q0o), qb_ = *(const bf16x8*)(ql + nt * qstride + q1o);
              s0 = mfma(kf[0][0], qa, s0); s1 = mfma(kf[1][0], qa, s1); s0 = mfma(kf[0][1], qb_, s0); s1 = mfma(kf[1][1], qb_, s1); }
            float sv[8]; bool ok[8]; float mx = -1e30f;
#pragma unroll
            for (int e = 0; e < 8; ++e) { sv[e] = (e < 4) ? s0[e & 3] : s1[e & 3]; const int key = kbase + kh * 32 + (e >> 2) * 16 + quad * 4 + (e & 3);
                ok[e] = maskf(nt, ck[e], key, sv[e]); if (ok[e]) mx = fmaxf(mx, sv[e]); }
            mx = fmaxf(mx, __shfl_xor(mx, 16)); mx = fmaxf(mx, __shfl_xor(mx, 32));
            const float mn = fmaxf(m[nt], mx), alpha = __expf(m[nt] - mn);
            float pv[8]; float rs = 0.f;
#pragma unroll
            for (int e = 0; e < 8; ++e) { pv[e] = ok[e] ? __expf(sv[e] - mn) : 0.f; rs += pv[e]; }
            rs += __shfl_xor(rs, 16); rs += __shfl_xor(rs, 32);
            l[nt] = l[nt] * alpha + rs; m[nt] = mn;
            const bf16x8 P = mk8(pk2(pv[0], pv[1]), pk2(pv[2], pv[3]), pk2(pv[4], pv[5]), pk2(pv[6], pv[7]));
#pragma unroll
            for (int dt = 0; dt < 4; ++dt) { O[dt][nt] = O[dt][nt] * alpha; O[dt][nt] = mfma(vf[dt], P, O[dt][nt]); }
        }
    }
}

template <class MaskF>
DEVI void attn_stream(u64 tiles, const bf16_t* Kbase, int ldk, const bf16_t* Vbase, int ldv, char* kvbuf, int jb_wave_min, int jb_wave_max,
                      const char* ql, int q0o, int q1o, int qstride, const float* cb, f32x4 (&O)[4][4], float (&m)[4], float (&l)[4], int tid, int lane, MaskF maskf) {
    if (tiles == 0ull) return;
    int jb = __ffsll((long long)tiles) - 1; tiles &= tiles - 1;
    tile_glds(Kbase + (size_t)jb * 64 * ldk, ldk, Vbase + jb * 64, ldv, kvbuf, tid);
    __syncthreads();
    int cur = 0;
#pragma unroll 1
    for (;;) {
        const bool more = tiles != 0ull;
        int jbn = 0;
        if (more) { jbn = __ffsll((long long)tiles) - 1; tiles &= tiles - 1; tile_glds(Kbase + (size_t)jbn * 64 * ldk, ldk, Vbase + jbn * 64, ldv, kvbuf + (cur ^ 1) * KV_BUF, tid); }
        if (jb >= jb_wave_min && jb <= jb_wave_max) attn_block64(kvbuf + cur * KV_BUF, jb * 64, ql, q0o, q1o, qstride, cb, O, m, l, lane, [&](int nt, float ckv, int key, float& s) { return maskf(nt, ckv, key, jb, s); });
        __syncthreads();
        if (!more) break;
        jb = jbn; cur ^= 1;
    }
}

DEVI void attn_store2(bf16_t* mix, size_t token0, int tokstride, int col0, int colstride, const f32x4 (&O)[4][4], const float (&sc)[4], int lane, bool accum) {
    const int quad = lane >> 4, l15 = lane & 15;
#pragma unroll
    for (int nt = 0; nt < 4; ++nt)
#pragma unroll
        for (int dt = 0; dt < 4; ++dt) {
            bf16_t* dst = mix + (token0 + nt * tokstride + l15) * DM + col0 + nt * colstride + dt * 16 + quad * 4;
            float a0 = O[dt][nt][0] * sc[nt], a1 = O[dt][nt][1] * sc[nt], a2 = O[dt][nt][2] * sc[nt], a3 = O[dt][nt][3] * sc[nt];
            if (accum) { const uint2 old = *(const uint2*)dst; a0 += bflo(old.x); a1 += bfhi(old.x); a2 += bflo(old.y); a3 += bfhi(old.y); }
            uint2 o; o.x = pk2(a0, a1); o.y = pk2(a2, a3);
            *(uint2*)dst = o;
        }
}

__device__ void nsa_unit(const Params& p, int L, int b, int g, int blk, char* lds) {
    const int tid = otid(), lane = tid & 63, w = tid >> 6, quad = lane >> 4, l15 = lane & 15;
    const bf16_t* proj = (const bf16_t*)(p.ws + OFF_BIG); const bf16_t* VT = (const bf16_t*)(p.ws + OFF_BIG + OFF_VT_IN_BIG);
    const float* gates = (const float*)(p.ws + OFF_GATES);
    bf16_t* mix = (bf16_t*)(p.ws + OFF_ACT);
    char* kvbuf = lds; float* impL = (float*)(lds + KV_BUF)  ; char* Qs = lds + 32768; u64* selm = (u64*)(lds + 65536);
    const int q0 = blk * 64; const int tq = q0 + w * 16 + l15; const size_t token = (size_t)b * 4096 + tq;
    const size_t token0 = (size_t)b * 4096 + q0 + w * 16;
    const int mixcol = 256 + g * 256;
#pragma unroll
    for (int t = 0; t < 8; ++t) { const int idx = t * 64 + lane, rr = idx >> 3, c = idx & 7, hh = rr >> 4, r16 = rr & 15;
        const uint4 v = *(const uint4*)(proj + (token0 + r16) * PJ_LD + 1024 + (g * 4 + hh) * 64 + c * 8);
        *(uint4*)(Qs + (hh * 64 + w * 16 + r16) * 128 + ((c ^ (r16 & 7)) << 4)) = v; }
    const char* ql = Qs + (w * 16 + l15) * 128; const int q0o = ((quad) ^ (l15 & 7)) << 4, q1o = ((4 + quad) ^ (l15 & 7)) << 4; const int qstride = 8192;
    __syncthreads();
    f32x4 O[4][4]; float m[4], l[4];
    const bf16_t* Kc = (const bf16_t*)(p.ws + OFF_KC) + (size_t)(b * 2 + g) * 256 * 64;
    const bf16_t* VcT = (const bf16_t*)(p.ws + OFF_VCT) + (size_t)(b * 2 + g) * 64 * 256;
    const int ncb = (4 * blk + 3 + 63) >> 6;
#pragma unroll
    for (int nt = 0; nt < 4; ++nt) { m[nt] = -1e30f; l[nt] = 0.f; }
    {
#pragma unroll 1
        for (int pass = 0; pass < 2; ++pass) {
            float inv[4]; float prevr = 0.f;
            if (pass == 1) {
#pragma unroll
                for (int nt = 0; nt < 4; ++nt) inv[nt] = 1.0f / fmaxf(l[nt], 1e-30f);
#pragma unroll
                for (int dt = 0; dt < 4; ++dt)
#pragma unroll
                    for (int nt = 0; nt < 4; ++nt) O[dt][nt] = (f32x4){0.f, 0.f, 0.f, 0.f};
            }
#pragma unroll 1
            for (int ct = 0; ct < ncb; ++ct) {
                tile_glds(Kc + (size_t)ct * 64 * 64, 64, VcT + ct * 64, 256, kvbuf, tid);
                __syncthreads();
                const char* buf = kvbuf;
#pragma unroll
                for (int kh = 0; kh < 2; ++kh) {
                    bf16x8 kf[2][2]; lds_kf(buf, kh, lane, kf);
                    if (pass == 0) {
#pragma unroll
                        for (int nt = 0; nt < 4; ++nt) {
                            f32x4 s0 = (f32x4){0.f, 0.f, 0.f, 0.f}, s1 = s0;
                            { const bf16x8 qa = *(const bf16x8*)(ql + nt * qstride + q0o), qb_ = *(const bf16x8*)(ql + nt * qstride + q1o);
                              s0 = mfma(kf[0][0], qa, s0); s1 = mfma(kf[1][0], qa, s1); s0 = mfma(kf[0][1], qb_, s0); s1 = mfma(kf[1][1], qb_, s1); }
                            float sv[8]; bool ok[8]; float mx = -1e30f;
#pragma unroll
                            for (int e = 0; e < 8; ++e) { sv[e] = (e < 4) ? s0[e & 3] : s1[e & 3]; const int n = ct * 64 + kh * 32 + (e >> 2) * 16 + quad * 4 + (e & 3);
                                ok[e] = (16 * n + 31 <= tq); if (ok[e]) mx = fmaxf(mx, sv[e]); }
                            mx = fmaxf(mx, __shfl_xor(mx, 16)); mx = fmaxf(mx, __shfl_xor(mx, 32));
                            const float mn = fmaxf(m[nt], mx), alpha = __expf(m[nt] - mn);
                            float rs = 0.f;
#pragma unroll
                            for (int e = 0; e < 8; ++e) rs += ok[e] ? __expf(sv[e] - mn) : 0.f;
                            rs += __shfl_xor(rs, 16); rs += __shfl_xor(rs, 32);
                            l[nt] = l[nt] * alpha + rs; m[nt] = mn;
                        }
                    } else {
                        bf16x8 vf[4]; lds_vf(buf, kh, lane, vf);
                        float As[2] = {0.f, 0.f}, p3[2] = {0.f, 0.f};
#pragma unroll
                        for (int nt = 0; nt < 4; ++nt) {
                            f32x4 s0 = (f32x4){0.f, 0.f, 0.f, 0.f}, s1 = s0;
                            { const bf16x8 qa = *(const bf16x8*)(ql + nt * qstride + q0o), qb_ = *(const bf16x8*)(ql + nt * qstride + q1o);
                              s0 = mfma(kf[0][0], qa, s0); s1 = mfma(kf[1][0], qa, s1); s0 = mfma(kf[0][1], qb_, s0); s1 = mfma(kf[1][1], qb_, s1); }
                            float pv[8];
#pragma unroll
                            for (int e = 0; e < 8; ++e) { const float s = (e < 4) ? s0[e & 3] : s1[e & 3]; const int n = ct * 64 + kh * 32 + (e >> 2) * 16 + quad * 4 + (e & 3);
                                pv[e] = (16 * n + 31 <= tq) ? __expf(s - m[nt]) * inv[nt] : 0.f; }
                            As[0] += (pv[0] + pv[1]) + (pv[2] + pv[3]); As[1] += (pv[4] + pv[5]) + (pv[6] + pv[7]); p3[0] += pv[3]; p3[1] += pv[7];
                            const bf16x8 P = mk8(pk2(pv[0], pv[1]), pk2(pv[2], pv[3]), pk2(pv[4], pv[5]), pk2(pv[6], pv[7]));
#pragma unroll
                            for (int dt = 0; dt < 4; ++dt) O[dt][nt] = mfma(vf[dt], P, O[dt][nt]);
                        }
                        const int qq = w * 16 + l15;
#pragma unroll
                        for (int t2 = 0; t2 < 2; ++t2) {
                            const float rr = __shfl(p3[t2], (lane + 48) & 63);
                            const float carry = (quad == 0) ? prevr : rr; prevr = rr;
                            const int jb = ct * 16 + kh * 8 + t2 * 4 + quad;
                            impL[jb * 64 + ((qq ^ jb) & 63)] = As[t2] + carry;
                        }
                    }
                }
                __syncthreads();
            }
        }
    }
    {
        const float4 gv = *(const float4*)(gates + token * 32 + 0 * 8 + g * 4);
        const float sc[4] = {gv.x, gv.y, gv.z, gv.w};
        attn_store2(mix, token0, 0, mixcol, 64, O, sc, lane, false);
    }
#pragma unroll 1
    for (int qi = 0; qi < 16; ++qi) {
        const int q = w * 16 + qi, jb = lane;
        float val = impL[jb * 64 + ((q ^ jb) & 63)];
        if (jb > blk) val = -1e30f;
        else if (jb == 0 || jb == blk || jb == blk - 1) val = 1e30f;
        int rank = 0;
        for (int jp = 0; jp < 64; ++jp) { const float vj = __shfl(val, jp); rank += ((vj > val) || (vj == val && jp < jb)) ? 1 : 0; }
        const bool sel = (rank < 16) && (val > -5e29f);
        const u64 mask = __ballot(sel);
        if (lane == 0) selm[q] = mask;
    }
    __syncthreads();
    u64 uni = 0;
    for (int q = 0; q < 64; ++q) uni |= selm[q];
    const u64 sm = selm[w * 16 + l15];
    {
#pragma unroll
        for (int nt = 0; nt < 4; ++nt) { m[nt] = -1e30f; l[nt] = 0.f; }
#pragma unroll
        for (int dt = 0; dt < 4; ++dt)
#pragma unroll
            for (int nt = 0; nt < 4; ++nt) O[dt][nt] = (f32x4){0.f, 0.f, 0.f, 0.f};
        const u64 tiles = uni & ((blk == 63) ? ~0ull : ((2ull << blk) - 1ull));
        attn_stream(tiles, proj + (size_t)b * 4096 * PJ_LD + 1792 + g * 64, PJ_LD, VT + ((size_t)((4 + g) * 8 + b) * 64) * 4096, 4096, kvbuf, 0, 63, ql, q0o, q1o, qstride, nullptr, O, m, l, tid, lane,
                    [&](int nt, float ckv, int key, int jb, float& s) { return (((sm >> jb) & 1ull) != 0) && (key <= tq); });
        const float4 gv = *(const float4*)(gates + token * 32 + 1 * 8 + g * 4);
        const float sc[4] = {gv.x / fmaxf(l[0], 1e-30f), gv.y / fmaxf(l[1], 1e-30f), gv.z / fmaxf(l[2], 1e-30f), gv.w / fmaxf(l[3], 1e-30f)};
        attn_store2(mix, token0, 0, mixcol, 64, O, sc, lane, true);
    }
    {
#pragma unroll
        for (int nt = 0; nt < 4; ++nt) { m[nt] = -1e30f; l[nt] = 0.f; }
#pragma unroll
        for (int dt = 0; dt < 4; ++dt)
#pragma unroll
            for (int nt = 0; nt < 4; ++nt) O[dt][nt] = (f32x4){0.f, 0.f, 0.f, 0.f};
        const int jlo = blk > 8 ? blk - 8 : 0;
        const u64 upto = (blk == 63) ? ~0ull : ((2ull << blk) - 1ull);
        const u64 tiles = upto & ~((1ull << jlo) - 1ull);
        attn_stream(tiles, proj + (size_t)b * 4096 * PJ_LD + 2048 + g * 64, PJ_LD, VT + ((size_t)((6 + g) * 8 + b) * 64) * 4096, 4096, kvbuf, 0, 63, ql, q0o, q1o, qstride, nullptr, O, m, l, tid, lane,
                    [&](int nt, float ckv, int key, int jb, float& s) { return (key <= tq) && (key + 512 > tq); });
        const float4 gv = *(const float4*)(gates + token * 32 + 2 * 8 + g * 4);
        const float sc[4] = {gv.x / fmaxf(l[0], 1e-30f), gv.y / fmaxf(l[1], 1e-30f), gv.z / fmaxf(l[2], 1e-30f), gv.w / fmaxf(l[3], 1e-30f)};
        attn_store2(mix, token0, 0, mixcol, 64, O, sc, lane, true);
    }
    __syncthreads();
}

__device__ void fox_unit(const Params& p, int L, int b, int h, int qb, char* lds) {
    const int tid = otid(), lane = tid & 63, w = tid >> 6, quad = lane >> 4, l15 = lane & 15;
    const bf16_t* proj = (const bf16_t*)(p.ws + OFF_BIG); const bf16_t* VT = (const bf16_t*)(p.ws + OFF_BIG + OFF_VT_IN_BIG);
    bf16_t* mix = (bf16_t*)(p.ws + OFF_ACT);
    const float* cc = (const float*)(p.ws + OFF_FOXC) + (size_t)(b * 4 + h) * 4096;
    const int q0 = qb * 256 + w * 64; const size_t token0 = (size_t)b * 4096 + q0;
    int tq[4]; float cq[4];
#pragma unroll
    for (int nt = 0; nt < 4; ++nt) { tq[nt] = q0 + nt * 16 + l15; cq[nt] = cc[tq[nt]]; }
    char* Qs = lds + 32768;
#pragma unroll
    for (int t = 0; t < 8; ++t) { const int idx = t * 64 + lane, rr = idx >> 3, c = idx & 7;
        const uint4 v = *(const uint4*)(proj + (token0 + rr) * PJ_LD + 2304 + h * 64 + c * 8);
        *(uint4*)(Qs + (w * 64 + rr) * 128 + ((c ^ (rr & 7)) << 4)) = v; }
    const char* ql = Qs + (w * 64 + l15) * 128; const int q0o = ((quad) ^ (l15 & 7)) << 4, q1o = ((4 + quad) ^ (l15 & 7)) << 4; const int qstride = 2048;
    __syncthreads();
    f32x4 O[4][4]; float m[4], l[4];
#pragma unroll
    for (int nt = 0; nt < 4; ++nt) { m[nt] = -1e30f; l[nt] = 0.f; }
#pragma unroll
    for (int dt = 0; dt < 4; ++dt)
#pragma unroll
        for (int nt = 0; nt < 4; ++nt) O[dt][nt] = (f32x4){0.f, 0.f, 0.f, 0.f};
    const int jmax = qb * 4 + 3;
    int jlo_w, jlo_b;
    { const float cq0 = cc[q0]; int lo = 0, hi = qb * 4 + w;
      while (lo < hi) { const int mid = (lo + hi) >> 1; if (cq0 - cc[mid * 64 + 63] >= -140.f) hi = mid; else lo = mid + 1; }
      jlo_w = lo; }
    { const float cq0 = cc[qb * 256]; int lo = 0, hi = qb * 4;
      while (lo < hi) { const int mid = (lo + hi) >> 1; if (cq0 - cc[mid * 64 + 63] >= -140.f) hi = mid; else lo = mid + 1; }
      jlo_b = lo; }
    const u64 tiles = ((jmax == 63) ? ~0ull : ((2ull << jmax) - 1ull)) & ~((1ull << jlo_b) - 1ull);
    attn_stream(tiles, proj + (size_t)b * 4096 * PJ_LD + 2560 + h * 64, PJ_LD, VT + ((size_t)((8 + h) * 8 + b) * 64) * 4096, 4096, lds, jlo_w, qb * 4 + w, ql, q0o, q1o, qstride, cc, O, m, l, tid, lane,
                [&](int nt, float ckv, int key, int jb, float& s) { s += cq[nt] - ckv; return key <= tq[nt]; });
    float sc[4];
#pragma unroll
    for (int nt = 0; nt < 4; ++nt) sc[nt] = 1.0f / fmaxf(l[nt], 1e-30f);
    attn_store2(mix, token0, 16, 768 + h * 64, 0, O, sc, lane, false);
}

__device__ void mixA_phase(const Params& p, int L, char* lds);
DEVI int next_unit(unsigned* ctr, char* lds) {
    int* slot = (int*)(lds + LDS_BYTES - 16);
    __syncthreads();
    if (otid() == 0) *slot = (int)atomicAdd(ctr, 1u);
    __syncthreads();
    return *slot;
}
__device__ void mixA_phase(const Params& p, int L, char* lds) {
    unsigned* ctr = (unsigned*)(p.ws + OFF_CTR) + L * 4 + 3;
#pragma unroll 1
    for (;;) {
        const int job = next_unit(ctr, lds); if (job >= 160 + 2048) break;
        if (job < 128) compress_unit(p, L, job, lds);
        else if (job < 160) foxc_job(p, L, job - 128, lds);
        else hgrn_a_unit(p, L, job - 160, lds);
    }
}
__device__ void mixB_phase(const Params& p, int L, char* lds) {
    unsigned* ctr = (unsigned*)(p.ws + OFF_CTR) + L * 4;
#pragma unroll 1
    for (;;) { const int f = next_unit(ctr + 0, lds); if (f >= 512) break; const int qb = 15 - (f >> 5), bh = f & 31; fox_unit(p, L, bh >> 2, bh & 3, qb, lds); }
#pragma unroll 1
    for (;;) { const int n = next_unit(ctr + 1, lds); if (n >= 1024) break; const int blk = 63 - (n >> 4), bg = n & 15; nsa_unit(p, L, bg >> 1, bg & 1, blk, lds); }
#pragma unroll 1
    for (;;) { const int u = next_unit(ctr + 2, lds); if (u >= 2048) break; hgrn_c_unit(p, L, u, lds); }
}

__device__ void run_phase(const Params& p, int ph, char* lds) {
    if (ph == 0) { prep_phase(p, lds); return; }
    const int L = (ph - 1) / 9, s = (ph - 1) % 9;
    switch (s) {
        case 0: gemm_phase<EPI_PROJ>(p, L, lds); break;
        case 1: mixA_phase(p, L, lds); break;
        case 2: hgrn_scan_phase(p); break;
        case 3: mixB_phase(p, L, lds); break;
        case 4: gemm_phase<EPI_WO>(p, L, lds); break;
        case 5: norm_phase(p.out, p.norm2_g + L * 1024, (bf16_t*)(p.ws + OFF_ACT)); break;
        case 6: gemm_phase<EPI_UP>(p, L, lds); break;
        case 7: gemm_phase<EPI_DOWN>(p, L, lds); break;
        default: norm_phase(p.out, p.norm1_g + (L + 1) * 1024, (bf16_t*)(p.ws + OFF_ACT)); break;
    }
}

__global__ void __launch_bounds__(256, 2) fwd_kernel(Params p, int ph_lo, int ph_hi) {
    __shared__ __attribute__((aligned(16))) char lds[LDS_BYTES];
    for (int ph = ph_lo; ph < ph_hi; ++ph) {
#ifdef REPEAT_MASK
        const int nrep = (ph >= 1 && ((REPEAT_MASK >> ((ph - 1) % 9)) & 1)) ? 2 : 1;
#pragma unroll 1
        for (int rep = 0; rep < nrep; ++rep) {
            if (rep) cg::this_grid().sync();
            run_phase(p, ph, lds);
        }
#else
        run_phase(p, ph, lds);
#endif
        if (ph + 1 < ph_hi) { cg::this_grid().sync(); }
    }
}

extern "C" void kernel_launch(void* const* d_in, const int* in_sizes, int n_in, void* d_out, int out_size, void* d_ws, size_t ws_size,
                              hipStream_t stream) {
    if (ws_size < WS_NEED) { fprintf(stderr, "workspace too small: %zu < %zu\n", ws_size, (size_t)WS_NEED); return; }
    Params p{};
    p.x = (const float*)d_in[0]; p.norm1_g = (const float*)d_in[1]; p.w_in = (const float*)d_in[2]; p.lb_logits = (const float*)d_in[3];
    p.onorm_g = (const float*)d_in[4]; p.nsa_qn_g = (const float*)d_in[5]; p.nsa_kn_g = (const float*)d_in[6]; p.cmp_pos = (const float*)d_in[7];
    p.cmp_w1 = (const float*)d_in[8]; p.cmp_w2 = (const float*)d_in[9]; p.fox_qn_g = (const float*)d_in[10]; p.fox_kn_g = (const float*)d_in[11];
    p.fox_fb = (const float*)d_in[12]; p.w_o = (const float*)d_in[13]; p.norm2_g = (const float*)d_in[14]; p.w_up = (const float*)d_in[15];
    p.w_down = (const float*)d_in[16];
    p.out = (float*)d_out; p.ws = (char*)d_ws;
#if MULTI_LAUNCH
    for (int ph = 0; ph < NPHASE; ++ph) hipLaunchKernelGGL(fwd_kernel, dim3(512), dim3(256), 0, stream, p, ph, ph + 1);
#else
    static int grid_blocks = 0;
    if (!grid_blocks) {
        int dev = 0, cus = 0, per_cu = 0;
        hipGetDevice(&dev);
        hipDeviceGetAttribute(&cus, hipDeviceAttributeMultiprocessorCount, dev);
        hipOccupancyMaxActiveBlocksPerMultiprocessor(&per_cu, fwd_kernel, 256, 0);
        per_cu = 2;
        grid_blocks = cus * per_cu;
        grid_blocks &= ~7;
    }
    int lo = 0, hi = NPHASE;
    void* args[] = {&p, &lo, &hi};
    hipError_t e = hipLaunchCooperativeKernel((void*)fwd_kernel, dim3(grid_blocks), dim3(256), args, 0, stream);
    if (e != hipSuccess) fprintf(stderr, "cooperative launch failed: %s (grid %d)\n", hipGetErrorString(e), grid_blocks);
#endif
}
```

```cpp
#include <hip/hip_runtime.h>
#include <hip/hip_cooperative_groups.h>
#include <stdint.h>
#include <cstdio>
namespace cg = cooperative_groups;

#ifndef MULTI_LAUNCH
#define MULTI_LAUNCH 0
#endif

typedef unsigned short bf16_t;
typedef short bf16x8 __attribute__((ext_vector_type(8)));
typedef float f32x4 __attribute__((ext_vector_type(4)));
typedef unsigned long long u64;
typedef __attribute__((address_space(3))) unsigned* ldsp_t;
typedef unsigned u32x16 __attribute__((ext_vector_type(16)));
#define DEVI __device__ __forceinline__

constexpr int T_TOK = 32768, SEQ = 4096, DM = 1024, DFF = 4096;
constexpr int PJ_LD = 3072;
constexpr int NW_IN = 3100, NW_IN_PAD = 3200;
constexpr int NPHASE = 18;

constexpr size_t OFF_WIN = 0;
constexpr size_t OFF_WO = OFF_WIN + (size_t)2 * NW_IN_PAD * 1024 * 2;
constexpr size_t OFF_WUP = OFF_WO + (size_t)2 * 1024 * 1024 * 2;
constexpr size_t OFF_WDN = OFF_WUP + (size_t)2 * 4096 * 1024 * 2;
constexpr size_t OFF_W1T = OFF_WDN + (size_t)2 * 4096 * 1024 * 2;
constexpr size_t OFF_W2T = OFF_W1T + (size_t)2 * 2 * 128 * 2048 * 2;
constexpr size_t OFF_CBIAS = OFF_W2T + (size_t)2 * 2 * 64 * 128 * 2;
constexpr size_t OFF_CTR = OFF_CBIAS + 2048;
constexpr size_t OFF_ROPE = OFF_CTR + 256;
constexpr size_t OFF_GATES = OFF_ROPE + (size_t)4096 * 16 * 4;
constexpr size_t OFF_FOXC = OFF_GATES + (size_t)T_TOK * 32 * 4;
constexpr size_t OFF_KC = OFF_FOXC + (size_t)8 * 4 * 4096 * 4;
constexpr size_t OFF_VCT = OFF_KC + (size_t)8 * 2 * 256 * 64 * 2;
constexpr size_t OFF_DECAY = OFF_VCT + (size_t)8 * 2 * 256 * 64 * 2;
constexpr size_t OFF_KVT = OFF_DECAY + (size_t)2048 * 64 * 4;
constexpr size_t OFF_ST = OFF_KVT + (size_t)2048 * 4096 * 4;
constexpr size_t OFF_ACT = OFF_ST + (size_t)2048 * 4096 * 2;
constexpr size_t OFF_BIG = OFF_ACT + (size_t)T_TOK * 1024 * 2;
constexpr size_t OFF_VT_IN_BIG = (size_t)T_TOK * PJ_LD * 2;
constexpr size_t WS_NEED = OFF_BIG + (size_t)T_TOK * 4096 * 2;

constexpr int LDS_BYTES = 67584;

struct Params {
    const float *x, *norm1_g, *w_in, *lb_logits, *onorm_g, *nsa_qn_g, *nsa_kn_g, *cmp_pos, *cmp_w1, *cmp_w2,
        *fox_qn_g, *fox_kn_g, *fox_fb, *w_o, *norm2_g, *w_up, *w_down;
    float* out;
    char* ws;
};

DEVI unsigned pk2(float lo, float hi) { unsigned r; asm("v_cvt_pk_bf16_f32 %0, %1, %2" : "=v"(r) : "v"(lo), "v"(hi)); return r; }
DEVI bf16_t f2bf(float f) { return (bf16_t)(pk2(f, 0.f) & 0xffffu); }
DEVI float bf2f(bf16_t h) { return __uint_as_float(((unsigned)h) << 16); }
DEVI float bflo(unsigned u) { return __uint_as_float(u << 16); }
DEVI float bfhi(unsigned u) { return __uint_as_float(u & 0xffff0000u); }
DEVI f32x4 mfma(bf16x8 a, bf16x8 b, f32x4 c) { return __builtin_amdgcn_mfma_f32_16x16x32_bf16(a, b, c, 0, 0, 0); }
DEVI int otid() { int t; asm volatile("v_mov_b32 %0, %1" : "=v"(t) : "v"(threadIdx.x)); return t; }
DEVI float wave_sum(float v) {
#pragma unroll
    for (int o = 32; o >= 1; o >>= 1) v += __shfl_xor(v, o);
    return v;
}
DEVI bf16x8 mk8(unsigned a, unsigned b, unsigned c, unsigned d) {
    uint4 u = make_uint4(a, b, c, d);
    return *(bf16x8*)&u;
}
DEVI bf16x8 ld8(const bf16_t* p) { uint4 u = *(const uint4*)p; return *(bf16x8*)&u; }
DEVI bf16x8 ld4x2(const bf16_t* p0, const bf16_t* p1) {
    uint2 a = *(const uint2*)p0, b = *(const uint2*)p1;
    return mk8(a.x, a.y, b.x, b.y);
}

DEVI int win_colmap(int n) {
    if (n < 2304) return n;
    if (n < 3072) return n + 24;
    if (n < 3096) return n - 768;
    return n;
}
__device__ void transpose_tile(const float* __restrict__ src, int ld_src, bf16_t* __restrict__ dst, int ld_dst, int k0, int n0, int nvalid,
                               int colmode, float* tile) {
    const int tid = otid();
    for (int idx = tid; idx < 4096; idx += 256) {
        const int i = idx >> 6, j = idx & 63, n = n0 + j;
        float v = 0.f;
        if (n < nvalid) v = src[(size_t)(k0 + i) * ld_src + (colmode ? win_colmap(n) : n)];
        tile[i * 65 + j] = v;
    }
    __syncthreads();
    for (int idx = tid; idx < 4096; idx += 256) {
        const int j = idx >> 6, i = idx & 63;
        dst[(size_t)(n0 + j) * ld_dst + k0 + i] = f2bf(tile[i * 65 + j]);
    }
    __syncthreads();
}

__device__ void norm_phase(const float* __restrict__ xin, const float* __restrict__ g, bf16_t* __restrict__ hout) {
    const int tid = otid(); const int lane = tid & 63, w = tid >> 6;
    for (int row = blockIdx.x * 4 + w; row < T_TOK; row += gridDim.x * 4) {
        const float4* xr = (const float4*)(xin + (size_t)row * DM);
        float4 v[4]; float ss = 0.f;
#pragma unroll
        for (int i = 0; i < 4; ++i) { v[i] = xr[lane + 64 * i]; ss += v[i].x * v[i].x + v[i].y * v[i].y + v[i].z * v[i].z + v[i].w * v[i].w; }
        ss = wave_sum(ss);
        const float r = rsqrtf(ss * (1.0f / 1024.0f) + 1e-6f);
#pragma unroll
        for (int i = 0; i < 4; ++i) {
            const float4 gg = ((const float4*)g)[lane + 64 * i];
            uint2 o; o.x = pk2(v[i].x * r * gg.x, v[i].y * r * gg.y); o.y = pk2(v[i].z * r * gg.z, v[i].w * r * gg.w);
            *(uint2*)(hout + (size_t)row * DM + (lane + 64 * i) * 4) = o;
        }
    }
}

__device__ void prep_phase(const Params& p, char* lds) {
    float* tile = (float*)lds;
    if (blockIdx.x == 0 && otid() < 64) ((unsigned*)(p.ws + OFF_CTR))[otid()] = 0u;
    bf16_t* win_t = (bf16_t*)(p.ws + OFF_WIN); bf16_t* wo_t = (bf16_t*)(p.ws + OFF_WO);
    bf16_t* wup_t = (bf16_t*)(p.ws + OFF_WUP); bf16_t* wdn_t = (bf16_t*)(p.ws + OFF_WDN);
    bf16_t* w1t = (bf16_t*)(p.ws + OFF_W1T); bf16_t* w2t = (bf16_t*)(p.ws + OFF_W2T);
    const int J0 = 1600, J1 = J0 + 512, J2 = J1 + 2048, J3 = J2 + 2048, J4 = J3 + 256, J5 = J4 + 8, J6 = J5 + 128, J7 = J6 + 128;
    for (int job = blockIdx.x; job < J7; job += gridDim.x) {
        if (job < J0) { const int L = job / 800, r = job % 800, kt = r / 50, nt = r % 50;
            transpose_tile(p.w_in + (size_t)L * 1024 * NW_IN, NW_IN, win_t + (size_t)L * NW_IN_PAD * 1024, 1024, kt * 64, nt * 64, NW_IN, 1, tile);
        } else if (job < J1) { const int j = job - J0, L = j / 256, r = j % 256, kt = r / 16, nt = r % 16;
            transpose_tile(p.w_o + (size_t)L * 1024 * 1024, 1024, wo_t + (size_t)L * 1024 * 1024, 1024, kt * 64, nt * 64, 1024, 0, tile);
        } else if (job < J2) { const int j = job - J1, L = j / 1024, r = j % 1024, kt = r / 64, nt = r % 64;
            transpose_tile(p.w_up + (size_t)L * 1024 * 4096, 4096, wup_t + (size_t)L * 4096 * 1024, 1024, kt * 64, nt * 64, 4096, 0, tile);
        } else if (job < J3) { const int j = job - J2, L = j / 1024, r = j % 1024, kt = r / 16, nt = r % 16;
            transpose_tile(p.w_down + (size_t)L * 4096 * 1024, 1024, wdn_t + (size_t)L * 1024 * 4096, 4096, kt * 64, nt * 64, 1024, 0, tile);
        } else if (job < J4) { const int j = job - J3, lw = j / 64, r = j % 64, kt = r / 2, nt = r % 2;
            transpose_tile(p.cmp_w1 + (size_t)lw * 2048 * 128, 128, w1t + (size_t)lw * 128 * 2048, 2048, kt * 64, nt * 64, 128, 0, tile);
        } else if (job < J5) { const int j = job - J4, lw = j / 2, kt = j % 2;
            transpose_tile(p.cmp_w2 + (size_t)lw * 128 * 64, 64, w2t + (size_t)lw * 64 * 128, 128, kt * 64, 0, 64, 0, tile);
        } else if (job < J6) {
            const int t_ = otid(); const int o = (job - J5) * 4 + (t_ >> 6), lane = t_ & 63, lw = o >> 7, hid = o & 127;
            const float* pos = p.cmp_pos + (size_t)lw * 2048; const float* w1 = p.cmp_w1 + (size_t)lw * 2048 * 128 + hid;
            float s = 0.f;
            for (int k = lane; k < 2048; k += 64) s += pos[k] * w1[(size_t)k * 128];
            s = wave_sum(s);
            if (lane == 0) ((float*)(p.ws + OFF_CBIAS))[o] = s;
        } else {
            const int e = (job - J6) * 256 + otid(), pos = e >> 3, i = e & 7;
            const float invf[8] = {1.0f, 0.1939227432012558f, 0.03760603070259094f, 0.007292664609849453f, 0.0014142135623842478f,
                                   0.00027424818836152554f, 5.318296098266728e-05f, 1.0313386155758053e-05f};
            float fr = 1.0f;
#pragma unroll
            for (int q = 0; q < 8; ++q) if (i == q) fr = invf[q];
            const float ang = (float)pos * fr;
            const double a = (double)ang; const double n = rint(a * 0.15915494309189535); const float rr = (float)(a - n * 6.283185307179586);
            float* rt = (float*)(p.ws + OFF_ROPE);
            rt[pos * 16 + i] = __cosf(rr); rt[pos * 16 + 8 + i] = __sinf(rr);
        }
    }
    norm_phase(p.x, p.norm1_g, (bf16_t*)(p.ws + OFF_ACT));
}

enum { EPI_PROJ = 0, EPI_WO = 1, EPI_UP = 2, EPI_DOWN = 3 };

DEVI void proj_epilogue(const Params& p, int L, const f32x4 (&acc)[4][4], int m0w, int cc, int lane) {
    const int quad = lane >> 4, l15 = lane & 15;
    bf16_t* proj = (bf16_t*)(p.ws + OFF_BIG); bf16_t* VT = (bf16_t*)(p.ws + OFF_BIG + OFF_VT_IN_BIG);
    float* gates = (float*)(p.ws + OFF_GATES); const float* rope = (const float*)(p.ws + OFF_ROPE);
    if (cc > 48) return;
    int kind = 0, vidx = 0; const float* gain = nullptr; float scale = 1.f; bool dorope = false;
    if (cc >= 8 && cc < 12) { kind = 5; vidx = cc - 8; }
    else if (cc >= 16 && cc < 24) { kind = 1; gain = p.nsa_qn_g + L * 64; scale = 0.125f; dorope = true; }
    else if (cc == 28 || cc == 29 || cc == 32 || cc == 33) { kind = 1; gain = p.nsa_kn_g + L * 64; dorope = true; }
    else if (cc == 30 || cc == 31) { kind = 5; vidx = 4 + (cc - 30); }
    else if (cc == 34 || cc == 35) { kind = 5; vidx = 6 + (cc - 34); }
    else if (cc >= 36 && cc < 40) { kind = 1; gain = p.fox_qn_g + L * 64; scale = 0.125f; }
    else if (cc >= 40 && cc < 44) { kind = 1; gain = p.fox_kn_g + L * 64; }
    else if (cc >= 44 && cc < 48) { kind = 5; vidx = 8 + (cc - 44); }
    else if (cc == 48) kind = 6;
#pragma unroll
    for (int mi = 0; mi < 4; ++mi) {
        const int token = m0w + mi * 16 + l15, pos = token & 4095, bb = token >> 12;
        float v[4][4];
#pragma unroll
        for (int ni = 0; ni < 4; ++ni)
#pragma unroll
            for (int j = 0; j < 4; ++j) v[ni][j] = acc[mi][ni][j];
        if (kind == 6) {
#pragma unroll
            for (int ni = 0; ni < 2; ++ni)
#pragma unroll
                for (int j = 0; j < 4; ++j) { const int d = ni * 16 + quad * 4 + j;
                    if (d < 24) gates[(size_t)token * 32 + d] = 1.0f / (1.0f + __expf(-v[ni][j]));
                    else if (d < 28) gates[(size_t)token * 32 + d] = v[ni][j]; }
            continue;
        }
        if (kind == 1) {
            float ss = 0.f;
#pragma unroll
            for (int ni = 0; ni < 4; ++ni)
#pragma unroll
                for (int j = 0; j < 4; ++j) ss += v[ni][j] * v[ni][j];
            ss += __shfl_xor(ss, 16); ss += __shfl_xor(ss, 32);
            const float r = rsqrtf(ss * (1.0f / 64.0f) + 1e-6f);
#pragma unroll
            for (int ni = 0; ni < 4; ++ni) { const float4 gg = *(const float4*)(gain + ni * 16 + quad * 4);
                v[ni][0] *= r * gg.x; v[ni][1] *= r * gg.y; v[ni][2] *= r * gg.z; v[ni][3] *= r * gg.w; }
            if (dorope) {
                const float4 cs = *(const float4*)(rope + pos * 16 + (quad & 1) * 4), sn = *(const float4*)(rope + pos * 16 + 8 + (quad & 1) * 4);
                const float cv[4] = {cs.x, cs.y, cs.z, cs.w}, sv[4] = {sn.x, sn.y, sn.z, sn.w};
#pragma unroll
                for (int j = 0; j < 4; ++j) { const float xx = v[0][j], pp = __shfl_xor(xx, 32);
                    v[0][j] = (quad < 2) ? (xx * cv[j] - pp * sv[j]) : (xx * cv[j] + pp * sv[j]); }
            }
#pragma unroll
            for (int ni = 0; ni < 4; ++ni)
#pragma unroll
                for (int j = 0; j < 4; ++j) v[ni][j] *= scale;
        }
        if (kind == 5) {
#pragma unroll
            for (int ni = 0; ni < 4; ++ni)
#pragma unroll
                for (int j = 0; j < 4; ++j) { const int d = ni * 16 + quad * 4 + j;
                    VT[((size_t)(vidx * 8 + bb) * 64 + d) * 4096 + pos] = f2bf(v[ni][j]); }
        } else {
#pragma unroll
            for (int ni = 0; ni < 4; ++ni) { uint2 o; o.x = pk2(v[ni][0], v[ni][1]); o.y = pk2(v[ni][2], v[ni][3]);
                *(uint2*)(proj + (size_t)token * PJ_LD + cc * 64 + ni * 16 + quad * 4) = o; }
        }
    }
}

DEVI void g_load(uint4 (&RA)[4], uint4 (&RB)[4], const bf16_t* Ap, const bf16_t* Bp, int K, int KT) {
#pragma unroll
    for (int i = 0; i < 4; ++i) { RA[i] = *(const uint4*)(Ap + (size_t)(32 * i) * K + KT * 64); RB[i] = *(const uint4*)(Bp + (size_t)(32 * i) * K + KT * 64); }
}
DEVI void g_swrite(const uint4 (&RA)[4], const uint4 (&RB)[4], char* d_) {
#pragma unroll
    for (int i = 0; i < 4; ++i) { *(uint4*)(d_ + i * 4096) = RA[i]; *(uint4*)(d_ + 16384 + i * 4096) = RB[i]; }
}
DEVI void g_compute(const char* sA, f32x4 (&acc)[4][4], int wm, int wn, int quad, int l15) {
    const char* sB = sA + 16384;
#pragma unroll
    for (int ks = 0; ks < 2; ++ks) {
        bf16x8 af[4], bfr[4]; const int ch = ks * 4 + quad;
#pragma unroll
        for (int mi = 0; mi < 4; ++mi) { const int row = wm * 64 + mi * 16 + l15; af[mi] = *(const bf16x8*)(sA + row * 128 + ((ch ^ (row & 7)) << 4)); }
#pragma unroll
        for (int ni = 0; ni < 4; ++ni) { const int row = wn * 64 + ni * 16 + l15; bfr[ni] = *(const bf16x8*)(sB + row * 128 + ((ch ^ (row & 7)) << 4)); }
#pragma unroll
        for (int mi = 0; mi < 4; ++mi)
#pragma unroll
            for (int ni = 0; ni < 4; ++ni) acc[mi][ni] = mfma(bfr[ni], af[mi], acc[mi][ni]);
    }
}

template <int EPI>
__device__ void gemm_phase(const Params& p, int L, char* lds) {
    const bf16_t* A; const bf16_t* Bt; int K, nNt;
    if (EPI == EPI_PROJ) { A = (const bf16_t*)(p.ws + OFF_ACT); Bt = (const bf16_t*)(p.ws + OFF_WIN) + (size_t)L * NW_IN_PAD * 1024; K = 1024; nNt = 25; }
    else if (EPI == EPI_WO) { A = (const bf16_t*)(p.ws + OFF_ACT); Bt = (const bf16_t*)(p.ws + OFF_WO) + (size_t)L * 1024 * 1024; K = 1024; nNt = 8; }
    else if (EPI == EPI_UP) { A = (const bf16_t*)(p.ws + OFF_ACT); Bt = (const bf16_t*)(p.ws + OFF_WUP) + (size_t)L * 4096 * 1024; K = 1024; nNt = 32; }
    else { A = (const bf16_t*)(p.ws + OFF_BIG); Bt = (const bf16_t*)(p.ws + OFF_WDN) + (size_t)L * 1024 * 4096; K = 4096; nNt = 8; }
    const int tid = otid(), lane = tid & 63, w = tid >> 6, quad = lane >> 4, l15 = lane & 15, wm = w >> 1, wn = w & 1;
    const int xcd = blockIdx.x & 7, loc = blockIdx.x >> 3, nloc = gridDim.x >> 3;
    const int nk = K / 64;
    for (int it = loc; it < 32 * nNt; it += nloc) {
        const int gsz = 8 * nNt, mloc = (it / gsz) * 8 + (it & 7), nloc_t = (it % gsz) >> 3;
        const int m0 = (xcd + 8 * mloc) * 128, n0 = nloc_t * 128;
        f32x4 acc[4][4];
#pragma unroll
        for (int a = 0; a < 4; ++a)
#pragma unroll
            for (int b = 0; b < 4; ++b) acc[a][b] = (f32x4){0.f, 0.f, 0.f, 0.f};
        u32x16 ra0, rb0, ra1, rb1;
        const int lrow = tid >> 3, lc = tid & 7;
        const bf16_t* Ap = A + (size_t)(m0 + lrow) * K + lc * 8;
        const bf16_t* Bp = Bt + (size_t)(n0 + lrow) * K + lc * 8;
        const int woff = lrow * 128 + ((lc ^ (lrow & 7)) << 4);
#define G_LD1(R, P, I, KT) { const uint4 t_ = *(const uint4*)((P) + (size_t)(32 * I) * K + (KT) * 64); R[4 * I] = t_.x; R[4 * I + 1] = t_.y; R[4 * I + 2] = t_.z; R[4 * I + 3] = t_.w; }
#define G_LOAD(RA, RB, KT) { G_LD1(RA, Ap, 0, KT) G_LD1(RB, Bp, 0, KT) G_LD1(RA, Ap, 1, KT) G_LD1(RB, Bp, 1, KT) G_LD1(RA, Ap, 2, KT) G_LD1(RB, Bp, 2, KT) G_LD1(RA, Ap, 3, KT) G_LD1(RB, Bp, 3, KT) }
#define G_SW1(R, D, I) *(uint4*)((D) + I * 4096) = make_uint4(R[4 * I], R[4 * I + 1], R[4 * I + 2], R[4 * I + 3]);
#define G_SWRITE(RA, RB, DST) { G_SW1(RA, DST, 0) G_SW1(RB, (DST) + 16384, 0) G_SW1(RA, DST, 1) G_SW1(RB, (DST) + 16384, 1) G_SW1(RA, DST, 2) G_SW1(RB, (DST) + 16384, 2) G_SW1(RA, DST, 3) G_SW1(RB, (DST) + 16384, 3) }
        G_LOAD(ra0, rb0, 0)
        G_LOAD(ra1, rb1, 1)
        G_SWRITE(ra0, rb0, lds + woff)
        __syncthreads();
#pragma unroll 1
        for (int kt = 0; kt < nk - 2; kt += 2) {
            G_LOAD(ra0, rb0, kt + 2)
            __builtin_amdgcn_sched_barrier(0);
            g_compute(lds, acc, wm, wn, quad, l15);
            G_SWRITE(ra1, rb1, lds + 32768 + woff)
            __syncthreads();
            G_LOAD(ra1, rb1, kt + 3)
            __builtin_amdgcn_sched_barrier(0);
            g_compute(lds + 32768, acc, wm, wn, quad, l15);
            G_SWRITE(ra0, rb0, lds + woff)
            __syncthreads();
        }
        g_compute(lds, acc, wm, wn, quad, l15);
        G_SWRITE(ra1, rb1, lds + 32768 + woff)
        __syncthreads();
        g_compute(lds + 32768, acc, wm, wn, quad, l15);
        __syncthreads();
#undef G_LOAD
#undef G_SWRITE
#undef G_LD1
#undef G_SW1
        if (EPI == EPI_PROJ) {
            proj_epilogue(p, L, acc, m0 + wm * 64, (n0 + wn * 64) >> 6, lane);
        } else if (EPI == EPI_UP) {
            bf16_t* hid = (bf16_t*)(p.ws + OFF_BIG);
#pragma unroll
            for (int mi = 0; mi < 4; ++mi)
#pragma unroll
                for (int ni = 0; ni < 4; ++ni) { const int m = m0 + wm * 64 + mi * 16 + l15, n = n0 + wn * 64 + ni * 16 + quad * 4;
                    float a0 = fmaxf(acc[mi][ni][0], 0.f), a1 = fmaxf(acc[mi][ni][1], 0.f), a2 = fmaxf(acc[mi][ni][2], 0.f), a3 = fmaxf(acc[mi][ni][3], 0.f);
                    uint2 o; o.x = pk2(a0 * a0, a1 * a1); o.y = pk2(a2 * a2, a3 * a3);
                    *(uint2*)(hid + (size_t)m * DFF + n) = o; }
        } else {
            const float* xin = (EPI == EPI_WO && L == 0) ? p.x : p.out;
#pragma unroll
            for (int mi = 0; mi < 4; ++mi)
#pragma unroll
                for (int ni = 0; ni < 4; ++ni) { const int m = m0 + wm * 64 + mi * 16 + l15, n = n0 + wn * 64 + ni * 16 + quad * 4;
                    float4 xv = *(const float4*)(xin + (size_t)m * DM + n);
                    xv.x += acc[mi][ni][0]; xv.y += acc[mi][ni][1]; xv.z += acc[mi][ni][2]; xv.w += acc[mi][ni][3];
                    *(float4*)(p.out + (size_t)m * DM + n) = xv; }
        }
    }
}

DEVI float hgrn_lb(const Params& p, int L, int hk) {
    if (L == 0) return 0.f;
    const float l0 = p.lb_logits[hk], l1 = p.lb_logits[256 + hk];
    return 1.0f / (1.0f + __expf(l0 - l1));
}

__device__ void hgrn_a_unit(const Params& p, int L, int u, char* lds) {
    const int tid = otid(), lane = tid & 63, w = tid >> 6, quad = lane >> 4, l15 = lane & 15;
    const int c = u & 63, h = (u >> 6) & 3, b = u >> 8;
    const bf16_t* proj = (const bf16_t*)(p.ws + OFF_BIG); const bf16_t* VT = (const bf16_t*)(p.ws + OFF_BIG + OFF_VT_IN_BIG);
    float* segtot = (float*)lds;
    bf16_t* KDt = (bf16_t*)(lds + 1024);
    const int k = tid & 63, seg = tid >> 6;
    const float lb = hgrn_lb(p, L, h * 64 + k);
    float gl[16], kkv[16]; float run = 0.f;
    const bf16_t* zp = proj + (size_t)(b * 4096 + c * 64 + seg * 16) * PJ_LD + 256 + h * 64 + k;
#pragma unroll
    for (int i = 0; i < 16; ++i) {
        const float z = bf2f(zp[(size_t)i * PJ_LD]);
        const float sg = 1.0f / (1.0f + __expf(-z)), sn = 1.0f / (1.0f + __expf(z));
        const float f = lb + (1.0f - lb) * sg;
        run += __logf(fmaxf(f, 1e-30f)); gl[i] = run; kkv[i] = (1.0f - lb) * sn;
    }
    segtot[seg * 64 + k] = run;
    __syncthreads();
    float off = 0.f, tot = 0.f;
#pragma unroll
    for (int s = 0; s < 4; ++s) { const float t = segtot[s * 64 + k]; tot += t; if (s < seg) off += t; }
    unsigned pkd[8];
#pragma unroll
    for (int i = 0; i < 8; ++i) {
        const float a0 = kkv[2 * i] * __expf(tot - (off + gl[2 * i])), a1 = kkv[2 * i + 1] * __expf(tot - (off + gl[2 * i + 1]));
        pkd[i] = pk2(a0, a1);
    }
    *(uint4*)(KDt + k * 72 + seg * 16) = make_uint4(pkd[0], pkd[1], pkd[2], pkd[3]);
    *(uint4*)(KDt + k * 72 + seg * 16 + 8) = make_uint4(pkd[4], pkd[5], pkd[6], pkd[7]);
    if (seg == 0) ((float*)(p.ws + OFF_DECAY))[u * 64 + k] = __expf(tot);
    __syncthreads();
    const bf16_t* vt = VT + ((size_t)(h * 8 + b) * 64) * 4096 + c * 64;
    float* kvt = (float*)(p.ws + OFF_KVT) + (size_t)u * 4096;
    bf16x8 af[2];
#pragma unroll
    for (int ks = 0; ks < 2; ++ks) af[ks] = ld8(vt + (size_t)(w * 16 + l15) * 4096 + ks * 32 + quad * 8);
#pragma unroll
    for (int kt = 0; kt < 4; ++kt) {
        f32x4 acc = (f32x4){0.f, 0.f, 0.f, 0.f};
#pragma unroll
        for (int ks = 0; ks < 2; ++ks) { const bf16x8 bfr = *(const bf16x8*)(KDt + (kt * 16 + l15) * 72 + ks * 32 + quad * 8); acc = mfma(af[ks], bfr, acc); }
#pragma unroll
        for (int j = 0; j < 4; ++j) kvt[(w * 16 + quad * 4 + j) * 64 + kt * 16 + l15] = acc[j];
    }
    __syncthreads();
}

__device__ void hgrn_scan_phase(const Params& p) {
    const float* kvt = (const float*)(p.ws + OFF_KVT); const float* dec = (const float*)(p.ws + OFF_DECAY);
    bf16_t* st = (bf16_t*)(p.ws + OFF_ST);
    for (int e = blockIdx.x * 256 + otid(); e < 32 * 4096; e += gridDim.x * 256) {
        const int bh = e >> 12, vk = e & 4095, k = vk & 63;
        float S = 0.f;
#pragma unroll 8
        for (int c = 0; c < 64; ++c) {
            const int u = bh * 64 + c;
            st[(size_t)u * 4096 + vk] = f2bf(S);
            S = S * dec[u * 64 + k] + kvt[(size_t)u * 4096 + vk];
        }
    }
}

__device__ void hgrn_c_unit(const Params& p, int L, int u, char* lds) {
    const int tid = otid(), lane = tid & 63, w = tid >> 6, quad = lane >> 4, l15 = lane & 15;
    const int c = u & 63, h = (u >> 6) & 3, b = u >> 8;
    const bf16_t* proj = (const bf16_t*)(p.ws + OFF_BIG); const bf16_t* VT = (const bf16_t*)(p.ws + OFF_BIG + OFF_VT_IN_BIG);
    float* Gs = (float*)lds; float* KKs = Gs + 64 * 65; float* Qs = KKs + 64 * 65; float* segtot = Qs + 64 * 65;
    {
        const int k = tid & 63, seg = tid >> 6;
        const float lb = hgrn_lb(p, L, h * 64 + k);
        float gl[16], kkv[16]; float run = 0.f;
        const bf16_t* zp = proj + (size_t)(b * 4096 + c * 64 + seg * 16) * PJ_LD + 256 + h * 64 + k;
#pragma unroll
        for (int i = 0; i < 16; ++i) {
            const float z = bf2f(zp[(size_t)i * PJ_LD]);
            const float sg = 1.0f / (1.0f + __expf(-z)), sn = 1.0f / (1.0f + __expf(z));
            const float f = lb + (1.0f - lb) * sg;
            run += __logf(fmaxf(f, 1e-30f)); gl[i] = run; kkv[i] = (1.0f - lb) * sn;
            Qs[(seg * 16 + i) * 65 + k] = bf2f(zp[(size_t)i * PJ_LD - 256]) * 0.125f;
        }
        segtot[seg * 64 + k] = run;
        __syncthreads();
        float off = 0.f;
#pragma unroll
        for (int s = 0; s < 4; ++s) { const float t = segtot[s * 64 + k]; if (s < seg) off += t; }
#pragma unroll
        for (int i = 0; i < 16; ++i) { Gs[(seg * 16 + i) * 65 + k] = off + gl[i]; KKs[(seg * 16 + i) * 65 + k] = kkv[i]; }
        __syncthreads();
    }
    const int I = w;
    const int tq = 16 * I + l15;
    bf16x8 qt[2], qg[2];
#pragma unroll
    for (int ks = 0; ks < 2; ++ks) {
        float a[8], g8[8];
#pragma unroll
        for (int j = 0; j < 8; ++j) {
            const int k = ks * 32 + quad * 8 + j;
            const float G = Gs[tq * 65 + k], q = Qs[tq * 65 + k];
            const float gref = (I == 0) ? 0.f : Gs[(16 * I - 1) * 65 + k];
            a[j] = q * __expf(G - gref); g8[j] = q * __expf(G);
        }
        qt[ks] = mk8(pk2(a[0], a[1]), pk2(a[2], a[3]), pk2(a[4], a[5]), pk2(a[6], a[7]));
        qg[ks] = mk8(pk2(g8[0], g8[1]), pk2(g8[2], g8[3]), pk2(g8[4], g8[5]), pk2(g8[6], g8[7]));
    }
    f32x4 O[4];
#pragma unroll
    for (int vt = 0; vt < 4; ++vt) O[vt] = (f32x4){0.f, 0.f, 0.f, 0.f};
    const bf16_t* st = (const bf16_t*)(p.ws + OFF_ST) + (size_t)u * 4096;
#pragma unroll
    for (int vt = 0; vt < 4; ++vt)
#pragma unroll
        for (int ks = 0; ks < 2; ++ks) O[vt] = mfma(ld8(st + (vt * 16 + l15) * 64 + ks * 32 + quad * 8), qg[ks], O[vt]);
    const bf16_t* vtp = VT + ((size_t)(h * 8 + b) * 64) * 4096 + c * 64;
    for (int Jp = 0; Jp <= (I >> 1); ++Jp) {
        f32x4 sc[2];
#pragma unroll
        for (int jj = 0; jj < 2; ++jj) {
            const int J = 2 * Jp + jj;
            sc[jj] = (f32x4){0.f, 0.f, 0.f, 0.f};
            if (J <= I) {
                const int s = 16 * J + l15;
#pragma unroll
                for (int ks = 0; ks < 2; ++ks) {
                    float a[8];
#pragma unroll
                    for (int j = 0; j < 8; ++j) {
                        const int k = ks * 32 + quad * 8 + j;
                        const float gref = (I == 0) ? 0.f : Gs[(16 * I - 1) * 65 + k];
                        a[j] = KKs[s * 65 + k] * __expf(gref - Gs[s * 65 + k]);
                    }
                    sc[jj] = mfma(mk8(pk2(a[0], a[1]), pk2(a[2], a[3]), pk2(a[4], a[5]), pk2(a[6], a[7])), qt[ks], sc[jj]);
                }
#pragma unroll
                for (int j = 0; j < 4; ++j) { const int s2 = 16 * J + quad * 4 + j; if (s2 > tq) sc[jj][j] = 0.f; }
            }
        }
        const bf16x8 P = mk8(pk2(sc[0][0], sc[0][1]), pk2(sc[0][2], sc[0][3]), pk2(sc[1][0], sc[1][1]), pk2(sc[1][2], sc[1][3]));
#pragma unroll
        for (int vt = 0; vt < 4; ++vt) {
            const bf16_t* r = vtp + (size_t)(vt * 16 + l15) * 4096 + 32 * Jp + quad * 4;
            O[vt] = mfma(ld4x2(r, r + 16), P, O[vt]);
        }
    }
    float ss = 0.f;
#pragma unroll
    for (int vt = 0; vt < 4; ++vt)
#pragma unroll
        for (int j = 0; j < 4; ++j) ss += O[vt][j] * O[vt][j];
    ss += __shfl_xor(ss, 16); ss += __shfl_xor(ss, 32);
    const float r = rsqrtf(ss * (1.0f / 64.0f) + 1e-6f);
    const size_t token = (size_t)b * 4096 + c * 64 + tq;
    bf16_t* mix = (bf16_t*)(p.ws + OFF_ACT);
#pragma unroll
    for (int vt = 0; vt < 4; ++vt) {
        const int v0 = vt * 16 + quad * 4;
        const float4 og = *(const float4*)(p.onorm_g + L * 64 + v0);
        const uint2 gz = *(const uint2*)(proj + token * PJ_LD + 768 + h * 64 + v0);
        const float g0 = bflo(gz.x), g1 = bfhi(gz.x), g2 = bflo(gz.y), g3 = bfhi(gz.y);
        const float o0 = O[vt][0] * r * og.x * (g0 / (1.0f + __expf(-g0))), o1 = O[vt][1] * r * og.y * (g1 / (1.0f + __expf(-g1)));
        const float o2 = O[vt][2] * r * og.z * (g2 / (1.0f + __expf(-g2))), o3 = O[vt][3] * r * og.w * (g3 / (1.0f + __expf(-g3)));
        uint2 o; o.x = pk2(o0, o1); o.y = pk2(o2, o3);
        *(uint2*)(mix + token * DM + h * 64 + v0) = o;
    }
    __syncthreads();
}

__device__ void compress_unit(const Params& p, int L, int u, char* lds) {
    const int tid = otid(), lane = tid & 63, w = tid >> 6, quad = lane >> 4, l15 = lane & 15;
    const int which = u & 1, g = (u >> 1) & 1, b = (u >> 2) & 7, ntile = u >> 5;
    const bf16_t* proj = (const bf16_t*)(p.ws + OFF_BIG);
    const bf16_t* w1t = (const bf16_t*)(p.ws + OFF_W1T) + (size_t)(L * 2 + which) * 128 * 2048;
    const bf16_t* w2t = (const bf16_t*)(p.ws + OFF_W2T) + (size_t)(L * 2 + which) * 64 * 128;
    const float* cbias = (const float*)(p.ws + OFF_CBIAS) + (L * 2 + which) * 128;
    bf16_t* Hs = (bf16_t*)lds + w * 16 * 136;
    const int nrow = ntile * 64 + w * 16 + l15;
    int tokbase = 16 * nrow; if (tokbase > 4096 - 32) tokbase = 4096 - 32;
    const bf16_t* xa = proj + ((size_t)b * 4096 + tokbase) * PJ_LD + (which ? 1664 : 1536) + g * 64;
    f32x4 acc[8];
#pragma unroll
    for (int i = 0; i < 8; ++i) acc[i] = (f32x4){0.f, 0.f, 0.f, 0.f};
#pragma unroll 2
    for (int kk = 0; kk < 64; ++kk) {
        const int l = kk >> 1, d = (kk & 1) * 32 + quad * 8;
        const bf16x8 a = ld8(xa + (size_t)l * PJ_LD + d);
#pragma unroll
        for (int ni = 0; ni < 8; ++ni) acc[ni] = mfma(a, ld8(w1t + (size_t)(ni * 16 + l15) * 2048 + kk * 32 + quad * 8), acc[ni]);
    }
#pragma unroll
    for (int ni = 0; ni < 8; ++ni) { const float bsv = cbias[ni * 16 + l15];
#pragma unroll
        for (int j = 0; j < 4; ++j) { const float x = acc[ni][j] + bsv;
            const float uu = 0.7978845608028654f * (x + 0.044715f * x * x * x);
            const float th = 1.0f - 2.0f / (1.0f + __expf(2.0f * uu));
            Hs[(quad * 4 + j) * 136 + ni * 16 + l15] = f2bf(0.5f * x * (1.0f + th)); } }
    __syncthreads();
    f32x4 o[4];
#pragma unroll
    for (int i = 0; i < 4; ++i) o[i] = (f32x4){0.f, 0.f, 0.f, 0.f};
#pragma unroll
    for (int ks = 0; ks < 4; ++ks) { const bf16x8 a = *(const bf16x8*)(Hs + l15 * 136 + ks * 32 + quad * 8);
#pragma unroll
        for (int ni = 0; ni < 4; ++ni) o[ni] = mfma(a, ld8(w2t + (size_t)(ni * 16 + l15) * 128 + ks * 32 + quad * 8), o[ni]); }
    const int nb = ntile * 64 + w * 16 + quad * 4;
    if (which == 0) {
        bf16_t* kc = (bf16_t*)(p.ws + OFF_KC) + (size_t)(b * 2 + g) * 256 * 64;
        const float* rope = (const float*)(p.ws + OFF_ROPE);
#pragma unroll
        for (int j = 0; j < 4; ++j) {
            const int n = nb + j;
            float ss = o[0][j] * o[0][j] + o[1][j] * o[1][j] + o[2][j] * o[2][j] + o[3][j] * o[3][j];
            ss += __shfl_xor(ss, 1); ss += __shfl_xor(ss, 2); ss += __shfl_xor(ss, 4); ss += __shfl_xor(ss, 8);
            const float r = rsqrtf(ss * (1.0f / 64.0f) + 1e-6f);
            float v[4];
#pragma unroll
            for (int ni = 0; ni < 4; ++ni) v[ni] = o[ni][j] * r * p.nsa_kn_g[L * 64 + ni * 16 + l15];
            int pos = 16 * n + 31; if (pos > 4095) pos = 4095;
            const float cs = rope[pos * 16 + (l15 & 7)], sn = rope[pos * 16 + 8 + (l15 & 7)];
            const float pp = __shfl_xor(v[0], 8);
            v[0] = (l15 < 8) ? (v[0] * cs - pp * sn) : (v[0] * cs + pp * sn);
#pragma unroll
            for (int ni = 0; ni < 4; ++ni) kc[(size_t)n * 64 + ni * 16 + l15] = (n < 255) ? f2bf(v[ni]) : (bf16_t)0;
        }
    } else {
        bf16_t* vct = (bf16_t*)(p.ws + OFF_VCT) + (size_t)(b * 2 + g) * 64 * 256;
#pragma unroll
        for (int ni = 0; ni < 4; ++ni) {
            float v0 = o[ni][0], v1 = o[ni][1], v2 = o[ni][2], v3 = o[ni][3];
            if (nb + 3 >= 255) v3 = 0.f;
            uint2 ov; ov.x = pk2(v0, v1); ov.y = pk2(v2, v3);
            *(uint2*)(vct + (size_t)(ni * 16 + l15) * 256 + nb) = ov;
        }
    }
    __syncthreads();
}

__device__ void foxc_job(const Params& p, int L, int bh, char* lds) {
    const int tid = otid(), lane = tid & 63, w = tid >> 6, b = bh >> 2, h = bh & 3;
    const float* gates = (const float*)(p.ws + OFF_GATES);
    float* cc = (float*)(p.ws + OFF_FOXC) + (size_t)bh * 4096;
    float* wtot = (float*)lds;
    const float fb = p.fox_fb[L * 4 + h];
    float v[16];
#pragma unroll
    for (int i = 0; i < 16; ++i) v[i] = gates[((size_t)b * 4096 + tid * 16 + i) * 32 + 24 + h] + fb;
    float run = 0.f;
#pragma unroll
    for (int i = 0; i < 16; ++i) { const float x = v[i]; run += (x >= 0.f) ? -log1pf(__expf(-x)) : (x - log1pf(__expf(x))); v[i] = run; }
    float incl = run;
#pragma unroll
    for (int o = 1; o < 64; o <<= 1) { const float t = __shfl_up(incl, o); if (lane >= o) incl += t; }
    if (lane == 63) wtot[w] = incl;
    __syncthreads();
    float pre = incl - run;
#pragma unroll
    for (int s = 0; s < 4; ++s) if (s < w) pre += wtot[s];
#pragma unroll
    for (int i = 0; i < 4; ++i) *(float4*)(cc + tid * 16 + i * 4) = make_float4(pre + v[4 * i], pre + v[4 * i + 1], pre + v[4 * i + 2], pre + v[4 * i + 3]);
    __syncthreads();
}

constexpr int KV_BUF = 16384;
DEVI void tile_glds(const bf16_t* Kg, int ldk, const bf16_t* Vg, int ldv, char* buf, int tid) {
    const int w = tid >> 6, i = tid & 63;
#pragma unroll
    for (int jj = 0; jj < 2; ++jj) {
        const int j = w * 2 + jj, row = 8 * j + (i >> 3), slot = i & 7;
        const bf16_t* kp = Kg + (size_t)row * ldk + ((slot ^ (row & 7)) << 3);
        const bf16_t* vp = Vg + (size_t)row * ldv + ((slot ^ ((row >> 1) & 7)) << 3);
        __builtin_amdgcn_global_load_lds((const unsigned*)kp, (ldsp_t)(unsigned)(size_t)(buf + j * 1024), 16, 0, 0);
        __builtin_amdgcn_global_load_lds((const unsigned*)vp, (ldsp_t)(unsigned)(size_t)(buf + 8192 + j * 1024), 16, 0, 0);
    }
}
DEVI void lds_kf(const char* buf, int kh, int lane, bf16x8 (&kf)[2][2]) {
    const int quad = lane >> 4, l15 = lane & 15;
#pragma unroll
    for (int t2 = 0; t2 < 2; ++t2)
#pragma unroll
        for (int ks = 0; ks < 2; ++ks) { const int row = kh * 32 + t2 * 16 + l15, ch = ks * 4 + quad; kf[t2][ks] = *(const bf16x8*)(buf + row * 128 + ((ch ^ (row & 7)) << 4)); }
}
DEVI void lds_vf(const char* buf, int kh, int lane, bf16x8 (&vf)[4]) {
    const int quad = lane >> 4, l15 = lane & 15;
#pragma unroll
    for (int dt = 0; dt < 4; ++dt) { const int d = dt * 16 + l15, u0 = kh * 8 + quad, u1 = u0 + 4;
        const uint2 a = *(const uint2*)(buf + 8192 + d * 128 + ((u0 ^ (d & 14)) << 3)), b = *(const uint2*)(buf + 8192 + d * 128 + ((u1 ^ (d & 14)) << 3));
        vf[dt] = mk8(a.x, a.y, b.x, b.y); }
}

template <class MaskF>
DEVI void attn_block64(const char* buf, int kbase, const char* ql, int q0o, int q1o, int qstride, const float* cb, f32x4 (&O)[4][4], float (&m)[4], float (&l)[4], int lane, MaskF maskf) {
    const int quad = lane >> 4;
#pragma unroll
    for (int kh = 0; kh < 2; ++kh) {
        bf16x8 kf[2][2], vf[4];
        lds_kf(buf, kh, lane, kf); lds_vf(buf, kh, lane, vf);
        float ck[8] = {0.f, 0.f, 0.f, 0.f, 0.f, 0.f, 0.f, 0.f};
        if (cb) { const float4 c0 = *(const float4*)(cb + kbase + kh * 32 + quad * 4), c1 = *(const float4*)(cb + kbase + kh * 32 + 16 + quad * 4);
            ck[0] = c0.x; ck[1] = c0.y; ck[2] = c0.z; ck[3] = c0.w; ck[4] = c1.x; ck[5] = c1.y; ck[6] = c1.z; ck[7] = c1.w; }
#pragma unroll
        for (int nt = 0; nt < 4; ++nt) {
            f32x4 s0 = (f32x4){0.f, 0.f, 0.f, 0.f}, s1 = s0;
            { const bf16x8 qa = *(const bf16x8*)(ql + nt * qstride + q0o), qb_ = *(const bf16x8*)(ql + nt * qstride + q1o);
              s0 = mfma(kf[0][0], qa, s0); s1 = mfma(kf[1][0], qa, s1); s0 = mfma(kf[0][1], qb_, s0); s1 = mfma(kf[1][1], qb_, s1); }
            float sv[8]; bool ok[8]; float mx = -1e30f;
#pragma unroll
            for (int e = 0; e < 8; ++e) { sv[e] = (e < 4) ? s0[e & 3] : s1[e & 3]; const int key = kbase + kh * 32 + (e >> 2) * 16 + quad * 4 + (e & 3);
                ok[e] = maskf(nt, ck[e], key, sv[e]); if (ok[e]) mx = fmaxf(mx, sv[e]); }
            mx = fmaxf(mx, __shfl_xor(mx, 16)); mx = fmaxf(mx, __shfl_xor(mx, 32));
            const float mn = fmaxf(m[nt], mx), alpha = __expf(m[nt] - mn);
            float pv[8]; float rs = 0.f;
#pragma unroll
            for (int e = 0; e < 8; ++e) { pv[e] = ok[e] ? __expf(sv[e] - mn) : 0.f; rs += pv[e]; }
            rs += __shfl_xor(rs, 16); rs += __shfl_xor(rs, 32);
            l[nt] = l[nt] * alpha + rs; m[nt] = mn;
            const bf16x8 P = mk8(pk2(pv[0], pv[1]), pk2(pv[2], pv[3]), pk2(pv[4], pv[5]), pk2(pv[6], pv[7]));
#pragma unroll
            for (int dt = 0; dt < 4; ++dt) { O[dt][nt] = O[dt][nt] * alpha; O[dt][nt] = mfma(vf[dt], P, O[dt][nt]); }
        }
    }
}

template <class MaskF>
DEVI void attn_stream(u64 tiles, const bf16_t* Kbase, int ldk, const bf16_t* Vbase, int ldv, char* kvbuf, int jb_wave_min, int jb_wave_max,
                      const char* ql, int q0o, int q1o, int qstride, const float* cb, f32x4 (&O)[4][4], float (&m)[4], float (&l)[4], int tid, int lane, MaskF maskf) {
    if (tiles == 0ull) return;
    int jb = __ffsll((long long)tiles) - 1; tiles &= tiles - 1;
    tile_glds(Kbase + (size_t)jb * 64 * ldk, ldk, Vbase + jb * 64, ldv, kvbuf, tid);
    __syncthreads();
    int cur = 0;
#pragma unroll 1
    for (;;) {
        const bool more = tiles != 0ull;
        int jbn = 0;
        if (more) { jbn = __ffsll((long long)tiles) - 1; tiles &= tiles - 1; tile_glds(Kbase + (size_t)jbn * 64 * ldk, ldk, Vbase + jbn * 64, ldv, kvbuf + (cur ^ 1) * KV_BUF, tid); }
        if (jb >= jb_wave_min && jb <= jb_wave_max) attn_block64(kvbuf + cur * KV_BUF, jb * 64, ql, q0o, q1o, qstride, cb, O, m, l, lane, [&](int nt, float ckv, int key, float& s) { return maskf(nt, ckv, key, jb, s); });
        __syncthreads();
        if (!more) break;
        jb = jbn; cur ^= 1;
    }
}

DEVI void attn_store2(bf16_t* mix, size_t token0, int tokstride, int col0, int colstride, const f32x4 (&O)[4][4], const float (&sc)[4], int lane, bool accum) {
    const int quad = lane >> 4, l15 = lane & 15;
#pragma unroll
    for (int nt = 0; nt < 4; ++nt)
#pragma unroll
        for (int dt = 0; dt < 4; ++dt) {
            bf16_t* dst = mix + (token0 + nt * tokstride + l15) * DM + col0 + nt * colstride + dt * 16 + quad * 4;
            float a0 = O[dt][nt][0] * sc[nt], a1 = O[dt][nt][1] * sc[nt], a2 = O[dt][nt][2] * sc[nt], a3 = O[dt][nt][3] * sc[nt];
            if (accum) { const uint2 old = *(const uint2*)dst; a0 += bflo(old.x); a1 += bfhi(old.x); a2 += bflo(old.y); a3 += bfhi(old.y); }
            uint2 o; o.x = pk2(a0, a1); o.y = pk2(a2, a3);
            *(uint2*)dst = o;
        }
}

__device__ void nsa_unit(const Params& p, int L, int b, int g, int blk, char* lds) {
    const int tid = otid(), lane = tid & 63, w = tid >> 6, quad = lane >> 4, l15 = lane & 15;
    const bf16_t* proj = (const bf16_t*)(p.ws + OFF_BIG); const bf16_t* VT = (const bf16_t*)(p.ws + OFF_BIG + OFF_VT_IN_BIG);
    const float* gates = (const float*)(p.ws + OFF_GATES);
    bf16_t* mix = (bf16_t*)(p.ws + OFF_ACT);
    char* kvbuf = lds; float* impL = (float*)(lds + KV_BUF)  ; char* Qs = lds + 32768; u64* selm = (u64*)(lds + 65536);
    const int q0 = blk * 64; const int tq = q0 + w * 16 + l15; const size_t token = (size_t)b * 4096 + tq;
    const size_t token0 = (size_t)b * 4096 + q0 + w * 16;
    const int mixcol = 256 + g * 256;
#pragma unroll
    for (int t = 0; t < 8; ++t) { const int idx = t * 64 + lane, rr = idx >> 3, c = idx & 7, hh = rr >> 4, r16 = rr & 15;
        const uint4 v = *(const uint4*)(proj + (token0 + r16) * PJ_LD + 1024 + (g * 4 + hh) * 64 + c * 8);
        *(uint4*)(Qs + (hh * 64 + w * 16 + r16) * 128 + ((c ^ (r16 & 7)) << 4)) = v; }
    const char* ql = Qs + (w * 16 + l15) * 128; const int q0o = ((quad) ^ (l15 & 7)) << 4, q1o = ((4 + quad) ^ (l15 & 7)) << 4; const int qstride = 8192;
    __syncthreads();
    f32x4 O[4][4]; float m[4], l[4];
    const bf16_t* Kc = (const bf16_t*)(p.ws + OFF_KC) + (size_t)(b * 2 + g) * 256 * 64;
    const bf16_t* VcT = (const bf16_t*)(p.ws + OFF_VCT) + (size_t)(b * 2 + g) * 64 * 256;
    const int ncb = (4 * blk + 3 + 63) >> 6;
#pragma unroll
    for (int nt = 0; nt < 4; ++nt) { m[nt] = -1e30f; l[nt] = 0.f; }
    {
#pragma unroll 1
        for (int pass = 0; pass < 2; ++pass) {
            float inv[4]; float prevr = 0.f;
            if (pass == 1) {
#pragma unroll
                for (int nt = 0; nt < 4; ++nt) inv[nt] = 1.0f / fmaxf(l[nt], 1e-30f);
#pragma unroll
                for (int dt = 0; dt < 4; ++dt)
#pragma unroll
                    for (int nt = 0; nt < 4; ++nt) O[dt][nt] = (f32x4){0.f, 0.f, 0.f, 0.f};
            }
#pragma unroll 1
            for (int ct = 0; ct < ncb; ++ct) {
                tile_glds(Kc + (size_t)ct * 64 * 64, 64, VcT + ct * 64, 256, kvbuf, tid);
                __syncthreads();
                const char* buf = kvbuf;
#pragma unroll
                for (int kh = 0; kh < 2; ++kh) {
                    bf16x8 kf[2][2]; lds_kf(buf, kh, lane, kf);
                    if (pass == 0) {
#pragma unroll
                        for (int nt = 0; nt < 4; ++nt) {
                            f32x4 s0 = (f32x4){0.f, 0.f, 0.f, 0.f}, s1 = s0;
                            { const bf16x8 qa = *(const bf16x8*)(ql + nt * qstride + q0o), qb_ = *(const bf16x8*)(ql + nt * qstride + q1o);
                              s0 = mfma(kf[0][0], qa, s0); s1 = mfma(kf[1][0], qa, s1); s0 = mfma(kf[0][1], qb_, s0); s1 = mfma(kf[1][1], qb_, s1); }
                            float sv[8]; bool ok[8]; float mx = -1e30f;
#pragma unroll
                            for (int e = 0; e < 8; ++e) { sv[e] = (e < 4) ? s0[e & 3] : s1[e & 3]; const int n = ct * 64 + kh * 32 + (e >> 2) * 16 + quad * 4 + (e & 3);
                                ok[e] = (16 * n + 31 <= tq); if (ok[e]) mx = fmaxf(mx, sv[e]); }
                            mx = fmaxf(mx, __shfl_xor(mx, 16)); mx = fmaxf(mx, __shfl_xor(mx, 32));
                            const float mn = fmaxf(m[nt], mx), alpha = __expf(m[nt] - mn);
                            float rs = 0.f;
#pragma unroll
                            for (int e = 0; e < 8; ++e) rs += ok[e] ? __expf(sv[e] - mn) : 0.f;
                            rs += __shfl_xor(rs, 16); rs += __shfl_xor(rs, 32);
                            l[nt] = l[nt] * alpha + rs; m[nt] = mn;
                        }
                    } else {
                        bf16x8 vf[4]; lds_vf(buf, kh, lane, vf);
                        float As[2] = {0.f, 0.f}, p3[2] = {0.f, 0.f};
#pragma unroll
                        for (int nt = 0; nt < 4; ++nt) {
                            f32x4 s0 = (f32x4){0.f, 0.f, 0.f, 0.f}, s1 = s0;
                            { const bf16x8 qa = *(const bf16x8*)(ql + nt * qstride + q0o), qb_ = *(const bf16x8*)(ql + nt * qstride + q1o);
                              s0 = mfma(kf[0][0], qa, s0); s1 = mfma(kf[1][0], qa, s1); s0 = mfma(kf[0][1], qb_, s0); s1 = mfma(kf[1][1], qb_, s1); }
                            float pv[8];
#pragma unroll
                            for (int e = 0; e < 8; ++e) { const float s = (e < 4) ? s0[e & 3] : s1[e & 3]; const int n = ct * 64 + kh * 32 + (e >> 2) * 16 + quad * 4 + (e & 3);
                                pv[e] = (16 * n + 31 <= tq) ? __expf(s - m[nt]) * inv[nt] : 0.f; }
                            As[0] += (pv[0] + pv[1]) + (pv[2] + pv[3]); As[1] += (pv[4] + pv[5]) + (pv[6] + pv[7]); p3[0] += pv[3]; p3[1] += pv[7];
                            const bf16x8 P = mk8(pk2(pv[0], pv[1]), pk2(pv[2], pv[3]), pk2(pv[4], pv[5]), pk2(pv[6], pv[7]));
#pragma unroll
                            for (int dt = 0; dt < 4; ++dt) O[dt][nt] = mfma(vf[dt], P, O[dt][nt]);
                        }
                        const int qq = w * 16 + l15;
#pragma unroll
                        for (int t2 = 0; t2 < 2; ++t2) {
                            const float rr = __shfl(p3[t2], (lane + 48) & 63);
                            const float carry = (quad == 0) ? prevr : rr; prevr = rr;
                            const int jb = ct * 16 + kh * 8 + t2 * 4 + quad;
                            impL[jb * 64 + ((qq ^ jb) & 63)] = As[t2] + carry;
                        }
                    }
                }
                __syncthreads();
            }
        }
    }
    {
        const float4 gv = *(const float4*)(gates + token * 32 + 0 * 8 + g * 4);
        const float sc[4] = {gv.x, gv.y, gv.z, gv.w};
        attn_store2(mix, token0, 0, mixcol, 64, O, sc, lane, false);
    }
#pragma unroll 1
    for (int qi = 0; qi < 16; ++qi) {
        const int q = w * 16 + qi, jb = lane;
        float val = impL[jb * 64 + ((q ^ jb) & 63)];
        if (jb > blk) val = -1e30f;
        else if (jb == 0 || jb == blk || jb == blk - 1) val = 1e30f;
        int rank = 0;
        for (int jp = 0; jp < 64; ++jp) { const float vj = __shfl(val, jp); rank += ((vj > val) || (vj == val && jp < jb)) ? 1 : 0; }
        const bool sel = (rank < 16) && (val > -5e29f);
        const u64 mask = __ballot(sel);
        if (lane == 0) selm[q] = mask;
    }
    __syncthreads();
    u64 uni = 0;
    for (int q = 0; q < 64; ++q) uni |= selm[q];
    const u64 sm = selm[w * 16 + l15];
    {
#pragma unroll
        for (int nt = 0; nt < 4; ++nt) { m[nt] = -1e30f; l[nt] = 0.f; }
#pragma unroll
        for (int dt = 0; dt < 4; ++dt)
#pragma unroll
            for (int nt = 0; nt < 4; ++nt) O[dt][nt] = (f32x4){0.f, 0.f, 0.f, 0.f};
        const u64 tiles = uni & ((blk == 63) ? ~0ull : ((2ull << blk) - 1ull));
        attn_stream(tiles, proj + (size_t)b * 4096 * PJ_LD + 1792 + g * 64, PJ_LD, VT + ((size_t)((4 + g) * 8 + b) * 64) * 4096, 4096, kvbuf, 0, 63, ql, q0o, q1o, qstride, nullptr, O, m, l, tid, lane,
                    [&](int nt, float ckv, int key, int jb, float& s) { return (((sm >> jb) & 1ull) != 0) && (key <= tq); });
        const float4 gv = *(const float4*)(gates + token * 32 + 1 * 8 + g * 4);
        const float sc[4] = {gv.x / fmaxf(l[0], 1e-30f), gv.y / fmaxf(l[1], 1e-30f), gv.z / fmaxf(l[2], 1e-30f), gv.w / fmaxf(l[3], 1e-30f)};
        attn_store2(mix, token0, 0, mixcol, 64, O, sc, lane, true);
    }
    {
#pragma unroll
        for (int nt = 0; nt < 4; ++nt) { m[nt] = -1e30f; l[nt] = 0.f; }
#pragma unroll
        for (int dt = 0; dt < 4; ++dt)
#pragma unroll
            for (int nt = 0; nt < 4; ++nt) O[dt][nt] = (f32x4){0.f, 0.f, 0.f, 0.f};
        const int jlo = blk > 8 ? blk - 8 : 0;
        const u64 upto = (blk == 63) ? ~0ull : ((2ull << blk) - 1ull);
        const u64 tiles = upto & ~((1ull << jlo) - 1ull);
        attn_stream(tiles, proj + (size_t)b * 4096 * PJ_LD + 2048 + g * 64, PJ_LD, VT + ((size_t)((6 + g) * 8 + b) * 64) * 4096, 4096, kvbuf, 0, 63, ql, q0o, q1o, qstride, nullptr, O, m, l, tid, lane,
                    [&](int nt, float ckv, int key, int jb, float& s) { return (key <= tq) && (key + 512 > tq); });
        const float4 gv = *(const float4*)(gates + token * 32 + 2 * 8 + g * 4);
        const float sc[4] = {gv.x / fmaxf(l[0], 1e-30f), gv.y / fmaxf(l[1], 1e-30f), gv.z / fmaxf(l[2], 1e-30f), gv.w / fmaxf(l[3], 1e-30f)};
        attn_store2(mix, token0, 0, mixcol, 64, O, sc, lane, true);
    }
    __syncthreads();
}

__device__ void fox_unit(const Params& p, int L, int b, int h, int qb, char* lds) {
    const int tid = otid(), lane = tid & 63, w = tid >> 6, quad = lane >> 4, l15 = lane & 15;
    const bf16_t* proj = (const bf16_t*)(p.ws + OFF_BIG); const bf16_t* VT = (const bf16_t*)(p.ws + OFF_BIG + OFF_VT_IN_BIG);
    bf16_t* mix = (bf16_t*)(p.ws + OFF_ACT);
    const float* cc = (const float*)(p.ws + OFF_FOXC) + (size_t)(b * 4 + h) * 4096;
    const int q0 = qb * 256 + w * 64; const size_t token0 = (size_t)b * 4096 + q0;
    int tq[4]; float cq[4];
#pragma unroll
    for (int nt = 0; nt < 4; ++nt) { tq[nt] = q0 + nt * 16 + l15; cq[nt] = cc[tq[nt]]; }
    char* Qs = lds + 32768;
#pragma unroll
    for (int t = 0; t < 8; ++t) { const int idx = t * 64 + lane, rr = idx >> 3, c = idx & 7;
        const uint4 v = *(const uint4*)(proj + (token0 + rr) * PJ_LD + 2304 + h * 64 + c * 8);
        *(uint4*)(Qs + (w * 64 + rr) * 128 + ((c ^ (rr & 7)) << 4)) = v; }
    const char* ql = Qs + (w * 64 + l15) * 128; const int q0o = ((quad) ^ (l15 & 7)) << 4, q1o = ((4 + quad) ^ (l15 & 7)) << 4; const int qstride = 2048;
    __syncthreads();
    f32x4 O[4][4]; float m[4], l[4];
#pragma unroll
    for (int nt = 0; nt < 4; ++nt) { m[nt] = -1e30f; l[nt] = 0.f; }
#pragma unroll
    for (int dt = 0; dt < 4; ++dt)
#pragma unroll
        for (int nt = 0; nt < 4; ++nt) O[dt][nt] = (f32x4){0.f, 0.f, 0.f, 0.f};
    const int jmax = qb * 4 + 3;
    int jlo_w, jlo_b;
    { const float cq0 = cc[q0]; int lo = 0, hi = qb * 4 + w;
      while (lo < hi) { const int mid = (lo + hi) >> 1; if (cq0 - cc[mid * 64 + 63] >= -140.f) hi = mid; else lo = mid + 1; }
      jlo_w = lo; }
    { const float cq0 = cc[qb * 256]; int lo = 0, hi = qb * 4;
      while (lo < hi) { const int mid = (lo + hi) >> 1; if (cq0 - cc[mid * 64 + 63] >= -140.f) hi = mid; else lo = mid + 1; }
      jlo_b = lo; }
    const u64 tiles = ((jmax == 63) ? ~0ull : ((2ull << jmax) - 1ull)) & ~((1ull << jlo_b) - 1ull);
    attn_stream(tiles, proj + (size_t)b * 4096 * PJ_LD + 2560 + h * 64, PJ_LD, VT + ((size_t)((8 + h) * 8 + b) * 64) * 4096, 4096, lds, jlo_w, qb * 4 + w, ql, q0o, q1o, qstride, cc, O, m, l, tid, lane,
                [&](int nt, float ckv, int key, int jb, float& s) { s += cq[nt] - ckv; return key <= tq[nt]; });
    float sc[4];
#pragma unroll
    for (int nt = 0; nt < 4; ++nt) sc[nt] = 1.0f / fmaxf(l[nt], 1e-30f);
    attn_store2(mix, token0, 16, 768 + h * 64, 0, O, sc, lane, false);
}

__device__ void mixA_phase(const Params& p, int L, char* lds);
DEVI int next_unit(unsigned* ctr, char* lds) {
    int* slot = (int*)(lds + LDS_BYTES - 16);
    __syncthreads();
    if (otid() == 0) *slot = (int)atomicAdd(ctr, 1u);
    __syncthreads();
    return *slot;
}
__device__ void mixA_phase(const Params& p, int L, char* lds) {
    unsigned* ctr = (unsigned*)(p.ws + OFF_CTR) + L * 4 + 3;
#pragma unroll 1
    for (;;) {
        const int job = next_unit(ctr, lds); if (job >= 160 + 512) break;
        if (job < 128) compress_unit(p, L, job, lds);
        else if (job < 160) foxc_job(p, L, job - 128, lds);
        else {
#pragma unroll 1
            for (int u = (job - 160) * 4; u < (job - 160) * 4 + 4; ++u) hgrn_a_unit(p, L, u, lds);
        }
    }
}
__device__ void mixB_phase(const Params& p, int L, char* lds) {
    unsigned* ctr = (unsigned*)(p.ws + OFF_CTR) + L * 4;
#pragma unroll 1
    for (;;) { const int f = next_unit(ctr + 0, lds); if (f >= 512) break; const int qb = 15 - (f >> 5), bh = f & 31; fox_unit(p, L, bh >> 2, bh & 3, qb, lds); }
#pragma unroll 1
    for (;;) { const int n = next_unit(ctr + 1, lds); if (n >= 1024) break; const int blk = 63 - (n >> 4), bg = n & 15; nsa_unit(p, L, bg >> 1, bg & 1, blk, lds); }
#pragma unroll 1
    for (;;) { const int c = next_unit(ctr + 2, lds); if (c >= 1024) break;
#pragma unroll 1
        for (int u = c * 2; u < c * 2 + 2; ++u) hgrn_c_unit(p, L, u, lds); }
}

__device__ void run_phase(const Params& p, int ph, char* lds) {
    if (ph == 0) { prep_phase(p, lds); return; }
    const int L = (ph - 1) / 9, s = (ph - 1) % 9;
    switch (s) {
        case 0: gemm_phase<EPI_PROJ>(p, L, lds); break;
        case 1: mixA_phase(p, L, lds); break;
        case 2: hgrn_scan_phase(p); break;
        case 3: mixB_phase(p, L, lds); break;
        case 4: gemm_phase<EPI_WO>(p, L, lds); break;
        case 5: norm_phase(p.out, p.norm2_g + L * 1024, (bf16_t*)(p.ws + OFF_ACT)); break;
        case 6: gemm_phase<EPI_UP>(p, L, lds); break;
        case 7: gemm_phase<EPI_DOWN>(p, L, lds); break;
        default: norm_phase(p.out, p.norm1_g + (L + 1) * 1024, (bf16_t*)(p.ws + OFF_ACT)); break;
    }
}

__global__ void __launch_bounds__(256, 2) fwd_kernel(Params p, int ph_lo, int ph_hi) {
    __shared__ __attribute__((aligned(16))) char lds[LDS_BYTES];
    for (int ph = ph_lo; ph < ph_hi; ++ph) {
#ifdef REPEAT_MASK
        const int nrep = (ph >= 1 && ((REPEAT_MASK >> ((ph - 1) % 9)) & 1)) ? 2 : 1;
#pragma unroll 1
        for (int rep = 0; rep < nrep; ++rep) {
            if (rep) cg::this_grid().sync();
            run_phase(p, ph, lds);
        }
#else
        run_phase(p, ph, lds);
#endif
        if (ph + 1 < ph_hi) { cg::this_grid().sync(); }
    }
}

extern "C" void kernel_launch(void* const* d_in, const int* in_sizes, int n_in, void* d_out, int out_size, void* d_ws, size_t ws_size,
                              hipStream_t stream) {
    if (ws_size < WS_NEED) { fprintf(stderr, "workspace too small: %zu < %zu\n", ws_size, (size_t)WS_NEED); return; }
    Params p{};
    p.x = (const float*)d_in[0]; p.norm1_g = (const float*)d_in[1]; p.w_in = (const float*)d_in[2]; p.lb_logits = (const float*)d_in[3];
    p.onorm_g = (const float*)d_in[4]; p.nsa_qn_g = (const float*)d_in[5]; p.nsa_kn_g = (const float*)d_in[6]; p.cmp_pos = (const float*)d_in[7];
    p.cmp_w1 = (const float*)d_in[8]; p.cmp_w2 = (const float*)d_in[9]; p.fox_qn_g = (const float*)d_in[10]; p.fox_kn_g = (const float*)d_in[11];
    p.fox_fb = (const float*)d_in[12]; p.w_o = (const float*)d_in[13]; p.norm2_g = (const float*)d_in[14]; p.w_up = (const float*)d_in[15];
    p.w_down = (const float*)d_in[16];
    p.out = (float*)d_out; p.ws = (char*)d_ws;
#if MULTI_LAUNCH
    for (int ph = 0; ph < NPHASE; ++ph) hipLaunchKernelGGL(fwd_kernel, dim3(512), dim3(256), 0, stream, p, ph, ph + 1);
#else
    static int grid_blocks = 0;
    if (!grid_blocks) {
        int dev = 0, cus = 0, per_cu = 0;
        hipGetDevice(&dev);
        hipDeviceGetAttribute(&cus, hipDeviceAttributeMultiprocessorCount, dev);
        hipOccupancyMaxActiveBlocksPerMultiprocessor(&per_cu, fwd_kernel, 256, 0);
        per_cu = 2;
        grid_blocks = cus * per_cu;
        grid_blocks &= ~7;
    }
    int lo = 0, hi = NPHASE;
    void* args[] = {&p, &lo, &hi};
    hipError_t e = hipLaunchCooperativeKernel((void*)fwd_kernel, dim3(grid_blocks), dim3(256), args, 0, stream);
    if (e != hipSuccess) fprintf(stderr, "cooperative launch failed: %s (grid %d)\n", hipGetErrorString(e), grid_blocks);
#endif
}
```

```cpp
#include <hip/hip_runtime.h>
#include <hip/hip_cooperative_groups.h>
#include <stdint.h>
#include <cstdio>
namespace cg = cooperative_groups;

#ifndef MULTI_LAUNCH
#define MULTI_LAUNCH 0
#endif

typedef unsigned short bf16_t;
typedef short bf16x8 __attribute__((ext_vector_type(8)));
typedef float f32x4 __attribute__((ext_vector_type(4)));
typedef unsigned long long u64;
typedef __attribute__((address_space(3))) unsigned* ldsp_t;
typedef unsigned u32x16 __attribute__((ext_vector_type(16)));
#define DEVI __device__ __forceinline__

constexpr int T_TOK = 32768, SEQ = 4096, DM = 1024, DFF = 4096;
constexpr int PJ_LD = 3072;
constexpr int NW_IN = 3100, NW_IN_PAD = 3200;
constexpr int NPHASE = 15;

constexpr size_t OFF_WIN = 0;
constexpr size_t OFF_WO = OFF_WIN + (size_t)2 * NW_IN_PAD * 1024 * 2;
constexpr size_t OFF_WUP = OFF_WO + (size_t)2 * 1024 * 1024 * 2;
constexpr size_t OFF_WDN = OFF_WUP + (size_t)2 * 4096 * 1024 * 2;
constexpr size_t OFF_W1T = OFF_WDN + (size_t)2 * 4096 * 1024 * 2;
constexpr size_t OFF_W2T = OFF_W1T + (size_t)2 * 2 * 128 * 2048 * 2;
constexpr size_t OFF_CBIAS = OFF_W2T + (size_t)2 * 2 * 64 * 128 * 2;
constexpr size_t OFF_CTR = OFF_CBIAS + 2048;
constexpr size_t OFF_ROPE = OFF_CTR + 256;
constexpr size_t OFF_GATES = OFF_ROPE + (size_t)4096 * 16 * 4;
constexpr size_t OFF_FOXC = OFF_GATES + (size_t)T_TOK * 32 * 4;
constexpr size_t OFF_KC = OFF_FOXC + (size_t)8 * 4 * 4096 * 4;
constexpr size_t OFF_VCT = OFF_KC + (size_t)8 * 2 * 256 * 64 * 2;
constexpr size_t OFF_DECAY = OFF_VCT + (size_t)8 * 2 * 256 * 64 * 2;
constexpr size_t OFF_KVT = OFF_DECAY + (size_t)2048 * 64 * 4;
constexpr size_t OFF_ST = OFF_KVT + (size_t)2048 * 4096 * 4;
constexpr size_t OFF_ACT = OFF_ST + (size_t)2048 * 4096 * 2;
constexpr size_t OFF_BIG = OFF_ACT + (size_t)T_TOK * 1024 * 2;
constexpr size_t OFF_VT_IN_BIG = (size_t)T_TOK * PJ_LD * 2;
constexpr size_t OFF_ACT2 = OFF_BIG + (size_t)T_TOK * 4096 * 2;
constexpr size_t OFF_SSQ = OFF_ACT2 + (size_t)T_TOK * 1024 * 2;
constexpr size_t WS_NEED = OFF_SSQ + (size_t)T_TOK * 16 * 4;

constexpr int LDS_BYTES = 67584;

struct Params {
    const float *x, *norm1_g, *w_in, *lb_logits, *onorm_g, *nsa_qn_g, *nsa_kn_g, *cmp_pos, *cmp_w1, *cmp_w2,
        *fox_qn_g, *fox_kn_g, *fox_fb, *w_o, *norm2_g, *w_up, *w_down;
    float* out;
    char* ws;
};

DEVI unsigned pk2(float lo, float hi) { unsigned r; asm("v_cvt_pk_bf16_f32 %0, %1, %2" : "=v"(r) : "v"(lo), "v"(hi)); return r; }
DEVI bf16_t f2bf(float f) { return (bf16_t)(pk2(f, 0.f) & 0xffffu); }
DEVI float bf2f(bf16_t h) { return __uint_as_float(((unsigned)h) << 16); }
DEVI float bflo(unsigned u) { return __uint_as_float(u << 16); }
DEVI float bfhi(unsigned u) { return __uint_as_float(u & 0xffff0000u); }
DEVI f32x4 mfma(bf16x8 a, bf16x8 b, f32x4 c) { return __builtin_amdgcn_mfma_f32_16x16x32_bf16(a, b, c, 0, 0, 0); }
DEVI int otid() { int t; asm volatile("v_mov_b32 %0, %1" : "=v"(t) : "v"(threadIdx.x)); return t; }
DEVI float wave_sum(float v) {
#pragma unroll
    for (int o = 32; o >= 1; o >>= 1) v += __shfl_xor(v, o);
    return v;
}
DEVI bf16x8 mk8(unsigned a, unsigned b, unsigned c, unsigned d) {
    uint4 u = make_uint4(a, b, c, d);
    return *(bf16x8*)&u;
}
DEVI bf16x8 ld8(const bf16_t* p) { uint4 u = *(const uint4*)p; return *(bf16x8*)&u; }
DEVI bf16x8 ld4x2(const bf16_t* p0, const bf16_t* p1) {
    uint2 a = *(const uint2*)p0, b = *(const uint2*)p1;
    return mk8(a.x, a.y, b.x, b.y);
}

DEVI int win_colmap(int n) {
    if (n < 2304) return n;
    if (n < 3072) return n + 24;
    if (n < 3096) return n - 768;
    return n;
}
__device__ void transpose_tile(const float* __restrict__ src, int ld_src, bf16_t* __restrict__ dst, int ld_dst, int k0, int n0, int nvalid,
                               int colmode, float* tile) {
    const int tid = otid();
    for (int idx = tid; idx < 4096; idx += 256) {
        const int i = idx >> 6, j = idx & 63, n = n0 + j;
        float v = 0.f;
        if (n < nvalid) v = src[(size_t)(k0 + i) * ld_src + (colmode ? win_colmap(n) : n)];
        tile[i * 65 + j] = v;
    }
    __syncthreads();
    for (int idx = tid; idx < 4096; idx += 256) {
        const int j = idx >> 6, i = idx & 63;
        dst[(size_t)(n0 + j) * ld_dst + k0 + i] = f2bf(tile[i * 65 + j]);
    }
    __syncthreads();
}

__device__ void norm_phase(const float* __restrict__ xin, const float* __restrict__ g, bf16_t* __restrict__ hout) {
    const int tid = otid(); const int lane = tid & 63, w = tid >> 6;
    for (int row = blockIdx.x * 4 + w; row < T_TOK; row += gridDim.x * 4) {
        const float4* xr = (const float4*)(xin + (size_t)row * DM);
        float4 v[4]; float ss = 0.f;
#pragma unroll
        for (int i = 0; i < 4; ++i) { v[i] = xr[lane + 64 * i]; ss += v[i].x * v[i].x + v[i].y * v[i].y + v[i].z * v[i].z + v[i].w * v[i].w; }
        ss = wave_sum(ss);
        const float r = rsqrtf(ss * (1.0f / 1024.0f) + 1e-6f);
#pragma unroll
        for (int i = 0; i < 4; ++i) {
            const float4 gg = ((const float4*)g)[lane + 64 * i];
            uint2 o; o.x = pk2(v[i].x * r * gg.x, v[i].y * r * gg.y); o.y = pk2(v[i].z * r * gg.z, v[i].w * r * gg.w);
            *(uint2*)(hout + (size_t)row * DM + (lane + 64 * i) * 4) = o;
        }
    }
}

__device__ void prep_phase(const Params& p, char* lds) {
    float* tile = (float*)lds;
    if (blockIdx.x == 0 && otid() < 64) ((unsigned*)(p.ws + OFF_CTR))[otid()] = 0u;
    bf16_t* win_t = (bf16_t*)(p.ws + OFF_WIN); bf16_t* wo_t = (bf16_t*)(p.ws + OFF_WO);
    bf16_t* wup_t = (bf16_t*)(p.ws + OFF_WUP); bf16_t* wdn_t = (bf16_t*)(p.ws + OFF_WDN);
    bf16_t* w1t = (bf16_t*)(p.ws + OFF_W1T); bf16_t* w2t = (bf16_t*)(p.ws + OFF_W2T);
    const int J0 = 1600, J1 = J0 + 512, J2 = J1 + 2048, J3 = J2 + 2048, J4 = J3 + 256, J5 = J4 + 8, J6 = J5 + 128, J7 = J6 + 128;
    for (int job = blockIdx.x; job < J7; job += gridDim.x) {
        if (job < J0) { const int L = job / 800, r = job % 800, kt = r / 50, nt = r % 50;
            transpose_tile(p.w_in + (size_t)L * 1024 * NW_IN, NW_IN, win_t + (size_t)L * NW_IN_PAD * 1024, 1024, kt * 64, nt * 64, NW_IN, 1, tile);
        } else if (job < J1) { const int j = job - J0, L = j / 256, r = j % 256, kt = r / 16, nt = r % 16;
            transpose_tile(p.w_o + (size_t)L * 1024 * 1024, 1024, wo_t + (size_t)L * 1024 * 1024, 1024, kt * 64, nt * 64, 1024, 0, tile);
        } else if (job < J2) { const int j = job - J1, L = j / 1024, r = j % 1024, kt = r / 64, nt = r % 64;
            transpose_tile(p.w_up + (size_t)L * 1024 * 4096, 4096, wup_t + (size_t)L * 4096 * 1024, 1024, kt * 64, nt * 64, 4096, 0, tile);
        } else if (job < J3) { const int j = job - J2, L = j / 1024, r = j % 1024, kt = r / 16, nt = r % 16;
            transpose_tile(p.w_down + (size_t)L * 4096 * 1024, 1024, wdn_t + (size_t)L * 1024 * 4096, 4096, kt * 64, nt * 64, 1024, 0, tile);
        } else if (job < J4) { const int j = job - J3, lw = j / 64, r = j % 64, kt = r / 2, nt = r % 2;
            transpose_tile(p.cmp_w1 + (size_t)lw * 2048 * 128, 128, w1t + (size_t)lw * 128 * 2048, 2048, kt * 64, nt * 64, 128, 0, tile);
        } else if (job < J5) { const int j = job - J4, lw = j / 2, kt = j % 2;
            transpose_tile(p.cmp_w2 + (size_t)lw * 128 * 64, 64, w2t + (size_t)lw * 64 * 128, 128, kt * 64, 0, 64, 0, tile);
        } else if (job < J6) {
            const int t_ = otid(); const int o = (job - J5) * 4 + (t_ >> 6), lane = t_ & 63, lw = o >> 7, hid = o & 127;
            const float* pos = p.cmp_pos + (size_t)lw * 2048; const float* w1 = p.cmp_w1 + (size_t)lw * 2048 * 128 + hid;
            float s = 0.f;
            for (int k = lane; k < 2048; k += 64) s += pos[k] * w1[(size_t)k * 128];
            s = wave_sum(s);
            if (lane == 0) ((float*)(p.ws + OFF_CBIAS))[o] = s;
        } else {
            const int e = (job - J6) * 256 + otid(), pos = e >> 3, i = e & 7;
            const float invf[8] = {1.0f, 0.1939227432012558f, 0.03760603070259094f, 0.007292664609849453f, 0.0014142135623842478f,
                                   0.00027424818836152554f, 5.318296098266728e-05f, 1.0313386155758053e-05f};
            float fr = 1.0f;
#pragma unroll
            for (int q = 0; q < 8; ++q) if (i == q) fr = invf[q];
            const float ang = (float)pos * fr;
            const double a = (double)ang; const double n = rint(a * 0.15915494309189535); const float rr = (float)(a - n * 6.283185307179586);
            float* rt = (float*)(p.ws + OFF_ROPE);
            rt[pos * 16 + i] = __cosf(rr); rt[pos * 16 + 8 + i] = __sinf(rr);
        }
    }
    norm_phase(p.x, p.norm1_g, (bf16_t*)(p.ws + OFF_ACT));
}

enum { EPI_PROJ = 0, EPI_WO = 1, EPI_UP = 2, EPI_DOWN = 3 };

DEVI void proj_epilogue(const Params& p, int L, const f32x4 (&acc)[4][4], int m0w, int cc, int lane) {
    const int quad = lane >> 4, l15 = lane & 15;
    bf16_t* proj = (bf16_t*)(p.ws + OFF_BIG); bf16_t* VT = (bf16_t*)(p.ws + OFF_BIG + OFF_VT_IN_BIG);
    float* gates = (float*)(p.ws + OFF_GATES); const float* rope = (const float*)(p.ws + OFF_ROPE);
    if (cc > 48) return;
    int kind = 0, vidx = 0; const float* gain = nullptr; float scale = 1.f; bool dorope = false;
    if (cc >= 8 && cc < 12) { kind = 5; vidx = cc - 8; }
    else if (cc >= 16 && cc < 24) { kind = 1; gain = p.nsa_qn_g + L * 64; scale = 0.125f; dorope = true; }
    else if (cc == 28 || cc == 29 || cc == 32 || cc == 33) { kind = 1; gain = p.nsa_kn_g + L * 64; dorope = true; }
    else if (cc == 30 || cc == 31) { kind = 5; vidx = 4 + (cc - 30); }
    else if (cc == 34 || cc == 35) { kind = 5; vidx = 6 + (cc - 34); }
    else if (cc >= 36 && cc < 40) { kind = 1; gain = p.fox_qn_g + L * 64; scale = 0.125f; }
    else if (cc >= 40 && cc < 44) { kind = 1; gain = p.fox_kn_g + L * 64; }
    else if (cc >= 44 && cc < 48) { kind = 5; vidx = 8 + (cc - 44); }
    else if (cc == 48) kind = 6;
#pragma unroll
    for (int mi = 0; mi < 4; ++mi) {
        const int token = m0w + mi * 16 + l15, pos = token & 4095, bb = token >> 12;
        float v[4][4];
#pragma unroll
        for (int ni = 0; ni < 4; ++ni)
#pragma unroll
            for (int j = 0; j < 4; ++j) v[ni][j] = acc[mi][ni][j];
        if (kind == 6) {
#pragma unroll
            for (int ni = 0; ni < 2; ++ni)
#pragma unroll
                for (int j = 0; j < 4; ++j) { const int d = ni * 16 + quad * 4 + j;
                    if (d < 24) gates[(size_t)token * 32 + d] = 1.0f / (1.0f + __expf(-v[ni][j]));
                    else if (d < 28) gates[(size_t)token * 32 + d] = v[ni][j]; }
            continue;
        }
        if (kind == 1) {
            float ss = 0.f;
#pragma unroll
            for (int ni = 0; ni < 4; ++ni)
#pragma unroll
                for (int j = 0; j < 4; ++j) ss += v[ni][j] * v[ni][j];
            ss += __shfl_xor(ss, 16); ss += __shfl_xor(ss, 32);
            const float r = rsqrtf(ss * (1.0f / 64.0f) + 1e-6f);
#pragma unroll
            for (int ni = 0; ni < 4; ++ni) { const float4 gg = *(const float4*)(gain + ni * 16 + quad * 4);
                v[ni][0] *= r * gg.x; v[ni][1] *= r * gg.y; v[ni][2] *= r * gg.z; v[ni][3] *= r * gg.w; }
            if (dorope) {
                const float4 cs = *(const float4*)(rope + pos * 16 + (quad & 1) * 4), sn = *(const float4*)(rope + pos * 16 + 8 + (quad & 1) * 4);
                const float cv[4] = {cs.x, cs.y, cs.z, cs.w}, sv[4] = {sn.x, sn.y, sn.z, sn.w};
#pragma unroll
                for (int j = 0; j < 4; ++j) { const float xx = v[0][j], pp = __shfl_xor(xx, 32);
                    v[0][j] = (quad < 2) ? (xx * cv[j] - pp * sv[j]) : (xx * cv[j] + pp * sv[j]); }
            }
#pragma unroll
            for (int ni = 0; ni < 4; ++ni)
#pragma unroll
                for (int j = 0; j < 4; ++j) v[ni][j] *= scale;
        }
        if (kind == 5) {
#pragma unroll
            for (int ni = 0; ni < 4; ++ni)
#pragma unroll
                for (int j = 0; j < 4; ++j) { const int d = ni * 16 + quad * 4 + j;
                    VT[((size_t)(vidx * 8 + bb) * 64 + d) * 4096 + pos] = f2bf(v[ni][j]); }
        } else {
#pragma unroll
            for (int ni = 0; ni < 4; ++ni) { uint2 o; o.x = pk2(v[ni][0], v[ni][1]); o.y = pk2(v[ni][2], v[ni][3]);
                *(uint2*)(proj + (size_t)token * PJ_LD + cc * 64 + ni * 16 + quad * 4) = o; }
        }
    }
}

DEVI void g_load(uint4 (&RA)[4], uint4 (&RB)[4], const bf16_t* Ap, const bf16_t* Bp, int K, int KT) {
#pragma unroll
    for (int i = 0; i < 4; ++i) { RA[i] = *(const uint4*)(Ap + (size_t)(32 * i) * K + KT * 64); RB[i] = *(const uint4*)(Bp + (size_t)(32 * i) * K + KT * 64); }
}
DEVI void g_swrite(const uint4 (&RA)[4], const uint4 (&RB)[4], char* d_) {
#pragma unroll
    for (int i = 0; i < 4; ++i) { *(uint4*)(d_ + i * 4096) = RA[i]; *(uint4*)(d_ + 16384 + i * 4096) = RB[i]; }
}
DEVI void g_compute(const char* sA, f32x4 (&acc)[4][4], int wm, int wn, int quad, int l15) {
    const char* sB = sA + 16384;
#pragma unroll
    for (int ks = 0; ks < 2; ++ks) {
        bf16x8 af[4], bfr[4]; const int ch = ks * 4 + quad;
#pragma unroll
        for (int mi = 0; mi < 4; ++mi) { const int row = wm * 64 + mi * 16 + l15; af[mi] = *(const bf16x8*)(sA + row * 128 + ((ch ^ (row & 7)) << 4)); }
#pragma unroll
        for (int ni = 0; ni < 4; ++ni) { const int row = wn * 64 + ni * 16 + l15; bfr[ni] = *(const bf16x8*)(sB + row * 128 + ((ch ^ (row & 7)) << 4)); }
#pragma unroll
        for (int mi = 0; mi < 4; ++mi)
#pragma unroll
            for (int ni = 0; ni < 4; ++ni) acc[mi][ni] = mfma(bfr[ni], af[mi], acc[mi][ni]);
    }
}

DEVI float row_rstd(const float* ssq, int m) {
    const float4 a = *(const float4*)(ssq + (size_t)m * 16), b = *(const float4*)(ssq + (size_t)m * 16 + 4), c = *(const float4*)(ssq + (size_t)m * 16 + 8), d = *(const float4*)(ssq + (size_t)m * 16 + 12);
    const float t = ((a.x + a.y) + (a.z + a.w)) + ((b.x + b.y) + (b.z + b.w)) + ((c.x + c.y) + (c.z + c.w)) + ((d.x + d.y) + (d.z + d.w));
    return rsqrtf(t * (1.0f / 1024.0f) + 1e-6f);
}

template <int EPI>
__device__ void gemm_phase(const Params& p, int L, char* lds) {
    const bf16_t* A; const bf16_t* Bt; int K, nNt;
    if (EPI == EPI_PROJ) { A = (const bf16_t*)(p.ws + OFF_ACT); Bt = (const bf16_t*)(p.ws + OFF_WIN) + (size_t)L * NW_IN_PAD * 1024; K = 1024; nNt = 25; }
    else if (EPI == EPI_WO) { A = (const bf16_t*)(p.ws + OFF_ACT); Bt = (const bf16_t*)(p.ws + OFF_WO) + (size_t)L * 1024 * 1024; K = 1024; nNt = 8; }
    else if (EPI == EPI_UP) { A = (const bf16_t*)(p.ws + OFF_ACT2); Bt = (const bf16_t*)(p.ws + OFF_WUP) + (size_t)L * 4096 * 1024; K = 1024; nNt = 32; }
    else { A = (const bf16_t*)(p.ws + OFF_BIG); Bt = (const bf16_t*)(p.ws + OFF_WDN) + (size_t)L * 1024 * 4096; K = 4096; nNt = 8; }
    const int tid = otid(), lane = tid & 63, w = tid >> 6, quad = lane >> 4, l15 = lane & 15, wm = w >> 1, wn = w & 1;
    const int xcd = blockIdx.x & 7, loc = blockIdx.x >> 3, nloc = gridDim.x >> 3;
    const int nk = K / 64;
    for (int it = loc; it < 32 * nNt; it += nloc) {
        const int gsz = 8 * nNt, mloc = (it / gsz) * 8 + (it & 7), nloc_t = (it % gsz) >> 3;
        const int m0 = (xcd + 8 * mloc) * 128, n0 = nloc_t * 128;
        f32x4 acc[4][4];
#pragma unroll
        for (int a = 0; a < 4; ++a)
#pragma unroll
            for (int b = 0; b < 4; ++b) acc[a][b] = (f32x4){0.f, 0.f, 0.f, 0.f};
        u32x16 ra0, rb0, ra1, rb1;
        const int lrow = tid >> 3, lc = tid & 7;
        const bf16_t* Ap = A + (size_t)(m0 + lrow) * K + lc * 8;
        const bf16_t* Bp = Bt + (size_t)(n0 + lrow) * K + lc * 8;
        const int woff = lrow * 128 + ((lc ^ (lrow & 7)) << 4);
#define G_LD1(R, P, I, KT) { const uint4 t_ = *(const uint4*)((P) + (size_t)(32 * I) * K + (KT) * 64); R[4 * I] = t_.x; R[4 * I + 1] = t_.y; R[4 * I + 2] = t_.z; R[4 * I + 3] = t_.w; }
#define G_LOAD(RA, RB, KT) { G_LD1(RA, Ap, 0, KT) G_LD1(RB, Bp, 0, KT) G_LD1(RA, Ap, 1, KT) G_LD1(RB, Bp, 1, KT) G_LD1(RA, Ap, 2, KT) G_LD1(RB, Bp, 2, KT) G_LD1(RA, Ap, 3, KT) G_LD1(RB, Bp, 3, KT) }
#define G_SW1(R, D, I) *(uint4*)((D) + I * 4096) = make_uint4(R[4 * I], R[4 * I + 1], R[4 * I + 2], R[4 * I + 3]);
#define G_SWRITE(RA, RB, DST) { G_SW1(RA, DST, 0) G_SW1(RB, (DST) + 16384, 0) G_SW1(RA, DST, 1) G_SW1(RB, (DST) + 16384, 1) G_SW1(RA, DST, 2) G_SW1(RB, (DST) + 16384, 2) G_SW1(RA, DST, 3) G_SW1(RB, (DST) + 16384, 3) }
        G_LOAD(ra0, rb0, 0)
        G_LOAD(ra1, rb1, 1)
        G_SWRITE(ra0, rb0, lds + woff)
        __syncthreads();
#pragma unroll 1
        for (int kt = 0; kt < nk - 2; kt += 2) {
            G_LOAD(ra0, rb0, kt + 2)
            __builtin_amdgcn_sched_barrier(0);
            g_compute(lds, acc, wm, wn, quad, l15);
            G_SWRITE(ra1, rb1, lds + 32768 + woff)
            __syncthreads();
            G_LOAD(ra1, rb1, kt + 3)
            __builtin_amdgcn_sched_barrier(0);
            g_compute(lds + 32768, acc, wm, wn, quad, l15);
            G_SWRITE(ra0, rb0, lds + woff)
            __syncthreads();
        }
        g_compute(lds, acc, wm, wn, quad, l15);
        G_SWRITE(ra1, rb1, lds + 32768 + woff)
        __syncthreads();
        g_compute(lds + 32768, acc, wm, wn, quad, l15);
        __syncthreads();
#undef G_LOAD
#undef G_SWRITE
#undef G_LD1
#undef G_SW1
        if (EPI == EPI_PROJ) {
            if (L > 0) {
#pragma unroll
                for (int mi = 0; mi < 4; ++mi) { const float r = row_rstd((const float*)(p.ws + OFF_SSQ), m0 + wm * 64 + mi * 16 + l15);
#pragma unroll
                    for (int ni = 0; ni < 4; ++ni) acc[mi][ni] = acc[mi][ni] * r; }
            }
            proj_epilogue(p, L, acc, m0 + wm * 64, (n0 + wn * 64) >> 6, lane);
        } else if (EPI == EPI_UP) {
            bf16_t* hid = (bf16_t*)(p.ws + OFF_BIG);
#pragma unroll
            for (int mi = 0; mi < 4; ++mi) { const float r = row_rstd((const float*)(p.ws + OFF_SSQ), m0 + wm * 64 + mi * 16 + l15);
#pragma unroll
                for (int ni = 0; ni < 4; ++ni) { const int m = m0 + wm * 64 + mi * 16 + l15, n = n0 + wn * 64 + ni * 16 + quad * 4;
                    float a0 = fmaxf(acc[mi][ni][0] * r, 0.f), a1 = fmaxf(acc[mi][ni][1] * r, 0.f), a2 = fmaxf(acc[mi][ni][2] * r, 0.f), a3 = fmaxf(acc[mi][ni][3] * r, 0.f);
                    uint2 o; o.x = pk2(a0 * a0, a1 * a1); o.y = pk2(a2 * a2, a3 * a3);
                    *(uint2*)(hid + (size_t)m * DFF + n) = o; } }
        } else {
            const float* xin = (EPI == EPI_WO && L == 0) ? p.x : p.out;
            const bool emit = (EPI == EPI_WO) || (L + 1 < 2);
            const float* gn = (EPI == EPI_WO) ? (p.norm2_g + L * 1024) : (p.norm1_g + (L + 1 < 2 ? L + 1 : L) * 1024);
            bf16_t* hn = (bf16_t*)(p.ws + ((EPI == EPI_WO) ? OFF_ACT2 : OFF_ACT));
            float* ssq = (float*)(p.ws + OFF_SSQ);
#pragma unroll
            for (int mi = 0; mi < 4; ++mi) {
                const int m = m0 + wm * 64 + mi * 16 + l15; float ss = 0.f;
#pragma unroll
                for (int ni = 0; ni < 4; ++ni) { const int n = n0 + wn * 64 + ni * 16 + quad * 4;
                    float4 xv = *(const float4*)(xin + (size_t)m * DM + n);
                    xv.x += acc[mi][ni][0]; xv.y += acc[mi][ni][1]; xv.z += acc[mi][ni][2]; xv.w += acc[mi][ni][3];
                    *(float4*)(p.out + (size_t)m * DM + n) = xv;
                    if (emit) { const float4 gg = *(const float4*)(gn + n);
                        uint2 o; o.x = pk2(xv.x * gg.x, xv.y * gg.y); o.y = pk2(xv.z * gg.z, xv.w * gg.w);
                        *(uint2*)(hn + (size_t)m * DM + n) = o;
                        ss += (xv.x * xv.x + xv.y * xv.y) + (xv.z * xv.z + xv.w * xv.w); } }
                if (emit) { ss += __shfl_xor(ss, 16); ss += __shfl_xor(ss, 32);
                    if (quad == 0) ssq[(size_t)m * 16 + (n0 >> 7) * 2 + wn] = ss; }
            }
        }
    }
}

DEVI float hgrn_lb(const Params& p, int L, int hk) {
    if (L == 0) return 0.f;
    const float l0 = p.lb_logits[hk], l1 = p.lb_logits[256 + hk];
    return 1.0f / (1.0f + __expf(l0 - l1));
}

__device__ void hgrn_a_unit(const Params& p, int L, int u, char* lds) {
    const int tid = otid(), lane = tid & 63, w = tid >> 6, quad = lane >> 4, l15 = lane & 15;
    const int c = u & 63, h = (u >> 6) & 3, b = u >> 8;
    const bf16_t* proj = (const bf16_t*)(p.ws + OFF_BIG); const bf16_t* VT = (const bf16_t*)(p.ws + OFF_BIG + OFF_VT_IN_BIG);
    float* segtot = (float*)lds;
    bf16_t* KDt = (bf16_t*)(lds + 1024);
    const int k = tid & 63, seg = tid >> 6;
    const float lb = hgrn_lb(p, L, h * 64 + k);
    float gl[16], kkv[16]; float run = 0.f;
    const bf16_t* zp = proj + (size_t)(b * 4096 + c * 64 + seg * 16) * PJ_LD + 256 + h * 64 + k;
#pragma unroll
    for (int i = 0; i < 16; ++i) {
        const float z = bf2f(zp[(size_t)i * PJ_LD]);
        const float sg = 1.0f / (1.0f + __expf(-z)), sn = 1.0f / (1.0f + __expf(z));
        const float f = lb + (1.0f - lb) * sg;
        run += __logf(fmaxf(f, 1e-30f)); gl[i] = run; kkv[i] = (1.0f - lb) * sn;
    }
    segtot[seg * 64 + k] = run;
    __syncthreads();
    float off = 0.f, tot = 0.f;
#pragma unroll
    for (int s = 0; s < 4; ++s) { const float t = segtot[s * 64 + k]; tot += t; if (s < seg) off += t; }
    unsigned pkd[8];
#pragma unroll
    for (int i = 0; i < 8; ++i) {
        const float a0 = kkv[2 * i] * __expf(tot - (off + gl[2 * i])), a1 = kkv[2 * i + 1] * __expf(tot - (off + gl[2 * i + 1]));
        pkd[i] = pk2(a0, a1);
    }
    *(uint4*)(KDt + k * 72 + seg * 16) = make_uint4(pkd[0], pkd[1], pkd[2], pkd[3]);
    *(uint4*)(KDt + k * 72 + seg * 16 + 8) = make_uint4(pkd[4], pkd[5], pkd[6], pkd[7]);
    if (seg == 0) ((float*)(p.ws + OFF_DECAY))[u * 64 + k] = __expf(tot);
    __syncthreads();
    const bf16_t* vt = VT + ((size_t)(h * 8 + b) * 64) * 4096 + c * 64;
    float* kvt = (float*)(p.ws + OFF_KVT) + (size_t)u * 4096;
    bf16x8 af[2];
#pragma unroll
    for (int ks = 0; ks < 2; ++ks) af[ks] = ld8(vt + (size_t)(w * 16 + l15) * 4096 + ks * 32 + quad * 8);
#pragma unroll
    for (int kt = 0; kt < 4; ++kt) {
        f32x4 acc = (f32x4){0.f, 0.f, 0.f, 0.f};
#pragma unroll
        for (int ks = 0; ks < 2; ++ks) { const bf16x8 bfr = *(const bf16x8*)(KDt + (kt * 16 + l15) * 72 + ks * 32 + quad * 8); acc = mfma(af[ks], bfr, acc); }
#pragma unroll
        for (int j = 0; j < 4; ++j) kvt[(w * 16 + quad * 4 + j) * 64 + kt * 16 + l15] = acc[j];
    }
    __syncthreads();
}

__device__ void hgrn_scan_phase(const Params& p) {
    const float* kvt = (const float*)(p.ws + OFF_KVT); const float* dec = (const float*)(p.ws + OFF_DECAY);
    bf16_t* st = (bf16_t*)(p.ws + OFF_ST);
    for (int e = blockIdx.x * 256 + otid(); e < 32 * 4096; e += gridDim.x * 256) {
        const int bh = e >> 12, vk = e & 4095, k = vk & 63;
        float S = 0.f;
#pragma unroll 8
        for (int c = 0; c < 64; ++c) {
            const int u = bh * 64 + c;
            st[(size_t)u * 4096 + vk] = f2bf(S);
            S = S * dec[u * 64 + k] + kvt[(size_t)u * 4096 + vk];
        }
    }
}

__device__ void hgrn_c_unit(const Params& p, int L, int u, char* lds) {
    const int tid = otid(), lane = tid & 63, w = tid >> 6, quad = lane >> 4, l15 = lane & 15;
    const int c = u & 63, h = (u >> 6) & 3, b = u >> 8;
    const bf16_t* proj = (const bf16_t*)(p.ws + OFF_BIG); const bf16_t* VT = (const bf16_t*)(p.ws + OFF_BIG + OFF_VT_IN_BIG);
    float* Gs = (float*)lds; float* KKs = Gs + 64 * 65; float* Qs = KKs + 64 * 65; float* segtot = Qs + 64 * 65;
    {
        const int k = tid & 63, seg = tid >> 6;
        const float lb = hgrn_lb(p, L, h * 64 + k);
        float gl[16], kkv[16]; float run = 0.f;
        const bf16_t* zp = proj + (size_t)(b * 4096 + c * 64 + seg * 16) * PJ_LD + 256 + h * 64 + k;
#pragma unroll
        for (int i = 0; i < 16; ++i) {
            const float z = bf2f(zp[(size_t)i * PJ_LD]);
            const float sg = 1.0f / (1.0f + __expf(-z)), sn = 1.0f / (1.0f + __expf(z));
            const float f = lb + (1.0f - lb) * sg;
            run += __logf(fmaxf(f, 1e-30f)); gl[i] = run; kkv[i] = (1.0f - lb) * sn;
            Qs[(seg * 16 + i) * 65 + k] = bf2f(zp[(size_t)i * PJ_LD - 256]) * 0.125f;
        }
        segtot[seg * 64 + k] = run;
        __syncthreads();
        float off = 0.f;
#pragma unroll
        for (int s = 0; s < 4; ++s) { const float t = segtot[s * 64 + k]; if (s < seg) off += t; }
#pragma unroll
        for (int i = 0; i < 16; ++i) { Gs[(seg * 16 + i) * 65 + k] = off + gl[i]; KKs[(seg * 16 + i) * 65 + k] = kkv[i]; }
        __syncthreads();
    }
    const int I = w;
    const int tq = 16 * I + l15;
    bf16x8 qt[2], qg[2];
#pragma unroll
    for (int ks = 0; ks < 2; ++ks) {
        float a[8], g8[8];
#pragma unroll
        for (int j = 0; j < 8; ++j) {
            const int k = ks * 32 + quad * 8 + j;
            const float G = Gs[tq * 65 + k], q = Qs[tq * 65 + k];
            const float gref = (I == 0) ? 0.f : Gs[(16 * I - 1) * 65 + k];
            a[j] = q * __expf(G - gref); g8[j] = q * __expf(G);
        }
        qt[ks] = mk8(pk2(a[0], a[1]), pk2(a[2], a[3]), pk2(a[4], a[5]), pk2(a[6], a[7]));
        qg[ks] = mk8(pk2(g8[0], g8[1]), pk2(g8[2], g8[3]), pk2(g8[4], g8[5]), pk2(g8[6], g8[7]));
    }
    f32x4 O[4];
#pragma unroll
    for (int vt = 0; vt < 4; ++vt) O[vt] = (f32x4){0.f, 0.f, 0.f, 0.f};
    const bf16_t* st = (const bf16_t*)(p.ws + OFF_ST) + (size_t)u * 4096;
#pragma unroll
    for (int vt = 0; vt < 4; ++vt)
#pragma unroll
        for (int ks = 0; ks < 2; ++ks) O[vt] = mfma(ld8(st + (vt * 16 + l15) * 64 + ks * 32 + quad * 8), qg[ks], O[vt]);
    const bf16_t* vtp = VT + ((size_t)(h * 8 + b) * 64) * 4096 + c * 64;
    for (int Jp = 0; Jp <= (I >> 1); ++Jp) {
        f32x4 sc[2];
#pragma unroll
        for (int jj = 0; jj < 2; ++jj) {
            const int J = 2 * Jp + jj;
            sc[jj] = (f32x4){0.f, 0.f, 0.f, 0.f};
            if (J <= I) {
                const int s = 16 * J + l15;
#pragma unroll
                for (int ks = 0; ks < 2; ++ks) {
                    float a[8];
#pragma unroll
                    for (int j = 0; j < 8; ++j) {
                        const int k = ks * 32 + quad * 8 + j;
                        const float gref = (I == 0) ? 0.f : Gs[(16 * I - 1) * 65 + k];
                        a[j] = KKs[s * 65 + k] * __expf(gref - Gs[s * 65 + k]);
                    }
                    sc[jj] = mfma(mk8(pk2(a[0], a[1]), pk2(a[2], a[3]), pk2(a[4], a[5]), pk2(a[6], a[7])), qt[ks], sc[jj]);
                }
#pragma unroll
                for (int j = 0; j < 4; ++j) { const int s2 = 16 * J + quad * 4 + j; if (s2 > tq) sc[jj][j] = 0.f; }
            }
        }
        const bf16x8 P = mk8(pk2(sc[0][0], sc[0][1]), pk2(sc[0][2], sc[0][3]), pk2(sc[1][0], sc[1][1]), pk2(sc[1][2], sc[1][3]));
#pragma unroll
        for (int vt = 0; vt < 4; ++vt) {
            const bf16_t* r = vtp + (size_t)(vt * 16 + l15) * 4096 + 32 * Jp + quad * 4;
            O[vt] = mfma(ld4x2(r, r + 16), P, O[vt]);
        }
    }
    float ss = 0.f;
#pragma unroll
    for (int vt = 0; vt < 4; ++vt)
#pragma unroll
        for (int j = 0; j < 4; ++j) ss += O[vt][j] * O[vt][j];
    ss += __shfl_xor(ss, 16); ss += __shfl_xor(ss, 32);
    const float r = rsqrtf(ss * (1.0f / 64.0f) + 1e-6f);
    const size_t token = (size_t)b * 4096 + c * 64 + tq;
    bf16_t* mix = (bf16_t*)(p.ws + OFF_ACT);
#pragma unroll
    for (int vt = 0; vt < 4; ++vt) {
        const int v0 = vt * 16 + quad * 4;
        const float4 og = *(const float4*)(p.onorm_g + L * 64 + v0);
        const uint2 gz = *(const uint2*)(proj + token * PJ_LD + 768 + h * 64 + v0);
        const float g0 = bflo(gz.x), g1 = bfhi(gz.x), g2 = bflo(gz.y), g3 = bfhi(gz.y);
        const float o0 = O[vt][0] * r * og.x * (g0 / (1.0f + __expf(-g0))), o1 = O[vt][1] * r * og.y * (g1 / (1.0f + __expf(-g1)));
        const float o2 = O[vt][2] * r * og.z * (g2 / (1.0f + __expf(-g2))), o3 = O[vt][3] * r * og.w * (g3 / (1.0f + __expf(-g3)));
        uint2 o; o.x = pk2(o0, o1); o.y = pk2(o2, o3);
        *(uint2*)(mix + token * DM + h * 64 + v0) = o;
    }
    __syncthreads();
}

__device__ void compress_unit(const Params& p, int L, int u, char* lds) {
    const int tid = otid(), lane = tid & 63, w = tid >> 6, quad = lane >> 4, l15 = lane & 15;
    const int which = u & 1, g = (u >> 1) & 1, b = (u >> 2) & 7, ntile = u >> 5;
    const bf16_t* proj = (const bf16_t*)(p.ws + OFF_BIG);
    const bf16_t* w1t = (const bf16_t*)(p.ws + OFF_W1T) + (size_t)(L * 2 + which) * 128 * 2048;
    const bf16_t* w2t = (const bf16_t*)(p.ws + OFF_W2T) + (size_t)(L * 2 + which) * 64 * 128;
    const float* cbias = (const float*)(p.ws + OFF_CBIAS) + (L * 2 + which) * 128;
    bf16_t* Hs = (bf16_t*)lds + w * 16 * 136;
    const int nrow = ntile * 64 + w * 16 + l15;
    int tokbase = 16 * nrow; if (tokbase > 4096 - 32) tokbase = 4096 - 32;
    const bf16_t* xa = proj + ((size_t)b * 4096 + tokbase) * PJ_LD + (which ? 1664 : 1536) + g * 64;
    f32x4 acc[8];
#pragma unroll
    for (int i = 0; i < 8; ++i) acc[i] = (f32x4){0.f, 0.f, 0.f, 0.f};
#pragma unroll 2
    for (int kk = 0; kk < 64; ++kk) {
        const int l = kk >> 1, d = (kk & 1) * 32 + quad * 8;
        const bf16x8 a = ld8(xa + (size_t)l * PJ_LD + d);
#pragma unroll
        for (int ni = 0; ni < 8; ++ni) acc[ni] = mfma(a, ld8(w1t + (size_t)(ni * 16 + l15) * 2048 + kk * 32 + quad * 8), acc[ni]);
    }
#pragma unroll
    for (int ni = 0; ni < 8; ++ni) { const float bsv = cbias[ni * 16 + l15];
#pragma unroll
        for (int j = 0; j < 4; ++j) { const float x = acc[ni][j] + bsv;
            const float uu = 0.7978845608028654f * (x + 0.044715f * x * x * x);
            const float th = 1.0f - 2.0f / (1.0f + __expf(2.0f * uu));
            Hs[(quad * 4 + j) * 136 + ni * 16 + l15] = f2bf(0.5f * x * (1.0f + th)); } }
    __syncthreads();
    f32x4 o[4];
#pragma unroll
    for (int i = 0; i < 4; ++i) o[i] = (f32x4){0.f, 0.f, 0.f, 0.f};
#pragma unroll
    for (int ks = 0; ks < 4; ++ks) { const bf16x8 a = *(const bf16x8*)(Hs + l15 * 136 + ks * 32 + quad * 8);
#pragma unroll
        for (int ni = 0; ni < 4; ++ni) o[ni] = mfma(a, ld8(w2t + (size_t)(ni * 16 + l15) * 128 + ks * 32 + quad * 8), o[ni]); }
    const int nb = ntile * 64 + w * 16 + quad * 4;
    if (which == 0) {
        bf16_t* kc = (bf16_t*)(p.ws + OFF_KC) + (size_t)(b * 2 + g) * 256 * 64;
        const float* rope = (const float*)(p.ws + OFF_ROPE);
#pragma unroll
        for (int j = 0; j < 4; ++j) {
            const int n = nb + j;
            float ss = o[0][j] * o[0][j] + o[1][j] * o[1][j] + o[2][j] * o[2][j] + o[3][j] * o[3][j];
            ss += __shfl_xor(ss, 1); ss += __shfl_xor(ss, 2); ss += __shfl_xor(ss, 4); ss += __shfl_xor(ss, 8);
            const float r = rsqrtf(ss * (1.0f / 64.0f) + 1e-6f);
            float v[4];
#pragma unroll
            for (int ni = 0; ni < 4; ++ni) v[ni] = o[ni][j] * r * p.nsa_kn_g[L * 64 + ni * 16 + l15];
            int pos = 16 * n + 31; if (pos > 4095) pos = 4095;
            const float cs = rope[pos * 16 + (l15 & 7)], sn = rope[pos * 16 + 8 + (l15 & 7)];
            const float pp = __shfl_xor(v[0], 8);
            v[0] = (l15 < 8) ? (v[0] * cs - pp * sn) : (v[0] * cs + pp * sn);
#pragma unroll
            for (int ni = 0; ni < 4; ++ni) kc[(size_t)n * 64 + ni * 16 + l15] = (n < 255) ? f2bf(v[ni]) : (bf16_t)0;
        }
    } else {
        bf16_t* vct = (bf16_t*)(p.ws + OFF_VCT) + (size_t)(b * 2 + g) * 64 * 256;
#pragma unroll
        for (int ni = 0; ni < 4; ++ni) {
            float v0 = o[ni][0], v1 = o[ni][1], v2 = o[ni][2], v3 = o[ni][3];
            if (nb + 3 >= 255) v3 = 0.f;
            uint2 ov; ov.x = pk2(v0, v1); ov.y = pk2(v2, v3);
            *(uint2*)(vct + (size_t)(ni * 16 + l15) * 256 + nb) = ov;
        }
    }
    __syncthreads();
}

__device__ void foxc_job(const Params& p, int L, int bh, char* lds) {
    const int tid = otid(), lane = tid & 63, w = tid >> 6, b = bh >> 2, h = bh & 3;
    const float* gates = (const float*)(p.ws + OFF_GATES);
    float* cc = (float*)(p.ws + OFF_FOXC) + (size_t)bh * 4096;
    float* wtot = (float*)lds;
    const float fb = p.fox_fb[L * 4 + h];
    float v[16];
#pragma unroll
    for (int i = 0; i < 16; ++i) v[i] = gates[((size_t)b * 4096 + tid * 16 + i) * 32 + 24 + h] + fb;
    float run = 0.f;
#pragma unroll
    for (int i = 0; i < 16; ++i) { const float x = v[i]; run += (x >= 0.f) ? -log1pf(__expf(-x)) : (x - log1pf(__expf(x))); v[i] = run; }
    float incl = run;
#pragma unroll
    for (int o = 1; o < 64; o <<= 1) { const float t = __shfl_up(incl, o); if (lane >= o) incl += t; }
    if (lane == 63) wtot[w] = incl;
    __syncthreads();
    float pre = incl - run;
#pragma unroll
    for (int s = 0; s < 4; ++s) if (s < w) pre += wtot[s];
#pragma unroll
    for (int i = 0; i < 4; ++i) *(float4*)(cc + tid * 16 + i * 4) = make_float4(pre + v[4 * i], pre + v[4 * i + 1], pre + v[4 * i + 2], pre + v[4 * i + 3]);
    __syncthreads();
}

constexpr int KV_BUF = 16384;
DEVI void tile_glds(const bf16_t* Kg, int ldk, const bf16_t* Vg, int ldv, char* buf, int tid) {
    const int w = tid >> 6, i = tid & 63;
#pragma unroll
    for (int jj = 0; jj < 2; ++jj) {
        const int j = w * 2 + jj, row = 8 * j + (i >> 3), slot = i & 7;
        const bf16_t* kp = Kg + (size_t)row * ldk + ((slot ^ (row & 7)) << 3);
        const bf16_t* vp = Vg + (size_t)row * ldv + ((slot ^ ((row >> 1) & 7)) << 3);
        __builtin_amdgcn_global_load_lds((const unsigned*)kp, (ldsp_t)(unsigned)(size_t)(buf + j * 1024), 16, 0, 0);
        __builtin_amdgcn_global_load_lds((const unsigned*)vp, (ldsp_t)(unsigned)(size_t)(buf + 8192 + j * 1024), 16, 0, 0);
    }
}
DEVI void lds_kf(const char* buf, int kh, int lane, bf16x8 (&kf)[2][2]) {
    const int quad = lane >> 4, l15 = lane & 15;
#pragma unroll
    for (int t2 = 0; t2 < 2; ++t2)
#pragma unroll
        for (int ks = 0; ks < 2; ++ks) { const int row = kh * 32 + t2 * 16 + l15, ch = ks * 4 + quad; kf[t2][ks] = *(const bf16x8*)(buf + row * 128 + ((ch ^ (row & 7)) << 4)); }
}
DEVI void lds_vf(const char* buf, int kh, int lane, bf16x8 (&vf)[4]) {
    const int quad = lane >> 4, l15 = lane & 15;
#pragma unroll
    for (int dt = 0; dt < 4; ++dt) { const int d = dt * 16 + l15, u0 = kh * 8 + quad, u1 = u0 + 4;
        const uint2 a = *(const uint2*)(buf + 8192 + d * 128 + ((u0 ^ (d & 14)) << 3)), b = *(const uint2*)(buf + 8192 + d * 128 + ((u1 ^ (d & 14)) << 3));
        vf[dt] = mk8(a.x, a.y, b.x, b.y); }
}

template <class MaskF>
DEVI void attn_block64(const char* buf, int kbase, const char* ql, int q0o, int q1o, int qstride, const float* cb, f32x4 (&O)[4][4], float (&m)[4], float (&l)[4], int lane, MaskF maskf) {
    const int quad = lane >> 4;
#pragma unroll
    for (int kh = 0; kh < 2; ++kh) {
        bf16x8 kf[2][2], vf[4];
        lds_kf(buf, kh, lane, kf); lds_vf(buf, kh, lane, vf);
        float ck[8] = {0.f, 0.f, 0.f, 0.f, 0.f, 0.f, 0.f, 0.f};
        if (cb) { const float4 c0 = *(const float4*)(cb + kbase + kh * 32 + quad * 4), c1 = *(const float4*)(cb + kbase + kh * 32 + 16 + quad * 4);
            ck[0] = c0.x; ck[1] = c0.y; ck[2] = c0.z; ck[3] = c0.w; ck[4] = c1.x; ck[5] = c1.y; ck[6] = c1.z; ck[7] = c1.w; }
#pragma unroll
        for (int nt = 0; nt < 4; ++nt) {
            f32x4 s0 = (f32x4){0.f, 0.f, 0.f, 0.f}, s1 = s0;
            { const bf16x8 qa = *(const bf16x8*)(ql + nt * qstride + q0o), qb_ = *(const bf16x8*)(ql + nt * qstride + q1o);
              s0 = mfma(kf[0][0], qa, s0); s1 = mfma(kf[1][0], qa, s1); s0 = mfma(kf[0][1], qb_, s0); s1 = mfma(kf[1][1], qb_, s1); }
            float sv[8]; bool ok[8]; float mx = -1e30f;
#pragma unroll
            for (int e = 0; e < 8; ++e) { sv[e] = (e < 4) ? s0[e & 3] : s1[e & 3]; const int key = kbase + kh * 32 + (e >> 2) * 16 + quad * 4 + (e & 3);
                ok[e] = maskf(nt, ck[e], key, sv[e]); if (ok[e]) mx = fmaxf(mx, sv[e]); }
            mx = fmaxf(mx, __shfl_xor(mx, 16)); mx = fmaxf(mx, __shfl_xor(mx, 32));
            const float mn = fmaxf(m[nt], mx), alpha = __expf(m[nt] - mn);
            float pv[8]; float rs = 0.f;
#pragma unroll
            for (int e = 0; e < 8; ++e) { pv[e] = ok[e] ? __expf(sv[e] - mn) : 0.f; rs += pv[e]; }
            rs += __shfl_xor(rs, 16); rs += __shfl_xor(rs, 32);
            l[nt] = l[nt] * alpha + rs; m[nt] = mn;
            const bf16x8 P = mk8(pk2(pv[0], pv[1]), pk2(pv[2], pv[3]), pk2(pv[4], pv[5]), pk2(pv[6], pv[7]));
#pragma unroll
            for (int dt = 0; dt < 4; ++dt) { O[dt][nt] = O[dt][nt] * alpha; O[dt][nt] = mfma(vf[dt], P, O[dt][nt]); }
        }
    }
}

template <class MaskF>
DEVI void attn_stream(u64 tiles, const bf16_t* Kbase, int ldk, const bf16_t* Vbase, int ldv, char* kvbuf, int jb_wave_min, int jb_wave_max,
                      const char* ql, int q0o, int q1o, int qstride, const float* cb, f32x4 (&O)[4][4], float (&m)[4], float (&l)[4], int tid, int lane, MaskF maskf) {
    if (tiles == 0ull) return;
    int jb = __ffsll((long long)tiles) - 1; tiles &= tiles - 1;
    tile_glds(Kbase + (size_t)jb * 64 * ldk, ldk, Vbase + jb * 64, ldv, kvbuf, tid);
    __syncthreads();
    int cur = 0;
#pragma unroll 1
    for (;;) {
        const bool more = tiles != 0ull;
        int jbn = 0;
        if (more) { jbn = __ffsll((long long)tiles) - 1; tiles &= tiles - 1; tile_glds(Kbase + (size_t)jbn * 64 * ldk, ldk, Vbase + jbn * 64, ldv, kvbuf + (cur ^ 1) * KV_BUF, tid); }
        if (jb >= jb_wave_min && jb <= jb_wave_max) attn_block64(kvbuf + cur * KV_BUF, jb * 64, ql, q0o, q1o, qstride, cb, O, m, l, lane, [&](int nt, float ckv, int key, float& s) { return maskf(nt, ckv, key, jb, s); });
        __syncthreads();
        if (!more) break;
        jb = jbn; cur ^= 1;
    }
}

DEVI void attn_store2(bf16_t* mix, size_t token0, int tokstride, int col0, int colstride, const f32x4 (&O)[4][4], const float (&sc)[4], int lane, bool accum) {
    const int quad = lane >> 4, l15 = lane & 15;
#pragma unroll
    for (int nt = 0; nt < 4; ++nt)
#pragma unroll
        for (int dt = 0; dt < 4; ++dt) {
            bf16_t* dst = mix + (token0 + nt * tokstride + l15) * DM + col0 + nt * colstride + dt * 16 + quad * 4;
            float a0 = O[dt][nt][0] * sc[nt], a1 = O[dt][nt][1] * sc[nt], a2 = O[dt][nt][2] * sc[nt], a3 = O[dt][nt][3] * sc[nt];
            if (accum) { const uint2 old = *(const uint2*)dst; a0 += bflo(old.x); a1 += bfhi(old.x); a2 += bflo(old.y); a3 += bfhi(old.y); }
            uint2 o; o.x = pk2(a0, a1); o.y = pk2(a2, a3);
            *(uint2*)dst = o;
        }
}

__device__ void nsa_unit(const Params& p, int L, int b, int g, int blk, char* lds) {
    const int tid = otid(), lane = tid & 63, w = tid >> 6, quad = lane >> 4, l15 = lane & 15;
    const bf16_t* proj = (const bf16_t*)(p.ws + OFF_BIG); const bf16_t* VT = (const bf16_t*)(p.ws + OFF_BIG + OFF_VT_IN_BIG);
    const float* gates = (const float*)(p.ws + OFF_GATES);
    bf16_t* mix = (bf16_t*)(p.ws + OFF_ACT);
    char* kvbuf = lds; float* impL = (float*)(lds + KV_BUF)  ; char* Qs = lds + 32768; u64* selm = (u64*)(lds + 65536);
    const int q0 = blk * 64; const int tq = q0 + w * 16 + l15; const size_t token = (size_t)b * 4096 + tq;
    const size_t token0 = (size_t)b * 4096 + q0 + w * 16;
    const int mixcol = 256 + g * 256;
#pragma unroll
    for (int t = 0; t < 8; ++t) { const int idx = t * 64 + lane, rr = idx >> 3, c = idx & 7, hh = rr >> 4, r16 = rr & 15;
        const uint4 v = *(const uint4*)(proj + (token0 + r16) * PJ_LD + 1024 + (g * 4 + hh) * 64 + c * 8);
        *(uint4*)(Qs + (hh * 64 + w * 16 + r16) * 128 + ((c ^ (r16 & 7)) << 4)) = v; }
    const char* ql = Qs + (w * 16 + l15) * 128; const int q0o = ((quad) ^ (l15 & 7)) << 4, q1o = ((4 + quad) ^ (l15 & 7)) << 4; const int qstride = 8192;
    __syncthreads();
    f32x4 O[4][4]; float m[4], l[4];
    const bf16_t* Kc = (const bf16_t*)(p.ws + OFF_KC) + (size_t)(b * 2 + g) * 256 * 64;
    const bf16_t* VcT = (const bf16_t*)(p.ws + OFF_VCT) + (size_t)(b * 2 + g) * 64 * 256;
    const int ncb = (4 * blk + 3 + 63) >> 6;
#pragma unroll
    for (int nt = 0; nt < 4; ++nt) { m[nt] = -1e30f; l[nt] = 0.f; }
    {
#pragma unroll 1
        for (int pass = 0; pass < 2; ++pass) {
            float inv[4]; float prevr = 0.f;
            if (pass == 1) {
#pragma unroll
                for (int nt = 0; nt < 4; ++nt) inv[nt] = 1.0f / fmaxf(l[nt], 1e-30f);
#pragma unroll
                for (int dt = 0; dt < 4; ++dt)
#pragma unroll
                    for (int nt = 0; nt < 4; ++nt) O[dt][nt] = (f32x4){0.f, 0.f, 0.f, 0.f};
            }
#pragma unroll 1
            for (int ct = 0; ct < ncb; ++ct) {
                tile_glds(Kc + (size_t)ct * 64 * 64, 64, VcT + ct * 64, 256, kvbuf, tid);
                __syncthreads();
                const char* buf = kvbuf;
#pragma unroll
                for (int kh = 0; kh < 2; ++kh) {
                    bf16x8 kf[2][2]; lds_kf(buf, kh, lane, kf);
                    if (pass == 0) {
#pragma unroll
                        for (int nt = 0; nt < 4; ++nt) {
                            f32x4 s0 = (f32x4){0.f, 0.f, 0.f, 0.f}, s1 = s0;
                            { const bf16x8 qa = *(const bf16x8*)(ql + nt * qstride + q0o), qb_ = *(const bf16x8*)(ql + nt * qstride + q1o);
                              s0 = mfma(kf[0][0], qa, s0); s1 = mfma(kf[1][0], qa, s1); s0 = mfma(kf[0][1], qb_, s0); s1 = mfma(kf[1][1], qb_, s1); }
                            float sv[8]; bool ok[8]; float mx = -1e30f;
#pragma unroll
                            for (int e = 0; e < 8; ++e) { sv[e] = (e < 4) ? s0[e & 3] : s1[e & 3]; const int n = ct * 64 + kh * 32 + (e >> 2) * 16 + quad * 4 + (e & 3);
                                ok[e] = (16 * n + 31 <= tq); if (ok[e]) mx = fmaxf(mx, sv[e]); }
                            mx = fmaxf(mx, __shfl_xor(mx, 16)); mx = fmaxf(mx, __shfl_xor(mx, 32));
                            const float mn = fmaxf(m[nt], mx), alpha = __expf(m[nt] - mn);
                            float rs = 0.f;
#pragma unroll
                            for (int e = 0; e < 8; ++e) rs += ok[e] ? __expf(sv[e] - mn) : 0.f;
                            rs += __shfl_xor(rs, 16); rs += __shfl_xor(rs, 32);
                            l[nt] = l[nt] * alpha + rs; m[nt] = mn;
                        }
                    } else {
                        bf16x8 vf[4]; lds_vf(buf, kh, lane, vf);
                        float As[2] = {0.f, 0.f}, p3[2] = {0.f, 0.f};
#pragma unroll
                        for (int nt = 0; nt < 4; ++nt) {
                            f32x4 s0 = (f32x4){0.f, 0.f, 0.f, 0.f}, s1 = s0;
                            { const bf16x8 qa = *(const bf16x8*)(ql + nt * qstride + q0o), qb_ = *(const bf16x8*)(ql + nt * qstride + q1o);
                              s0 = mfma(kf[0][0], qa, s0); s1 = mfma(kf[1][0], qa, s1); s0 = mfma(kf[0][1], qb_, s0); s1 = mfma(kf[1][1], qb_, s1); }
                            float pv[8];
#pragma unroll
                            for (int e = 0; e < 8; ++e) { const float s = (e < 4) ? s0[e & 3] : s1[e & 3]; const int n = ct * 64 + kh * 32 + (e >> 2) * 16 + quad * 4 + (e & 3);
                                pv[e] = (16 * n + 31 <= tq) ? __expf(s - m[nt]) * inv[nt] : 0.f; }
                            As[0] += (pv[0] + pv[1]) + (pv[2] + pv[3]); As[1] += (pv[4] + pv[5]) + (pv[6] + pv[7]); p3[0] += pv[3]; p3[1] += pv[7];
                            const bf16x8 P = mk8(pk2(pv[0], pv[1]), pk2(pv[2], pv[3]), pk2(pv[4], pv[5]), pk2(pv[6], pv[7]));
#pragma unroll
                            for (int dt = 0; dt < 4; ++dt) O[dt][nt] = mfma(vf[dt], P, O[dt][nt]);
                        }
                        const int qq = w * 16 + l15;
#pragma unroll
                        for (int t2 = 0; t2 < 2; ++t2) {
                            const float rr = __shfl(p3[t2], (lane + 48) & 63);
                            const float carry = (quad == 0) ? prevr : rr; prevr = rr;
                            const int jb = ct * 16 + kh * 8 + t2 * 4 + quad;
                            impL[jb * 64 + ((qq ^ jb) & 63)] = As[t2] + carry;
                        }
                    }
                }
                __syncthreads();
            }
        }
    }
    {
        const float4 gv = *(const float4*)(gates + token * 32 + 0 * 8 + g * 4);
        const float sc[4] = {gv.x, gv.y, gv.z, gv.w};
        attn_store2(mix, token0, 0, mixcol, 64, O, sc, lane, false);
    }
#pragma unroll 1
    for (int qi = 0; qi < 16; ++qi) {
        const int q = w * 16 + qi, jb = lane;
        float val = impL[jb * 64 + ((q ^ jb) & 63)];
        if (jb > blk) val = -1e30f;
        else if (jb == 0 || jb == blk || jb == blk - 1) val = 1e30f;
        int rank = 0;
        for (int jp = 0; jp < 64; ++jp) { const float vj = __shfl(val, jp); rank += ((vj > val) || (vj == val && jp < jb)) ? 1 : 0; }
        const bool sel = (rank < 16) && (val > -5e29f);
        const u64 mask = __ballot(sel);
        if (lane == 0) selm[q] = mask;
    }
    __syncthreads();
    u64 uni = 0;
    for (int q = 0; q < 64; ++q) uni |= selm[q];
    const u64 sm = selm[w * 16 + l15];
    {
#pragma unroll
        for (int nt = 0; nt < 4; ++nt) { m[nt] = -1e30f; l[nt] = 0.f; }
#pragma unroll
        for (int dt = 0; dt < 4; ++dt)
#pragma unroll
            for (int nt = 0; nt < 4; ++nt) O[dt][nt] = (f32x4){0.f, 0.f, 0.f, 0.f};
        const u64 tiles = uni & ((blk == 63) ? ~0ull : ((2ull << blk) - 1ull));
        attn_stream(tiles, proj + (size_t)b * 4096 * PJ_LD + 1792 + g * 64, PJ_LD, VT + ((size_t)((4 + g) * 8 + b) * 64) * 4096, 4096, kvbuf, 0, 63, ql, q0o, q1o, qstride, nullptr, O, m, l, tid, lane,
                    [&](int nt, float ckv, int key, int jb, float& s) { return (((sm >> jb) & 1ull) != 0) && (key <= tq); });
        const float4 gv = *(const float4*)(gates + token * 32 + 1 * 8 + g * 4);
        const float sc[4] = {gv.x / fmaxf(l[0], 1e-30f), gv.y / fmaxf(l[1], 1e-30f), gv.z / fmaxf(l[2], 1e-30f), gv.w / fmaxf(l[3], 1e-30f)};
        attn_store2(mix, token0, 0, mixcol, 64, O, sc, lane, true);
    }
    {
#pragma unroll
        for (int nt = 0; nt < 4; ++nt) { m[nt] = -1e30f; l[nt] = 0.f; }
#pragma unroll
        for (int dt = 0; dt < 4; ++dt)
#pragma unroll
            for (int nt = 0; nt < 4; ++nt) O[dt][nt] = (f32x4){0.f, 0.f, 0.f, 0.f};
        const int jlo = blk > 8 ? blk - 8 : 0;
        const u64 upto = (blk == 63) ? ~0ull : ((2ull << blk) - 1ull);
        const u64 tiles = upto & ~((1ull << jlo) - 1ull);
        attn_stream(tiles, proj + (size_t)b * 4096 * PJ_LD + 2048 + g * 64, PJ_LD, VT + ((size_t)((6 + g) * 8 + b) * 64) * 4096, 4096, kvbuf, 0, 63, ql, q0o, q1o, qstride, nullptr, O, m, l, tid, lane,
                    [&](int nt, float ckv, int key, int jb, float& s) { return (key <= tq) && (key + 512 > tq); });
        const float4 gv = *(const float4*)(gates + token * 32 + 2 * 8 + g * 4);
        const float sc[4] = {gv.x / fmaxf(l[0], 1e-30f), gv.y / fmaxf(l[1], 1e-30f), gv.z / fmaxf(l[2], 1e-30f), gv.w / fmaxf(l[3], 1e-30f)};
        attn_store2(mix, token0, 0, mixcol, 64, O, sc, lane, true);
    }
    __syncthreads();
}

__device__ void fox_unit(const Params& p, int L, int b, int h, int qb, char* lds) {
    const int tid = otid(), lane = tid & 63, w = tid >> 6, quad = lane >> 4, l15 = lane & 15;
    const bf16_t* proj = (const bf16_t*)(p.ws + OFF_BIG); const bf16_t* VT = (const bf16_t*)(p.ws + OFF_BIG + OFF_VT_IN_BIG);
    bf16_t* mix = (bf16_t*)(p.ws + OFF_ACT);
    const float* cc = (const float*)(p.ws + OFF_FOXC) + (size_t)(b * 4 + h) * 4096;
    const int q0 = qb * 256 + w * 64; const size_t token0 = (size_t)b * 4096 + q0;
    int tq[4]; float cq[4];
#pragma unroll
    for (int nt = 0; nt < 4; ++nt) { tq[nt] = q0 + nt * 16 + l15; cq[nt] = cc[tq[nt]]; }
    char* Qs = lds + 32768;
#pragma unroll
    for (int t = 0; t < 8; ++t) { const int idx = t * 64 + lane, rr = idx >> 3, c = idx & 7;
        const uint4 v = *(const uint4*)(proj + (token0 + rr) * PJ_LD + 2304 + h * 64 + c * 8);
        *(uint4*)(Qs + (w * 64 + rr) * 128 + ((c ^ (rr & 7)) << 4)) = v; }
    const char* ql = Qs + (w * 64 + l15) * 128; const int q0o = ((quad) ^ (l15 & 7)) << 4, q1o = ((4 + quad) ^ (l15 & 7)) << 4; const int qstride = 2048;
    __syncthreads();
    f32x4 O[4][4]; float m[4], l[4];
#pragma unroll
    for (int nt = 0; nt < 4; ++nt) { m[nt] = -1e30f; l[nt] = 0.f; }
#pragma unroll
    for (int dt = 0; dt < 4; ++dt)
#pragma unroll
        for (int nt = 0; nt < 4; ++nt) O[dt][nt] = (f32x4){0.f, 0.f, 0.f, 0.f};
    const int jmax = qb * 4 + 3;
    int jlo_w, jlo_b;
    { const float cq0 = cc[q0]; int lo = 0, hi = qb * 4 + w;
      while (lo < hi) { const int mid = (lo + hi) >> 1; if (cq0 - cc[mid * 64 + 63] >= -140.f) hi = mid; else lo = mid + 1; }
      jlo_w = lo; }
    { const float cq0 = cc[qb * 256]; int lo = 0, hi = qb * 4;
      while (lo < hi) { const int mid = (lo + hi) >> 1; if (cq0 - cc[mid * 64 + 63] >= -140.f) hi = mid; else lo = mid + 1; }
      jlo_b = lo; }
    const u64 tiles = ((jmax == 63) ? ~0ull : ((2ull << jmax) - 1ull)) & ~((1ull << jlo_b) - 1ull);
    attn_stream(tiles, proj + (size_t)b * 4096 * PJ_LD + 2560 + h * 64, PJ_LD, VT + ((size_t)((8 + h) * 8 + b) * 64) * 4096, 4096, lds, jlo_w, qb * 4 + w, ql, q0o, q1o, qstride, cc, O, m, l, tid, lane,
                [&](int nt, float ckv, int key, int jb, float& s) { s += cq[nt] - ckv; return key <= tq[nt]; });
    float sc[4];
#pragma unroll
    for (int nt = 0; nt < 4; ++nt) sc[nt] = 1.0f / fmaxf(l[nt], 1e-30f);
    attn_store2(mix, token0, 16, 768 + h * 64, 0, O, sc, lane, false);
}

__device__ void mixA_phase(const Params& p, int L, char* lds);
DEVI int next_unit(unsigned* ctr, char* lds) {
    int* slot = (int*)(lds + LDS_BYTES - 16);
    __syncthreads();
    if (otid() == 0) *slot = (int)atomicAdd(ctr, 1u);
    __syncthreads();
    return *slot;
}
__device__ void mixA_phase(const Params& p, int L, char* lds) {
    unsigned* ctr = (unsigned*)(p.ws + OFF_CTR) + L * 4 + 3;
#pragma unroll 1
    for (;;) {
        const int job = next_unit(ctr, lds); if (job >= 160 + 512) break;
        if (job < 128) compress_unit(p, L, job, lds);
        else if (job < 160) foxc_job(p, L, job - 128, lds);
        else {
#pragma unroll 1
            for (int u = (job - 160) * 4; u < (job - 160) * 4 + 4; ++u) hgrn_a_unit(p, L, u, lds);
        }
    }
}
__device__ void mixB_phase(const Params& p, int L, char* lds) {
    unsigned* ctr = (unsigned*)(p.ws + OFF_CTR) + L * 4;
#pragma unroll 1
    for (;;) { const int f = next_unit(ctr + 0, lds); if (f >= 512) break; const int qb = 15 - (f >> 5), bh = f & 31; fox_unit(p, L, bh >> 2, bh & 3, qb, lds); }
#pragma unroll 1
    for (;;) { const int n = next_unit(ctr + 1, lds); if (n >= 1024) break; const int blk = 63 - (n >> 4), bg = n & 15; nsa_unit(p, L, bg >> 1, bg & 1, blk, lds); }
#pragma unroll 1
    for (;;) { const int c = next_unit(ctr + 2, lds); if (c >= 1024) break;
#pragma unroll 1
        for (int u = c * 2; u < c * 2 + 2; ++u) hgrn_c_unit(p, L, u, lds); }
}

__device__ void run_phase(const Params& p, int ph, char* lds) {
    if (ph == 0) { prep_phase(p, lds); return; }
    const int L = (ph - 1) / 7, s = (ph - 1) % 7;
    switch (s) {
        case 0: gemm_phase<EPI_PROJ>(p, L, lds); break;
        case 1: mixA_phase(p, L, lds); break;
        case 2: hgrn_scan_phase(p); break;
        case 3: mixB_phase(p, L, lds); break;
        case 4: gemm_phase<EPI_WO>(p, L, lds); break;
        case 5: gemm_phase<EPI_UP>(p, L, lds); break;
        default: gemm_phase<EPI_DOWN>(p, L, lds); break;
    }
}

__global__ void __launch_bounds__(256, 2) fwd_kernel(Params p, int ph_lo, int ph_hi) {
    __shared__ __attribute__((aligned(16))) char lds[LDS_BYTES];
    for (int ph = ph_lo; ph < ph_hi; ++ph) {
#ifdef REPEAT_MASK
        const int nrep = (ph >= 1 && ((REPEAT_MASK >> ((ph - 1) % 7)) & 1)) ? 2 : 1;
#pragma unroll 1
        for (int rep = 0; rep < nrep; ++rep) {
            if (rep) cg::this_grid().sync();
            run_phase(p, ph, lds);
        }
#else
        run_phase(p, ph, lds);
#endif
        if (ph + 1 < ph_hi) { cg::this_grid().sync(); }
    }
}

extern "C" void kernel_launch(void* const* d_in, const int* in_sizes, int n_in, void* d_out, int out_size, void* d_ws, size_t ws_size,
                              hipStream_t stream) {
    if (ws_size < WS_NEED) { fprintf(stderr, "workspace too small: %zu < %zu\n", ws_size, (size_t)WS_NEED); return; }
    Params p{};
    p.x = (const float*)d_in[0]; p.norm1_g = (const float*)d_in[1]; p.w_in = (const float*)d_in[2]; p.lb_logits = (const float*)d_in[3];
    p.onorm_g = (const float*)d_in[4]; p.nsa_qn_g = (const float*)d_in[5]; p.nsa_kn_g = (const float*)d_in[6]; p.cmp_pos = (const float*)d_in[7];
    p.cmp_w1 = (const float*)d_in[8]; p.cmp_w2 = (const float*)d_in[9]; p.fox_qn_g = (const float*)d_in[10]; p.fox_kn_g = (const float*)d_in[11];
    p.fox_fb = (const float*)d_in[12]; p.w_o = (const float*)d_in[13]; p.norm2_g = (const float*)d_in[14]; p.w_up = (const float*)d_in[15];
    p.w_down = (const float*)d_in[16];
    p.out = (float*)d_out; p.ws = (char*)d_ws;
#if MULTI_LAUNCH
    for (int ph = 0; ph < NPHASE; ++ph) hipLaunchKernelGGL(fwd_kernel, dim3(512), dim3(256), 0, stream, p, ph, ph + 1);
#else
    static int grid_blocks = 0;
    if (!grid_blocks) {
        int dev = 0, cus = 0, per_cu = 0;
        hipGetDevice(&dev);
        hipDeviceGetAttribute(&cus, hipDeviceAttributeMultiprocessorCount, dev);
        hipOccupancyMaxActiveBlocksPerMultiprocessor(&per_cu, fwd_kernel, 256, 0);
        per_cu = 2;
        grid_blocks = cus * per_cu;
        grid_blocks &= ~7;
    }
    int lo = 0, hi = NPHASE;
    void* args[] = {&p, &lo, &hi};
    hipError_t e = hipLaunchCooperativeKernel((void*)fwd_kernel, dim3(grid_blocks), dim3(256), args, 0, stream);
    if (e != hipSuccess) fprintf(stderr, "cooperative launch failed: %s (grid %d)\n", hipGetErrorString(e), grid_blocks);
#endif
}
```

```cpp
#include <hip/hip_runtime.h>
#include <hip/hip_cooperative_groups.h>
#include <stdint.h>
#include <cstdio>
namespace cg = cooperative_groups;

#ifndef MULTI_LAUNCH
#define MULTI_LAUNCH 0
#endif

typedef unsigned short bf16_t;
typedef short bf16x8 __attribute__((ext_vector_type(8)));
typedef float f32x4 __attribute__((ext_vector_type(4)));
typedef unsigned long long u64;
typedef __attribute__((address_space(3))) unsigned* ldsp_t;
typedef unsigned u32x16 __attribute__((ext_vector_type(16)));
typedef unsigned u32x8 __attribute__((ext_vector_type(8)));
#define DEVI __device__ __forceinline__

constexpr int T_TOK = 32768, SEQ = 4096, DM = 1024, DFF = 4096;
constexpr int PJ_LD = 3072;
constexpr int NW_IN = 3100, NW_IN_PAD = 3328;
constexpr int NPHASE = 15;

constexpr size_t OFF_WIN = 0;
constexpr size_t OFF_WO = OFF_WIN + (size_t)2 * NW_IN_PAD * 1024 * 2;
constexpr size_t OFF_WUP = OFF_WO + (size_t)2 * 1024 * 1024 * 2;
constexpr size_t OFF_WDN = OFF_WUP + (size_t)2 * 4096 * 1024 * 2;
constexpr size_t OFF_W1T = OFF_WDN + (size_t)2 * 4096 * 1024 * 2;
constexpr size_t OFF_W2T = OFF_W1T + (size_t)2 * 2 * 128 * 2048 * 2;
constexpr size_t OFF_CBIAS = OFF_W2T + (size_t)2 * 2 * 64 * 128 * 2;
constexpr size_t OFF_CTR = OFF_CBIAS + 2048;
constexpr size_t OFF_ROPE = OFF_CTR + 256;
constexpr size_t OFF_GATES = OFF_ROPE + (size_t)4096 * 16 * 4;
constexpr size_t OFF_FOXC = OFF_GATES + (size_t)T_TOK * 32 * 4;
constexpr size_t OFF_KC = OFF_FOXC + (size_t)8 * 4 * 4096 * 4;
constexpr size_t OFF_VCT = OFF_KC + (size_t)8 * 2 * 256 * 64 * 2;
constexpr size_t OFF_DECAY = OFF_VCT + (size_t)8 * 2 * 256 * 64 * 2;
constexpr size_t OFF_KVT = OFF_DECAY + (size_t)2048 * 64 * 4;
constexpr size_t OFF_ST = OFF_KVT + (size_t)2048 * 4096 * 4;
constexpr size_t OFF_ACT = OFF_ST + (size_t)2048 * 4096 * 2;
constexpr size_t OFF_BIG = OFF_ACT + (size_t)T_TOK * 1024 * 2;
constexpr size_t OFF_VT_IN_BIG = (size_t)T_TOK * PJ_LD * 2;
constexpr size_t OFF_ACT2 = OFF_BIG + (size_t)T_TOK * 4096 * 2;
constexpr size_t OFF_SSQ = OFF_ACT2 + (size_t)T_TOK * 1024 * 2;
constexpr size_t WS_NEED = OFF_SSQ + (size_t)T_TOK * 16 * 4;

constexpr int LDS_BYTES = 67584;

struct Params {
    const float *x, *norm1_g, *w_in, *lb_logits, *onorm_g, *nsa_qn_g, *nsa_kn_g, *cmp_pos, *cmp_w1, *cmp_w2,
        *fox_qn_g, *fox_kn_g, *fox_fb, *w_o, *norm2_g, *w_up, *w_down;
    float* out;
    char* ws;
};

DEVI unsigned pk2(float lo, float hi) { unsigned r; asm("v_cvt_pk_bf16_f32 %0, %1, %2" : "=v"(r) : "v"(lo), "v"(hi)); return r; }
DEVI bf16_t f2bf(float f) { return (bf16_t)(pk2(f, 0.f) & 0xffffu); }
DEVI float bf2f(bf16_t h) { return __uint_as_float(((unsigned)h) << 16); }
DEVI float bflo(unsigned u) { return __uint_as_float(u << 16); }
DEVI float bfhi(unsigned u) { return __uint_as_float(u & 0xffff0000u); }
DEVI f32x4 mfma(bf16x8 a, bf16x8 b, f32x4 c) { return __builtin_amdgcn_mfma_f32_16x16x32_bf16(a, b, c, 0, 0, 0); }
DEVI int otid() { int t; asm volatile("v_mov_b32 %0, %1" : "=v"(t) : "v"(threadIdx.x)); return t; }
DEVI float wave_sum(float v) {
#pragma unroll
    for (int o = 32; o >= 1; o >>= 1) v += __shfl_xor(v, o);
    return v;
}
DEVI bf16x8 mk8(unsigned a, unsigned b, unsigned c, unsigned d) {
    uint4 u = make_uint4(a, b, c, d);
    return *(bf16x8*)&u;
}
DEVI bf16x8 ld8(const bf16_t* p) { uint4 u = *(const uint4*)p; return *(bf16x8*)&u; }
DEVI bf16x8 ld4x2(const bf16_t* p0, const bf16_t* p1) {
    uint2 a = *(const uint2*)p0, b = *(const uint2*)p1;
    return mk8(a.x, a.y, b.x, b.y);
}

DEVI int win_colmap(int n) {
    if (n < 2304) return n;
    if (n < 3072) return n + 24;
    if (n < 3096) return n - 768;
    return n;
}
__device__ void transpose_tile(const float* __restrict__ src, int ld_src, bf16_t* __restrict__ dst, int ld_dst, int k0, int n0, int nvalid,
                               int colmode, float* tile) {
    const int tid = otid();
    for (int idx = tid; idx < 4096; idx += 256) {
        const int i = idx >> 6, j = idx & 63, n = n0 + j;
        float v = 0.f;
        if (n < nvalid) v = src[(size_t)(k0 + i) * ld_src + (colmode ? win_colmap(n) : n)];
        tile[i * 65 + j] = v;
    }
    __syncthreads();
    for (int idx = tid; idx < 4096; idx += 256) {
        const int j = idx >> 6, i = idx & 63;
        dst[(size_t)(n0 + j) * ld_dst + k0 + i] = f2bf(tile[i * 65 + j]);
    }
    __syncthreads();
}

__device__ void norm_phase(const float* __restrict__ xin, const float* __restrict__ g, bf16_t* __restrict__ hout) {
    const int tid = otid(); const int lane = tid & 63, w = tid >> 6;
    for (int row = blockIdx.x * 4 + w; row < T_TOK; row += gridDim.x * 4) {
        const float4* xr = (const float4*)(xin + (size_t)row * DM);
        float4 v[4]; float ss = 0.f;
#pragma unroll
        for (int i = 0; i < 4; ++i) { v[i] = xr[lane + 64 * i]; ss += v[i].x * v[i].x + v[i].y * v[i].y + v[i].z * v[i].z + v[i].w * v[i].w; }
        ss = wave_sum(ss);
        const float r = rsqrtf(ss * (1.0f / 1024.0f) + 1e-6f);
#pragma unroll
        for (int i = 0; i < 4; ++i) {
            const float4 gg = ((const float4*)g)[lane + 64 * i];
            uint2 o; o.x = pk2(v[i].x * r * gg.x, v[i].y * r * gg.y); o.y = pk2(v[i].z * r * gg.z, v[i].w * r * gg.w);
            *(uint2*)(hout + (size_t)row * DM + (lane + 64 * i) * 4) = o;
        }
    }
}

__device__ void prep_phase(const Params& p, char* lds) {
    float* tile = (float*)lds;
    if (blockIdx.x == 0 && otid() < 64) ((unsigned*)(p.ws + OFF_CTR))[otid()] = 0u;
    bf16_t* win_t = (bf16_t*)(p.ws + OFF_WIN); bf16_t* wo_t = (bf16_t*)(p.ws + OFF_WO);
    bf16_t* wup_t = (bf16_t*)(p.ws + OFF_WUP); bf16_t* wdn_t = (bf16_t*)(p.ws + OFF_WDN);
    bf16_t* w1t = (bf16_t*)(p.ws + OFF_W1T); bf16_t* w2t = (bf16_t*)(p.ws + OFF_W2T);
    const int J0 = 1664, J1 = J0 + 512, J2 = J1 + 2048, J3 = J2 + 2048, J4 = J3 + 256, J5 = J4 + 8, J6 = J5 + 128, J7 = J6 + 128;
    for (int job = blockIdx.x; job < J7; job += gridDim.x) {
        if (job < J0) { const int L = job / 832, r = job % 832, kt = r / 52, nt = r % 52;
            transpose_tile(p.w_in + (size_t)L * 1024 * NW_IN, NW_IN, win_t + (size_t)L * NW_IN_PAD * 1024, 1024, kt * 64, nt * 64, NW_IN, 1, tile);
        } else if (job < J1) { const int j = job - J0, L = j / 256, r = j % 256, kt = r / 16, nt = r % 16;
            transpose_tile(p.w_o + (size_t)L * 1024 * 1024, 1024, wo_t + (size_t)L * 1024 * 1024, 1024, kt * 64, nt * 64, 1024, 0, tile);
        } else if (job < J2) { const int j = job - J1, L = j / 1024, r = j % 1024, kt = r / 64, nt = r % 64;
            transpose_tile(p.w_up + (size_t)L * 1024 * 4096, 4096, wup_t + (size_t)L * 4096 * 1024, 1024, kt * 64, nt * 64, 4096, 0, tile);
        } else if (job < J3) { const int j = job - J2, L = j / 1024, r = j % 1024, kt = r / 16, nt = r % 16;
            transpose_tile(p.w_down + (size_t)L * 4096 * 1024, 1024, wdn_t + (size_t)L * 1024 * 4096, 4096, kt * 64, nt * 64, 1024, 0, tile);
        } else if (job < J4) { const int j = job - J3, lw = j / 64, r = j % 64, kt = r / 2, nt = r % 2;
            transpose_tile(p.cmp_w1 + (size_t)lw * 2048 * 128, 128, w1t + (size_t)lw * 128 * 2048, 2048, kt * 64, nt * 64, 128, 0, tile);
        } else if (job < J5) { const int j = job - J4, lw = j / 2, kt = j % 2;
            transpose_tile(p.cmp_w2 + (size_t)lw * 128 * 64, 64, w2t + (size_t)lw * 64 * 128, 128, kt * 64, 0, 64, 0, tile);
        } else if (job < J6) {
            const int t_ = otid(); const int o = (job - J5) * 4 + (t_ >> 6), lane = t_ & 63, lw = o >> 7, hid = o & 127;
            const float* pos = p.cmp_pos + (size_t)lw * 2048; const float* w1 = p.cmp_w1 + (size_t)lw * 2048 * 128 + hid;
            float s = 0.f;
            for (int k = lane; k < 2048; k += 64) s += pos[k] * w1[(size_t)k * 128];
            s = wave_sum(s);
            if (lane == 0) ((float*)(p.ws + OFF_CBIAS))[o] = s;
        } else {
            const int e = (job - J6) * 256 + otid(), pos = e >> 3, i = e & 7;
            const float invf[8] = {1.0f, 0.1939227432012558f, 0.03760603070259094f, 0.007292664609849453f, 0.0014142135623842478f,
                                   0.00027424818836152554f, 5.318296098266728e-05f, 1.0313386155758053e-05f};
            float fr = 1.0f;
#pragma unroll
            for (int q = 0; q < 8; ++q) if (i == q) fr = invf[q];
            const float ang = (float)pos * fr;
            const double a = (double)ang; const double n = rint(a * 0.15915494309189535); const float rr = (float)(a - n * 6.283185307179586);
            float* rt = (float*)(p.ws + OFF_ROPE);
            rt[pos * 16 + i] = __cosf(rr); rt[pos * 16 + 8 + i] = __sinf(rr);
        }
    }
    norm_phase(p.x, p.norm1_g, (bf16_t*)(p.ws + OFF_ACT));
}

enum { EPI_PROJ = 0, EPI_WO = 1, EPI_UP = 2, EPI_DOWN = 3 };

DEVI float row_rstd(const float* ssq, int m) {
    const float4 a = *(const float4*)(ssq + (size_t)m * 16), b = *(const float4*)(ssq + (size_t)m * 16 + 4), c = *(const float4*)(ssq + (size_t)m * 16 + 8), d = *(const float4*)(ssq + (size_t)m * 16 + 12);
    const float t = ((a.x + a.y) + (a.z + a.w)) + ((b.x + b.y) + (b.z + b.w)) + ((c.x + c.y) + (c.z + c.w)) + ((d.x + d.y) + (d.z + d.w));
    return rsqrtf(t * (1.0f / 1024.0f) + 1e-6f);
}

template <int CH>
DEVI void proj_epilogue(const Params& p, int L, const f32x4 (&acc)[4][8], int m0w, int cc, int lane) {
    const int quad = lane >> 4, l15 = lane & 15;
    bf16_t* proj = (bf16_t*)(p.ws + OFF_BIG); bf16_t* VT = (bf16_t*)(p.ws + OFF_BIG + OFF_VT_IN_BIG);
    float* gates = (float*)(p.ws + OFF_GATES); const float* rope = (const float*)(p.ws + OFF_ROPE);
    if (cc > 48) return;
    int kind = 0, vidx = 0; const float* gain = nullptr; float scale = 1.f; bool dorope = false;
    if (cc >= 8 && cc < 12) { kind = 5; vidx = cc - 8; }
    else if (cc >= 16 && cc < 24) { kind = 1; gain = p.nsa_qn_g + L * 64; scale = 0.125f; dorope = true; }
    else if (cc == 28 || cc == 29 || cc == 32 || cc == 33) { kind = 1; gain = p.nsa_kn_g + L * 64; dorope = true; }
    else if (cc == 30 || cc == 31) { kind = 5; vidx = 4 + (cc - 30); }
    else if (cc == 34 || cc == 35) { kind = 5; vidx = 6 + (cc - 34); }
    else if (cc >= 36 && cc < 40) { kind = 1; gain = p.fox_qn_g + L * 64; scale = 0.125f; }
    else if (cc >= 40 && cc < 44) { kind = 1; gain = p.fox_kn_g + L * 64; }
    else if (cc >= 44 && cc < 48) { kind = 5; vidx = 8 + (cc - 44); }
    else if (cc == 48) kind = 6;
#pragma unroll
    for (int mi = 0; mi < 4; ++mi) {
        const int token = m0w + mi * 16 + l15, pos = token & 4095, bb = token >> 12;
        const float rs = (L > 0) ? row_rstd((const float*)(p.ws + OFF_SSQ), token) : 1.0f;
        float v[4][4];
#pragma unroll
        for (int ni = 0; ni < 4; ++ni)
#pragma unroll
            for (int j = 0; j < 4; ++j) v[ni][j] = acc[mi][CH * 4 + ni][j] * rs;
        if (kind == 6) {
#pragma unroll
            for (int ni = 0; ni < 2; ++ni)
#pragma unroll
                for (int j = 0; j < 4; ++j) { const int d = ni * 16 + quad * 4 + j;
                    if (d < 24) gates[(size_t)token * 32 + d] = 1.0f / (1.0f + __expf(-v[ni][j]));
                    else if (d < 28) gates[(size_t)token * 32 + d] = v[ni][j]; }
            asm volatile("" ::: "memory");
            continue;
        }
        if (kind == 1) {
            float ss = 0.f;
#pragma unroll
            for (int ni = 0; ni < 4; ++ni)
#pragma unroll
                for (int j = 0; j < 4; ++j) ss += v[ni][j] * v[ni][j];
            ss += __shfl_xor(ss, 16); ss += __shfl_xor(ss, 32);
            const float r = rsqrtf(ss * (1.0f / 64.0f) + 1e-6f);
#pragma unroll
            for (int ni = 0; ni < 4; ++ni) { const float4 gg = *(const float4*)(gain + ni * 16 + quad * 4);
                v[ni][0] *= r * gg.x; v[ni][1] *= r * gg.y; v[ni][2] *= r * gg.z; v[ni][3] *= r * gg.w; }
            if (dorope) {
                const float4 cs = *(const float4*)(rope + pos * 16 + (quad & 1) * 4), sn = *(const float4*)(rope + pos * 16 + 8 + (quad & 1) * 4);
                const float cv[4] = {cs.x, cs.y, cs.z, cs.w}, sv[4] = {sn.x, sn.y, sn.z, sn.w};
#pragma unroll
                for (int j = 0; j < 4; ++j) { const float xx = v[0][j], pp = __shfl_xor(xx, 32);
                    v[0][j] = (quad < 2) ? (xx * cv[j] - pp * sv[j]) : (xx * cv[j] + pp * sv[j]); }
            }
#pragma unroll
            for (int ni = 0; ni < 4; ++ni)
#pragma unroll
                for (int j = 0; j < 4; ++j) v[ni][j] *= scale;
        }
        if (kind == 5) {
#pragma unroll
            for (int ni = 0; ni < 4; ++ni)
#pragma unroll
                for (int j = 0; j < 4; ++j) { const int d = ni * 16 + quad * 4 + j;
                    VT[((size_t)(vidx * 8 + bb) * 64 + d) * 4096 + pos] = f2bf(v[ni][j]); }
        } else {
#pragma unroll
            for (int ni = 0; ni < 4; ++ni) { uint2 o; o.x = pk2(v[ni][0], v[ni][1]); o.y = pk2(v[ni][2], v[ni][3]);
                *(uint2*)(proj + (size_t)token * PJ_LD + cc * 64 + ni * 16 + quad * 4) = o; }
        }
        asm volatile("" ::: "memory");
    }
}

DEVI void g_load(uint4 (&RA)[4], uint4 (&RB)[4], const bf16_t* Ap, const bf16_t* Bp, int K, int KT) {
#pragma unroll
    for (int i = 0; i < 4; ++i) { RA[i] = *(const uint4*)(Ap + (size_t)(32 * i) * K + KT * 64); RB[i] = *(const uint4*)(Bp + (size_t)(32 * i) * K + KT * 64); }
}
DEVI void g_swrite(const uint4 (&RA)[4], const uint4 (&RB)[4], char* d_) {
#pragma unroll
    for (int i = 0; i < 4; ++i) { *(uint4*)(d_ + i * 4096) = RA[i]; *(uint4*)(d_ + 16384 + i * 4096) = RB[i]; }
}
DEVI void g_compute(const char* sA, f32x4 (&acc)[4][4], int wm, int wn, int quad, int l15) {
    const char* sB = sA + 16384;
#pragma unroll
    for (int ks = 0; ks < 2; ++ks) {
        bf16x8 af[4], bfr[4]; const int ch = ks * 4 + quad;
#pragma unroll
        for (int mi = 0; mi < 4; ++mi) { const int row = wm * 64 + mi * 16 + l15; af[mi] = *(const bf16x8*)(sA + row * 128 + ((ch ^ (row & 7)) << 4)); }
#pragma unroll
        for (int ni = 0; ni < 4; ++ni) { const int row = wn * 64 + ni * 16 + l15; bfr[ni] = *(const bf16x8*)(sB + row * 128 + ((ch ^ (row & 7)) << 4)); }
#pragma unroll
        for (int mi = 0; mi < 4; ++mi)
#pragma unroll
            for (int ni = 0; ni < 4; ++ni) acc[mi][ni] = mfma(bfr[ni], af[mi], acc[mi][ni]);
    }
}

template <int EPI>
__device__ __forceinline__ void gemm_phase(const Params& p, int L, char* lds) {
    const bf16_t* A; const bf16_t* Bt; int K, nNt;
    if (EPI == EPI_PROJ) { A = (const bf16_t*)(p.ws + OFF_ACT); Bt = (const bf16_t*)(p.ws + OFF_WIN) + (size_t)L * NW_IN_PAD * 1024; K = 1024; nNt = NW_IN_PAD / 256; }
    else if (EPI == EPI_WO) { A = (const bf16_t*)(p.ws + OFF_ACT); Bt = (const bf16_t*)(p.ws + OFF_WO) + (size_t)L * 1024 * 1024; K = 1024; nNt = 4; }
    else if (EPI == EPI_UP) { A = (const bf16_t*)(p.ws + OFF_ACT2); Bt = (const bf16_t*)(p.ws + OFF_WUP) + (size_t)L * 4096 * 1024; K = 1024; nNt = 16; }
    else { A = (const bf16_t*)(p.ws + OFF_BIG); Bt = (const bf16_t*)(p.ws + OFF_WDN) + (size_t)L * 1024 * 4096; K = 4096; nNt = 4; }
    const int tid = otid(), lane = tid & 63, w = tid >> 6, quad = lane >> 4, l15 = lane & 15, wm = w >> 1, wn = w & 1;
    const int xcd = blockIdx.x & 7, loc = blockIdx.x >> 3, nloc = gridDim.x >> 3;
    const int nk = K / 32;
    const int gsw = (0x1230 >> (((l15 >> 2) & 3) * 4)) & 3;
    const int rsw = (quad ^ gsw) << 4;
    for (int it = loc; it < 32 * nNt; it += nloc) {
        const int tl = otid();
        const int lrow = tl >> 2, lc = tl & 3;
        const int woff = lrow * 64 + ((lc ^ ((0x1230 >> (((lrow >> 2) & 3) * 4)) & 3)) << 4);
        const int gsz = 8 * nNt, mloc = (it / gsz) * 8 + (it & 7), nloc_t = (it % gsz) >> 3;
        const int m0 = (xcd + 8 * mloc) * 128, n0 = nloc_t * 256;
        f32x4 acc[4][8];
#pragma unroll
        for (int a = 0; a < 4; ++a)
#pragma unroll
            for (int b = 0; b < 8; ++b) acc[a][b] = (f32x4){0.f, 0.f, 0.f, 0.f};
        u32x8 ra0, ra1; u32x16 rb0, rb1;
        const bf16_t* Ap = A + (size_t)(m0 + lrow) * K + lc * 8;
        const bf16_t* Bp = Bt + (size_t)(n0 + lrow) * K + lc * 8;
#define G_LD1(R, P, I, KT) { const uint4 t_ = *(const uint4*)((P) + (size_t)(64 * I) * K + (KT) * 32); R[4 * I] = t_.x; R[4 * I + 1] = t_.y; R[4 * I + 2] = t_.z; R[4 * I + 3] = t_.w; }
#define G_LOAD(RA, RB, KT) { G_LD1(RA, Ap, 0, KT) G_LD1(RB, Bp, 0, KT) G_LD1(RA, Ap, 1, KT) G_LD1(RB, Bp, 1, KT) G_LD1(RB, Bp, 2, KT) G_LD1(RB, Bp, 3, KT) }
#define G_SW1(R, D, I) *(uint4*)((D) + I * 4096) = make_uint4(R[4 * I], R[4 * I + 1], R[4 * I + 2], R[4 * I + 3]);
#define G_SWRITE(RA, RB, DST) { G_SW1(RA, DST, 0) G_SW1(RB, (DST) + 8192, 0) G_SW1(RA, DST, 1) G_SW1(RB, (DST) + 8192, 1) G_SW1(RB, (DST) + 8192, 2) G_SW1(RB, (DST) + 8192, 3) }
#define G_COMPUTE(BUF) { const char* sA_ = (BUF) + (wm * 64 + l15) * 64 + rsw; const char* sB_ = (BUF) + 8192 + (wn * 128 + l15) * 64 + rsw; \
            bf16x8 af[4]; \
            _Pragma("unroll") for (int i_ = 0; i_ < 4; ++i_) af[i_] = *(const bf16x8*)(sA_ + i_ * 1024); \
            _Pragma("unroll") for (int nh = 0; nh < 2; ++nh) { bf16x8 bfr[4]; \
                _Pragma("unroll") for (int i_ = 0; i_ < 4; ++i_) bfr[i_] = *(const bf16x8*)(sB_ + (nh * 4 + i_) * 1024); \
                _Pragma("unroll") for (int mi = 0; mi < 4; ++mi) _Pragma("unroll") for (int ni = 0; ni < 4; ++ni) acc[mi][nh * 4 + ni] = mfma(bfr[ni], af[mi], acc[mi][nh * 4 + ni]); } }
        G_LOAD(ra0, rb0, 0)
        G_LOAD(ra1, rb1, 1)
        G_SWRITE(ra0, rb0, lds + woff)
        __syncthreads();
#pragma unroll 1
        for (int kt = 0; kt < nk - 2; kt += 2) {
            G_LOAD(ra0, rb0, kt + 2)
            __builtin_amdgcn_sched_barrier(0);
            G_COMPUTE(lds)
            G_SWRITE(ra1, rb1, lds + 24576 + woff)
            __syncthreads();
            G_LOAD(ra1, rb1, kt + 3)
            __builtin_amdgcn_sched_barrier(0);
            G_COMPUTE(lds + 24576)
            G_SWRITE(ra0, rb0, lds + woff)
            __syncthreads();
        }
        G_COMPUTE(lds)
        G_SWRITE(ra1, rb1, lds + 24576 + woff)
        __syncthreads();
        G_COMPUTE(lds + 24576)
        __syncthreads();
#undef G_LOAD
#undef G_SWRITE
#undef G_LD1
#undef G_SW1
#undef G_COMPUTE
        const int te = otid(); const int lane_e = te & 63, quad_e = lane_e >> 4, l15_e = lane_e & 15;
        const int mw = m0 + ((te >> 7) & 1) * 64, nw = n0 + ((te >> 6) & 1) * 128;
        if (EPI == EPI_PROJ) {
            proj_epilogue<0>(p, L, acc, mw, (nw >> 6), lane_e);
            proj_epilogue<1>(p, L, acc, mw, (nw >> 6) + 1, lane_e);
        } else if (EPI == EPI_UP) {
            bf16_t* hid = (bf16_t*)(p.ws + OFF_BIG);
#pragma unroll
            for (int mi = 0; mi < 4; ++mi) { const int m = mw + mi * 16 + l15_e; const float r = row_rstd((const float*)(p.ws + OFF_SSQ), m);
#pragma unroll
                for (int ni = 0; ni < 8; ++ni) { const int n = nw + ni * 16 + quad_e * 4;
                    float a0 = fmaxf(acc[mi][ni][0] * r, 0.f), a1 = fmaxf(acc[mi][ni][1] * r, 0.f), a2 = fmaxf(acc[mi][ni][2] * r, 0.f), a3 = fmaxf(acc[mi][ni][3] * r, 0.f);
                    uint2 o; o.x = pk2(a0 * a0, a1 * a1); o.y = pk2(a2 * a2, a3 * a3);
                    *(uint2*)(hid + (size_t)m * DFF + n) = o; } }
        } else {
            const float* xin = (EPI == EPI_WO && L == 0) ? p.x : p.out;
            const bool emit = (EPI == EPI_WO) || (L + 1 < 2);
            const float* gn = (EPI == EPI_WO) ? (p.norm2_g + L * 1024) : (p.norm1_g + (L + 1 < 2 ? L + 1 : L) * 1024);
            bf16_t* hn = (bf16_t*)(p.ws + ((EPI == EPI_WO) ? OFF_ACT2 : OFF_ACT));
            float* ssq = (float*)(p.ws + OFF_SSQ);
#pragma unroll
            for (int mi = 0; mi < 4; ++mi) {
#pragma unroll
                for (int hf = 0; hf < 2; ++hf) {
                    const int t3 = otid(); const int l15_e = t3 & 15, quad_e = (t3 >> 4) & 3;
                    const int m = mw + mi * 16 + l15_e;
                    float ss = 0.f;
#pragma unroll
                    for (int n4 = 0; n4 < 4; ++n4) { const int ni = hf * 4 + n4; const int n = nw + ni * 16 + quad_e * 4;
                        float4 xv = *(const float4*)(xin + (size_t)m * DM + n);
                        xv.x += acc[mi][ni][0]; xv.y += acc[mi][ni][1]; xv.z += acc[mi][ni][2]; xv.w += acc[mi][ni][3];
                        *(float4*)(p.out + (size_t)m * DM + n) = xv;
                        if (emit) { const float4 gg = *(const float4*)(gn + n);
                            uint2 o; o.x = pk2(xv.x * gg.x, xv.y * gg.y); o.y = pk2(xv.z * gg.z, xv.w * gg.w);
                            *(uint2*)(hn + (size_t)m * DM + n) = o;
                            ss += (xv.x * xv.x + xv.y * xv.y) + (xv.z * xv.z + xv.w * xv.w); } }
                    if (emit) { ss += __shfl_xor(ss, 16); ss += __shfl_xor(ss, 32);
                        if (quad_e == 0) ssq[(size_t)m * 16 + ((nw >> 6) + hf)] = ss; }
                    asm volatile("" ::: "memory");
                }
            }
        }
    }
}

DEVI float hgrn_lb(const Params& p, int L, int hk) {
    if (L == 0) return 0.f;
    const float l0 = p.lb_logits[hk], l1 = p.lb_logits[256 + hk];
    return 1.0f / (1.0f + __expf(l0 - l1));
}

__device__ void hgrn_a_unit(const Params& p, int L, int u, char* lds) {
    const int tid = otid(), lane = tid & 63, w = tid >> 6, quad = lane >> 4, l15 = lane & 15;
    const int c = u & 63, h = (u >> 6) & 3, b = u >> 8;
    const bf16_t* proj = (const bf16_t*)(p.ws + OFF_BIG); const bf16_t* VT = (const bf16_t*)(p.ws + OFF_BIG + OFF_VT_IN_BIG);
    float* segtot = (float*)lds;
    bf16_t* KDt = (bf16_t*)(lds + 1024);
    const int k = tid & 63, seg = tid >> 6;
    const float lb = hgrn_lb(p, L, h * 64 + k);
    float gl[16], kkv[16]; float run = 0.f;
    const bf16_t* zp = proj + (size_t)(b * 4096 + c * 64 + seg * 16) * PJ_LD + 256 + h * 64 + k;
#pragma unroll
    for (int i = 0; i < 16; ++i) {
        const float z = bf2f(zp[(size_t)i * PJ_LD]);
        const float sg = 1.0f / (1.0f + __expf(-z)), sn = 1.0f / (1.0f + __expf(z));
        const float f = lb + (1.0f - lb) * sg;
        run += __logf(fmaxf(f, 1e-30f)); gl[i] = run; kkv[i] = (1.0f - lb) * sn;
    }
    segtot[seg * 64 + k] = run;
    __syncthreads();
    float off = 0.f, tot = 0.f;
#pragma unroll
    for (int s = 0; s < 4; ++s) { const float t = segtot[s * 64 + k]; tot += t; if (s < seg) off += t; }
    unsigned pkd[8];
#pragma unroll
    for (int i = 0; i < 8; ++i) {
        const float a0 = kkv[2 * i] * __expf(tot - (off + gl[2 * i])), a1 = kkv[2 * i + 1] * __expf(tot - (off + gl[2 * i + 1]));
        pkd[i] = pk2(a0, a1);
    }
    *(uint4*)(KDt + k * 72 + seg * 16) = make_uint4(pkd[0], pkd[1], pkd[2], pkd[3]);
    *(uint4*)(KDt + k * 72 + seg * 16 + 8) = make_uint4(pkd[4], pkd[5], pkd[6], pkd[7]);
    if (seg == 0) ((float*)(p.ws + OFF_DECAY))[u * 64 + k] = __expf(tot);
    __syncthreads();
    const bf16_t* vt = VT + ((size_t)(h * 8 + b) * 64) * 4096 + c * 64;
    float* kvt = (float*)(p.ws + OFF_KVT) + (size_t)u * 4096;
    bf16x8 af[2];
#pragma unroll
    for (int ks = 0; ks < 2; ++ks) af[ks] = ld8(vt + (size_t)(w * 16 + l15) * 4096 + ks * 32 + quad * 8);
#pragma unroll
    for (int kt = 0; kt < 4; ++kt) {
        f32x4 acc = (f32x4){0.f, 0.f, 0.f, 0.f};
#pragma unroll
        for (int ks = 0; ks < 2; ++ks) { const bf16x8 bfr = *(const bf16x8*)(KDt + (kt * 16 + l15) * 72 + ks * 32 + quad * 8); acc = mfma(af[ks], bfr, acc); }
#pragma unroll
        for (int j = 0; j < 4; ++j) kvt[(w * 16 + quad * 4 + j) * 64 + kt * 16 + l15] = acc[j];
    }
    __syncthreads();
}

__device__ void hgrn_scan_phase(const Params& p) {
    const float* kvt = (const float*)(p.ws + OFF_KVT); const float* dec = (const float*)(p.ws + OFF_DECAY);
    bf16_t* st = (bf16_t*)(p.ws + OFF_ST);
    for (int e = blockIdx.x * 256 + otid(); e < 32 * 4096; e += gridDim.x * 256) {
        const int bh = e >> 12, vk = e & 4095, k = vk & 63;
        float S = 0.f;
#pragma unroll 8
        for (int c = 0; c < 64; ++c) {
            const int u = bh * 64 + c;
            st[(size_t)u * 4096 + vk] = f2bf(S);
            S = S * dec[u * 64 + k] + kvt[(size_t)u * 4096 + vk];
        }
    }
}

__device__ void hgrn_c_unit(const Params& p, int L, int u, char* lds) {
    const int tid = otid(), lane = tid & 63, w = tid >> 6, quad = lane >> 4, l15 = lane & 15;
    const int c = u & 63, h = (u >> 6) & 3, b = u >> 8;
    const bf16_t* proj = (const bf16_t*)(p.ws + OFF_BIG); const bf16_t* VT = (const bf16_t*)(p.ws + OFF_BIG + OFF_VT_IN_BIG);
    float* Gs = (float*)lds; float* KKs = Gs + 64 * 65; float* Qs = KKs + 64 * 65; float* segtot = Qs + 64 * 65;
    {
        const int k = tid & 63, seg = tid >> 6;
        const float lb = hgrn_lb(p, L, h * 64 + k);
        float gl[16], kkv[16]; float run = 0.f;
        const bf16_t* zp = proj + (size_t)(b * 4096 + c * 64 + seg * 16) * PJ_LD + 256 + h * 64 + k;
#pragma unroll
        for (int i = 0; i < 16; ++i) {
            const float z = bf2f(zp[(size_t)i * PJ_LD]);
            const float sg = 1.0f / (1.0f + __expf(-z)), sn = 1.0f / (1.0f + __expf(z));
            const float f = lb + (1.0f - lb) * sg;
            run += __logf(fmaxf(f, 1e-30f)); gl[i] = run; kkv[i] = (1.0f - lb) * sn;
            Qs[(seg * 16 + i) * 65 + k] = bf2f(zp[(size_t)i * PJ_LD - 256]) * 0.125f;
        }
        segtot[seg * 64 + k] = run;
        __syncthreads();
        float off = 0.f;
#pragma unroll
        for (int s = 0; s < 4; ++s) { const float t = segtot[s * 64 + k]; if (s < seg) off += t; }
#pragma unroll
        for (int i = 0; i < 16; ++i) { Gs[(seg * 16 + i) * 65 + k] = off + gl[i]; KKs[(seg * 16 + i) * 65 + k] = kkv[i]; }
        __syncthreads();
    }
    const int I = w;
    const int tq = 16 * I + l15;
    bf16x8 qt[2], qg[2];
#pragma unroll
    for (int ks = 0; ks < 2; ++ks) {
        float a[8], g8[8];
#pragma unroll
        for (int j = 0; j < 8; ++j) {
            const int k = ks * 32 + quad * 8 + j;
            const float G = Gs[tq * 65 + k], q = Qs[tq * 65 + k];
            const float gref = (I == 0) ? 0.f : Gs[(16 * I - 1) * 65 + k];
            a[j] = q * __expf(G - gref); g8[j] = q * __expf(G);
        }
        qt[ks] = mk8(pk2(a[0], a[1]), pk2(a[2], a[3]), pk2(a[4], a[5]), pk2(a[6], a[7]));
        qg[ks] = mk8(pk2(g8[0], g8[1]), pk2(g8[2], g8[3]), pk2(g8[4], g8[5]), pk2(g8[6], g8[7]));
    }
    f32x4 O[4];
#pragma unroll
    for (int vt = 0; vt < 4; ++vt) O[vt] = (f32x4){0.f, 0.f, 0.f, 0.f};
    const bf16_t* st = (const bf16_t*)(p.ws + OFF_ST) + (size_t)u * 4096;
#pragma unroll
    for (int vt = 0; vt < 4; ++vt)
#pragma unroll
        for (int ks = 0; ks < 2; ++ks) O[vt] = mfma(ld8(st + (vt * 16 + l15) * 64 + ks * 32 + quad * 8), qg[ks], O[vt]);
    const bf16_t* vtp = VT + ((size_t)(h * 8 + b) * 64) * 4096 + c * 64;
    for (int Jp = 0; Jp <= (I >> 1); ++Jp) {
        f32x4 sc[2];
#pragma unroll
        for (int jj = 0; jj < 2; ++jj) {
            const int J = 2 * Jp + jj;
            sc[jj] = (f32x4){0.f, 0.f, 0.f, 0.f};
            if (J <= I) {
                const int s = 16 * J + l15;
#pragma unroll
                for (int ks = 0; ks < 2; ++ks) {
                    float a[8];
#pragma unroll
                    for (int j = 0; j < 8; ++j) {
                        const int k = ks * 32 + quad * 8 + j;
                        const float gref = (I == 0) ? 0.f : Gs[(16 * I - 1) * 65 + k];
                        a[j] = KKs[s * 65 + k] * __expf(gref - Gs[s * 65 + k]);
                    }
                    sc[jj] = mfma(mk8(pk2(a[0], a[1]), pk2(a[2], a[3]), pk2(a[4], a[5]), pk2(a[6], a[7])), qt[ks], sc[jj]);
                }
#pragma unroll
                for (int j = 0; j < 4; ++j) { const int s2 = 16 * J + quad * 4 + j; if (s2 > tq) sc[jj][j] = 0.f; }
            }
        }
        const bf16x8 P = mk8(pk2(sc[0][0], sc[0][1]), pk2(sc[0][2], sc[0][3]), pk2(sc[1][0], sc[1][1]), pk2(sc[1][2], sc[1][3]));
#pragma unroll
        for (int vt = 0; vt < 4; ++vt) {
            const bf16_t* r = vtp + (size_t)(vt * 16 + l15) * 4096 + 32 * Jp + quad * 4;
            O[vt] = mfma(ld4x2(r, r + 16), P, O[vt]);
        }
    }
    float ss = 0.f;
#pragma unroll
    for (int vt = 0; vt < 4; ++vt)
#pragma unroll
        for (int j = 0; j < 4; ++j) ss += O[vt][j] * O[vt][j];
    ss += __shfl_xor(ss, 16); ss += __shfl_xor(ss, 32);
    const float r = rsqrtf(ss * (1.0f / 64.0f) + 1e-6f);
    const size_t token = (size_t)b * 4096 + c * 64 + tq;
    bf16_t* mix = (bf16_t*)(p.ws + OFF_ACT);
#pragma unroll
    for (int vt = 0; vt < 4; ++vt) {
        const int v0 = vt * 16 + quad * 4;
        const float4 og = *(const float4*)(p.onorm_g + L * 64 + v0);
        const uint2 gz = *(const uint2*)(proj + token * PJ_LD + 768 + h * 64 + v0);
        const float g0 = bflo(gz.x), g1 = bfhi(gz.x), g2 = bflo(gz.y), g3 = bfhi(gz.y);
        const float o0 = O[vt][0] * r * og.x * (g0 / (1.0f + __expf(-g0))), o1 = O[vt][1] * r * og.y * (g1 / (1.0f + __expf(-g1)));
        const float o2 = O[vt][2] * r * og.z * (g2 / (1.0f + __expf(-g2))), o3 = O[vt][3] * r * og.w * (g3 / (1.0f + __expf(-g3)));
        uint2 o; o.x = pk2(o0, o1); o.y = pk2(o2, o3);
        *(uint2*)(mix + token * DM + h * 64 + v0) = o;
    }
    __syncthreads();
}

__device__ void compress_unit(const Params& p, int L, int u, char* lds) {
    const int tid = otid(), lane = tid & 63, w = tid >> 6, quad = lane >> 4, l15 = lane & 15;
    const int which = u & 1, g = (u >> 1) & 1, b = (u >> 2) & 7, ntile = u >> 5;
    const bf16_t* proj = (const bf16_t*)(p.ws + OFF_BIG);
    const bf16_t* w1t = (const bf16_t*)(p.ws + OFF_W1T) + (size_t)(L * 2 + which) * 128 * 2048;
    const bf16_t* w2t = (const bf16_t*)(p.ws + OFF_W2T) + (size_t)(L * 2 + which) * 64 * 128;
    const float* cbias = (const float*)(p.ws + OFF_CBIAS) + (L * 2 + which) * 128;
    bf16_t* Hs = (bf16_t*)lds + w * 16 * 136;
    const int nrow = ntile * 64 + w * 16 + l15;
    int tokbase = 16 * nrow; if (tokbase > 4096 - 32) tokbase = 4096 - 32;
    const bf16_t* xa = proj + ((size_t)b * 4096 + tokbase) * PJ_LD + (which ? 1664 : 1536) + g * 64;
    f32x4 acc[8];
#pragma unroll
    for (int i = 0; i < 8; ++i) acc[i] = (f32x4){0.f, 0.f, 0.f, 0.f};
#pragma unroll 2
    for (int kk = 0; kk < 64; ++kk) {
        const int l = kk >> 1, d = (kk & 1) * 32 + quad * 8;
        const bf16x8 a = ld8(xa + (size_t)l * PJ_LD + d);
#pragma unroll
        for (int ni = 0; ni < 8; ++ni) acc[ni] = mfma(a, ld8(w1t + (size_t)(ni * 16 + l15) * 2048 + kk * 32 + quad * 8), acc[ni]);
    }
#pragma unroll
    for (int ni = 0; ni < 8; ++ni) { const float bsv = cbias[ni * 16 + l15];
#pragma unroll
        for (int j = 0; j < 4; ++j) { const float x = acc[ni][j] + bsv;
            const float uu = 0.7978845608028654f * (x + 0.044715f * x * x * x);
            const float th = 1.0f - 2.0f / (1.0f + __expf(2.0f * uu));
            Hs[(quad * 4 + j) * 136 + ni * 16 + l15] = f2bf(0.5f * x * (1.0f + th)); } }
    __syncthreads();
    f32x4 o[4];
#pragma unroll
    for (int i = 0; i < 4; ++i) o[i] = (f32x4){0.f, 0.f, 0.f, 0.f};
#pragma unroll
    for (int ks = 0; ks < 4; ++ks) { const bf16x8 a = *(const bf16x8*)(Hs + l15 * 136 + ks * 32 + quad * 8);
#pragma unroll
        for (int ni = 0; ni < 4; ++ni) o[ni] = mfma(a, ld8(w2t + (size_t)(ni * 16 + l15) * 128 + ks * 32 + quad * 8), o[ni]); }
    const int nb = ntile * 64 + w * 16 + quad * 4;
    if (which == 0) {
        bf16_t* kc = (bf16_t*)(p.ws + OFF_KC) + (size_t)(b * 2 + g) * 256 * 64;
        const float* rope = (const float*)(p.ws + OFF_ROPE);
#pragma unroll
        for (int j = 0; j < 4; ++j) {
            const int n = nb + j;
            float ss = o[0][j] * o[0][j] + o[1][j] * o[1][j] + o[2][j] * o[2][j] + o[3][j] * o[3][j];
            ss += __shfl_xor(ss, 1); ss += __shfl_xor(ss, 2); ss += __shfl_xor(ss, 4); ss += __shfl_xor(ss, 8);
            const float r = rsqrtf(ss * (1.0f / 64.0f) + 1e-6f);
            float v[4];
#pragma unroll
            for (int ni = 0; ni < 4; ++ni) v[ni] = o[ni][j] * r * p.nsa_kn_g[L * 64 + ni * 16 + l15];
            int pos = 16 * n + 31; if (pos > 4095) pos = 4095;
            const float cs = rope[pos * 16 + (l15 & 7)], sn = rope[pos * 16 + 8 + (l15 & 7)];
            const float pp = __shfl_xor(v[0], 8);
            v[0] = (l15 < 8) ? (v[0] * cs - pp * sn) : (v[0] * cs + pp * sn);
#pragma unroll
            for (int ni = 0; ni < 4; ++ni) kc[(size_t)n * 64 + ni * 16 + l15] = (n < 255) ? f2bf(v[ni]) : (bf16_t)0;
        }
    } else {
        bf16_t* vct = (bf16_t*)(p.ws + OFF_VCT) + (size_t)(b * 2 + g) * 64 * 256;
#pragma unroll
        for (int ni = 0; ni < 4; ++ni) {
            float v0 = o[ni][0], v1 = o[ni][1], v2 = o[ni][2], v3 = o[ni][3];
            if (nb + 3 >= 255) v3 = 0.f;
            uint2 ov; ov.x = pk2(v0, v1); ov.y = pk2(v2, v3);
            *(uint2*)(vct + (size_t)(ni * 16 + l15) * 256 + nb) = ov;
        }
    }
    __syncthreads();
}

__device__ void foxc_job(const Params& p, int L, int bh, char* lds) {
    const int tid = otid(), lane = tid & 63, w = tid >> 6, b = bh >> 2, h = bh & 3;
    const float* gates = (const float*)(p.ws + OFF_GATES);
    float* cc = (float*)(p.ws + OFF_FOXC) + (size_t)bh * 4096;
    float* wtot = (float*)lds;
    const float fb = p.fox_fb[L * 4 + h];
    float v[16];
#pragma unroll
    for (int i = 0; i < 16; ++i) v[i] = gates[((size_t)b * 4096 + tid * 16 + i) * 32 + 24 + h] + fb;
    float run = 0.f;
#pragma unroll
    for (int i = 0; i < 16; ++i) { const float x = v[i]; run += (x >= 0.f) ? -log1pf(__expf(-x)) : (x - log1pf(__expf(x))); v[i] = run; }
    float incl = run;
#pragma unroll
    for (int o = 1; o < 64; o <<= 1) { const float t = __shfl_up(incl, o); if (lane >= o) incl += t; }
    if (lane == 63) wtot[w] = incl;
    __syncthreads();
    float pre = incl - run;
#pragma unroll
    for (int s = 0; s < 4; ++s) if (s < w) pre += wtot[s];
#pragma unroll
    for (int i = 0; i < 4; ++i) *(float4*)(cc + tid * 16 + i * 4) = make_float4(pre + v[4 * i], pre + v[4 * i + 1], pre + v[4 * i + 2], pre + v[4 * i + 3]);
    __syncthreads();
}

constexpr int KV_BUF = 16384;
DEVI void tile_glds(const bf16_t* Kg, int ldk, const bf16_t* Vg, int ldv, char* buf, int tid) {
    const int w = tid >> 6, i = tid & 63;
#pragma unroll
    for (int jj = 0; jj < 2; ++jj) {
        const int j = w * 2 + jj, row = 8 * j + (i >> 3), slot = i & 7;
        const bf16_t* kp = Kg + (size_t)row * ldk + ((slot ^ (row & 7)) << 3);
        const bf16_t* vp = Vg + (size_t)row * ldv + ((slot ^ ((row >> 1) & 7)) << 3);
        __builtin_amdgcn_global_load_lds((const unsigned*)kp, (ldsp_t)(unsigned)(size_t)(buf + j * 1024), 16, 0, 0);
        __builtin_amdgcn_global_load_lds((const unsigned*)vp, (ldsp_t)(unsigned)(size_t)(buf + 8192 + j * 1024), 16, 0, 0);
    }
}
DEVI void lds_kf(const char* buf, int kh, int lane, bf16x8 (&kf)[2][2]) {
    const int quad = lane >> 4, l15 = lane & 15;
#pragma unroll
    for (int t2 = 0; t2 < 2; ++t2)
#pragma unroll
        for (int ks = 0; ks < 2; ++ks) { const int row = kh * 32 + t2 * 16 + l15, ch = ks * 4 + quad; kf[t2][ks] = *(const bf16x8*)(buf + row * 128 + ((ch ^ (row & 7)) << 4)); }
}
DEVI void lds_vf(const char* buf, int kh, int lane, bf16x8 (&vf)[4]) {
    const int quad = lane >> 4, l15 = lane & 15;
#pragma unroll
    for (int dt = 0; dt < 4; ++dt) { const int d = dt * 16 + l15, u0 = kh * 8 + quad, u1 = u0 + 4;
        const uint2 a = *(const uint2*)(buf + 8192 + d * 128 + ((u0 ^ (d & 14)) << 3)), b = *(const uint2*)(buf + 8192 + d * 128 + ((u1 ^ (d & 14)) << 3));
        vf[dt] = mk8(a.x, a.y, b.x, b.y); }
}

template <class MaskF>
DEVI void attn_block64(const char* buf, int kbase, const char* ql, int q0o, int q1o, int qstride, const float* cb, f32x4 (&O)[4][4], float (&m)[4], float (&l)[4], int lane, MaskF maskf) {
    const int quad = lane >> 4;
#pragma unroll
    for (int kh = 0; kh < 2; ++kh) {
        bf16x8 kf[2][2], vf[4];
        lds_kf(buf, kh, lane, kf); lds_vf(buf, kh, lane, vf);
        float ck[8] = {0.f, 0.f, 0.f, 0.f, 0.f, 0.f, 0.f, 0.f};
        if (cb) { const float4 c0 = *(const float4*)(cb + kbase + kh * 32 + quad * 4), c1 = *(const float4*)(cb + kbase + kh * 32 + 16 + quad * 4);
            ck[0] = c0.x; ck[1] = c0.y; ck[2] = c0.z; ck[3] = c0.w; ck[4] = c1.x; ck[5] = c1.y; ck[6] = c1.z; ck[7] = c1.w; }
#pragma unroll
        for (int nt = 0; nt < 4; ++nt) {
            f32x4 s0 = (f32x4){0.f, 0.f, 0.f, 0.f}, s1 = s0;
            { const bf16x8 qa = *(const bf16x8*)(ql + nt * qstride + q0o), qb_ = *(const bf16x8*)(ql + nt * qstride + q1o);
              s0 = mfma(kf[0][0], qa, s0); s1 = mfma(kf[1][0], qa, s1); s0 = mfma(kf[0][1], qb_, s0); s1 = mfma(kf[1][1], qb_, s1); }
            float sv[8]; bool ok[8]; float mx = -1e30f;
#pragma unroll
            for (int e = 0; e < 8; ++e) { sv[e] = (e < 4) ? s0[e & 3] : s1[e & 3]; const int key = kbase + kh * 32 + (e >> 2) * 16 + quad * 4 + (e & 3);
                ok[e] = maskf(nt, ck[e], key, sv[e]); if (ok[e]) mx = fmaxf(mx, sv[e]); }
            mx = fmaxf(mx, __shfl_xor(mx, 16)); mx = fmaxf(mx, __shfl_xor(mx, 32));
            const float mn = fmaxf(m[nt], mx), alpha = __expf(m[nt] - mn);
            float pv[8]; float rs = 0.f;
#pragma unroll
            for (int e = 0; e < 8; ++e) { pv[e] = ok[e] ? __expf(sv[e] - mn) : 0.f; rs += pv[e]; }
            rs += __shfl_xor(rs, 16); rs += __shfl_xor(rs, 32);
            l[nt] = l[nt] * alpha + rs; m[nt] = mn;
            const bf16x8 P = mk8(pk2(pv[0], pv[1]), pk2(pv[2], pv[3]), pk2(pv[4], pv[5]), pk2(pv[6], pv[7]));
#pragma unroll
            for (int dt = 0; dt < 4; ++dt) { O[dt][nt] = O[dt][nt] * alpha; O[dt][nt] = mfma(vf[dt], P, O[dt][nt]); }
        }
    }
}

template <class MaskF>
DEVI void attn_stream(u64 tiles, const bf16_t* Kbase, int ldk, const bf16_t* Vbase, int ldv, char* kvbuf, int jb_wave_min, int jb_wave_max,
                      const char* ql, int q0o, int q1o, int qstride, const float* cb, f32x4 (&O)[4][4], float (&m)[4], float (&l)[4], int tid, int lane, MaskF maskf) {
    if (tiles == 0ull) return;
    int jb = __ffsll((long long)tiles) - 1; tiles &= tiles - 1;
    tile_glds(Kbase + (size_t)jb * 64 * ldk, ldk, Vbase + jb * 64, ldv, kvbuf, tid);
    __syncthreads();
    int cur = 0;
#pragma unroll 1
    for (;;) {
        const bool more = tiles != 0ull;
        int jbn = 0;
        if (more) { jbn = __ffsll((long long)tiles) - 1; tiles &= tiles - 1; tile_glds(Kbase + (size_t)jbn * 64 * ldk, ldk, Vbase + jbn * 64, ldv, kvbuf + (cur ^ 1) * KV_BUF, tid); }
        if (jb >= jb_wave_min && jb <= jb_wave_max) attn_block64(kvbuf + cur * KV_BUF, jb * 64, ql, q0o, q1o, qstride, cb, O, m, l, lane, [&](int nt, float ckv, int key, float& s) { return maskf(nt, ckv, key, jb, s); });
        __syncthreads();
        if (!more) break;
        jb = jbn; cur ^= 1;
    }
}

DEVI void attn_store2(bf16_t* mix, size_t token0, int tokstride, int col0, int colstride, const f32x4 (&O)[4][4], const float (&sc)[4], int lane, bool accum) {
    const int quad = lane >> 4, l15 = lane & 15;
#pragma unroll
    for (int nt = 0; nt < 4; ++nt)
#pragma unroll
        for (int dt = 0; dt < 4; ++dt) {
            bf16_t* dst = mix + (token0 + nt * tokstride + l15) * DM + col0 + nt * colstride + dt * 16 + quad * 4;
            float a0 = O[dt][nt][0] * sc[nt], a1 = O[dt][nt][1] * sc[nt], a2 = O[dt][nt][2] * sc[nt], a3 = O[dt][nt][3] * sc[nt];
            if (accum) { const uint2 old = *(const uint2*)dst; a0 += bflo(old.x); a1 += bfhi(old.x); a2 += bflo(old.y); a3 += bfhi(old.y); }
            uint2 o; o.x = pk2(a0, a1); o.y = pk2(a2, a3);
            *(uint2*)dst = o;
        }
}

__device__ void nsa_unit(const Params& p, int L, int b, int g, int blk, char* lds) {
    const int tid = otid(), lane = tid & 63, w = tid >> 6, quad = lane >> 4, l15 = lane & 15;
    const bf16_t* proj = (const bf16_t*)(p.ws + OFF_BIG); const bf16_t* VT = (const bf16_t*)(p.ws + OFF_BIG + OFF_VT_IN_BIG);
    const float* gates = (const float*)(p.ws + OFF_GATES);
    bf16_t* mix = (bf16_t*)(p.ws + OFF_ACT);
    char* kvbuf = lds; float* impL = (float*)(lds + KV_BUF)  ; char* Qs = lds + 32768; u64* selm = (u64*)(lds + 65536);
    const int q0 = blk * 64; const int tq = q0 + w * 16 + l15; const size_t token = (size_t)b * 4096 + tq;
    const size_t token0 = (size_t)b * 4096 + q0 + w * 16;
    const int mixcol = 256 + g * 256;
#pragma unroll
    for (int t = 0; t < 8; ++t) { const int idx = t * 64 + lane, rr = idx >> 3, c = idx & 7, hh = rr >> 4, r16 = rr & 15;
        const uint4 v = *(const uint4*)(proj + (token0 + r16) * PJ_LD + 1024 + (g * 4 + hh) * 64 + c * 8);
        *(uint4*)(Qs + (hh * 64 + w * 16 + r16) * 128 + ((c ^ (r16 & 7)) << 4)) = v; }
    const char* ql = Qs + (w * 16 + l15) * 128; const int q0o = ((quad) ^ (l15 & 7)) << 4, q1o = ((4 + quad) ^ (l15 & 7)) << 4; const int qstride = 8192;
    __syncthreads();
    f32x4 O[4][4]; float m[4], l[4];
    const bf16_t* Kc = (const bf16_t*)(p.ws + OFF_KC) + (size_t)(b * 2 + g) * 256 * 64;
    const bf16_t* VcT = (const bf16_t*)(p.ws + OFF_VCT) + (size_t)(b * 2 + g) * 64 * 256;
    const int ncb = (4 * blk + 3 + 63) >> 6;
#pragma unroll
    for (int nt = 0; nt < 4; ++nt) { m[nt] = -1e30f; l[nt] = 0.f; }
    {
#pragma unroll 1
        for (int pass = 0; pass < 2; ++pass) {
            float inv[4]; float prevr = 0.f;
            if (pass == 1) {
#pragma unroll
                for (int nt = 0; nt < 4; ++nt) inv[nt] = 1.0f / fmaxf(l[nt], 1e-30f);
#pragma unroll
                for (int dt = 0; dt < 4; ++dt)
#pragma unroll
                    for (int nt = 0; nt < 4; ++nt) O[dt][nt] = (f32x4){0.f, 0.f, 0.f, 0.f};
            }
#pragma unroll 1
            for (int ct = 0; ct < ncb; ++ct) {
                tile_glds(Kc + (size_t)ct * 64 * 64, 64, VcT + ct * 64, 256, kvbuf, tid);
                __syncthreads();
                const char* buf = kvbuf;
#pragma unroll
                for (int kh = 0; kh < 2; ++kh) {
                    bf16x8 kf[2][2]; lds_kf(buf, kh, lane, kf);
                    if (pass == 0) {
#pragma unroll
                        for (int nt = 0; nt < 4; ++nt) {
                            f32x4 s0 = (f32x4){0.f, 0.f, 0.f, 0.f}, s1 = s0;
                            { const bf16x8 qa = *(const bf16x8*)(ql + nt * qstride + q0o), qb_ = *(const bf16x8*)(ql + nt * qstride + q1o);
                              s0 = mfma(kf[0][0], qa, s0); s1 = mfma(kf[1][0], qa, s1); s0 = mfma(kf[0][1], qb_, s0); s1 = mfma(kf[1][1], qb_, s1); }
                            float sv[8]; bool ok[8]; float mx = -1e30f;
#pragma unroll
                            for (int e = 0; e < 8; ++e) { sv[e] = (e < 4) ? s0[e & 3] : s1[e & 3]; const int n = ct * 64 + kh * 32 + (e >> 2) * 16 + quad * 4 + (e & 3);
                                ok[e] = (16 * n + 31 <= tq); if (ok[e]) mx = fmaxf(mx, sv[e]); }
                            mx = fmaxf(mx, __shfl_xor(mx, 16)); mx = fmaxf(mx, __shfl_xor(mx, 32));
                            const float mn = fmaxf(m[nt], mx), alpha = __expf(m[nt] - mn);
                            float rs = 0.f;
#pragma unroll
                            for (int e = 0; e < 8; ++e) rs += ok[e] ? __expf(sv[e] - mn) : 0.f;
                            rs += __shfl_xor(rs, 16); rs += __shfl_xor(rs, 32);
                            l[nt] = l[nt] * alpha + rs; m[nt] = mn;
                        }
                    } else {
                        bf16x8 vf[4]; lds_vf(buf, kh, lane, vf);
                        float As[2] = {0.f, 0.f}, p3[2] = {0.f, 0.f};
#pragma unroll
                        for (int nt = 0; nt < 4; ++nt) {
                            f32x4 s0 = (f32x4){0.f, 0.f, 0.f, 0.f}, s1 = s0;
                            { const bf16x8 qa = *(const bf16x8*)(ql + nt * qstride + q0o), qb_ = *(const bf16x8*)(ql + nt * qstride + q1o);
                              s0 = mfma(kf[0][0], qa, s0); s1 = mfma(kf[1][0], qa, s1); s0 = mfma(kf[0][1], qb_, s0); s1 = mfma(kf[1][1], qb_, s1); }
                            float pv[8];
#pragma unroll
                            for (int e = 0; e < 8; ++e) { const float s = (e < 4) ? s0[e & 3] : s1[e & 3]; const int n = ct * 64 + kh * 32 + (e >> 2) * 16 + quad * 4 + (e & 3);
                                pv[e] = (16 * n + 31 <= tq) ? __expf(s - m[nt]) * inv[nt] : 0.f; }
                            As[0] += (pv[0] + pv[1]) + (pv[2] + pv[3]); As[1] += (pv[4] + pv[5]) + (pv[6] + pv[7]); p3[0] += pv[3]; p3[1] += pv[7];
                            const bf16x8 P = mk8(pk2(pv[0], pv[1]), pk2(pv[2], pv[3]), pk2(pv[4], pv[5]), pk2(pv[6], pv[7]));
#pragma unroll
                            for (int dt = 0; dt < 4; ++dt) O[dt][nt] = mfma(vf[dt], P, O[dt][nt]);
                        }
                        const int qq = w * 16 + l15;
#pragma unroll
                        for (int t2 = 0; t2 < 2; ++t2) {
                            const float rr = __shfl(p3[t2], (lane + 48) & 63);
                            const float carry = (quad == 0) ? prevr : rr; prevr = rr;
                            const int jb = ct * 16 + kh * 8 + t2 * 4 + quad;
                            impL[jb * 64 + ((qq ^ jb) & 63)] = As[t2] + carry;
                        }
                    }
                }
                __syncthreads();
            }
        }
    }
    {
        const float4 gv = *(const float4*)(gates + token * 32 + 0 * 8 + g * 4);
        const float sc[4] = {gv.x, gv.y, gv.z, gv.w};
        attn_store2(mix, token0, 0, mixcol, 64, O, sc, lane, false);
    }
#pragma unroll 1
    for (int qi = 0; qi < 16; ++qi) {
        const int q = w * 16 + qi, jb = lane;
        float val = impL[jb * 64 + ((q ^ jb) & 63)];
        if (jb > blk) val = -1e30f;
        else if (jb == 0 || jb == blk || jb == blk - 1) val = 1e30f;
        int rank = 0;
        for (int jp = 0; jp < 64; ++jp) { const float vj = __shfl(val, jp); rank += ((vj > val) || (vj == val && jp < jb)) ? 1 : 0; }
        const bool sel = (rank < 16) && (val > -5e29f);
        const u64 mask = __ballot(sel);
        if (lane == 0) selm[q] = mask;
    }
    __syncthreads();
    u64 uni = 0;
    for (int q = 0; q < 64; ++q) uni |= selm[q];
    const u64 sm = selm[w * 16 + l15];
    {
#pragma unroll
        for (int nt = 0; nt < 4; ++nt) { m[nt] = -1e30f; l[nt] = 0.f; }
#pragma unroll
        for (int dt = 0; dt < 4; ++dt)
#pragma unroll
            for (int nt = 0; nt < 4; ++nt) O[dt][nt] = (f32x4){0.f, 0.f, 0.f, 0.f};
        const u64 tiles = uni & ((blk == 63) ? ~0ull : ((2ull << blk) - 1ull));
        attn_stream(tiles, proj + (size_t)b * 4096 * PJ_LD + 1792 + g * 64, PJ_LD, VT + ((size_t)((4 + g) * 8 + b) * 64) * 4096, 4096, kvbuf, 0, 63, ql, q0o, q1o, qstride, nullptr, O, m, l, tid, lane,
                    [&](int nt, float ckv, int key, int jb, float& s) { return (((sm >> jb) & 1ull) != 0) && (key <= tq); });
        const float4 gv = *(const float4*)(gates + token * 32 + 1 * 8 + g * 4);
        const float sc[4] = {gv.x / fmaxf(l[0], 1e-30f), gv.y / fmaxf(l[1], 1e-30f), gv.z / fmaxf(l[2], 1e-30f), gv.w / fmaxf(l[3], 1e-30f)};
        attn_store2(mix, token0, 0, mixcol, 64, O, sc, lane, true);
    }
    {
#pragma unroll
        for (int nt = 0; nt < 4; ++nt) { m[nt] = -1e30f; l[nt] = 0.f; }
#pragma unroll
        for (int dt = 0; dt < 4; ++dt)
#pragma unroll
            for (int nt = 0; nt < 4; ++nt) O[dt][nt] = (f32x4){0.f, 0.f, 0.f, 0.f};
        const int jlo = blk > 8 ? blk - 8 : 0;
        const u64 upto = (blk == 63) ? ~0ull : ((2ull << blk) - 1ull);
        const u64 tiles = upto & ~((1ull << jlo) - 1ull);
        attn_stream(tiles, proj + (size_t)b * 4096 * PJ_LD + 2048 + g * 64, PJ_LD, VT + ((size_t)((6 + g) * 8 + b) * 64) * 4096, 4096, kvbuf, 0, 63, ql, q0o, q1o, qstride, nullptr, O, m, l, tid, lane,
                    [&](int nt, float ckv, int key, int jb, float& s) { return (key <= tq) && (key + 512 > tq); });
        const float4 gv = *(const float4*)(gates + token * 32 + 2 * 8 + g * 4);
        const float sc[4] = {gv.x / fmaxf(l[0], 1e-30f), gv.y / fmaxf(l[1], 1e-30f), gv.z / fmaxf(l[2], 1e-30f), gv.w / fmaxf(l[3], 1e-30f)};
        attn_store2(mix, token0, 0, mixcol, 64, O, sc, lane, true);
    }
    __syncthreads();
}

__device__ void fox_unit(const Params& p, int L, int b, int h, int qb, char* lds) {
    const int tid = otid(), lane = tid & 63, w = tid >> 6, quad = lane >> 4, l15 = lane & 15;
    const bf16_t* proj = (const bf16_t*)(p.ws + OFF_BIG); const bf16_t* VT = (const bf16_t*)(p.ws + OFF_BIG + OFF_VT_IN_BIG);
    bf16_t* mix = (bf16_t*)(p.ws + OFF_ACT);
    const float* cc = (const float*)(p.ws + OFF_FOXC) + (size_t)(b * 4 + h) * 4096;
    const int q0 = qb * 256 + w * 64; const size_t token0 = (size_t)b * 4096 + q0;
    int tq[4]; float cq[4];
#pragma unroll
    for (int nt = 0; nt < 4; ++nt) { tq[nt] = q0 + nt * 16 + l15; cq[nt] = cc[tq[nt]]; }
    char* Qs = lds + 32768;
#pragma unroll
    for (int t = 0; t < 8; ++t) { const int idx = t * 64 + lane, rr = idx >> 3, c = idx & 7;
        const uint4 v = *(const uint4*)(proj + (token0 + rr) * PJ_LD + 2304 + h * 64 + c * 8);
        *(uint4*)(Qs + (w * 64 + rr) * 128 + ((c ^ (rr & 7)) << 4)) = v; }
    const char* ql = Qs + (w * 64 + l15) * 128; const int q0o = ((quad) ^ (l15 & 7)) << 4, q1o = ((4 + quad) ^ (l15 & 7)) << 4; const int qstride = 2048;
    __syncthreads();
    f32x4 O[4][4]; float m[4], l[4];
#pragma unroll
    for (int nt = 0; nt < 4; ++nt) { m[nt] = -1e30f; l[nt] = 0.f; }
#pragma unroll
    for (int dt = 0; dt < 4; ++dt)
#pragma unroll
        for (int nt = 0; nt < 4; ++nt) O[dt][nt] = (f32x4){0.f, 0.f, 0.f, 0.f};
    const int jmax = qb * 4 + 3;
    int jlo_w, jlo_b;
    { const float cq0 = cc[q0]; int lo = 0, hi = qb * 4 + w;
      while (lo < hi) { const int mid = (lo + hi) >> 1; if (cq0 - cc[mid * 64 + 63] >= -140.f) hi = mid; else lo = mid + 1; }
      jlo_w = lo; }
    { const float cq0 = cc[qb * 256]; int lo = 0, hi = qb * 4;
      while (lo < hi) { const int mid = (lo + hi) >> 1; if (cq0 - cc[mid * 64 + 63] >= -140.f) hi = mid; else lo = mid + 1; }
      jlo_b = lo; }
    const u64 tiles = ((jmax == 63) ? ~0ull : ((2ull << jmax) - 1ull)) & ~((1ull << jlo_b) - 1ull);
    attn_stream(tiles, proj + (size_t)b * 4096 * PJ_LD + 2560 + h * 64, PJ_LD, VT + ((size_t)((8 + h) * 8 + b) * 64) * 4096, 4096, lds, jlo_w, qb * 4 + w, ql, q0o, q1o, qstride, cc, O, m, l, tid, lane,
                [&](int nt, float ckv, int key, int jb, float& s) { s += cq[nt] - ckv; return key <= tq[nt]; });
    float sc[4];
#pragma unroll
    for (int nt = 0; nt < 4; ++nt) sc[nt] = 1.0f / fmaxf(l[nt], 1e-30f);
    attn_store2(mix, token0, 16, 768 + h * 64, 0, O, sc, lane, false);
}

__device__ void mixA_phase(const Params& p, int L, char* lds);
DEVI int next_unit(unsigned* ctr, char* lds) {
    int* slot = (int*)(lds + LDS_BYTES - 16);
    __syncthreads();
    if (otid() == 0) *slot = (int)atomicAdd(ctr, 1u);
    __syncthreads();
    return *slot;
}
__device__ void mixA_phase(const Params& p, int L, char* lds) {
    unsigned* ctr = (unsigned*)(p.ws + OFF_CTR) + L * 4 + 3;
#pragma unroll 1
    for (;;) {
        const int job = next_unit(ctr, lds); if (job >= 160 + 512) break;
        if (job < 128) compress_unit(p, L, job, lds);
        else if (job < 160) foxc_job(p, L, job - 128, lds);
        else {
#pragma unroll 1
            for (int u = (job - 160) * 4; u < (job - 160) * 4 + 4; ++u) hgrn_a_unit(p, L, u, lds);
        }
    }
}
__device__ void mixB_phase(const Params& p, int L, char* lds) {
    unsigned* ctr = (unsigned*)(p.ws + OFF_CTR) + L * 4;
#pragma unroll 1
    for (;;) { const int f = next_unit(ctr + 0, lds); if (f >= 512) break; const int qb = 15 - (f >> 5), bh = f & 31; fox_unit(p, L, bh >> 2, bh & 3, qb, lds); }
#pragma unroll 1
    for (;;) { const int n = next_unit(ctr + 1, lds); if (n >= 1024) break; const int blk = 63 - (n >> 4), bg = n & 15; nsa_unit(p, L, bg >> 1, bg & 1, blk, lds); }
#pragma unroll 1
    for (;;) { const int c = next_unit(ctr + 2, lds); if (c >= 1024) break;
#pragma unroll 1
        for (int u = c * 2; u < c * 2 + 2; ++u) hgrn_c_unit(p, L, u, lds); }
}

__device__ void run_phase(const Params& p, int ph, char* lds) {
    if (ph == 0) { prep_phase(p, lds); return; }
    const int L = (ph - 1) / 7, s = (ph - 1) % 7;
    switch (s) {
        case 0: gemm_phase<EPI_PROJ>(p, L, lds); break;
        case 1: mixA_phase(p, L, lds); break;
        case 2: hgrn_scan_phase(p); break;
        case 3: mixB_phase(p, L, lds); break;
        case 4: gemm_phase<EPI_WO>(p, L, lds); break;
        case 5: gemm_phase<EPI_UP>(p, L, lds); break;
        default: gemm_phase<EPI_DOWN>(p, L, lds); break;
    }
}

__global__ void __launch_bounds__(256, 2) fwd_kernel(Params p, int ph_lo, int ph_hi) {
    __shared__ __attribute__((aligned(16))) char lds[LDS_BYTES];
    for (int ph = ph_lo; ph < ph_hi; ++ph) {
#ifdef REPEAT_MASK
        const int nrep = (ph >= 1 && ((REPEAT_MASK >> ((ph - 1) % 7)) & 1)) ? 2 : 1;
#pragma unroll 1
        for (int rep = 0; rep < nrep; ++rep) {
            if (rep) cg::this_grid().sync();
            run_phase(p, ph, lds);
        }
#else
        run_phase(p, ph, lds);
#endif
        if (ph + 1 < ph_hi) { cg::this_grid().sync(); }
    }
}

extern "C" void kernel_launch(void* const* d_in, const int* in_sizes, int n_in, void* d_out, int out_size, void* d_ws, size_t ws_size,
                              hipStream_t stream) {
    if (ws_size < WS_NEED) { fprintf(stderr, "workspace too small: %zu < %zu\n", ws_size, (size_t)WS_NEED); return; }
    Params p{};
    p.x = (const float*)d_in[0]; p.norm1_g = (const float*)d_in[1]; p.w_in = (const float*)d_in[2]; p.lb_logits = (const float*)d_in[3];
    p.onorm_g = (const float*)d_in[4]; p.nsa_qn_g = (const float*)d_in[5]; p.nsa_kn_g = (const float*)d_in[6]; p.cmp_pos = (const float*)d_in[7];
    p.cmp_w1 = (const float*)d_in[8]; p.cmp_w2 = (const float*)d_in[9]; p.fox_qn_g = (const float*)d_in[10]; p.fox_kn_g = (const float*)d_in[11];
    p.fox_fb = (const float*)d_in[12]; p.w_o = (const float*)d_in[13]; p.norm2_g = (const float*)d_in[14]; p.w_up = (const float*)d_in[15];
    p.w_down = (const float*)d_in[16];
    p.out = (float*)d_out; p.ws = (char*)d_ws;
#if MULTI_LAUNCH
    for (int ph = 0; ph < NPHASE; ++ph) hipLaunchKernelGGL(fwd_kernel, dim3(512), dim3(256), 0, stream, p, ph, ph + 1);
#else
    static int grid_blocks = 0;
    if (!grid_blocks) {
        int dev = 0, cus = 0, per_cu = 0;
        hipGetDevice(&dev);
        hipDeviceGetAttribute(&cus, hipDeviceAttributeMultiprocessorCount, dev);
        hipOccupancyMaxActiveBlocksPerMultiprocessor(&per_cu, fwd_kernel, 256, 0);
        per_cu = 2;
        grid_blocks = cus * per_cu;
        grid_blocks &= ~7;
    }
    int lo = 0, hi = NPHASE;
    void* args[] = {&p, &lo, &hi};
    hipError_t e = hipLaunchCooperativeKernel((void*)fwd_kernel, dim3(grid_blocks), dim3(256), args, 0, stream);
    if (e != hipSuccess) fprintf(stderr, "cooperative launch failed: %s (grid %d)\n", hipGetErrorString(e), grid_blocks);
#endif
}
```

```cpp
#include <hip/hip_runtime.h>
#include <hip/hip_cooperative_groups.h>
#include <stdint.h>
#include <cstdio>
namespace cg = cooperative_groups;

#ifndef MULTI_LAUNCH
#define MULTI_LAUNCH 0
#endif

typedef unsigned short bf16_t;
typedef short bf16x8 __attribute__((ext_vector_type(8)));
typedef float f32x4 __attribute__((ext_vector_type(4)));
typedef unsigned long long u64;
typedef __attribute__((address_space(3))) unsigned* ldsp_t;
typedef unsigned u32x16 __attribute__((ext_vector_type(16)));
typedef unsigned u32x8 __attribute__((ext_vector_type(8)));
#define DEVI __device__ __forceinline__

constexpr int T_TOK = 32768, SEQ = 4096, DM = 1024, DFF = 4096;
constexpr int PJ_LD = 3072;
constexpr int NW_IN = 3100, NW_IN_PAD = 3328;
constexpr int NPHASE = 15;

constexpr size_t OFF_WIN = 0;
constexpr size_t OFF_WO = OFF_WIN + (size_t)2 * NW_IN_PAD * 1024 * 2;
constexpr size_t OFF_WUP = OFF_WO + (size_t)2 * 1024 * 1024 * 2;
constexpr size_t OFF_WDN = OFF_WUP + (size_t)2 * 4096 * 1024 * 2;
constexpr size_t OFF_W1T = OFF_WDN + (size_t)2 * 4096 * 1024 * 2;
constexpr size_t OFF_W2T = OFF_W1T + (size_t)2 * 2 * 128 * 2048 * 2;
constexpr size_t OFF_CBIAS = OFF_W2T + (size_t)2 * 2 * 64 * 128 * 2;
constexpr size_t OFF_CTR = OFF_CBIAS + 2048;
constexpr size_t OFF_ROPE = OFF_CTR + 256;
constexpr size_t OFF_GATES = OFF_ROPE + (size_t)4096 * 16 * 4;
constexpr size_t OFF_FOXC = OFF_GATES + (size_t)T_TOK * 32 * 4;
constexpr size_t OFF_KC = OFF_FOXC + (size_t)8 * 4 * 4096 * 4;
constexpr size_t OFF_VCT = OFF_KC + (size_t)8 * 2 * 256 * 64 * 2;
constexpr size_t OFF_DECAY = OFF_VCT + (size_t)8 * 2 * 256 * 64 * 2;
constexpr size_t OFF_KVT = OFF_DECAY + (size_t)2048 * 64 * 4;
constexpr size_t OFF_ST = OFF_KVT + (size_t)2048 * 4096 * 4;
constexpr size_t OFF_ACT = OFF_ST + (size_t)2048 * 4096 * 2;
constexpr size_t OFF_BIG = OFF_ACT + (size_t)T_TOK * 1024 * 2;
constexpr size_t OFF_VT_IN_BIG = (size_t)T_TOK * PJ_LD * 2;
constexpr size_t OFF_ACT2 = OFF_BIG + (size_t)T_TOK * 4096 * 2;
constexpr size_t OFF_SSQ = OFF_ACT2 + (size_t)T_TOK * 1024 * 2;
constexpr size_t WS_NEED = OFF_SSQ + (size_t)T_TOK * 16 * 4;

constexpr int LDS_BYTES = 67584;

struct Params {
    const float *x, *norm1_g, *w_in, *lb_logits, *onorm_g, *nsa_qn_g, *nsa_kn_g, *cmp_pos, *cmp_w1, *cmp_w2,
        *fox_qn_g, *fox_kn_g, *fox_fb, *w_o, *norm2_g, *w_up, *w_down;
    float* out;
    char* ws;
};

DEVI unsigned pk2(float lo, float hi) { unsigned r; asm("v_cvt_pk_bf16_f32 %0, %1, %2" : "=v"(r) : "v"(lo), "v"(hi)); return r; }
DEVI bf16_t f2bf(float f) { return (bf16_t)(pk2(f, 0.f) & 0xffffu); }
DEVI float bf2f(bf16_t h) { return __uint_as_float(((unsigned)h) << 16); }
DEVI float bflo(unsigned u) { return __uint_as_float(u << 16); }
DEVI float bfhi(unsigned u) { return __uint_as_float(u & 0xffff0000u); }
DEVI f32x4 mfma(bf16x8 a, bf16x8 b, f32x4 c) { return __builtin_amdgcn_mfma_f32_16x16x32_bf16(a, b, c, 0, 0, 0); }
DEVI int otid() { int t; asm volatile("v_mov_b32 %0, %1" : "=v"(t) : "v"(threadIdx.x)); return t; }
DEVI float wave_sum(float v) {
#pragma unroll
    for (int o = 32; o >= 1; o >>= 1) v += __shfl_xor(v, o);
    return v;
}
DEVI bf16x8 mk8(unsigned a, unsigned b, unsigned c, unsigned d) {
    uint4 u = make_uint4(a, b, c, d);
    return *(bf16x8*)&u;
}
DEVI bf16x8 ld8(const bf16_t* p) { uint4 u = *(const uint4*)p; return *(bf16x8*)&u; }
DEVI bf16x8 ld4x2(const bf16_t* p0, const bf16_t* p1) {
    uint2 a = *(const uint2*)p0, b = *(const uint2*)p1;
    return mk8(a.x, a.y, b.x, b.y);
}

DEVI int win_colmap(int n) {
    if (n < 2304) return n;
    if (n < 3072) return n + 24;
    if (n < 3096) return n - 768;
    return n;
}
__device__ void transpose_tile(const float* __restrict__ src, int ld_src, bf16_t* __restrict__ dst, int ld_dst, int k0, int n0, int nvalid,
                               int colmode, float* tile) {
    const int tid = otid();
    for (int idx = tid; idx < 4096; idx += 256) {
        const int i = idx >> 6, j = idx & 63, n = n0 + j;
        float v = 0.f;
        if (n < nvalid) v = src[(size_t)(k0 + i) * ld_src + (colmode ? win_colmap(n) : n)];
        tile[i * 65 + j] = v;
    }
    __syncthreads();
    for (int idx = tid; idx < 4096; idx += 256) {
        const int j = idx >> 6, i = idx & 63;
        dst[(size_t)(n0 + j) * ld_dst + k0 + i] = f2bf(tile[i * 65 + j]);
    }
    __syncthreads();
}

__device__ void norm_phase(const float* __restrict__ xin, const float* __restrict__ g, bf16_t* __restrict__ hout) {
    const int tid = otid(); const int lane = tid & 63, w = tid >> 6;
    for (int row = blockIdx.x * 4 + w; row < T_TOK; row += gridDim.x * 4) {
        const float4* xr = (const float4*)(xin + (size_t)row * DM);
        float4 v[4]; float ss = 0.f;
#pragma unroll
        for (int i = 0; i < 4; ++i) { v[i] = xr[lane + 64 * i]; ss += v[i].x * v[i].x + v[i].y * v[i].y + v[i].z * v[i].z + v[i].w * v[i].w; }
        ss = wave_sum(ss);
        const float r = rsqrtf(ss * (1.0f / 1024.0f) + 1e-6f);
#pragma unroll
        for (int i = 0; i < 4; ++i) {
            const float4 gg = ((const float4*)g)[lane + 64 * i];
            uint2 o; o.x = pk2(v[i].x * r * gg.x, v[i].y * r * gg.y); o.y = pk2(v[i].z * r * gg.z, v[i].w * r * gg.w);
            *(uint2*)(hout + (size_t)row * DM + (lane + 64 * i) * 4) = o;
        }
    }
}

__device__ void prep_phase(const Params& p, char* lds) {
    float* tile = (float*)lds;
    if (blockIdx.x == 0 && otid() < 64) ((unsigned*)(p.ws + OFF_CTR))[otid()] = 0u;
    bf16_t* win_t = (bf16_t*)(p.ws + OFF_WIN); bf16_t* wo_t = (bf16_t*)(p.ws + OFF_WO);
    bf16_t* wup_t = (bf16_t*)(p.ws + OFF_WUP); bf16_t* wdn_t = (bf16_t*)(p.ws + OFF_WDN);
    bf16_t* w1t = (bf16_t*)(p.ws + OFF_W1T); bf16_t* w2t = (bf16_t*)(p.ws + OFF_W2T);
    const int J0 = 1664, J1 = J0 + 512, J2 = J1 + 2048, J3 = J2 + 2048, J4 = J3 + 256, J5 = J4 + 8, J6 = J5 + 128, J7 = J6 + 128;
    for (int job = blockIdx.x; job < J7; job += gridDim.x) {
        if (job < J0) { const int L = job / 832, r = job % 832, kt = r / 52, nt = r % 52;
            transpose_tile(p.w_in + (size_t)L * 1024 * NW_IN, NW_IN, win_t + (size_t)L * NW_IN_PAD * 1024, 1024, kt * 64, nt * 64, NW_IN, 1, tile);
        } else if (job < J1) { const int j = job - J0, L = j / 256, r = j % 256, kt = r / 16, nt = r % 16;
            transpose_tile(p.w_o + (size_t)L * 1024 * 1024, 1024, wo_t + (size_t)L * 1024 * 1024, 1024, kt * 64, nt * 64, 1024, 0, tile);
        } else if (job < J2) { const int j = job - J1, L = j / 1024, r = j % 1024, kt = r / 64, nt = r % 64;
            transpose_tile(p.w_up + (size_t)L * 1024 * 4096, 4096, wup_t + (size_t)L * 4096 * 1024, 1024, kt * 64, nt * 64, 4096, 0, tile);
        } else if (job < J3) { const int j = job - J2, L = j / 1024, r = j % 1024, kt = r / 16, nt = r % 16;
            transpose_tile(p.w_down + (size_t)L * 4096 * 1024, 1024, wdn_t + (size_t)L * 1024 * 4096, 4096, kt * 64, nt * 64, 1024, 0, tile);
        } else if (job < J4) { const int j = job - J3, lw = j / 64, r = j % 64, kt = r / 2, nt = r % 2;
            transpose_tile(p.cmp_w1 + (size_t)lw * 2048 * 128, 128, w1t + (size_t)lw * 128 * 2048, 2048, kt * 64, nt * 64, 128, 0, tile);
        } else if (job < J5) { const int j = job - J4, lw = j / 2, kt = j % 2;
            transpose_tile(p.cmp_w2 + (size_t)lw * 128 * 64, 64, w2t + (size_t)lw * 64 * 128, 128, kt * 64, 0, 64, 0, tile);
        } else if (job < J6) {
            const int t_ = otid(); const int o = (job - J5) * 4 + (t_ >> 6), lane = t_ & 63, lw = o >> 7, hid = o & 127;
            const float* pos = p.cmp_pos + (size_t)lw * 2048; const float* w1 = p.cmp_w1 + (size_t)lw * 2048 * 128 + hid;
            float s = 0.f;
            for (int k = lane; k < 2048; k += 64) s += pos[k] * w1[(size_t)k * 128];
            s = wave_sum(s);
            if (lane == 0) ((float*)(p.ws + OFF_CBIAS))[o] = s;
        } else {
            const int e = (job - J6) * 256 + otid(), pos = e >> 3, i = e & 7;
            const float invf[8] = {1.0f, 0.1939227432012558f, 0.03760603070259094f, 0.007292664609849453f, 0.0014142135623842478f,
                                   0.00027424818836152554f, 5.318296098266728e-05f, 1.0313386155758053e-05f};
            float fr = 1.0f;
#pragma unroll
            for (int q = 0; q < 8; ++q) if (i == q) fr = invf[q];
            const float ang = (float)pos * fr;
            const double a = (double)ang; const double n = rint(a * 0.15915494309189535); const float rr = (float)(a - n * 6.283185307179586);
            float* rt = (float*)(p.ws + OFF_ROPE);
            rt[pos * 16 + i] = __cosf(rr); rt[pos * 16 + 8 + i] = __sinf(rr);
        }
    }
    norm_phase(p.x, p.norm1_g, (bf16_t*)(p.ws + OFF_ACT));
}

enum { EPI_PROJ = 0, EPI_WO = 1, EPI_UP = 2, EPI_DOWN = 3 };

DEVI float row_rstd(const float* ssq, int m) {
    const float4 a = *(const float4*)(ssq + (size_t)m * 16), b = *(const float4*)(ssq + (size_t)m * 16 + 4), c = *(const float4*)(ssq + (size_t)m * 16 + 8), d = *(const float4*)(ssq + (size_t)m * 16 + 12);
    const float t = ((a.x + a.y) + (a.z + a.w)) + ((b.x + b.y) + (b.z + b.w)) + ((c.x + c.y) + (c.z + c.w)) + ((d.x + d.y) + (d.z + d.w));
    return rsqrtf(t * (1.0f / 1024.0f) + 1e-6f);
}

template <int CH>
DEVI void proj_epilogue(const Params& p, int L, const f32x4 (&acc)[4][8], int m0w, int cc, int lane) {
    const int quad = lane >> 4, l15 = lane & 15;
    bf16_t* proj = (bf16_t*)(p.ws + OFF_BIG); bf16_t* VT = (bf16_t*)(p.ws + OFF_BIG + OFF_VT_IN_BIG);
    float* gates = (float*)(p.ws + OFF_GATES); const float* rope = (const float*)(p.ws + OFF_ROPE);
    if (cc > 48) return;
    int kind = 0, vidx = 0; const float* gain = nullptr; float scale = 1.f; bool dorope = false;
    if (cc >= 8 && cc < 12) { kind = 5; vidx = cc - 8; }
    else if (cc >= 16 && cc < 24) { kind = 1; gain = p.nsa_qn_g + L * 64; scale = 0.125f * 1.4426950408889634f; dorope = true; }
    else if (cc == 28 || cc == 29 || cc == 32 || cc == 33) { kind = 1; gain = p.nsa_kn_g + L * 64; dorope = true; }
    else if (cc == 30 || cc == 31) { kind = 5; vidx = 4 + (cc - 30); }
    else if (cc == 34 || cc == 35) { kind = 5; vidx = 6 + (cc - 34); }
    else if (cc >= 36 && cc < 40) { kind = 1; gain = p.fox_qn_g + L * 64; scale = 0.125f * 1.4426950408889634f; }
    else if (cc >= 40 && cc < 44) { kind = 1; gain = p.fox_kn_g + L * 64; }
    else if (cc >= 44 && cc < 48) { kind = 5; vidx = 8 + (cc - 44); }
    else if (cc == 48) kind = 6;
#pragma unroll
    for (int mi = 0; mi < 4; ++mi) {
        const int token = m0w + mi * 16 + l15, pos = token & 4095, bb = token >> 12;
        const float rs = (L > 0) ? row_rstd((const float*)(p.ws + OFF_SSQ), token) : 1.0f;
        float v[4][4];
#pragma unroll
        for (int ni = 0; ni < 4; ++ni)
#pragma unroll
            for (int j = 0; j < 4; ++j) v[ni][j] = acc[mi][CH * 4 + ni][j] * rs;
        if (kind == 6) {
#pragma unroll
            for (int ni = 0; ni < 2; ++ni)
#pragma unroll
                for (int j = 0; j < 4; ++j) { const int d = ni * 16 + quad * 4 + j;
                    if (d < 24) gates[(size_t)token * 32 + d] = 1.0f / (1.0f + __expf(-v[ni][j]));
                    else if (d < 28) gates[(size_t)token * 32 + d] = v[ni][j]; }
            asm volatile("" ::: "memory");
            continue;
        }
        if (kind == 1) {
            float ss = 0.f;
#pragma unroll
            for (int ni = 0; ni < 4; ++ni)
#pragma unroll
                for (int j = 0; j < 4; ++j) ss += v[ni][j] * v[ni][j];
            ss += __shfl_xor(ss, 16); ss += __shfl_xor(ss, 32);
            const float r = rsqrtf(ss * (1.0f / 64.0f) + 1e-6f);
#pragma unroll
            for (int ni = 0; ni < 4; ++ni) { const float4 gg = *(const float4*)(gain + ni * 16 + quad * 4);
                v[ni][0] *= r * gg.x; v[ni][1] *= r * gg.y; v[ni][2] *= r * gg.z; v[ni][3] *= r * gg.w; }
            if (dorope) {
                const float4 cs = *(const float4*)(rope + pos * 16 + (quad & 1) * 4), sn = *(const float4*)(rope + pos * 16 + 8 + (quad & 1) * 4);
                const float cv[4] = {cs.x, cs.y, cs.z, cs.w}, sv[4] = {sn.x, sn.y, sn.z, sn.w};
#pragma unroll
                for (int j = 0; j < 4; ++j) { const float xx = v[0][j], pp = __shfl_xor(xx, 32);
                    v[0][j] = (quad < 2) ? (xx * cv[j] - pp * sv[j]) : (xx * cv[j] + pp * sv[j]); }
            }
#pragma unroll
            for (int ni = 0; ni < 4; ++ni)
#pragma unroll
                for (int j = 0; j < 4; ++j) v[ni][j] *= scale;
        }
        if (kind == 5) {
#pragma unroll
            for (int ni = 0; ni < 4; ++ni)
#pragma unroll
                for (int j = 0; j < 4; ++j) { const int d = ni * 16 + quad * 4 + j;
                    VT[((size_t)(vidx * 8 + bb) * 64 + d) * 4096 + pos] = f2bf(v[ni][j]); }
        } else {
#pragma unroll
            for (int ni = 0; ni < 4; ++ni) { uint2 o; o.x = pk2(v[ni][0], v[ni][1]); o.y = pk2(v[ni][2], v[ni][3]);
                *(uint2*)(proj + (size_t)token * PJ_LD + cc * 64 + ni * 16 + quad * 4) = o; }
        }
        asm volatile("" ::: "memory");
    }
}

DEVI void g_load(uint4 (&RA)[4], uint4 (&RB)[4], const bf16_t* Ap, const bf16_t* Bp, int K, int KT) {
#pragma unroll
    for (int i = 0; i < 4; ++i) { RA[i] = *(const uint4*)(Ap + (size_t)(32 * i) * K + KT * 64); RB[i] = *(const uint4*)(Bp + (size_t)(32 * i) * K + KT * 64); }
}
DEVI void g_swrite(const uint4 (&RA)[4], const uint4 (&RB)[4], char* d_) {
#pragma unroll
    for (int i = 0; i < 4; ++i) { *(uint4*)(d_ + i * 4096) = RA[i]; *(uint4*)(d_ + 16384 + i * 4096) = RB[i]; }
}
DEVI void g_compute(const char* sA, f32x4 (&acc)[4][4], int wm, int wn, int quad, int l15) {
    const char* sB = sA + 16384;
#pragma unroll
    for (int ks = 0; ks < 2; ++ks) {
        bf16x8 af[4], bfr[4]; const int ch = ks * 4 + quad;
#pragma unroll
        for (int mi = 0; mi < 4; ++mi) { const int row = wm * 64 + mi * 16 + l15; af[mi] = *(const bf16x8*)(sA + row * 128 + ((ch ^ (row & 7)) << 4)); }
#pragma unroll
        for (int ni = 0; ni < 4; ++ni) { const int row = wn * 64 + ni * 16 + l15; bfr[ni] = *(const bf16x8*)(sB + row * 128 + ((ch ^ (row & 7)) << 4)); }
#pragma unroll
        for (int mi = 0; mi < 4; ++mi)
#pragma unroll
            for (int ni = 0; ni < 4; ++ni) acc[mi][ni] = mfma(bfr[ni], af[mi], acc[mi][ni]);
    }
}

template <int EPI>
__device__ __forceinline__ void gemm_phase(const Params& p, int L, char* lds) {
    const bf16_t* A; const bf16_t* Bt; int K, nNt;
    if (EPI == EPI_PROJ) { A = (const bf16_t*)(p.ws + OFF_ACT); Bt = (const bf16_t*)(p.ws + OFF_WIN) + (size_t)L * NW_IN_PAD * 1024; K = 1024; nNt = NW_IN_PAD / 256; }
    else if (EPI == EPI_WO) { A = (const bf16_t*)(p.ws + OFF_ACT); Bt = (const bf16_t*)(p.ws + OFF_WO) + (size_t)L * 1024 * 1024; K = 1024; nNt = 4; }
    else if (EPI == EPI_UP) { A = (const bf16_t*)(p.ws + OFF_ACT2); Bt = (const bf16_t*)(p.ws + OFF_WUP) + (size_t)L * 4096 * 1024; K = 1024; nNt = 16; }
    else { A = (const bf16_t*)(p.ws + OFF_BIG); Bt = (const bf16_t*)(p.ws + OFF_WDN) + (size_t)L * 1024 * 4096; K = 4096; nNt = 4; }
    const int tid = otid(), lane = tid & 63, w = tid >> 6, quad = lane >> 4, l15 = lane & 15, wm = w >> 1, wn = w & 1;
    const int xcd = blockIdx.x & 7, loc = blockIdx.x >> 3, nloc = gridDim.x >> 3;
    const int nk = K / 32;
    const int gsw = (0x1230 >> (((l15 >> 2) & 3) * 4)) & 3;
    const int rsw = (quad ^ gsw) << 4;
    for (int it = loc; it < 32 * nNt; it += nloc) {
        const int tl = otid();
        const int lrow = tl >> 2, lc = tl & 3;
        const int woff = lrow * 64 + ((lc ^ ((0x1230 >> (((lrow >> 2) & 3) * 4)) & 3)) << 4);
        const int gsz = 8 * nNt, mloc = (it / gsz) * 8 + (it & 7), nloc_t = (it % gsz) >> 3;
        const int m0 = (xcd + 8 * mloc) * 128, n0 = nloc_t * 256;
        f32x4 acc[4][8];
#pragma unroll
        for (int a = 0; a < 4; ++a)
#pragma unroll
            for (int b = 0; b < 8; ++b) acc[a][b] = (f32x4){0.f, 0.f, 0.f, 0.f};
        u32x8 ra0, ra1; u32x16 rb0, rb1;
        const bf16_t* Ap = A + (size_t)(m0 + lrow) * K + lc * 8;
        const bf16_t* Bp = Bt + (size_t)(n0 + lrow) * K + lc * 8;
#define G_LD1(R, P, I, KT) { const uint4 t_ = *(const uint4*)((P) + (size_t)(64 * I) * K + (KT) * 32); R[4 * I] = t_.x; R[4 * I + 1] = t_.y; R[4 * I + 2] = t_.z; R[4 * I + 3] = t_.w; }
#define G_LOAD(RA, RB, KT) { G_LD1(RA, Ap, 0, KT) G_LD1(RB, Bp, 0, KT) G_LD1(RA, Ap, 1, KT) G_LD1(RB, Bp, 1, KT) G_LD1(RB, Bp, 2, KT) G_LD1(RB, Bp, 3, KT) }
#define G_SW1(R, D, I) *(uint4*)((D) + I * 4096) = make_uint4(R[4 * I], R[4 * I + 1], R[4 * I + 2], R[4 * I + 3]);
#define G_SWRITE(RA, RB, DST) { G_SW1(RA, DST, 0) G_SW1(RB, (DST) + 8192, 0) G_SW1(RA, DST, 1) G_SW1(RB, (DST) + 8192, 1) G_SW1(RB, (DST) + 8192, 2) G_SW1(RB, (DST) + 8192, 3) }
#define G_COMPUTE(BUF) { const char* sA_ = (BUF) + (wm * 64 + l15) * 64 + rsw; const char* sB_ = (BUF) + 8192 + (wn * 128 + l15) * 64 + rsw; \
            bf16x8 af[4]; \
            _Pragma("unroll") for (int i_ = 0; i_ < 4; ++i_) af[i_] = *(const bf16x8*)(sA_ + i_ * 1024); \
            _Pragma("unroll") for (int nh = 0; nh < 2; ++nh) { bf16x8 bfr[4]; \
                _Pragma("unroll") for (int i_ = 0; i_ < 4; ++i_) bfr[i_] = *(const bf16x8*)(sB_ + (nh * 4 + i_) * 1024); \
                _Pragma("unroll") for (int mi = 0; mi < 4; ++mi) _Pragma("unroll") for (int ni = 0; ni < 4; ++ni) acc[mi][nh * 4 + ni] = mfma(bfr[ni], af[mi], acc[mi][nh * 4 + ni]); } }
        G_LOAD(ra0, rb0, 0)
        G_LOAD(ra1, rb1, 1)
        G_SWRITE(ra0, rb0, lds + woff)
        __syncthreads();
#pragma unroll 1
        for (int kt = 0; kt < nk - 2; kt += 2) {
            G_LOAD(ra0, rb0, kt + 2)
            __builtin_amdgcn_sched_barrier(0);
            G_COMPUTE(lds)
            G_SWRITE(ra1, rb1, lds + 24576 + woff)
            __syncthreads();
            G_LOAD(ra1, rb1, kt + 3)
            __builtin_amdgcn_sched_barrier(0);
            G_COMPUTE(lds + 24576)
            G_SWRITE(ra0, rb0, lds + woff)
            __syncthreads();
        }
        G_COMPUTE(lds)
        G_SWRITE(ra1, rb1, lds + 24576 + woff)
        __syncthreads();
        G_COMPUTE(lds + 24576)
        __syncthreads();
#undef G_LOAD
#undef G_SWRITE
#undef G_LD1
#undef G_SW1
#undef G_COMPUTE
        const int te = otid(); const int lane_e = te & 63, quad_e = lane_e >> 4, l15_e = lane_e & 15;
        const int mw = m0 + ((te >> 7) & 1) * 64, nw = n0 + ((te >> 6) & 1) * 128;
        if (EPI == EPI_PROJ) {
            proj_epilogue<0>(p, L, acc, mw, (nw >> 6), lane_e);
            proj_epilogue<1>(p, L, acc, mw, (nw >> 6) + 1, lane_e);
        } else if (EPI == EPI_UP) {
            bf16_t* hid = (bf16_t*)(p.ws + OFF_BIG);
#pragma unroll
            for (int mi = 0; mi < 4; ++mi) { const int m = mw + mi * 16 + l15_e; const float r = row_rstd((const float*)(p.ws + OFF_SSQ), m);
#pragma unroll
                for (int ni = 0; ni < 8; ++ni) { const int n = nw + ni * 16 + quad_e * 4;
                    float a0 = fmaxf(acc[mi][ni][0] * r, 0.f), a1 = fmaxf(acc[mi][ni][1] * r, 0.f), a2 = fmaxf(acc[mi][ni][2] * r, 0.f), a3 = fmaxf(acc[mi][ni][3] * r, 0.f);
                    uint2 o; o.x = pk2(a0 * a0, a1 * a1); o.y = pk2(a2 * a2, a3 * a3);
                    *(uint2*)(hid + (size_t)m * DFF + n) = o; } }
        } else {
            const float* xin = (EPI == EPI_WO && L == 0) ? p.x : p.out;
            const bool emit = (EPI == EPI_WO) || (L + 1 < 2);
            const float* gn = (EPI == EPI_WO) ? (p.norm2_g + L * 1024) : (p.norm1_g + (L + 1 < 2 ? L + 1 : L) * 1024);
            bf16_t* hn = (bf16_t*)(p.ws + ((EPI == EPI_WO) ? OFF_ACT2 : OFF_ACT));
            float* ssq = (float*)(p.ws + OFF_SSQ);
#pragma unroll
            for (int mi = 0; mi < 4; ++mi) {
#pragma unroll
                for (int hf = 0; hf < 2; ++hf) {
                    const int t3 = otid(); const int l15_e = t3 & 15, quad_e = (t3 >> 4) & 3;
                    const int m = mw + mi * 16 + l15_e;
                    float ss = 0.f;
#pragma unroll
                    for (int n4 = 0; n4 < 4; ++n4) { const int ni = hf * 4 + n4; const int n = nw + ni * 16 + quad_e * 4;
                        float4 xv = *(const float4*)(xin + (size_t)m * DM + n);
                        xv.x += acc[mi][ni][0]; xv.y += acc[mi][ni][1]; xv.z += acc[mi][ni][2]; xv.w += acc[mi][ni][3];
                        *(float4*)(p.out + (size_t)m * DM + n) = xv;
                        if (emit) { const float4 gg = *(const float4*)(gn + n);
                            uint2 o; o.x = pk2(xv.x * gg.x, xv.y * gg.y); o.y = pk2(xv.z * gg.z, xv.w * gg.w);
                            *(uint2*)(hn + (size_t)m * DM + n) = o;
                            ss += (xv.x * xv.x + xv.y * xv.y) + (xv.z * xv.z + xv.w * xv.w); } }
                    if (emit) { ss += __shfl_xor(ss, 16); ss += __shfl_xor(ss, 32);
                        if (quad_e == 0) ssq[(size_t)m * 16 + ((nw >> 6) + hf)] = ss; }
                    asm volatile("" ::: "memory");
                }
            }
        }
    }
}

DEVI float hgrn_lb(const Params& p, int L, int hk) {
    if (L == 0) return 0.f;
    const float l0 = p.lb_logits[hk], l1 = p.lb_logits[256 + hk];
    return 1.0f / (1.0f + __expf(l0 - l1));
}

__device__ void hgrn_a_unit(const Params& p, int L, int u, char* lds) {
    const int tid = otid(), lane = tid & 63, w = tid >> 6, quad = lane >> 4, l15 = lane & 15;
    const int c = u & 63, h = (u >> 6) & 3, b = u >> 8;
    const bf16_t* proj = (const bf16_t*)(p.ws + OFF_BIG); const bf16_t* VT = (const bf16_t*)(p.ws + OFF_BIG + OFF_VT_IN_BIG);
    float* segtot = (float*)lds;
    bf16_t* KDt = (bf16_t*)(lds + 1024);
    const int k = tid & 63, seg = tid >> 6;
    const float lb = hgrn_lb(p, L, h * 64 + k);
    float gl[16], kkv[16]; float run = 0.f;
    const bf16_t* zp = proj + (size_t)(b * 4096 + c * 64 + seg * 16) * PJ_LD + 256 + h * 64 + k;
#pragma unroll
    for (int i = 0; i < 16; ++i) {
        const float z = bf2f(zp[(size_t)i * PJ_LD]);
        const float sg = 1.0f / (1.0f + __expf(-z)), sn = 1.0f / (1.0f + __expf(z));
        const float f = lb + (1.0f - lb) * sg;
        run += __logf(fmaxf(f, 1e-30f)); gl[i] = run; kkv[i] = (1.0f - lb) * sn;
    }
    segtot[seg * 64 + k] = run;
    __syncthreads();
    float off = 0.f, tot = 0.f;
#pragma unroll
    for (int s = 0; s < 4; ++s) { const float t = segtot[s * 64 + k]; tot += t; if (s < seg) off += t; }
    unsigned pkd[8];
#pragma unroll
    for (int i = 0; i < 8; ++i) {
        const float a0 = kkv[2 * i] * __expf(tot - (off + gl[2 * i])), a1 = kkv[2 * i + 1] * __expf(tot - (off + gl[2 * i + 1]));
        pkd[i] = pk2(a0, a1);
    }
    *(uint4*)(KDt + k * 72 + seg * 16) = make_uint4(pkd[0], pkd[1], pkd[2], pkd[3]);
    *(uint4*)(KDt + k * 72 + seg * 16 + 8) = make_uint4(pkd[4], pkd[5], pkd[6], pkd[7]);
    if (seg == 0) ((float*)(p.ws + OFF_DECAY))[u * 64 + k] = __expf(tot);
    __syncthreads();
    const bf16_t* vt = VT + ((size_t)(h * 8 + b) * 64) * 4096 + c * 64;
    float* kvt = (float*)(p.ws + OFF_KVT) + (size_t)u * 4096;
    bf16x8 af[2];
#pragma unroll
    for (int ks = 0; ks < 2; ++ks) af[ks] = ld8(vt + (size_t)(w * 16 + l15) * 4096 + ks * 32 + quad * 8);
#pragma unroll
    for (int kt = 0; kt < 4; ++kt) {
        f32x4 acc = (f32x4){0.f, 0.f, 0.f, 0.f};
#pragma unroll
        for (int ks = 0; ks < 2; ++ks) { const bf16x8 bfr = *(const bf16x8*)(KDt + (kt * 16 + l15) * 72 + ks * 32 + quad * 8); acc = mfma(af[ks], bfr, acc); }
#pragma unroll
        for (int j = 0; j < 4; ++j) kvt[(w * 16 + quad * 4 + j) * 64 + kt * 16 + l15] = acc[j];
    }
    __syncthreads();
}

__device__ void hgrn_scan_phase(const Params& p) {
    const float* kvt = (const float*)(p.ws + OFF_KVT); const float* dec = (const float*)(p.ws + OFF_DECAY);
    bf16_t* st = (bf16_t*)(p.ws + OFF_ST);
    for (int e = blockIdx.x * 256 + otid(); e < 32 * 4096; e += gridDim.x * 256) {
        const int bh = e >> 12, vk = e & 4095, k = vk & 63;
        float S = 0.f;
#pragma unroll 8
        for (int c = 0; c < 64; ++c) {
            const int u = bh * 64 + c;
            st[(size_t)u * 4096 + vk] = f2bf(S);
            S = S * dec[u * 64 + k] + kvt[(size_t)u * 4096 + vk];
        }
    }
}

__device__ void hgrn_c_unit(const Params& p, int L, int u, char* lds) {
    const int tid = otid(), lane = tid & 63, w = tid >> 6, quad = lane >> 4, l15 = lane & 15;
    const int c = u & 63, h = (u >> 6) & 3, b = u >> 8;
    const bf16_t* proj = (const bf16_t*)(p.ws + OFF_BIG); const bf16_t* VT = (const bf16_t*)(p.ws + OFF_BIG + OFF_VT_IN_BIG);
    float* Gs = (float*)lds; float* KKs = Gs + 64 * 65; float* Qs = KKs + 64 * 65; float* segtot = Qs + 64 * 65;
    {
        const int k = tid & 63, seg = tid >> 6;
        const float lb = hgrn_lb(p, L, h * 64 + k);
        float gl[16], kkv[16]; float run = 0.f;
        const bf16_t* zp = proj + (size_t)(b * 4096 + c * 64 + seg * 16) * PJ_LD + 256 + h * 64 + k;
#pragma unroll
        for (int i = 0; i < 16; ++i) {
            const float z = bf2f(zp[(size_t)i * PJ_LD]);
            const float sg = 1.0f / (1.0f + __expf(-z)), sn = 1.0f / (1.0f + __expf(z));
            const float f = lb + (1.0f - lb) * sg;
            run += __logf(fmaxf(f, 1e-30f)); gl[i] = run; kkv[i] = (1.0f - lb) * sn;
            Qs[(seg * 16 + i) * 65 + k] = bf2f(zp[(size_t)i * PJ_LD - 256]) * 0.125f;
        }
        segtot[seg * 64 + k] = run;
        __syncthreads();
        float off = 0.f;
#pragma unroll
        for (int s = 0; s < 4; ++s) { const float t = segtot[s * 64 + k]; if (s < seg) off += t; }
#pragma unroll
        for (int i = 0; i < 16; ++i) { Gs[(seg * 16 + i) * 65 + k] = off + gl[i]; KKs[(seg * 16 + i) * 65 + k] = kkv[i]; }
        __syncthreads();
    }
    const int I = w;
    const int tq = 16 * I + l15;
    bf16x8 qt[2], qg[2];
#pragma unroll
    for (int ks = 0; ks < 2; ++ks) {
        float a[8], g8[8];
#pragma unroll
        for (int j = 0; j < 8; ++j) {
            const int k = ks * 32 + quad * 8 + j;
            const float G = Gs[tq * 65 + k], q = Qs[tq * 65 + k];
            const float gref = (I == 0) ? 0.f : Gs[(16 * I - 1) * 65 + k];
            a[j] = q * __expf(G - gref); g8[j] = q * __expf(G);
        }
        qt[ks] = mk8(pk2(a[0], a[1]), pk2(a[2], a[3]), pk2(a[4], a[5]), pk2(a[6], a[7]));
        qg[ks] = mk8(pk2(g8[0], g8[1]), pk2(g8[2], g8[3]), pk2(g8[4], g8[5]), pk2(g8[6], g8[7]));
    }
    f32x4 O[4];
#pragma unroll
    for (int vt = 0; vt < 4; ++vt) O[vt] = (f32x4){0.f, 0.f, 0.f, 0.f};
    const bf16_t* st = (const bf16_t*)(p.ws + OFF_ST) + (size_t)u * 4096;
#pragma unroll
    for (int vt = 0; vt < 4; ++vt)
#pragma unroll
        for (int ks = 0; ks < 2; ++ks) O[vt] = mfma(ld8(st + (vt * 16 + l15) * 64 + ks * 32 + quad * 8), qg[ks], O[vt]);
    const bf16_t* vtp = VT + ((size_t)(h * 8 + b) * 64) * 4096 + c * 64;
    for (int Jp = 0; Jp <= (I >> 1); ++Jp) {
        f32x4 sc[2];
#pragma unroll
        for (int jj = 0; jj < 2; ++jj) {
            const int J = 2 * Jp + jj;
            sc[jj] = (f32x4){0.f, 0.f, 0.f, 0.f};
            if (J <= I) {
                const int s = 16 * J + l15;
#pragma unroll
                for (int ks = 0; ks < 2; ++ks) {
                    float a[8];
#pragma unroll
                    for (int j = 0; j < 8; ++j) {
                        const int k = ks * 32 + quad * 8 + j;
                        const float gref = (I == 0) ? 0.f : Gs[(16 * I - 1) * 65 + k];
                        a[j] = KKs[s * 65 + k] * __expf(gref - Gs[s * 65 + k]);
                    }
                    sc[jj] = mfma(mk8(pk2(a[0], a[1]), pk2(a[2], a[3]), pk2(a[4], a[5]), pk2(a[6], a[7])), qt[ks], sc[jj]);
                }
#pragma unroll
                for (int j = 0; j < 4; ++j) { const int s2 = 16 * J + quad * 4 + j; if (s2 > tq) sc[jj][j] = 0.f; }
            }
        }
        const bf16x8 P = mk8(pk2(sc[0][0], sc[0][1]), pk2(sc[0][2], sc[0][3]), pk2(sc[1][0], sc[1][1]), pk2(sc[1][2], sc[1][3]));
#pragma unroll
        for (int vt = 0; vt < 4; ++vt) {
            const bf16_t* r = vtp + (size_t)(vt * 16 + l15) * 4096 + 32 * Jp + quad * 4;
            O[vt] = mfma(ld4x2(r, r + 16), P, O[vt]);
        }
    }
    float ss = 0.f;
#pragma unroll
    for (int vt = 0; vt < 4; ++vt)
#pragma unroll
        for (int j = 0; j < 4; ++j) ss += O[vt][j] * O[vt][j];
    ss += __shfl_xor(ss, 16); ss += __shfl_xor(ss, 32);
    const float r = rsqrtf(ss * (1.0f / 64.0f) + 1e-6f);
    const size_t token = (size_t)b * 4096 + c * 64 + tq;
    bf16_t* mix = (bf16_t*)(p.ws + OFF_ACT);
#pragma unroll
    for (int vt = 0; vt < 4; ++vt) {
        const int v0 = vt * 16 + quad * 4;
        const float4 og = *(const float4*)(p.onorm_g + L * 64 + v0);
        const uint2 gz = *(const uint2*)(proj + token * PJ_LD + 768 + h * 64 + v0);
        const float g0 = bflo(gz.x), g1 = bfhi(gz.x), g2 = bflo(gz.y), g3 = bfhi(gz.y);
        const float o0 = O[vt][0] * r * og.x * (g0 / (1.0f + __expf(-g0))), o1 = O[vt][1] * r * og.y * (g1 / (1.0f + __expf(-g1)));
        const float o2 = O[vt][2] * r * og.z * (g2 / (1.0f + __expf(-g2))), o3 = O[vt][3] * r * og.w * (g3 / (1.0f + __expf(-g3)));
        uint2 o; o.x = pk2(o0, o1); o.y = pk2(o2, o3);
        *(uint2*)(mix + token * DM + h * 64 + v0) = o;
    }
    __syncthreads();
}

__device__ void compress_unit(const Params& p, int L, int u, char* lds) {
    const int tid = otid(), lane = tid & 63, w = tid >> 6, quad = lane >> 4, l15 = lane & 15;
    const int which = u & 1, g = (u >> 1) & 1, b = (u >> 2) & 7, ntile = u >> 5;
    const bf16_t* proj = (const bf16_t*)(p.ws + OFF_BIG);
    const bf16_t* w1t = (const bf16_t*)(p.ws + OFF_W1T) + (size_t)(L * 2 + which) * 128 * 2048;
    const bf16_t* w2t = (const bf16_t*)(p.ws + OFF_W2T) + (size_t)(L * 2 + which) * 64 * 128;
    const float* cbias = (const float*)(p.ws + OFF_CBIAS) + (L * 2 + which) * 128;
    bf16_t* Hs = (bf16_t*)lds + w * 16 * 136;
    const int nrow = ntile * 64 + w * 16 + l15;
    int tokbase = 16 * nrow; if (tokbase > 4096 - 32) tokbase = 4096 - 32;
    const bf16_t* xa = proj + ((size_t)b * 4096 + tokbase) * PJ_LD + (which ? 1664 : 1536) + g * 64;
    f32x4 acc[8];
#pragma unroll
    for (int i = 0; i < 8; ++i) acc[i] = (f32x4){0.f, 0.f, 0.f, 0.f};
#pragma unroll 2
    for (int kk = 0; kk < 64; ++kk) {
        const int l = kk >> 1, d = (kk & 1) * 32 + quad * 8;
        const bf16x8 a = ld8(xa + (size_t)l * PJ_LD + d);
#pragma unroll
        for (int ni = 0; ni < 8; ++ni) acc[ni] = mfma(a, ld8(w1t + (size_t)(ni * 16 + l15) * 2048 + kk * 32 + quad * 8), acc[ni]);
    }
#pragma unroll
    for (int ni = 0; ni < 8; ++ni) { const float bsv = cbias[ni * 16 + l15];
#pragma unroll
        for (int j = 0; j < 4; ++j) { const float x = acc[ni][j] + bsv;
            const float uu = 0.7978845608028654f * (x + 0.044715f * x * x * x);
            const float th = 1.0f - 2.0f / (1.0f + __expf(2.0f * uu));
            Hs[(quad * 4 + j) * 136 + ni * 16 + l15] = f2bf(0.5f * x * (1.0f + th)); } }
    __syncthreads();
    f32x4 o[4];
#pragma unroll
    for (int i = 0; i < 4; ++i) o[i] = (f32x4){0.f, 0.f, 0.f, 0.f};
#pragma unroll
    for (int ks = 0; ks < 4; ++ks) { const bf16x8 a = *(const bf16x8*)(Hs + l15 * 136 + ks * 32 + quad * 8);
#pragma unroll
        for (int ni = 0; ni < 4; ++ni) o[ni] = mfma(a, ld8(w2t + (size_t)(ni * 16 + l15) * 128 + ks * 32 + quad * 8), o[ni]); }
    const int nb = ntile * 64 + w * 16 + quad * 4;
    if (which == 0) {
        bf16_t* kc = (bf16_t*)(p.ws + OFF_KC) + (size_t)(b * 2 + g) * 256 * 64;
        const float* rope = (const float*)(p.ws + OFF_ROPE);
#pragma unroll
        for (int j = 0; j < 4; ++j) {
            const int n = nb + j;
            float ss = o[0][j] * o[0][j] + o[1][j] * o[1][j] + o[2][j] * o[2][j] + o[3][j] * o[3][j];
            ss += __shfl_xor(ss, 1); ss += __shfl_xor(ss, 2); ss += __shfl_xor(ss, 4); ss += __shfl_xor(ss, 8);
            const float r = rsqrtf(ss * (1.0f / 64.0f) + 1e-6f);
            float v[4];
#pragma unroll
            for (int ni = 0; ni < 4; ++ni) v[ni] = o[ni][j] * r * p.nsa_kn_g[L * 64 + ni * 16 + l15];
            int pos = 16 * n + 31; if (pos > 4095) pos = 4095;
            const float cs = rope[pos * 16 + (l15 & 7)], sn = rope[pos * 16 + 8 + (l15 & 7)];
            const float pp = __shfl_xor(v[0], 8);
            v[0] = (l15 < 8) ? (v[0] * cs - pp * sn) : (v[0] * cs + pp * sn);
#pragma unroll
            for (int ni = 0; ni < 4; ++ni) kc[(size_t)n * 64 + ni * 16 + l15] = (n < 255) ? f2bf(v[ni]) : (bf16_t)0;
        }
    } else {
        bf16_t* vct = (bf16_t*)(p.ws + OFF_VCT) + (size_t)(b * 2 + g) * 64 * 256;
#pragma unroll
        for (int ni = 0; ni < 4; ++ni) {
            float v0 = o[ni][0], v1 = o[ni][1], v2 = o[ni][2], v3 = o[ni][3];
            if (nb + 3 >= 255) v3 = 0.f;
            uint2 ov; ov.x = pk2(v0, v1); ov.y = pk2(v2, v3);
            *(uint2*)(vct + (size_t)(ni * 16 + l15) * 256 + nb) = ov;
        }
    }
    __syncthreads();
}

__device__ void foxc_job(const Params& p, int L, int bh, char* lds) {
    const int tid = otid(), lane = tid & 63, w = tid >> 6, b = bh >> 2, h = bh & 3;
    const float* gates = (const float*)(p.ws + OFF_GATES);
    float* cc = (float*)(p.ws + OFF_FOXC) + (size_t)bh * 4096;
    float* wtot = (float*)lds;
    const float fb = p.fox_fb[L * 4 + h];
    float v[16];
#pragma unroll
    for (int i = 0; i < 16; ++i) v[i] = gates[((size_t)b * 4096 + tid * 16 + i) * 32 + 24 + h] + fb;
    float run = 0.f;
#pragma unroll
    for (int i = 0; i < 16; ++i) { const float x = v[i]; run += (x >= 0.f) ? -log1pf(__expf(-x)) : (x - log1pf(__expf(x))); v[i] = run; }
    float incl = run;
#pragma unroll
    for (int o = 1; o < 64; o <<= 1) { const float t = __shfl_up(incl, o); if (lane >= o) incl += t; }
    if (lane == 63) wtot[w] = incl;
    __syncthreads();
    float pre = incl - run;
#pragma unroll
    for (int s = 0; s < 4; ++s) if (s < w) pre += wtot[s];
#pragma unroll
    for (int i = 0; i < 4; ++i) { const float k2 = 1.4426950408889634f;
        *(float4*)(cc + tid * 16 + i * 4) = make_float4((pre + v[4 * i]) * k2, (pre + v[4 * i + 1]) * k2, (pre + v[4 * i + 2]) * k2, (pre + v[4 * i + 3]) * k2); }
    __syncthreads();
}

constexpr int KV_BUF = 16384;
DEVI void tile_glds(const bf16_t* Kg, int ldk, const bf16_t* Vg, int ldv, char* buf, int tid) {
    const int w = tid >> 6, i = tid & 63;
#pragma unroll
    for (int jj = 0; jj < 2; ++jj) {
        const int j = w * 2 + jj, row = 8 * j + (i >> 3), slot = i & 7;
        const bf16_t* kp = Kg + (size_t)row * ldk + ((slot ^ (row & 7)) << 3);
        const bf16_t* vp = Vg + (size_t)row * ldv + ((slot ^ ((row >> 1) & 7)) << 3);
        __builtin_amdgcn_global_load_lds((const unsigned*)kp, (ldsp_t)(unsigned)(size_t)(buf + j * 1024), 16, 0, 0);
        __builtin_amdgcn_global_load_lds((const unsigned*)vp, (ldsp_t)(unsigned)(size_t)(buf + 8192 + j * 1024), 16, 0, 0);
    }
}
DEVI void lds_kf(const char* buf, int kh, int lane, bf16x8 (&kf)[2][2]) {
    const int quad = lane >> 4, l15 = lane & 15;
#pragma unroll
    for (int t2 = 0; t2 < 2; ++t2)
#pragma unroll
        for (int ks = 0; ks < 2; ++ks) { const int row = kh * 32 + t2 * 16 + l15, ch = ks * 4 + quad; kf[t2][ks] = *(const bf16x8*)(buf + row * 128 + ((ch ^ (row & 7)) << 4)); }
}
DEVI void lds_vf(const char* buf, int kh, int lane, bf16x8 (&vf)[4]) {
    const int quad = lane >> 4, l15 = lane & 15;
#pragma unroll
    for (int dt = 0; dt < 4; ++dt) { const int d = dt * 16 + l15, u0 = kh * 8 + quad, u1 = u0 + 4;
        const uint2 a = *(const uint2*)(buf + 8192 + d * 128 + ((u0 ^ (d & 14)) << 3)), b = *(const uint2*)(buf + 8192 + d * 128 + ((u1 ^ (d & 14)) << 3));
        vf[dt] = mk8(a.x, a.y, b.x, b.y); }
}

template <class MaskF>
DEVI void attn_block64(const char* buf, int kbase, const char* ql, int q0o, int q1o, int qstride, const float* cb, f32x4 (&O)[4][4], float (&m)[4], float (&l)[4], int lane, MaskF maskf) {
    const int quad = lane >> 4;
#pragma unroll
    for (int kh = 0; kh < 2; ++kh) {
        bf16x8 kf[2][2], vf[4];
        lds_kf(buf, kh, lane, kf); lds_vf(buf, kh, lane, vf);
        float ck[8] = {0.f, 0.f, 0.f, 0.f, 0.f, 0.f, 0.f, 0.f};
        if (cb) { const float4 c0 = *(const float4*)(cb + kbase + kh * 32 + quad * 4), c1 = *(const float4*)(cb + kbase + kh * 32 + 16 + quad * 4);
            ck[0] = c0.x; ck[1] = c0.y; ck[2] = c0.z; ck[3] = c0.w; ck[4] = c1.x; ck[5] = c1.y; ck[6] = c1.z; ck[7] = c1.w; }
#pragma unroll
        for (int nt = 0; nt < 4; ++nt) {
            f32x4 s0 = (f32x4){0.f, 0.f, 0.f, 0.f}, s1 = s0;
            { const bf16x8 qa = *(const bf16x8*)(ql + nt * qstride + q0o), qb_ = *(const bf16x8*)(ql + nt * qstride + q1o);
              s0 = mfma(kf[0][0], qa, s0); s1 = mfma(kf[1][0], qa, s1); s0 = mfma(kf[0][1], qb_, s0); s1 = mfma(kf[1][1], qb_, s1); }
            float sv[8]; bool ok[8]; float mx = -1e30f;
#pragma unroll
            for (int e = 0; e < 8; ++e) { sv[e] = (e < 4) ? s0[e & 3] : s1[e & 3]; const int key = kbase + kh * 32 + (e >> 2) * 16 + quad * 4 + (e & 3);
                ok[e] = maskf(nt, ck[e], key, sv[e]); if (ok[e]) mx = fmaxf(mx, sv[e]); }
            mx = fmaxf(mx, __shfl_xor(mx, 16)); mx = fmaxf(mx, __shfl_xor(mx, 32));
            const float mn = fmaxf(m[nt], mx), alpha = __builtin_amdgcn_exp2f(m[nt] - mn);
            float pv[8]; float rs = 0.f;
#pragma unroll
            for (int e = 0; e < 8; ++e) { pv[e] = ok[e] ? __builtin_amdgcn_exp2f(sv[e] - mn) : 0.f; rs += pv[e]; }
            rs += __shfl_xor(rs, 16); rs += __shfl_xor(rs, 32);
            l[nt] = l[nt] * alpha + rs; m[nt] = mn;
            const bf16x8 P = mk8(pk2(pv[0], pv[1]), pk2(pv[2], pv[3]), pk2(pv[4], pv[5]), pk2(pv[6], pv[7]));
#pragma unroll
            for (int dt = 0; dt < 4; ++dt) { O[dt][nt] = O[dt][nt] * alpha; O[dt][nt] = mfma(vf[dt], P, O[dt][nt]); }
        }
    }
}

template <class MaskF>
DEVI void attn_stream(u64 tiles, const bf16_t* Kbase, int ldk, const bf16_t* Vbase, int ldv, char* kvbuf, int jb_wave_min, int jb_wave_max,
                      const char* ql, int q0o, int q1o, int qstride, const float* cb, f32x4 (&O)[4][4], float (&m)[4], float (&l)[4], int tid, int lane, MaskF maskf) {
    if (tiles == 0ull) return;
    int jb = __ffsll((long long)tiles) - 1; tiles &= tiles - 1;
    tile_glds(Kbase + (size_t)jb * 64 * ldk, ldk, Vbase + jb * 64, ldv, kvbuf, tid);
    __syncthreads();
    int cur = 0;
#pragma unroll 1
    for (;;) {
        const bool more = tiles != 0ull;
        int jbn = 0;
        if (more) { jbn = __ffsll((long long)tiles) - 1; tiles &= tiles - 1; tile_glds(Kbase + (size_t)jbn * 64 * ldk, ldk, Vbase + jbn * 64, ldv, kvbuf + (cur ^ 1) * KV_BUF, tid); }
        if (jb >= jb_wave_min && jb <= jb_wave_max) attn_block64(kvbuf + cur * KV_BUF, jb * 64, ql, q0o, q1o, qstride, cb, O, m, l, lane, [&](int nt, float ckv, int key, float& s) { return maskf(nt, ckv, key, jb, s); });
        __syncthreads();
        if (!more) break;
        jb = jbn; cur ^= 1;
    }
}

DEVI void attn_store2(bf16_t* mix, size_t token0, int tokstride, int col0, int colstride, const f32x4 (&O)[4][4], const float (&sc)[4], int lane, bool accum) {
    const int quad = lane >> 4, l15 = lane & 15;
#pragma unroll
    for (int nt = 0; nt < 4; ++nt)
#pragma unroll
        for (int dt = 0; dt < 4; ++dt) {
            bf16_t* dst = mix + (token0 + nt * tokstride + l15) * DM + col0 + nt * colstride + dt * 16 + quad * 4;
            float a0 = O[dt][nt][0] * sc[nt], a1 = O[dt][nt][1] * sc[nt], a2 = O[dt][nt][2] * sc[nt], a3 = O[dt][nt][3] * sc[nt];
            if (accum) { const uint2 old = *(const uint2*)dst; a0 += bflo(old.x); a1 += bfhi(old.x); a2 += bflo(old.y); a3 += bfhi(old.y); }
            uint2 o; o.x = pk2(a0, a1); o.y = pk2(a2, a3);
            *(uint2*)dst = o;
        }
}

__device__ void nsa_unit(const Params& p, int L, int b, int g, int blk, char* lds) {
    const int tid = otid(), lane = tid & 63, w = tid >> 6, quad = lane >> 4, l15 = lane & 15;
    const bf16_t* proj = (const bf16_t*)(p.ws + OFF_BIG); const bf16_t* VT = (const bf16_t*)(p.ws + OFF_BIG + OFF_VT_IN_BIG);
    const float* gates = (const float*)(p.ws + OFF_GATES);
    bf16_t* mix = (bf16_t*)(p.ws + OFF_ACT);
    char* kvbuf = lds; float* impL = (float*)(lds + KV_BUF)  ; char* Qs = lds + 32768; u64* selm = (u64*)(lds + 65536);
    const int q0 = blk * 64; const int tq = q0 + w * 16 + l15; const size_t token = (size_t)b * 4096 + tq;
    const size_t token0 = (size_t)b * 4096 + q0 + w * 16;
    const int mixcol = 256 + g * 256;
#pragma unroll
    for (int t = 0; t < 8; ++t) { const int idx = t * 64 + lane, rr = idx >> 3, c = idx & 7, hh = rr >> 4, r16 = rr & 15;
        const uint4 v = *(const uint4*)(proj + (token0 + r16) * PJ_LD + 1024 + (g * 4 + hh) * 64 + c * 8);
        *(uint4*)(Qs + (hh * 64 + w * 16 + r16) * 128 + ((c ^ (r16 & 7)) << 4)) = v; }
    const char* ql = Qs + (w * 16 + l15) * 128; const int q0o = ((quad) ^ (l15 & 7)) << 4, q1o = ((4 + quad) ^ (l15 & 7)) << 4; const int qstride = 8192;
    __syncthreads();
    f32x4 O[4][4]; float m[4], l[4];
    const bf16_t* Kc = (const bf16_t*)(p.ws + OFF_KC) + (size_t)(b * 2 + g) * 256 * 64;
    const bf16_t* VcT = (const bf16_t*)(p.ws + OFF_VCT) + (size_t)(b * 2 + g) * 64 * 256;
    const int ncb = (4 * blk + 3 + 63) >> 6;
#pragma unroll
    for (int nt = 0; nt < 4; ++nt) { m[nt] = -1e30f; l[nt] = 0.f; }
    {
#pragma unroll 1
        for (int pass = 0; pass < 2; ++pass) {
            float inv[4]; float prevr = 0.f;
            if (pass == 1) {
#pragma unroll
                for (int nt = 0; nt < 4; ++nt) inv[nt] = 1.0f / fmaxf(l[nt], 1e-30f);
#pragma unroll
                for (int dt = 0; dt < 4; ++dt)
#pragma unroll
                    for (int nt = 0; nt < 4; ++nt) O[dt][nt] = (f32x4){0.f, 0.f, 0.f, 0.f};
            }
#pragma unroll 1
            for (int ct = 0; ct < ncb; ++ct) {
                tile_glds(Kc + (size_t)ct * 64 * 64, 64, VcT + ct * 64, 256, kvbuf, tid);
                __syncthreads();
                const char* buf = kvbuf;
#pragma unroll
                for (int kh = 0; kh < 2; ++kh) {
                    bf16x8 kf[2][2]; lds_kf(buf, kh, lane, kf);
                    if (pass == 0) {
#pragma unroll
                        for (int nt = 0; nt < 4; ++nt) {
                            f32x4 s0 = (f32x4){0.f, 0.f, 0.f, 0.f}, s1 = s0;
                            { const bf16x8 qa = *(const bf16x8*)(ql + nt * qstride + q0o), qb_ = *(const bf16x8*)(ql + nt * qstride + q1o);
                              s0 = mfma(kf[0][0], qa, s0); s1 = mfma(kf[1][0], qa, s1); s0 = mfma(kf[0][1], qb_, s0); s1 = mfma(kf[1][1], qb_, s1); }
                            float sv[8]; bool ok[8]; float mx = -1e30f;
#pragma unroll
                            for (int e = 0; e < 8; ++e) { sv[e] = (e < 4) ? s0[e & 3] : s1[e & 3]; const int n = ct * 64 + kh * 32 + (e >> 2) * 16 + quad * 4 + (e & 3);
                                ok[e] = (16 * n + 31 <= tq); if (ok[e]) mx = fmaxf(mx, sv[e]); }
                            mx = fmaxf(mx, __shfl_xor(mx, 16)); mx = fmaxf(mx, __shfl_xor(mx, 32));
                            const float mn = fmaxf(m[nt], mx), alpha = __builtin_amdgcn_exp2f(m[nt] - mn);
                            float rs = 0.f;
#pragma unroll
                            for (int e = 0; e < 8; ++e) rs += ok[e] ? __builtin_amdgcn_exp2f(sv[e] - mn) : 0.f;
                            rs += __shfl_xor(rs, 16); rs += __shfl_xor(rs, 32);
                            l[nt] = l[nt] * alpha + rs; m[nt] = mn;
                        }
                    } else {
                        bf16x8 vf[4]; lds_vf(buf, kh, lane, vf);
                        float As[2] = {0.f, 0.f}, p3[2] = {0.f, 0.f};
#pragma unroll
                        for (int nt = 0; nt < 4; ++nt) {
                            f32x4 s0 = (f32x4){0.f, 0.f, 0.f, 0.f}, s1 = s0;
                            { const bf16x8 qa = *(const bf16x8*)(ql + nt * qstride + q0o), qb_ = *(const bf16x8*)(ql + nt * qstride + q1o);
                              s0 = mfma(kf[0][0], qa, s0); s1 = mfma(kf[1][0], qa, s1); s0 = mfma(kf[0][1], qb_, s0); s1 = mfma(kf[1][1], qb_, s1); }
                            float pv[8];
#pragma unroll
                            for (int e = 0; e < 8; ++e) { const float s = (e < 4) ? s0[e & 3] : s1[e & 3]; const int n = ct * 64 + kh * 32 + (e >> 2) * 16 + quad * 4 + (e & 3);
                                pv[e] = (16 * n + 31 <= tq) ? __builtin_amdgcn_exp2f(s - m[nt]) * inv[nt] : 0.f; }
                            As[0] += (pv[0] + pv[1]) + (pv[2] + pv[3]); As[1] += (pv[4] + pv[5]) + (pv[6] + pv[7]); p3[0] += pv[3]; p3[1] += pv[7];
                            const bf16x8 P = mk8(pk2(pv[0], pv[1]), pk2(pv[2], pv[3]), pk2(pv[4], pv[5]), pk2(pv[6], pv[7]));
#pragma unroll
                            for (int dt = 0; dt < 4; ++dt) O[dt][nt] = mfma(vf[dt], P, O[dt][nt]);
                        }
                        const int qq = w * 16 + l15;
#pragma unroll
                        for (int t2 = 0; t2 < 2; ++t2) {
                            const float rr = __shfl(p3[t2], (lane + 48) & 63);
                            const float carry = (quad == 0) ? prevr : rr; prevr = rr;
                            const int jb = ct * 16 + kh * 8 + t2 * 4 + quad;
                            impL[jb * 64 + ((qq ^ jb) & 63)] = As[t2] + carry;
                        }
                    }
                }
                __syncthreads();
            }
        }
    }
    {
        const float4 gv = *(const float4*)(gates + token * 32 + 0 * 8 + g * 4);
        const float sc[4] = {gv.x, gv.y, gv.z, gv.w};
        attn_store2(mix, token0, 0, mixcol, 64, O, sc, lane, false);
    }
#pragma unroll 1
    for (int qi = 0; qi < 16; ++qi) {
        const int q = w * 16 + qi, jb = lane;
        float val = impL[jb * 64 + ((q ^ jb) & 63)];
        if (jb > blk) val = -1e30f;
        else if (jb == 0 || jb == blk || jb == blk - 1) val = 1e30f;
        int rank = 0;
        for (int jp = 0; jp < 64; ++jp) { const float vj = __shfl(val, jp); rank += ((vj > val) || (vj == val && jp < jb)) ? 1 : 0; }
        const bool sel = (rank < 16) && (val > -5e29f);
        const u64 mask = __ballot(sel);
        if (lane == 0) selm[q] = mask;
    }
    __syncthreads();
    u64 uni = 0;
    for (int q = 0; q < 64; ++q) uni |= selm[q];
    const u64 sm = selm[w * 16 + l15];
    {
#pragma unroll
        for (int nt = 0; nt < 4; ++nt) { m[nt] = -1e30f; l[nt] = 0.f; }
#pragma unroll
        for (int dt = 0; dt < 4; ++dt)
#pragma unroll
            for (int nt = 0; nt < 4; ++nt) O[dt][nt] = (f32x4){0.f, 0.f, 0.f, 0.f};
        const u64 tiles = uni & ((blk == 63) ? ~0ull : ((2ull << blk) - 1ull));
        attn_stream(tiles, proj + (size_t)b * 4096 * PJ_LD + 1792 + g * 64, PJ_LD, VT + ((size_t)((4 + g) * 8 + b) * 64) * 4096, 4096, kvbuf, 0, 63, ql, q0o, q1o, qstride, nullptr, O, m, l, tid, lane,
                    [&](int nt, float ckv, int key, int jb, float& s) { return (((sm >> jb) & 1ull) != 0) && (key <= tq); });
        const float4 gv = *(const float4*)(gates + token * 32 + 1 * 8 + g * 4);
        const float sc[4] = {gv.x / fmaxf(l[0], 1e-30f), gv.y / fmaxf(l[1], 1e-30f), gv.z / fmaxf(l[2], 1e-30f), gv.w / fmaxf(l[3], 1e-30f)};
        attn_store2(mix, token0, 0, mixcol, 64, O, sc, lane, true);
    }
    {
#pragma unroll
        for (int nt = 0; nt < 4; ++nt) { m[nt] = -1e30f; l[nt] = 0.f; }
#pragma unroll
        for (int dt = 0; dt < 4; ++dt)
#pragma unroll
            for (int nt = 0; nt < 4; ++nt) O[dt][nt] = (f32x4){0.f, 0.f, 0.f, 0.f};
        const int jlo = blk > 8 ? blk - 8 : 0;
        const u64 upto = (blk == 63) ? ~0ull : ((2ull << blk) - 1ull);
        const u64 tiles = upto & ~((1ull << jlo) - 1ull);
        attn_stream(tiles, proj + (size_t)b * 4096 * PJ_LD + 2048 + g * 64, PJ_LD, VT + ((size_t)((6 + g) * 8 + b) * 64) * 4096, 4096, kvbuf, 0, 63, ql, q0o, q1o, qstride, nullptr, O, m, l, tid, lane,
                    [&](int nt, float ckv, int key, int jb, float& s) { return (key <= tq) && (key + 512 > tq); });
        const float4 gv = *(const float4*)(gates + token * 32 + 2 * 8 + g * 4);
        const float sc[4] = {gv.x / fmaxf(l[0], 1e-30f), gv.y / fmaxf(l[1], 1e-30f), gv.z / fmaxf(l[2], 1e-30f), gv.w / fmaxf(l[3], 1e-30f)};
        attn_store2(mix, token0, 0, mixcol, 64, O, sc, lane, true);
    }
    __syncthreads();
}

__device__ void fox_unit(const Params& p, int L, int b, int h, int qb, char* lds) {
    const int tid = otid(), lane = tid & 63, w = tid >> 6, quad = lane >> 4, l15 = lane & 15;
    const bf16_t* proj = (const bf16_t*)(p.ws + OFF_BIG); const bf16_t* VT = (const bf16_t*)(p.ws + OFF_BIG + OFF_VT_IN_BIG);
    bf16_t* mix = (bf16_t*)(p.ws + OFF_ACT);
    const float* cc = (const float*)(p.ws + OFF_FOXC) + (size_t)(b * 4 + h) * 4096;
    const int q0 = qb * 256 + w * 64; const size_t token0 = (size_t)b * 4096 + q0;
    int tq[4]; float cq[4];
#pragma unroll
    for (int nt = 0; nt < 4; ++nt) { tq[nt] = q0 + nt * 16 + l15; cq[nt] = cc[tq[nt]]; }
    char* Qs = lds + 32768;
#pragma unroll
    for (int t = 0; t < 8; ++t) { const int idx = t * 64 + lane, rr = idx >> 3, c = idx & 7;
        const uint4 v = *(const uint4*)(proj + (token0 + rr) * PJ_LD + 2304 + h * 64 + c * 8);
        *(uint4*)(Qs + (w * 64 + rr) * 128 + ((c ^ (rr & 7)) << 4)) = v; }
    const char* ql = Qs + (w * 64 + l15) * 128; const int q0o = ((quad) ^ (l15 & 7)) << 4, q1o = ((4 + quad) ^ (l15 & 7)) << 4; const int qstride = 2048;
    __syncthreads();
    f32x4 O[4][4]; float m[4], l[4];
#pragma unroll
    for (int nt = 0; nt < 4; ++nt) { m[nt] = -1e30f; l[nt] = 0.f; }
#pragma unroll
    for (int dt = 0; dt < 4; ++dt)
#pragma unroll
        for (int nt = 0; nt < 4; ++nt) O[dt][nt] = (f32x4){0.f, 0.f, 0.f, 0.f};
    const int jmax = qb * 4 + 3;
    int jlo_w, jlo_b;
    { const float cq0 = cc[q0]; int lo = 0, hi = qb * 4 + w;
      while (lo < hi) { const int mid = (lo + hi) >> 1; if (cq0 - cc[mid * 64 + 63] >= -202.f) hi = mid; else lo = mid + 1; }
      jlo_w = lo; }
    { const float cq0 = cc[qb * 256]; int lo = 0, hi = qb * 4;
      while (lo < hi) { const int mid = (lo + hi) >> 1; if (cq0 - cc[mid * 64 + 63] >= -202.f) hi = mid; else lo = mid + 1; }
      jlo_b = lo; }
    const u64 tiles = ((jmax == 63) ? ~0ull : ((2ull << jmax) - 1ull)) & ~((1ull << jlo_b) - 1ull);
    attn_stream(tiles, proj + (size_t)b * 4096 * PJ_LD + 2560 + h * 64, PJ_LD, VT + ((size_t)((8 + h) * 8 + b) * 64) * 4096, 4096, lds, jlo_w, qb * 4 + w, ql, q0o, q1o, qstride, cc, O, m, l, tid, lane,
                [&](int nt, float ckv, int key, int jb, float& s) { s += cq[nt] - ckv; return key <= tq[nt]; });
    float sc[4];
#pragma unroll
    for (int nt = 0; nt < 4; ++nt) sc[nt] = 1.0f / fmaxf(l[nt], 1e-30f);
    attn_store2(mix, token0, 16, 768 + h * 64, 0, O, sc, lane, false);
}

__device__ void mixA_phase(const Params& p, int L, char* lds);
DEVI int next_unit(unsigned* ctr, char* lds) {
    int* slot = (int*)(lds + LDS_BYTES - 16);
    __syncthreads();
    if (otid() == 0) *slot = (int)atomicAdd(ctr, 1u);
    __syncthreads();
    return *slot;
}
__device__ void mixA_phase(const Params& p, int L, char* lds) {
    unsigned* ctr = (unsigned*)(p.ws + OFF_CTR) + L * 4 + 3;
#pragma unroll 1
    for (;;) {
        const int job = next_unit(ctr, lds); if (job >= 160 + 512) break;
        if (job < 128) compress_unit(p, L, job, lds);
        else if (job < 160) foxc_job(p, L, job - 128, lds);
        else {
#pragma unroll 1
            for (int u = (job - 160) * 4; u < (job - 160) * 4 + 4; ++u) hgrn_a_unit(p, L, u, lds);
        }
    }
}
__device__ void mixB_phase(const Params& p, int L, char* lds) {
    unsigned* ctr = (unsigned*)(p.ws + OFF_CTR) + L * 4;
#pragma unroll 1
    for (;;) { const int f = next_unit(ctr + 0, lds); if (f >= 512) break; const int qb = 15 - (f >> 5), bh = f & 31; fox_unit(p, L, bh >> 2, bh & 3, qb, lds); }
#pragma unroll 1
    for (;;) { const int n = next_unit(ctr + 1, lds); if (n >= 1024) break; const int blk = 63 - (n >> 4), bg = n & 15; nsa_unit(p, L, bg >> 1, bg & 1, blk, lds); }
#pragma unroll 1
    for (;;) { const int c = next_unit(ctr + 2, lds); if (c >= 1024) break;
#pragma unroll 1
        for (int u = c * 2; u < c * 2 + 2; ++u) hgrn_c_unit(p, L, u, lds); }
}

__device__ void run_phase(const Params& p, int ph, char* lds) {
    if (ph == 0) { prep_phase(p, lds); return; }
    const int L = (ph - 1) / 7, s = (ph - 1) % 7;
    switch (s) {
        case 0: gemm_phase<EPI_PROJ>(p, L, lds); break;
        case 1: mixA_phase(p, L, lds); break;
        case 2: hgrn_scan_phase(p); break;
        case 3: mixB_phase(p, L, lds); break;
        case 4: gemm_phase<EPI_WO>(p, L, lds); break;
        case 5: gemm_phase<EPI_UP>(p, L, lds); break;
        default: gemm_phase<EPI_DOWN>(p, L, lds); break;
    }
}

__global__ void __launch_bounds__(256, 2) fwd_kernel(Params p, int ph_lo, int ph_hi) {
    __shared__ __attribute__((aligned(16))) char lds[LDS_BYTES];
    for (int ph = ph_lo; ph < ph_hi; ++ph) {
#ifdef REPEAT_MASK
        const int nrep = (ph >= 1 && ((REPEAT_MASK >> ((ph - 1) % 7)) & 1)) ? 2 : 1;
#pragma unroll 1
        for (int rep = 0; rep < nrep; ++rep) {
            if (rep) cg::this_grid().sync();
            run_phase(p, ph, lds);
        }
#else
        run_phase(p, ph, lds);
#endif
        if (ph + 1 < ph_hi) { cg::this_grid().sync(); }
    }
}

extern "C" void kernel_launch(void* const* d_in, const int* in_sizes, int n_in, void* d_out, int out_size, void* d_ws, size_t ws_size,
                              hipStream_t stream) {
    if (ws_size < WS_NEED) { fprintf(stderr, "workspace too small: %zu < %zu\n", ws_size, (size_t)WS_NEED); return; }
    Params p{};
    p.x = (const float*)d_in[0]; p.norm1_g = (const float*)d_in[1]; p.w_in = (const float*)d_in[2]; p.lb_logits = (const float*)d_in[3];
    p.onorm_g = (const float*)d_in[4]; p.nsa_qn_g = (const float*)d_in[5]; p.nsa_kn_g = (const float*)d_in[6]; p.cmp_pos = (const float*)d_in[7];
    p.cmp_w1 = (const float*)d_in[8]; p.cmp_w2 = (const float*)d_in[9]; p.fox_qn_g = (const float*)d_in[10]; p.fox_kn_g = (const float*)d_in[11];
    p.fox_fb = (const float*)d_in[12]; p.w_o = (const float*)d_in[13]; p.norm2_g = (const float*)d_in[14]; p.w_up = (const float*)d_in[15];
    p.w_down = (const float*)d_in[16];
    p.out = (float*)d_out; p.ws = (char*)d_ws;
#if MULTI_LAUNCH
    for (int ph = 0; ph < NPHASE; ++ph) hipLaunchKernelGGL(fwd_kernel, dim3(512), dim3(256), 0, stream, p, ph, ph + 1);
#else
    static int grid_blocks = 0;
    if (!grid_blocks) {
        int dev = 0, cus = 0, per_cu = 0;
        hipGetDevice(&dev);
        hipDeviceGetAttribute(&cus, hipDeviceAttributeMultiprocessorCount, dev);
        hipOccupancyMaxActiveBlocksPerMultiprocessor(&per_cu, fwd_kernel, 256, 0);
        per_cu = 2;
        grid_blocks = cus * per_cu;
        grid_blocks &= ~7;
    }
    int lo = 0, hi = NPHASE;
    void* args[] = {&p, &lo, &hi};
    hipError_t e = hipLaunchCooperativeKernel((void*)fwd_kernel, dim3(grid_blocks), dim3(256), args, 0, stream);
    if (e != hipSuccess) fprintf(stderr, "cooperative launch failed: %s (grid %d)\n", hipGetErrorString(e), grid_blocks);
#endif
}
```

```cpp
#include <hip/hip_runtime.h>
#include <hip/hip_cooperative_groups.h>
#include <stdint.h>
#include <cstdio>
namespace cg = cooperative_groups;

#ifndef MULTI_LAUNCH
#define MULTI_LAUNCH 0
#endif

typedef unsigned short bf16_t;
typedef short bf16x8 __attribute__((ext_vector_type(8)));
typedef float f32x4 __attribute__((ext_vector_type(4)));
typedef unsigned long long u64;
typedef __attribute__((address_space(3))) unsigned* ldsp_t;
typedef unsigned u32x16 __attribute__((ext_vector_type(16)));
typedef unsigned u32x8 __attribute__((ext_vector_type(8)));
#define DEVI __device__ __forceinline__

constexpr int T_TOK = 32768, SEQ = 4096, DM = 1024, DFF = 4096;
constexpr int PJ_LD = 3072;
constexpr int NW_IN = 3100, NW_IN_PAD = 3328;
constexpr int NPHASE = 15;

constexpr size_t OFF_WIN = 0;
constexpr size_t OFF_WO = OFF_WIN + (size_t)2 * NW_IN_PAD * 1024 * 2;
constexpr size_t OFF_WUP = OFF_WO + (size_t)2 * 1024 * 1024 * 2;
constexpr size_t OFF_WDN = OFF_WUP + (size_t)2 * 4096 * 1024 * 2;
constexpr size_t OFF_W1T = OFF_WDN + (size_t)2 * 4096 * 1024 * 2;
constexpr size_t OFF_W2T = OFF_W1T + (size_t)2 * 2 * 128 * 2048 * 2;
constexpr size_t OFF_CBIAS = OFF_W2T + (size_t)2 * 2 * 64 * 128 * 2;
constexpr size_t OFF_CTR = OFF_CBIAS + 2048;
constexpr size_t OFF_ROPE = OFF_CTR + 256;
constexpr size_t OFF_GATES = OFF_ROPE + (size_t)4096 * 16 * 4;
constexpr size_t OFF_FOXC = OFF_GATES + (size_t)T_TOK * 32 * 4;
constexpr size_t OFF_KC = OFF_FOXC + (size_t)8 * 4 * 4096 * 4;
constexpr size_t OFF_VCT = OFF_KC + (size_t)8 * 2 * 256 * 64 * 2;
constexpr size_t OFF_DECAY = OFF_VCT + (size_t)8 * 2 * 256 * 64 * 2;
constexpr size_t OFF_KVT = OFF_DECAY + (size_t)2048 * 64 * 4;
constexpr size_t OFF_ST = OFF_KVT + (size_t)2048 * 4096 * 4;
constexpr size_t OFF_ACT = OFF_ST + (size_t)2048 * 4096 * 2;
constexpr size_t OFF_BIG = OFF_ACT + (size_t)T_TOK * 1024 * 2;
constexpr size_t OFF_VT_IN_BIG = (size_t)T_TOK * PJ_LD * 2;
constexpr size_t OFF_ACT2 = OFF_BIG + (size_t)T_TOK * 4096 * 2;
constexpr size_t OFF_SSQ = OFF_ACT2 + (size_t)T_TOK * 1024 * 2;
constexpr size_t OFF_XBAR = OFF_SSQ + (size_t)T_TOK * 16 * 4;
constexpr size_t WS_NEED = OFF_XBAR + 65536;

constexpr int LDS_BYTES = 67584;

struct Params {
    const float *x, *norm1_g, *w_in, *lb_logits, *onorm_g, *nsa_qn_g, *nsa_kn_g, *cmp_pos, *cmp_w1, *cmp_w2,
        *fox_qn_g, *fox_kn_g, *fox_fb, *w_o, *norm2_g, *w_up, *w_down;
    float* out;
    char* ws;
};

DEVI unsigned pk2(float lo, float hi) { unsigned r; asm("v_cvt_pk_bf16_f32 %0, %1, %2" : "=v"(r) : "v"(lo), "v"(hi)); return r; }
DEVI bf16_t f2bf(float f) { return (bf16_t)(pk2(f, 0.f) & 0xffffu); }
DEVI float bf2f(bf16_t h) { return __uint_as_float(((unsigned)h) << 16); }
DEVI float bflo(unsigned u) { return __uint_as_float(u << 16); }
DEVI float bfhi(unsigned u) { return __uint_as_float(u & 0xffff0000u); }
DEVI f32x4 mfma(bf16x8 a, bf16x8 b, f32x4 c) { return __builtin_amdgcn_mfma_f32_16x16x32_bf16(a, b, c, 0, 0, 0); }
DEVI int otid() { int t; asm volatile("v_mov_b32 %0, %1" : "=v"(t) : "v"(threadIdx.x)); return t; }
DEVI float wave_sum(float v) {
#pragma unroll
    for (int o = 32; o >= 1; o >>= 1) v += __shfl_xor(v, o);
    return v;
}
DEVI bf16x8 mk8(unsigned a, unsigned b, unsigned c, unsigned d) {
    uint4 u = make_uint4(a, b, c, d);
    return *(bf16x8*)&u;
}
DEVI bf16x8 ld8(const bf16_t* p) { uint4 u = *(const uint4*)p; return *(bf16x8*)&u; }
DEVI bf16x8 ld4x2(const bf16_t* p0, const bf16_t* p1) {
    uint2 a = *(const uint2*)p0, b = *(const uint2*)p1;
    return mk8(a.x, a.y, b.x, b.y);
}

DEVI int win_colmap(int n) {
    if (n < 2304) return n;
    if (n < 3072) return n + 24;
    if (n < 3096) return n - 768;
    return n;
}
__device__ void transpose_tile(const float* __restrict__ src, int ld_src, bf16_t* __restrict__ dst, int ld_dst, int k0, int n0, int nvalid,
                               int colmode, float* tile) {
    const int tid = otid();
    for (int idx = tid; idx < 4096; idx += 256) {
        const int i = idx >> 6, j = idx & 63, n = n0 + j;
        float v = 0.f;
        if (n < nvalid) v = src[(size_t)(k0 + i) * ld_src + (colmode ? win_colmap(n) : n)];
        tile[i * 65 + j] = v;
    }
    __syncthreads();
    for (int idx = tid; idx < 4096; idx += 256) {
        const int j = idx >> 6, i = idx & 63;
        dst[(size_t)(n0 + j) * ld_dst + k0 + i] = f2bf(tile[i * 65 + j]);
    }
    __syncthreads();
}

__device__ void norm_phase(const float* __restrict__ xin, const float* __restrict__ g, bf16_t* __restrict__ hout) {
    const int tid = otid(); const int lane = tid & 63, w = tid >> 6;
    for (int row = blockIdx.x * 4 + w; row < T_TOK; row += gridDim.x * 4) {
        const float4* xr = (const float4*)(xin + (size_t)row * DM);
        float4 v[4]; float ss = 0.f;
#pragma unroll
        for (int i = 0; i < 4; ++i) { v[i] = xr[lane + 64 * i]; ss += v[i].x * v[i].x + v[i].y * v[i].y + v[i].z * v[i].z + v[i].w * v[i].w; }
        ss = wave_sum(ss);
        const float r = rsqrtf(ss * (1.0f / 1024.0f) + 1e-6f);
#pragma unroll
        for (int i = 0; i < 4; ++i) {
            const float4 gg = ((const float4*)g)[lane + 64 * i];
            uint2 o; o.x = pk2(v[i].x * r * gg.x, v[i].y * r * gg.y); o.y = pk2(v[i].z * r * gg.z, v[i].w * r * gg.w);
            *(uint2*)(hout + (size_t)row * DM + (lane + 64 * i) * 4) = o;
        }
    }
}

__device__ void prep_phase(const Params& p, char* lds) {
    float* tile = (float*)lds;
    if (blockIdx.x == 0 && otid() < 64) ((unsigned*)(p.ws + OFF_CTR))[otid()] = 0u;
    if (blockIdx.x == 1) { for (int i = otid(); i < 16384; i += 256) ((unsigned*)(p.ws + OFF_XBAR))[i] = 0u; }
    bf16_t* win_t = (bf16_t*)(p.ws + OFF_WIN); bf16_t* wo_t = (bf16_t*)(p.ws + OFF_WO);
    bf16_t* wup_t = (bf16_t*)(p.ws + OFF_WUP); bf16_t* wdn_t = (bf16_t*)(p.ws + OFF_WDN);
    bf16_t* w1t = (bf16_t*)(p.ws + OFF_W1T); bf16_t* w2t = (bf16_t*)(p.ws + OFF_W2T);
    const int J0 = 1664, J1 = J0 + 512, J2 = J1 + 2048, J3 = J2 + 2048, J4 = J3 + 256, J5 = J4 + 8, J6 = J5 + 128, J7 = J6 + 128;
    for (int job = blockIdx.x; job < J7; job += gridDim.x) {
        if (job < J0) { const int L = job / 832, r = job % 832, kt = r / 52, nt = r % 52;
            transpose_tile(p.w_in + (size_t)L * 1024 * NW_IN, NW_IN, win_t + (size_t)L * NW_IN_PAD * 1024, 1024, kt * 64, nt * 64, NW_IN, 1, tile);
        } else if (job < J1) { const int j = job - J0, L = j / 256, r = j % 256, kt = r / 16, nt = r % 16;
            transpose_tile(p.w_o + (size_t)L * 1024 * 1024, 1024, wo_t + (size_t)L * 1024 * 1024, 1024, kt * 64, nt * 64, 1024, 0, tile);
        } else if (job < J2) { const int j = job - J1, L = j / 1024, r = j % 1024, kt = r / 64, nt = r % 64;
            transpose_tile(p.w_up + (size_t)L * 1024 * 4096, 4096, wup_t + (size_t)L * 4096 * 1024, 1024, kt * 64, nt * 64, 4096, 0, tile);
        } else if (job < J3) { const int j = job - J2, L = j / 1024, r = j % 1024, kt = r / 16, nt = r % 16;
            transpose_tile(p.w_down + (size_t)L * 4096 * 1024, 1024, wdn_t + (size_t)L * 1024 * 4096, 4096, kt * 64, nt * 64, 1024, 0, tile);
        } else if (job < J4) { const int j = job - J3, lw = j / 64, r = j % 64, kt = r / 2, nt = r % 2;
            transpose_tile(p.cmp_w1 + (size_t)lw * 2048 * 128, 128, w1t + (size_t)lw * 128 * 2048, 2048, kt * 64, nt * 64, 128, 0, tile);
        } else if (job < J5) { const int j = job - J4, lw = j / 2, kt = j % 2;
            transpose_tile(p.cmp_w2 + (size_t)lw * 128 * 64, 64, w2t + (size_t)lw * 64 * 128, 128, kt * 64, 0, 64, 0, tile);
        } else if (job < J6) {
            const int t_ = otid(); const int o = (job - J5) * 4 + (t_ >> 6), lane = t_ & 63, lw = o >> 7, hid = o & 127;
            const float* pos = p.cmp_pos + (size_t)lw * 2048; const float* w1 = p.cmp_w1 + (size_t)lw * 2048 * 128 + hid;
            float s = 0.f;
            for (int k = lane; k < 2048; k += 64) s += pos[k] * w1[(size_t)k * 128];
            s = wave_sum(s);
            if (lane == 0) ((float*)(p.ws + OFF_CBIAS))[o] = s;
        } else {
            const int e = (job - J6) * 256 + otid(), pos = e >> 3, i = e & 7;
            const float invf[8] = {1.0f, 0.1939227432012558f, 0.03760603070259094f, 0.007292664609849453f, 0.0014142135623842478f,
                                   0.00027424818836152554f, 5.318296098266728e-05f, 1.0313386155758053e-05f};
            float fr = 1.0f;
#pragma unroll
            for (int q = 0; q < 8; ++q) if (i == q) fr = invf[q];
            const float ang = (float)pos * fr;
            const double a = (double)ang; const double n = rint(a * 0.15915494309189535); const float rr = (float)(a - n * 6.283185307179586);
            float* rt = (float*)(p.ws + OFF_ROPE);
            rt[pos * 16 + i] = __cosf(rr); rt[pos * 16 + 8 + i] = __sinf(rr);
        }
    }
    norm_phase(p.x, p.norm1_g, (bf16_t*)(p.ws + OFF_ACT));
}

enum { EPI_PROJ = 0, EPI_WO = 1, EPI_UP = 2, EPI_DOWN = 3 };

DEVI float row_rstd(const float* ssq, int m) {
    const float4 a = *(const float4*)(ssq + (size_t)m * 16), b = *(const float4*)(ssq + (size_t)m * 16 + 4), c = *(const float4*)(ssq + (size_t)m * 16 + 8), d = *(const float4*)(ssq + (size_t)m * 16 + 12);
    const float t = ((a.x + a.y) + (a.z + a.w)) + ((b.x + b.y) + (b.z + b.w)) + ((c.x + c.y) + (c.z + c.w)) + ((d.x + d.y) + (d.z + d.w));
    return rsqrtf(t * (1.0f / 1024.0f) + 1e-6f);
}

template <int CH>
DEVI void proj_epilogue(const Params& p, int L, const f32x4 (&acc)[4][8], int m0w, int cc, int lane) {
    const int quad = lane >> 4, l15 = lane & 15;
    bf16_t* proj = (bf16_t*)(p.ws + OFF_BIG); bf16_t* VT = (bf16_t*)(p.ws + OFF_BIG + OFF_VT_IN_BIG);
    float* gates = (float*)(p.ws + OFF_GATES); const float* rope = (const float*)(p.ws + OFF_ROPE);
    if (cc > 48) return;
    int kind = 0, vidx = 0; const float* gain = nullptr; float scale = 1.f; bool dorope = false;
    if (cc >= 8 && cc < 12) { kind = 5; vidx = cc - 8; }
    else if (cc >= 16 && cc < 24) { kind = 1; gain = p.nsa_qn_g + L * 64; scale = 0.125f * 1.4426950408889634f; dorope = true; }
    else if (cc == 28 || cc == 29 || cc == 32 || cc == 33) { kind = 1; gain = p.nsa_kn_g + L * 64; dorope = true; }
    else if (cc == 30 || cc == 31) { kind = 5; vidx = 4 + (cc - 30); }
    else if (cc == 34 || cc == 35) { kind = 5; vidx = 6 + (cc - 34); }
    else if (cc >= 36 && cc < 40) { kind = 1; gain = p.fox_qn_g + L * 64; scale = 0.125f * 1.4426950408889634f; }
    else if (cc >= 40 && cc < 44) { kind = 1; gain = p.fox_kn_g + L * 64; }
    else if (cc >= 44 && cc < 48) { kind = 5; vidx = 8 + (cc - 44); }
    else if (cc == 48) kind = 6;
#pragma unroll
    for (int mi = 0; mi < 4; ++mi) {
        const int token = m0w + mi * 16 + l15, pos = token & 4095, bb = token >> 12;
        const float rs = (L > 0) ? row_rstd((const float*)(p.ws + OFF_SSQ), token) : 1.0f;
        float v[4][4];
#pragma unroll
        for (int ni = 0; ni < 4; ++ni)
#pragma unroll
            for (int j = 0; j < 4; ++j) v[ni][j] = acc[mi][CH * 4 + ni][j] * rs;
        if (kind == 6) {
#pragma unroll
            for (int ni = 0; ni < 2; ++ni)
#pragma unroll
                for (int j = 0; j < 4; ++j) { const int d = ni * 16 + quad * 4 + j;
                    if (d < 24) gates[(size_t)token * 32 + d] = 1.0f / (1.0f + __expf(-v[ni][j]));
                    else if (d < 28) gates[(size_t)token * 32 + d] = v[ni][j]; }
            asm volatile("" ::: "memory");
            continue;
        }
        if (kind == 1) {
            float ss = 0.f;
#pragma unroll
            for (int ni = 0; ni < 4; ++ni)
#pragma unroll
                for (int j = 0; j < 4; ++j) ss += v[ni][j] * v[ni][j];
            ss += __shfl_xor(ss, 16); ss += __shfl_xor(ss, 32);
            const float r = rsqrtf(ss * (1.0f / 64.0f) + 1e-6f);
#pragma unroll
            for (int ni = 0; ni < 4; ++ni) { const float4 gg = *(const float4*)(gain + ni * 16 + quad * 4);
                v[ni][0] *= r * gg.x; v[ni][1] *= r * gg.y; v[ni][2] *= r * gg.z; v[ni][3] *= r * gg.w; }
            if (dorope) {
                const float4 cs = *(const float4*)(rope + pos * 16 + (quad & 1) * 4), sn = *(const float4*)(rope + pos * 16 + 8 + (quad & 1) * 4);
                const float cv[4] = {cs.x, cs.y, cs.z, cs.w}, sv[4] = {sn.x, sn.y, sn.z, sn.w};
#pragma unroll
                for (int j = 0; j < 4; ++j) { const float xx = v[0][j], pp = __shfl_xor(xx, 32);
                    v[0][j] = (quad < 2) ? (xx * cv[j] - pp * sv[j]) : (xx * cv[j] + pp * sv[j]); }
            }
#pragma unroll
            for (int ni = 0; ni < 4; ++ni)
#pragma unroll
                for (int j = 0; j < 4; ++j) v[ni][j] *= scale;
        }
        if (kind == 5) {
#pragma unroll
            for (int ni = 0; ni < 4; ++ni)
#pragma unroll
                for (int j = 0; j < 4; ++j) { const int d = ni * 16 + quad * 4 + j;
                    VT[((size_t)(vidx * 8 + bb) * 64 + d) * 4096 + pos] = f2bf(v[ni][j]); }
        } else {
#pragma unroll
            for (int ni = 0; ni < 4; ++ni) { uint2 o; o.x = pk2(v[ni][0], v[ni][1]); o.y = pk2(v[ni][2], v[ni][3]);
                *(uint2*)(proj + (size_t)token * PJ_LD + cc * 64 + ni * 16 + quad * 4) = o; }
        }
        asm volatile("" ::: "memory");
    }
}

DEVI void g_load(uint4 (&RA)[4], uint4 (&RB)[4], const bf16_t* Ap, const bf16_t* Bp, int K, int KT) {
#pragma unroll
    for (int i = 0; i < 4; ++i) { RA[i] = *(const uint4*)(Ap + (size_t)(32 * i) * K + KT * 64); RB[i] = *(const uint4*)(Bp + (size_t)(32 * i) * K + KT * 64); }
}
DEVI void g_swrite(const uint4 (&RA)[4], const uint4 (&RB)[4], char* d_) {
#pragma unroll
    for (int i = 0; i < 4; ++i) { *(uint4*)(d_ + i * 4096) = RA[i]; *(uint4*)(d_ + 16384 + i * 4096) = RB[i]; }
}
DEVI void g_compute(const char* sA, f32x4 (&acc)[4][4], int wm, int wn, int quad, int l15) {
    const char* sB = sA + 16384;
#pragma unroll
    for (int ks = 0; ks < 2; ++ks) {
        bf16x8 af[4], bfr[4]; const int ch = ks * 4 + quad;
#pragma unroll
        for (int mi = 0; mi < 4; ++mi) { const int row = wm * 64 + mi * 16 + l15; af[mi] = *(const bf16x8*)(sA + row * 128 + ((ch ^ (row & 7)) << 4)); }
#pragma unroll
        for (int ni = 0; ni < 4; ++ni) { const int row = wn * 64 + ni * 16 + l15; bfr[ni] = *(const bf16x8*)(sB + row * 128 + ((ch ^ (row & 7)) << 4)); }
#pragma unroll
        for (int mi = 0; mi < 4; ++mi)
#pragma unroll
            for (int ni = 0; ni < 4; ++ni) acc[mi][ni] = mfma(bfr[ni], af[mi], acc[mi][ni]);
    }
}

template <int EPI>
__device__ __forceinline__ void gemm_phase(const Params& p, int L, char* lds) {
    const bf16_t* A; const bf16_t* Bt; int K, nNt;
    if (EPI == EPI_PROJ) { A = (const bf16_t*)(p.ws + OFF_ACT); Bt = (const bf16_t*)(p.ws + OFF_WIN) + (size_t)L * NW_IN_PAD * 1024; K = 1024; nNt = NW_IN_PAD / 256; }
    else if (EPI == EPI_WO) { A = (const bf16_t*)(p.ws + OFF_ACT); Bt = (const bf16_t*)(p.ws + OFF_WO) + (size_t)L * 1024 * 1024; K = 1024; nNt = 4; }
    else if (EPI == EPI_UP) { A = (const bf16_t*)(p.ws + OFF_ACT2); Bt = (const bf16_t*)(p.ws + OFF_WUP) + (size_t)L * 4096 * 1024; K = 1024; nNt = 16; }
    else { A = (const bf16_t*)(p.ws + OFF_BIG); Bt = (const bf16_t*)(p.ws + OFF_WDN) + (size_t)L * 1024 * 4096; K = 4096; nNt = 4; }
    const int tid = otid(), lane = tid & 63, w = tid >> 6, quad = lane >> 4, l15 = lane & 15, wm = w >> 1, wn = w & 1;
    const int xcd = blockIdx.x & 7, loc = blockIdx.x >> 3, nloc = gridDim.x >> 3;
    const int nk = K / 32;
    const int gsw = (0x1230 >> (((l15 >> 2) & 3) * 4)) & 3;
    const int rsw = (quad ^ gsw) << 4;
    for (int it = loc; it < 32 * nNt; it += nloc) {
        const int tl = otid();
        const int lrow = tl >> 2, lc = tl & 3;
        const int woff = lrow * 64 + ((lc ^ ((0x1230 >> (((lrow >> 2) & 3) * 4)) & 3)) << 4);
        const int gsz = 8 * nNt, mloc = (it / gsz) * 8 + (it & 7), nloc_t = (it % gsz) >> 3;
        const int m0 = (xcd + 8 * mloc) * 128, n0 = nloc_t * 256;
        f32x4 acc[4][8];
#pragma unroll
        for (int a = 0; a < 4; ++a)
#pragma unroll
            for (int b = 0; b < 8; ++b) acc[a][b] = (f32x4){0.f, 0.f, 0.f, 0.f};
        u32x8 ra0, ra1; u32x16 rb0, rb1;
        const bf16_t* Ap = A + (size_t)(m0 + lrow) * K + lc * 8;
        const bf16_t* Bp = Bt + (size_t)(n0 + lrow) * K + lc * 8;
#define G_LD1(R, P, I, KT) { const uint4 t_ = *(const uint4*)((P) + (size_t)(64 * I) * K + (KT) * 32); R[4 * I] = t_.x; R[4 * I + 1] = t_.y; R[4 * I + 2] = t_.z; R[4 * I + 3] = t_.w; }
#define G_LOAD(RA, RB, KT) { G_LD1(RA, Ap, 0, KT) G_LD1(RB, Bp, 0, KT) G_LD1(RA, Ap, 1, KT) G_LD1(RB, Bp, 1, KT) G_LD1(RB, Bp, 2, KT) G_LD1(RB, Bp, 3, KT) }
#define G_SW1(R, D, I) *(uint4*)((D) + I * 4096) = make_uint4(R[4 * I], R[4 * I + 1], R[4 * I + 2], R[4 * I + 3]);
#define G_SWRITE(RA, RB, DST) { G_SW1(RA, DST, 0) G_SW1(RB, (DST) + 8192, 0) G_SW1(RA, DST, 1) G_SW1(RB, (DST) + 8192, 1) G_SW1(RB, (DST) + 8192, 2) G_SW1(RB, (DST) + 8192, 3) }
#define G_COMPUTE(BUF) { const char* sA_ = (BUF) + (wm * 64 + l15) * 64 + rsw; const char* sB_ = (BUF) + 8192 + (wn * 128 + l15) * 64 + rsw; \
            bf16x8 af[4]; \
            _Pragma("unroll") for (int i_ = 0; i_ < 4; ++i_) af[i_] = *(const bf16x8*)(sA_ + i_ * 1024); \
            _Pragma("unroll") for (int nh = 0; nh < 2; ++nh) { bf16x8 bfr[4]; \
                _Pragma("unroll") for (int i_ = 0; i_ < 4; ++i_) bfr[i_] = *(const bf16x8*)(sB_ + (nh * 4 + i_) * 1024); \
                _Pragma("unroll") for (int mi = 0; mi < 4; ++mi) _Pragma("unroll") for (int ni = 0; ni < 4; ++ni) acc[mi][nh * 4 + ni] = mfma(bfr[ni], af[mi], acc[mi][nh * 4 + ni]); } }
        G_LOAD(ra0, rb0, 0)
        G_LOAD(ra1, rb1, 1)
        G_SWRITE(ra0, rb0, lds + woff)
        __syncthreads();
#pragma unroll 1
        for (int kt = 0; kt < nk - 2; kt += 2) {
            G_LOAD(ra0, rb0, kt + 2)
            __builtin_amdgcn_sched_barrier(0);
            G_COMPUTE(lds)
            G_SWRITE(ra1, rb1, lds + 24576 + woff)
            __syncthreads();
            G_LOAD(ra1, rb1, kt + 3)
            __builtin_amdgcn_sched_barrier(0);
            G_COMPUTE(lds + 24576)
            G_SWRITE(ra0, rb0, lds + woff)
            __syncthreads();
        }
        G_COMPUTE(lds)
        G_SWRITE(ra1, rb1, lds + 24576 + woff)
        __syncthreads();
        G_COMPUTE(lds + 24576)
        __syncthreads();
#undef G_LOAD
#undef G_SWRITE
#undef G_LD1
#undef G_SW1
#undef G_COMPUTE
        const int te = otid(); const int lane_e = te & 63, quad_e = lane_e >> 4, l15_e = lane_e & 15;
        const int mw = m0 + ((te >> 7) & 1) * 64, nw = n0 + ((te >> 6) & 1) * 128;
        if (EPI == EPI_PROJ) {
            proj_epilogue<0>(p, L, acc, mw, (nw >> 6), lane_e);
            proj_epilogue<1>(p, L, acc, mw, (nw >> 6) + 1, lane_e);
        } else if (EPI == EPI_UP) {
            bf16_t* hid = (bf16_t*)(p.ws + OFF_BIG);
#pragma unroll
            for (int mi = 0; mi < 4; ++mi) { const int m = mw + mi * 16 + l15_e; const float r = row_rstd((const float*)(p.ws + OFF_SSQ), m);
#pragma unroll
                for (int ni = 0; ni < 8; ++ni) { const int n = nw + ni * 16 + quad_e * 4;
                    float a0 = fmaxf(acc[mi][ni][0] * r, 0.f), a1 = fmaxf(acc[mi][ni][1] * r, 0.f), a2 = fmaxf(acc[mi][ni][2] * r, 0.f), a3 = fmaxf(acc[mi][ni][3] * r, 0.f);
                    uint2 o; o.x = pk2(a0 * a0, a1 * a1); o.y = pk2(a2 * a2, a3 * a3);
                    *(uint2*)(hid + (size_t)m * DFF + n) = o; } }
        } else {
            const float* xin = (EPI == EPI_WO && L == 0) ? p.x : p.out;
            const bool emit = (EPI == EPI_WO) || (L + 1 < 2);
            const float* gn = (EPI == EPI_WO) ? (p.norm2_g + L * 1024) : (p.norm1_g + (L + 1 < 2 ? L + 1 : L) * 1024);
            bf16_t* hn = (bf16_t*)(p.ws + ((EPI == EPI_WO) ? OFF_ACT2 : OFF_ACT));
            float* ssq = (float*)(p.ws + OFF_SSQ);
#pragma unroll
            for (int mi = 0; mi < 4; ++mi) {
#pragma unroll
                for (int hf = 0; hf < 2; ++hf) {
                    const int t3 = otid(); const int l15_e = t3 & 15, quad_e = (t3 >> 4) & 3;
                    const int m = mw + mi * 16 + l15_e;
                    float ss = 0.f;
#pragma unroll
                    for (int n4 = 0; n4 < 4; ++n4) { const int ni = hf * 4 + n4; const int n = nw + ni * 16 + quad_e * 4;
                        float4 xv = *(const float4*)(xin + (size_t)m * DM + n);
                        xv.x += acc[mi][ni][0]; xv.y += acc[mi][ni][1]; xv.z += acc[mi][ni][2]; xv.w += acc[mi][ni][3];
                        *(float4*)(p.out + (size_t)m * DM + n) = xv;
                        if (emit) { const float4 gg = *(const float4*)(gn + n);
                            uint2 o; o.x = pk2(xv.x * gg.x, xv.y * gg.y); o.y = pk2(xv.z * gg.z, xv.w * gg.w);
                            *(uint2*)(hn + (size_t)m * DM + n) = o;
                            ss += (xv.x * xv.x + xv.y * xv.y) + (xv.z * xv.z + xv.w * xv.w); } }
                    if (emit) { ss += __shfl_xor(ss, 16); ss += __shfl_xor(ss, 32);
                        if (quad_e == 0) ssq[(size_t)m * 16 + ((nw >> 6) + hf)] = ss; }
                    asm volatile("" ::: "memory");
                }
            }
        }
    }
}

DEVI float hgrn_lb(const Params& p, int L, int hk) {
    if (L == 0) return 0.f;
    const float l0 = p.lb_logits[hk], l1 = p.lb_logits[256 + hk];
    return 1.0f / (1.0f + __expf(l0 - l1));
}

__device__ void hgrn_a_unit(const Params& p, int L, int u, char* lds) {
    const int tid = otid(), lane = tid & 63, w = tid >> 6, quad = lane >> 4, l15 = lane & 15;
    const int c = u & 63, h = (u >> 6) & 3, b = u >> 8;
    const bf16_t* proj = (const bf16_t*)(p.ws + OFF_BIG); const bf16_t* VT = (const bf16_t*)(p.ws + OFF_BIG + OFF_VT_IN_BIG);
    float* segtot = (float*)lds;
    bf16_t* KDt = (bf16_t*)(lds + 1024);
    const int k = tid & 63, seg = tid >> 6;
    const float lb = hgrn_lb(p, L, h * 64 + k);
    float gl[16], kkv[16]; float run = 0.f;
    const bf16_t* zp = proj + (size_t)(b * 4096 + c * 64 + seg * 16) * PJ_LD + 256 + h * 64 + k;
#pragma unroll
    for (int i = 0; i < 16; ++i) {
        const float z = bf2f(zp[(size_t)i * PJ_LD]);
        const float sg = 1.0f / (1.0f + __expf(-z)), sn = 1.0f / (1.0f + __expf(z));
        const float f = lb + (1.0f - lb) * sg;
        run += __logf(fmaxf(f, 1e-30f)); gl[i] = run; kkv[i] = (1.0f - lb) * sn;
    }
    segtot[seg * 64 + k] = run;
    __syncthreads();
    float off = 0.f, tot = 0.f;
#pragma unroll
    for (int s = 0; s < 4; ++s) { const float t = segtot[s * 64 + k]; tot += t; if (s < seg) off += t; }
    unsigned pkd[8];
#pragma unroll
    for (int i = 0; i < 8; ++i) {
        const float a0 = kkv[2 * i] * __expf(tot - (off + gl[2 * i])), a1 = kkv[2 * i + 1] * __expf(tot - (off + gl[2 * i + 1]));
        pkd[i] = pk2(a0, a1);
    }
    *(uint4*)(KDt + k * 72 + seg * 16) = make_uint4(pkd[0], pkd[1], pkd[2], pkd[3]);
    *(uint4*)(KDt + k * 72 + seg * 16 + 8) = make_uint4(pkd[4], pkd[5], pkd[6], pkd[7]);
    if (seg == 0) ((float*)(p.ws + OFF_DECAY))[u * 64 + k] = __expf(tot);
    __syncthreads();
    const bf16_t* vt = VT + ((size_t)(h * 8 + b) * 64) * 4096 + c * 64;
    float* kvt = (float*)(p.ws + OFF_KVT) + (size_t)u * 4096;
    bf16x8 af[2];
#pragma unroll
    for (int ks = 0; ks < 2; ++ks) af[ks] = ld8(vt + (size_t)(w * 16 + l15) * 4096 + ks * 32 + quad * 8);
#pragma unroll
    for (int kt = 0; kt < 4; ++kt) {
        f32x4 acc = (f32x4){0.f, 0.f, 0.f, 0.f};
#pragma unroll
        for (int ks = 0; ks < 2; ++ks) { const bf16x8 bfr = *(const bf16x8*)(KDt + (kt * 16 + l15) * 72 + ks * 32 + quad * 8); acc = mfma(af[ks], bfr, acc); }
#pragma unroll
        for (int j = 0; j < 4; ++j) kvt[(w * 16 + quad * 4 + j) * 64 + kt * 16 + l15] = acc[j];
    }
    __syncthreads();
}

__device__ void hgrn_scan_phase(const Params& p) {
    const float* kvt = (const float*)(p.ws + OFF_KVT); const float* dec = (const float*)(p.ws + OFF_DECAY);
    bf16_t* st = (bf16_t*)(p.ws + OFF_ST);
    for (int e = blockIdx.x * 256 + otid(); e < 32 * 4096; e += gridDim.x * 256) {
        const int bh = e >> 12, vk = e & 4095, k = vk & 63;
        float S = 0.f;
#pragma unroll 8
        for (int c = 0; c < 64; ++c) {
            const int u = bh * 64 + c;
            st[(size_t)u * 4096 + vk] = f2bf(S);
            S = S * dec[u * 64 + k] + kvt[(size_t)u * 4096 + vk];
        }
    }
}

__device__ void hgrn_c_unit(const Params& p, int L, int u, char* lds) {
    const int tid = otid(), lane = tid & 63, w = tid >> 6, quad = lane >> 4, l15 = lane & 15;
    const int c = u & 63, h = (u >> 6) & 3, b = u >> 8;
    const bf16_t* proj = (const bf16_t*)(p.ws + OFF_BIG); const bf16_t* VT = (const bf16_t*)(p.ws + OFF_BIG + OFF_VT_IN_BIG);
    float* Gs = (float*)lds; float* KKs = Gs + 64 * 65; float* Qs = KKs + 64 * 65; float* segtot = Qs + 64 * 65;
    {
        const int k = tid & 63, seg = tid >> 6;
        const float lb = hgrn_lb(p, L, h * 64 + k);
        float gl[16], kkv[16]; float run = 0.f;
        const bf16_t* zp = proj + (size_t)(b * 4096 + c * 64 + seg * 16) * PJ_LD + 256 + h * 64 + k;
#pragma unroll
        for (int i = 0; i < 16; ++i) {
            const float z = bf2f(zp[(size_t)i * PJ_LD]);
            const float sg = 1.0f / (1.0f + __expf(-z)), sn = 1.0f / (1.0f + __expf(z));
            const float f = lb + (1.0f - lb) * sg;
            run += __logf(fmaxf(f, 1e-30f)); gl[i] = run; kkv[i] = (1.0f - lb) * sn;
            Qs[(seg * 16 + i) * 65 + k] = bf2f(zp[(size_t)i * PJ_LD - 256]) * 0.125f;
        }
        segtot[seg * 64 + k] = run;
        __syncthreads();
        float off = 0.f;
#pragma unroll
        for (int s = 0; s < 4; ++s) { const float t = segtot[s * 64 + k]; if (s < seg) off += t; }
#pragma unroll
        for (int i = 0; i < 16; ++i) { Gs[(seg * 16 + i) * 65 + k] = off + gl[i]; KKs[(seg * 16 + i) * 65 + k] = kkv[i]; }
        __syncthreads();
    }
    const int I = w;
    const int tq = 16 * I + l15;
    bf16x8 qt[2], qg[2];
#pragma unroll
    for (int ks = 0; ks < 2; ++ks) {
        float a[8], g8[8];
#pragma unroll
        for (int j = 0; j < 8; ++j) {
            const int k = ks * 32 + quad * 8 + j;
            const float G = Gs[tq * 65 + k], q = Qs[tq * 65 + k];
            const float gref = (I == 0) ? 0.f : Gs[(16 * I - 1) * 65 + k];
            a[j] = q * __expf(G - gref); g8[j] = q * __expf(G);
        }
        qt[ks] = mk8(pk2(a[0], a[1]), pk2(a[2], a[3]), pk2(a[4], a[5]), pk2(a[6], a[7]));
        qg[ks] = mk8(pk2(g8[0], g8[1]), pk2(g8[2], g8[3]), pk2(g8[4], g8[5]), pk2(g8[6], g8[7]));
    }
    f32x4 O[4];
#pragma unroll
    for (int vt = 0; vt < 4; ++vt) O[vt] = (f32x4){0.f, 0.f, 0.f, 0.f};
    const bf16_t* st = (const bf16_t*)(p.ws + OFF_ST) + (size_t)u * 4096;
#pragma unroll
    for (int vt = 0; vt < 4; ++vt)
#pragma unroll
        for (int ks = 0; ks < 2; ++ks) O[vt] = mfma(ld8(st + (vt * 16 + l15) * 64 + ks * 32 + quad * 8), qg[ks], O[vt]);
    const bf16_t* vtp = VT + ((size_t)(h * 8 + b) * 64) * 4096 + c * 64;
    for (int Jp = 0; Jp <= (I >> 1); ++Jp) {
        f32x4 sc[2];
#pragma unroll
        for (int jj = 0; jj < 2; ++jj) {
            const int J = 2 * Jp + jj;
            sc[jj] = (f32x4){0.f, 0.f, 0.f, 0.f};
            if (J <= I) {
                const int s = 16 * J + l15;
#pragma unroll
                for (int ks = 0; ks < 2; ++ks) {
                    float a[8];
#pragma unroll
                    for (int j = 0; j < 8; ++j) {
                        const int k = ks * 32 + quad * 8 + j;
                        const float gref = (I == 0) ? 0.f : Gs[(16 * I - 1) * 65 + k];
                        a[j] = KKs[s * 65 + k] * __expf(gref - Gs[s * 65 + k]);
                    }
                    sc[jj] = mfma(mk8(pk2(a[0], a[1]), pk2(a[2], a[3]), pk2(a[4], a[5]), pk2(a[6], a[7])), qt[ks], sc[jj]);
                }
#pragma unroll
                for (int j = 0; j < 4; ++j) { const int s2 = 16 * J + quad * 4 + j; if (s2 > tq) sc[jj][j] = 0.f; }
            }
        }
        const bf16x8 P = mk8(pk2(sc[0][0], sc[0][1]), pk2(sc[0][2], sc[0][3]), pk2(sc[1][0], sc[1][1]), pk2(sc[1][2], sc[1][3]));
#pragma unroll
        for (int vt = 0; vt < 4; ++vt) {
            const bf16_t* r = vtp + (size_t)(vt * 16 + l15) * 4096 + 32 * Jp + quad * 4;
            O[vt] = mfma(ld4x2(r, r + 16), P, O[vt]);
        }
    }
    float ss = 0.f;
#pragma unroll
    for (int vt = 0; vt < 4; ++vt)
#pragma unroll
        for (int j = 0; j < 4; ++j) ss += O[vt][j] * O[vt][j];
    ss += __shfl_xor(ss, 16); ss += __shfl_xor(ss, 32);
    const float r = rsqrtf(ss * (1.0f / 64.0f) + 1e-6f);
    const size_t token = (size_t)b * 4096 + c * 64 + tq;
    bf16_t* mix = (bf16_t*)(p.ws + OFF_ACT);
#pragma unroll
    for (int vt = 0; vt < 4; ++vt) {
        const int v0 = vt * 16 + quad * 4;
        const float4 og = *(const float4*)(p.onorm_g + L * 64 + v0);
        const uint2 gz = *(const uint2*)(proj + token * PJ_LD + 768 + h * 64 + v0);
        const float g0 = bflo(gz.x), g1 = bfhi(gz.x), g2 = bflo(gz.y), g3 = bfhi(gz.y);
        const float o0 = O[vt][0] * r * og.x * (g0 / (1.0f + __expf(-g0))), o1 = O[vt][1] * r * og.y * (g1 / (1.0f + __expf(-g1)));
        const float o2 = O[vt][2] * r * og.z * (g2 / (1.0f + __expf(-g2))), o3 = O[vt][3] * r * og.w * (g3 / (1.0f + __expf(-g3)));
        uint2 o; o.x = pk2(o0, o1); o.y = pk2(o2, o3);
        *(uint2*)(mix + token * DM + h * 64 + v0) = o;
    }
    __syncthreads();
}

__device__ void compress_unit(const Params& p, int L, int u, char* lds) {
    const int tid = otid(), lane = tid & 63, w = tid >> 6, quad = lane >> 4, l15 = lane & 15;
    const int which = u & 1, g = (u >> 1) & 1, b = (u >> 2) & 7, ntile = u >> 5;
    const bf16_t* proj = (const bf16_t*)(p.ws + OFF_BIG);
    const bf16_t* w1t = (const bf16_t*)(p.ws + OFF_W1T) + (size_t)(L * 2 + which) * 128 * 2048;
    const bf16_t* w2t = (const bf16_t*)(p.ws + OFF_W2T) + (size_t)(L * 2 + which) * 64 * 128;
    const float* cbias = (const float*)(p.ws + OFF_CBIAS) + (L * 2 + which) * 128;
    bf16_t* Hs = (bf16_t*)lds + w * 16 * 136;
    const int nrow = ntile * 64 + w * 16 + l15;
    int tokbase = 16 * nrow; if (tokbase > 4096 - 32) tokbase = 4096 - 32;
    const bf16_t* xa = proj + ((size_t)b * 4096 + tokbase) * PJ_LD + (which ? 1664 : 1536) + g * 64;
    f32x4 acc[8];
#pragma unroll
    for (int i = 0; i < 8; ++i) acc[i] = (f32x4){0.f, 0.f, 0.f, 0.f};
#pragma unroll 2
    for (int kk = 0; kk < 64; ++kk) {
        const int l = kk >> 1, d = (kk & 1) * 32 + quad * 8;
        const bf16x8 a = ld8(xa + (size_t)l * PJ_LD + d);
#pragma unroll
        for (int ni = 0; ni < 8; ++ni) acc[ni] = mfma(a, ld8(w1t + (size_t)(ni * 16 + l15) * 2048 + kk * 32 + quad * 8), acc[ni]);
    }
#pragma unroll
    for (int ni = 0; ni < 8; ++ni) { const float bsv = cbias[ni * 16 + l15];
#pragma unroll
        for (int j = 0; j < 4; ++j) { const float x = acc[ni][j] + bsv;
            const float uu = 0.7978845608028654f * (x + 0.044715f * x * x * x);
            const float th = 1.0f - 2.0f / (1.0f + __expf(2.0f * uu));
            Hs[(quad * 4 + j) * 136 + ni * 16 + l15] = f2bf(0.5f * x * (1.0f + th)); } }
    __syncthreads();
    f32x4 o[4];
#pragma unroll
    for (int i = 0; i < 4; ++i) o[i] = (f32x4){0.f, 0.f, 0.f, 0.f};
#pragma unroll
    for (int ks = 0; ks < 4; ++ks) { const bf16x8 a = *(const bf16x8*)(Hs + l15 * 136 + ks * 32 + quad * 8);
#pragma unroll
        for (int ni = 0; ni < 4; ++ni) o[ni] = mfma(a, ld8(w2t + (size_t)(ni * 16 + l15) * 128 + ks * 32 + quad * 8), o[ni]); }
    const int nb = ntile * 64 + w * 16 + quad * 4;
    if (which == 0) {
        bf16_t* kc = (bf16_t*)(p.ws + OFF_KC) + (size_t)(b * 2 + g) * 256 * 64;
        const float* rope = (const float*)(p.ws + OFF_ROPE);
#pragma unroll
        for (int j = 0; j < 4; ++j) {
            const int n = nb + j;
            float ss = o[0][j] * o[0][j] + o[1][j] * o[1][j] + o[2][j] * o[2][j] + o[3][j] * o[3][j];
            ss += __shfl_xor(ss, 1); ss += __shfl_xor(ss, 2); ss += __shfl_xor(ss, 4); ss += __shfl_xor(ss, 8);
            const float r = rsqrtf(ss * (1.0f / 64.0f) + 1e-6f);
            float v[4];
#pragma unroll
            for (int ni = 0; ni < 4; ++ni) v[ni] = o[ni][j] * r * p.nsa_kn_g[L * 64 + ni * 16 + l15];
            int pos = 16 * n + 31; if (pos > 4095) pos = 4095;
            const float cs = rope[pos * 16 + (l15 & 7)], sn = rope[pos * 16 + 8 + (l15 & 7)];
            const float pp = __shfl_xor(v[0], 8);
            v[0] = (l15 < 8) ? (v[0] * cs - pp * sn) : (v[0] * cs + pp * sn);
#pragma unroll
            for (int ni = 0; ni < 4; ++ni) kc[(size_t)n * 64 + ni * 16 + l15] = (n < 255) ? f2bf(v[ni]) : (bf16_t)0;
        }
    } else {
        bf16_t* vct = (bf16_t*)(p.ws + OFF_VCT) + (size_t)(b * 2 + g) * 64 * 256;
#pragma unroll
        for (int ni = 0; ni < 4; ++ni) {
            float v0 = o[ni][0], v1 = o[ni][1], v2 = o[ni][2], v3 = o[ni][3];
            if (nb + 3 >= 255) v3 = 0.f;
            uint2 ov; ov.x = pk2(v0, v1); ov.y = pk2(v2, v3);
            *(uint2*)(vct + (size_t)(ni * 16 + l15) * 256 + nb) = ov;
        }
    }
    __syncthreads();
}

__device__ void foxc_job(const Params& p, int L, int bh, char* lds) {
    const int tid = otid(), lane = tid & 63, w = tid >> 6, b = bh >> 2, h = bh & 3;
    const float* gates = (const float*)(p.ws + OFF_GATES);
    float* cc = (float*)(p.ws + OFF_FOXC) + (size_t)bh * 4096;
    float* wtot = (float*)lds;
    const float fb = p.fox_fb[L * 4 + h];
    float v[16];
#pragma unroll
    for (int i = 0; i < 16; ++i) v[i] = gates[((size_t)b * 4096 + tid * 16 + i) * 32 + 24 + h] + fb;
    float run = 0.f;
#pragma unroll
    for (int i = 0; i < 16; ++i) { const float x = v[i]; run += (x >= 0.f) ? -log1pf(__expf(-x)) : (x - log1pf(__expf(x))); v[i] = run; }
    float incl = run;
#pragma unroll
    for (int o = 1; o < 64; o <<= 1) { const float t = __shfl_up(incl, o); if (lane >= o) incl += t; }
    if (lane == 63) wtot[w] = incl;
    __syncthreads();
    float pre = incl - run;
#pragma unroll
    for (int s = 0; s < 4; ++s) if (s < w) pre += wtot[s];
#pragma unroll
    for (int i = 0; i < 4; ++i) { const float k2 = 1.4426950408889634f;
        *(float4*)(cc + tid * 16 + i * 4) = make_float4((pre + v[4 * i]) * k2, (pre + v[4 * i + 1]) * k2, (pre + v[4 * i + 2]) * k2, (pre + v[4 * i + 3]) * k2); }
    __syncthreads();
}

constexpr int KV_BUF = 16384;
DEVI void tile_glds(const bf16_t* Kg, int ldk, const bf16_t* Vg, int ldv, char* buf, int tid) {
    const int w = tid >> 6, i = tid & 63;
#pragma unroll
    for (int jj = 0; jj < 2; ++jj) {
        const int j = w * 2 + jj, row = 8 * j + (i >> 3), slot = i & 7;
        const bf16_t* kp = Kg + (size_t)row * ldk + ((slot ^ (row & 7)) << 3);
        const bf16_t* vp = Vg + (size_t)row * ldv + ((slot ^ ((row >> 1) & 7)) << 3);
        __builtin_amdgcn_global_load_lds((const unsigned*)kp, (ldsp_t)(unsigned)(size_t)(buf + j * 1024), 16, 0, 0);
        __builtin_amdgcn_global_load_lds((const unsigned*)vp, (ldsp_t)(unsigned)(size_t)(buf + 8192 + j * 1024), 16, 0, 0);
    }
}
DEVI void lds_kf(const char* buf, int kh, int lane, bf16x8 (&kf)[2][2]) {
    const int quad = lane >> 4, l15 = lane & 15;
#pragma unroll
    for (int t2 = 0; t2 < 2; ++t2)
#pragma unroll
        for (int ks = 0; ks < 2; ++ks) { const int row = kh * 32 + t2 * 16 + l15, ch = ks * 4 + quad; kf[t2][ks] = *(const bf16x8*)(buf + row * 128 + ((ch ^ (row & 7)) << 4)); }
}
DEVI void lds_vf(const char* buf, int kh, int lane, bf16x8 (&vf)[4]) {
    const int quad = lane >> 4, l15 = lane & 15;
#pragma unroll
    for (int dt = 0; dt < 4; ++dt) { const int d = dt * 16 + l15, u0 = kh * 8 + quad, u1 = u0 + 4;
        const uint2 a = *(const uint2*)(buf + 8192 + d * 128 + ((u0 ^ (d & 14)) << 3)), b = *(const uint2*)(buf + 8192 + d * 128 + ((u1 ^ (d & 14)) << 3));
        vf[dt] = mk8(a.x, a.y, b.x, b.y); }
}

template <class MaskF>
DEVI void attn_block64(const char* buf, int kbase, const char* ql, int q0o, int q1o, int qstride, const float* cb, f32x4 (&O)[4][4], float (&m)[4], float (&l)[4], int lane, MaskF maskf) {
    const int quad = lane >> 4;
#pragma unroll
    for (int kh = 0; kh < 2; ++kh) {
        bf16x8 kf[2][2], vf[4];
        lds_kf(buf, kh, lane, kf); lds_vf(buf, kh, lane, vf);
        float ck[8] = {0.f, 0.f, 0.f, 0.f, 0.f, 0.f, 0.f, 0.f};
        if (cb) { const float4 c0 = *(const float4*)(cb + kbase + kh * 32 + quad * 4), c1 = *(const float4*)(cb + kbase + kh * 32 + 16 + quad * 4);
            ck[0] = c0.x; ck[1] = c0.y; ck[2] = c0.z; ck[3] = c0.w; ck[4] = c1.x; ck[5] = c1.y; ck[6] = c1.z; ck[7] = c1.w; }
#pragma unroll
        for (int nt = 0; nt < 4; ++nt) {
            f32x4 s0 = (f32x4){0.f, 0.f, 0.f, 0.f}, s1 = s0;
            { const bf16x8 qa = *(const bf16x8*)(ql + nt * qstride + q0o), qb_ = *(const bf16x8*)(ql + nt * qstride + q1o);
              s0 = mfma(kf[0][0], qa, s0); s1 = mfma(kf[1][0], qa, s1); s0 = mfma(kf[0][1], qb_, s0); s1 = mfma(kf[1][1], qb_, s1); }
            float sv[8]; bool ok[8]; float mx = -1e30f;
#pragma unroll
            for (int e = 0; e < 8; ++e) { sv[e] = (e < 4) ? s0[e & 3] : s1[e & 3]; const int key = kbase + kh * 32 + (e >> 2) * 16 + quad * 4 + (e & 3);
                ok[e] = maskf(nt, ck[e], key, sv[e]); if (ok[e]) mx = fmaxf(mx, sv[e]); }
            mx = fmaxf(mx, __shfl_xor(mx, 16)); mx = fmaxf(mx, __shfl_xor(mx, 32));
            const float mn = fmaxf(m[nt], mx), alpha = __builtin_amdgcn_exp2f(m[nt] - mn);
            float pv[8]; float rs = 0.f;
#pragma unroll
            for (int e = 0; e < 8; ++e) { pv[e] = ok[e] ? __builtin_amdgcn_exp2f(sv[e] - mn) : 0.f; rs += pv[e]; }
            rs += __shfl_xor(rs, 16); rs += __shfl_xor(rs, 32);
            l[nt] = l[nt] * alpha + rs; m[nt] = mn;
            const bf16x8 P = mk8(pk2(pv[0], pv[1]), pk2(pv[2], pv[3]), pk2(pv[4], pv[5]), pk2(pv[6], pv[7]));
#pragma unroll
            for (int dt = 0; dt < 4; ++dt) { O[dt][nt] = O[dt][nt] * alpha; O[dt][nt] = mfma(vf[dt], P, O[dt][nt]); }
        }
    }
}

template <class MaskF>
DEVI void attn_stream(u64 tiles, const bf16_t* Kbase, int ldk, const bf16_t* Vbase, int ldv, char* kvbuf, int jb_wave_min, int jb_wave_max,
                      const char* ql, int q0o, int q1o, int qstride, const float* cb, f32x4 (&O)[4][4], float (&m)[4], float (&l)[4], int tid, int lane, MaskF maskf) {
    if (tiles == 0ull) return;
    int jb = __ffsll((long long)tiles) - 1; tiles &= tiles - 1;
    tile_glds(Kbase + (size_t)jb * 64 * ldk, ldk, Vbase + jb * 64, ldv, kvbuf, tid);
    __syncthreads();
    int cur = 0;
#pragma unroll 1
    for (;;) {
        const bool more = tiles != 0ull;
        int jbn = 0;
        if (more) { jbn = __ffsll((long long)tiles) - 1; tiles &= tiles - 1; tile_glds(Kbase + (size_t)jbn * 64 * ldk, ldk, Vbase + jbn * 64, ldv, kvbuf + (cur ^ 1) * KV_BUF, tid); }
        if (jb >= jb_wave_min && jb <= jb_wave_max) attn_block64(kvbuf + cur * KV_BUF, jb * 64, ql, q0o, q1o, qstride, cb, O, m, l, lane, [&](int nt, float ckv, int key, float& s) { return maskf(nt, ckv, key, jb, s); });
        __syncthreads();
        if (!more) break;
        jb = jbn; cur ^= 1;
    }
}

DEVI void attn_store2(bf16_t* mix, size_t token0, int tokstride, int col0, int colstride, const f32x4 (&O)[4][4], const float (&sc)[4], int lane, bool accum) {
    const int quad = lane >> 4, l15 = lane & 15;
#pragma unroll
    for (int nt = 0; nt < 4; ++nt)
#pragma unroll
        for (int dt = 0; dt < 4; ++dt) {
            bf16_t* dst = mix + (token0 + nt * tokstride + l15) * DM + col0 + nt * colstride + dt * 16 + quad * 4;
            float a0 = O[dt][nt][0] * sc[nt], a1 = O[dt][nt][1] * sc[nt], a2 = O[dt][nt][2] * sc[nt], a3 = O[dt][nt][3] * sc[nt];
            if (accum) { const uint2 old = *(const uint2*)dst; a0 += bflo(old.x); a1 += bfhi(old.x); a2 += bflo(old.y); a3 += bfhi(old.y); }
            uint2 o; o.x = pk2(a0, a1); o.y = pk2(a2, a3);
            *(uint2*)dst = o;
        }
}

__device__ void nsa_unit(const Params& p, int L, int b, int g, int blk, char* lds) {
    const int tid = otid(), lane = tid & 63, w = tid >> 6, quad = lane >> 4, l15 = lane & 15;
    const bf16_t* proj = (const bf16_t*)(p.ws + OFF_BIG); const bf16_t* VT = (const bf16_t*)(p.ws + OFF_BIG + OFF_VT_IN_BIG);
    const float* gates = (const float*)(p.ws + OFF_GATES);
    bf16_t* mix = (bf16_t*)(p.ws + OFF_ACT);
    char* kvbuf = lds; float* impL = (float*)(lds + KV_BUF)  ; char* Qs = lds + 32768; u64* selm = (u64*)(lds + 65536);
    const int q0 = blk * 64; const int tq = q0 + w * 16 + l15; const size_t token = (size_t)b * 4096 + tq;
    const size_t token0 = (size_t)b * 4096 + q0 + w * 16;
    const int mixcol = 256 + g * 256;
#pragma unroll
    for (int t = 0; t < 8; ++t) { const int idx = t * 64 + lane, rr = idx >> 3, c = idx & 7, hh = rr >> 4, r16 = rr & 15;
        const uint4 v = *(const uint4*)(proj + (token0 + r16) * PJ_LD + 1024 + (g * 4 + hh) * 64 + c * 8);
        *(uint4*)(Qs + (hh * 64 + w * 16 + r16) * 128 + ((c ^ (r16 & 7)) << 4)) = v; }
    const char* ql = Qs + (w * 16 + l15) * 128; const int q0o = ((quad) ^ (l15 & 7)) << 4, q1o = ((4 + quad) ^ (l15 & 7)) << 4; const int qstride = 8192;
    __syncthreads();
    f32x4 O[4][4]; float m[4], l[4];
    const bf16_t* Kc = (const bf16_t*)(p.ws + OFF_KC) + (size_t)(b * 2 + g) * 256 * 64;
    const bf16_t* VcT = (const bf16_t*)(p.ws + OFF_VCT) + (size_t)(b * 2 + g) * 64 * 256;
    const int ncb = (4 * blk + 3 + 63) >> 6;
#pragma unroll
    for (int nt = 0; nt < 4; ++nt) { m[nt] = -1e30f; l[nt] = 0.f; }
    {
#pragma unroll 1
        for (int pass = 0; pass < 2; ++pass) {
            float inv[4]; float prevr = 0.f;
            if (pass == 1) {
#pragma unroll
                for (int nt = 0; nt < 4; ++nt) inv[nt] = 1.0f / fmaxf(l[nt], 1e-30f);
#pragma unroll
                for (int dt = 0; dt < 4; ++dt)
#pragma unroll
                    for (int nt = 0; nt < 4; ++nt) O[dt][nt] = (f32x4){0.f, 0.f, 0.f, 0.f};
            }
#pragma unroll 1
            for (int ct = 0; ct < ncb; ++ct) {
                tile_glds(Kc + (size_t)ct * 64 * 64, 64, VcT + ct * 64, 256, kvbuf, tid);
                __syncthreads();
                const char* buf = kvbuf;
#pragma unroll
                for (int kh = 0; kh < 2; ++kh) {
                    bf16x8 kf[2][2]; lds_kf(buf, kh, lane, kf);
                    if (pass == 0) {
#pragma unroll
                        for (int nt = 0; nt < 4; ++nt) {
                            f32x4 s0 = (f32x4){0.f, 0.f, 0.f, 0.f}, s1 = s0;
                            { const bf16x8 qa = *(const bf16x8*)(ql + nt * qstride + q0o), qb_ = *(const bf16x8*)(ql + nt * qstride + q1o);
                              s0 = mfma(kf[0][0], qa, s0); s1 = mfma(kf[1][0], qa, s1); s0 = mfma(kf[0][1], qb_, s0); s1 = mfma(kf[1][1], qb_, s1); }
                            float sv[8]; bool ok[8]; float mx = -1e30f;
#pragma unroll
                            for (int e = 0; e < 8; ++e) { sv[e] = (e < 4) ? s0[e & 3] : s1[e & 3]; const int n = ct * 64 + kh * 32 + (e >> 2) * 16 + quad * 4 + (e & 3);
                                ok[e] = (16 * n + 31 <= tq); if (ok[e]) mx = fmaxf(mx, sv[e]); }
                            mx = fmaxf(mx, __shfl_xor(mx, 16)); mx = fmaxf(mx, __shfl_xor(mx, 32));
                            const float mn = fmaxf(m[nt], mx), alpha = __builtin_amdgcn_exp2f(m[nt] - mn);
                            float rs = 0.f;
#pragma unroll
                            for (int e = 0; e < 8; ++e) rs += ok[e] ? __builtin_amdgcn_exp2f(sv[e] - mn) : 0.f;
                            rs += __shfl_xor(rs, 16); rs += __shfl_xor(rs, 32);
                            l[nt] = l[nt] * alpha + rs; m[nt] = mn;
                        }
                    } else {
                        bf16x8 vf[4]; lds_vf(buf, kh, lane, vf);
                        float As[2] = {0.f, 0.f}, p3[2] = {0.f, 0.f};
#pragma unroll
                        for (int nt = 0; nt < 4; ++nt) {
                            f32x4 s0 = (f32x4){0.f, 0.f, 0.f, 0.f}, s1 = s0;
                            { const bf16x8 qa = *(const bf16x8*)(ql + nt * qstride + q0o), qb_ = *(const bf16x8*)(ql + nt * qstride + q1o);
                              s0 = mfma(kf[0][0], qa, s0); s1 = mfma(kf[1][0], qa, s1); s0 = mfma(kf[0][1], qb_, s0); s1 = mfma(kf[1][1], qb_, s1); }
                            float pv[8];
#pragma unroll
                            for (int e = 0; e < 8; ++e) { const float s = (e < 4) ? s0[e & 3] : s1[e & 3]; const int n = ct * 64 + kh * 32 + (e >> 2) * 16 + quad * 4 + (e & 3);
                                pv[e] = (16 * n + 31 <= tq) ? __builtin_amdgcn_exp2f(s - m[nt]) * inv[nt] : 0.f; }
                            As[0] += (pv[0] + pv[1]) + (pv[2] + pv[3]); As[1] += (pv[4] + pv[5]) + (pv[6] + pv[7]); p3[0] += pv[3]; p3[1] += pv[7];
                            const bf16x8 P = mk8(pk2(pv[0], pv[1]), pk2(pv[2], pv[3]), pk2(pv[4], pv[5]), pk2(pv[6], pv[7]));
#pragma unroll
                            for (int dt = 0; dt < 4; ++dt) O[dt][nt] = mfma(vf[dt], P, O[dt][nt]);
                        }
                        const int qq = w * 16 + l15;
#pragma unroll
                        for (int t2 = 0; t2 < 2; ++t2) {
                            const float rr = __shfl(p3[t2], (lane + 48) & 63);
                            const float carry = (quad == 0) ? prevr : rr; prevr = rr;
                            const int jb = ct * 16 + kh * 8 + t2 * 4 + quad;
                            impL[jb * 64 + ((qq ^ jb) & 63)] = As[t2] + carry;
                        }
                    }
                }
                __syncthreads();
            }
        }
    }
    {
        const float4 gv = *(const float4*)(gates + token * 32 + 0 * 8 + g * 4);
        const float sc[4] = {gv.x, gv.y, gv.z, gv.w};
        attn_store2(mix, token0, 0, mixcol, 64, O, sc, lane, false);
    }
#pragma unroll 1
    for (int qi = 0; qi < 16; ++qi) {
        const int q = w * 16 + qi, jb = lane;
        float val = impL[jb * 64 + ((q ^ jb) & 63)];
        if (jb > blk) val = -1e30f;
        else if (jb == 0 || jb == blk || jb == blk - 1) val = 1e30f;
        int rank = 0;
        for (int jp = 0; jp < 64; ++jp) { const float vj = __shfl(val, jp); rank += ((vj > val) || (vj == val && jp < jb)) ? 1 : 0; }
        const bool sel = (rank < 16) && (val > -5e29f);
        const u64 mask = __ballot(sel);
        if (lane == 0) selm[q] = mask;
    }
    __syncthreads();
    u64 uni = 0;
    for (int q = 0; q < 64; ++q) uni |= selm[q];
    const u64 sm = selm[w * 16 + l15];
    {
#pragma unroll
        for (int nt = 0; nt < 4; ++nt) { m[nt] = -1e30f; l[nt] = 0.f; }
#pragma unroll
        for (int dt = 0; dt < 4; ++dt)
#pragma unroll
            for (int nt = 0; nt < 4; ++nt) O[dt][nt] = (f32x4){0.f, 0.f, 0.f, 0.f};
        const u64 tiles = uni & ((blk == 63) ? ~0ull : ((2ull << blk) - 1ull));
        attn_stream(tiles, proj + (size_t)b * 4096 * PJ_LD + 1792 + g * 64, PJ_LD, VT + ((size_t)((4 + g) * 8 + b) * 64) * 4096, 4096, kvbuf, 0, 63, ql, q0o, q1o, qstride, nullptr, O, m, l, tid, lane,
                    [&](int nt, float ckv, int key, int jb, float& s) { return (((sm >> jb) & 1ull) != 0) && (key <= tq); });
        const float4 gv = *(const float4*)(gates + token * 32 + 1 * 8 + g * 4);
        const float sc[4] = {gv.x / fmaxf(l[0], 1e-30f), gv.y / fmaxf(l[1], 1e-30f), gv.z / fmaxf(l[2], 1e-30f), gv.w / fmaxf(l[3], 1e-30f)};
        attn_store2(mix, token0, 0, mixcol, 64, O, sc, lane, true);
    }
    {
#pragma unroll
        for (int nt = 0; nt < 4; ++nt) { m[nt] = -1e30f; l[nt] = 0.f; }
#pragma unroll
        for (int dt = 0; dt < 4; ++dt)
#pragma unroll
            for (int nt = 0; nt < 4; ++nt) O[dt][nt] = (f32x4){0.f, 0.f, 0.f, 0.f};
        const int jlo = blk > 8 ? blk - 8 : 0;
        const u64 upto = (blk == 63) ? ~0ull : ((2ull << blk) - 1ull);
        const u64 tiles = upto & ~((1ull << jlo) - 1ull);
        attn_stream(tiles, proj + (size_t)b * 4096 * PJ_LD + 2048 + g * 64, PJ_LD, VT + ((size_t)((6 + g) * 8 + b) * 64) * 4096, 4096, kvbuf, 0, 63, ql, q0o, q1o, qstride, nullptr, O, m, l, tid, lane,
                    [&](int nt, float ckv, int key, int jb, float& s) { return (key <= tq) && (key + 512 > tq); });
        const float4 gv = *(const float4*)(gates + token * 32 + 2 * 8 + g * 4);
        const float sc[4] = {gv.x / fmaxf(l[0], 1e-30f), gv.y / fmaxf(l[1], 1e-30f), gv.z / fmaxf(l[2], 1e-30f), gv.w / fmaxf(l[3], 1e-30f)};
        attn_store2(mix, token0, 0, mixcol, 64, O, sc, lane, true);
    }
    __syncthreads();
}

__device__ void fox_unit(const Params& p, int L, int b, int h, int qb, char* lds) {
    const int tid = otid(), lane = tid & 63, w = tid >> 6, quad = lane >> 4, l15 = lane & 15;
    const bf16_t* proj = (const bf16_t*)(p.ws + OFF_BIG); const bf16_t* VT = (const bf16_t*)(p.ws + OFF_BIG + OFF_VT_IN_BIG);
    bf16_t* mix = (bf16_t*)(p.ws + OFF_ACT);
    const float* cc = (const float*)(p.ws + OFF_FOXC) + (size_t)(b * 4 + h) * 4096;
    const int q0 = qb * 256 + w * 64; const size_t token0 = (size_t)b * 4096 + q0;
    int tq[4]; float cq[4];
#pragma unroll
    for (int nt = 0; nt < 4; ++nt) { tq[nt] = q0 + nt * 16 + l15; cq[nt] = cc[tq[nt]]; }
    char* Qs = lds + 32768;
#pragma unroll
    for (int t = 0; t < 8; ++t) { const int idx = t * 64 + lane, rr = idx >> 3, c = idx & 7;
        const uint4 v = *(const uint4*)(proj + (token0 + rr) * PJ_LD + 2304 + h * 64 + c * 8);
        *(uint4*)(Qs + (w * 64 + rr) * 128 + ((c ^ (rr & 7)) << 4)) = v; }
    const char* ql = Qs + (w * 64 + l15) * 128; const int q0o = ((quad) ^ (l15 & 7)) << 4, q1o = ((4 + quad) ^ (l15 & 7)) << 4; const int qstride = 2048;
    __syncthreads();
    f32x4 O[4][4]; float m[4], l[4];
#pragma unroll
    for (int nt = 0; nt < 4; ++nt) { m[nt] = -1e30f; l[nt] = 0.f; }
#pragma unroll
    for (int dt = 0; dt < 4; ++dt)
#pragma unroll
        for (int nt = 0; nt < 4; ++nt) O[dt][nt] = (f32x4){0.f, 0.f, 0.f, 0.f};
    const int jmax = qb * 4 + 3;
    int jlo_w, jlo_b;
    { const float cq0 = cc[q0]; int lo = 0, hi = qb * 4 + w;
      while (lo < hi) { const int mid = (lo + hi) >> 1; if (cq0 - cc[mid * 64 + 63] >= -202.f) hi = mid; else lo = mid + 1; }
      jlo_w = lo; }
    { const float cq0 = cc[qb * 256]; int lo = 0, hi = qb * 4;
      while (lo < hi) { const int mid = (lo + hi) >> 1; if (cq0 - cc[mid * 64 + 63] >= -202.f) hi = mid; else lo = mid + 1; }
      jlo_b = lo; }
    const u64 tiles = ((jmax == 63) ? ~0ull : ((2ull << jmax) - 1ull)) & ~((1ull << jlo_b) - 1ull);
    attn_stream(tiles, proj + (size_t)b * 4096 * PJ_LD + 2560 + h * 64, PJ_LD, VT + ((size_t)((8 + h) * 8 + b) * 64) * 4096, 4096, lds, jlo_w, qb * 4 + w, ql, q0o, q1o, qstride, cc, O, m, l, tid, lane,
                [&](int nt, float ckv, int key, int jb, float& s) { s += cq[nt] - ckv; return key <= tq[nt]; });
    float sc[4];
#pragma unroll
    for (int nt = 0; nt < 4; ++nt) sc[nt] = 1.0f / fmaxf(l[nt], 1e-30f);
    attn_store2(mix, token0, 16, 768 + h * 64, 0, O, sc, lane, false);
}

__device__ void mixA_phase(const Params& p, int L, char* lds);
DEVI int next_unit(unsigned* ctr, char* lds) {
    int* slot = (int*)(lds + LDS_BYTES - 16);
    __syncthreads();
    if (otid() == 0) *slot = (int)atomicAdd(ctr, 1u);
    __syncthreads();
    return *slot;
}
__device__ void mixA_phase(const Params& p, int L, char* lds) {
    unsigned* ctr = (unsigned*)(p.ws + OFF_CTR) + L * 4 + 3;
#pragma unroll 1
    for (;;) {
        const int job = next_unit(ctr, lds); if (job >= 160 + 512) break;
        if (job < 128) compress_unit(p, L, job, lds);
        else if (job < 160) foxc_job(p, L, job - 128, lds);
        else {
#pragma unroll 1
            for (int u = (job - 160) * 4; u < (job - 160) * 4 + 4; ++u) hgrn_a_unit(p, L, u, lds);
        }
    }
}
__device__ void mixB_phase(const Params& p, int L, char* lds) {
    unsigned* ctr = (unsigned*)(p.ws + OFF_CTR) + L * 4;
#pragma unroll 1
    for (;;) { const int f = next_unit(ctr + 0, lds); if (f >= 512) break; const int qb = 15 - (f >> 5), bh = f & 31; fox_unit(p, L, bh >> 2, bh & 3, qb, lds); }
#pragma unroll 1
    for (;;) { const int n = next_unit(ctr + 1, lds); if (n >= 1024) break; const int blk = 63 - (n >> 4), bg = n & 15; nsa_unit(p, L, bg >> 1, bg & 1, blk, lds); }
#pragma unroll 1
    for (;;) { const int c = next_unit(ctr + 2, lds); if (c >= 1024) break;
#pragma unroll 1
        for (int u = c * 2; u < c * 2 + 2; ++u) hgrn_c_unit(p, L, u, lds); }
}


#define XB_TMO      128
#define XB_XCNT(j)  (256  + 64 * (j))
#define XB_XSUB(j)  (1280 + 64 * (j))
#define XB_XGEN(j)  (2304 + 64 * (j))
#define XB_TOP      3328
#define XB_TOPGEN   3392
#define XCD_BAR_WORDS 3456
#define XB_SPIN_CAP (1u << 18)
#define LAS __attribute__((address_space(3)))
DEVI unsigned xb_ld(unsigned* p)              { return __hip_atomic_load(p, __ATOMIC_RELAXED, __HIP_MEMORY_SCOPE_AGENT); }
DEVI unsigned xb_add(unsigned* p, unsigned v) { return __hip_atomic_fetch_add(p, v, __ATOMIC_RELAXED, __HIP_MEMORY_SCOPE_AGENT); }
DEVI unsigned xb_xcc_id() { return (unsigned)__builtin_amdgcn_s_getreg((3 << 11) | 20) & 0xFu; }
#define XB_SPIN(cond, bar) do { unsigned _sp = 0; while (cond) { __builtin_amdgcn_s_sleep(1); \
    if ((++_sp & 255u) == 0u) { if (xb_ld(&(bar)[XB_TMO])) break; if (_sp > XB_SPIN_CAP) { atomicAdd(&(bar)[XB_TMO], 1u); break; } } } } while (0)
struct XcdBarrier { unsigned* bar; unsigned x; volatile LAS unsigned* st; };
DEVI XcdBarrier xcd_barrier_post(unsigned* bar, volatile LAS unsigned* st) {
    XcdBarrier b; b.bar = bar; b.x = xb_xcc_id(); b.st = st;
    if (threadIdx.x == 0) (void)xb_add(&bar[XB_XCNT(b.x)], 1u);
    return b;
}
DEVI void xcd_barrier_complete(unsigned* bar, unsigned x, unsigned& nloc, unsigned& nx) {
    const unsigned G = gridDim.x * gridDim.y * gridDim.z;
    unsigned sum, cnt, mine, sp = 0u;
    for (;;) {
        sum = 0u; cnt = 0u; mine = 0u;
#pragma unroll
        for (unsigned j = 0; j < 16; ++j) { const unsigned c = xb_ld(&bar[XB_XCNT(j)]); sum += c; cnt += (c > 0u) ? 1u : 0u; mine = (j == x) ? c : mine; }
        if (sum == G) break;
        __builtin_amdgcn_s_sleep(1);
        if ((++sp & 255u) == 0u) { if (xb_ld(&bar[XB_TMO])) break; if (sp > XB_SPIN_CAP) { atomicAdd(&bar[XB_TMO], 1u); break; } }
    }
    nloc = mine > 0u ? mine : 1u; nx = cnt > 0u ? cnt : 1u;
}
DEVI void xcd_barrier(const XcdBarrier& b) {
    __builtin_amdgcn_fence(__ATOMIC_RELEASE, "agent");
    asm volatile("s_waitcnt vmcnt(0)" ::: "memory");
    __syncthreads();
    if (threadIdx.x == 0) {
        unsigned* bar = b.bar;
        __builtin_amdgcn_s_waitcnt(0);
        unsigned nloc = b.st[0], nx = b.st[1];
        if (nloc == 0u) { xcd_barrier_complete(bar, b.x, nloc, nx); b.st[0] = nloc; b.st[1] = nx; }
        const unsigned old = xb_add(&bar[XB_XSUB(b.x)], 1u);
        const unsigned gen = old / nloc;
        if (old + 1u == (gen + 1u) * nloc) {
            __builtin_amdgcn_fence(__ATOMIC_RELEASE, "agent");
            asm volatile("s_waitcnt vmcnt(0)" ::: "memory");
            const unsigned og = xb_add(&bar[XB_TOP], 1u);
            const unsigned tg = og / nx;
            if (og + 1u == (tg + 1u) * nx) xb_add(&bar[XB_TOPGEN], 1u);
            else XB_SPIN(xb_ld(&bar[XB_TOPGEN]) == tg, bar);
            __builtin_amdgcn_fence(__ATOMIC_ACQUIRE, "agent");
            xb_add(&bar[XB_XGEN(b.x)], 1u);
            asm volatile("s_waitcnt vmcnt(0)" ::: "memory");
        } else {
            XB_SPIN(xb_ld(&bar[XB_XGEN(b.x)]) == gen, bar);
            __builtin_amdgcn_fence(__ATOMIC_ACQUIRE, "agent");
            asm volatile("s_waitcnt vmcnt(0)" ::: "memory");
        }
    }
    __syncthreads();
    __builtin_amdgcn_fence(__ATOMIC_ACQUIRE, "agent");
    asm volatile("s_waitcnt vmcnt(0)" ::: "memory");
}

__device__ void run_phase(const Params& p, int ph, char* lds) {
    if (ph == 0) { prep_phase(p, lds); return; }
    const int L = (ph - 1) / 7, s = (ph - 1) % 7;
    switch (s) {
        case 0: gemm_phase<EPI_PROJ>(p, L, lds); break;
        case 1: mixA_phase(p, L, lds); break;
        case 2: hgrn_scan_phase(p); break;
        case 3: mixB_phase(p, L, lds); break;
        case 4: gemm_phase<EPI_WO>(p, L, lds); break;
        case 5: gemm_phase<EPI_UP>(p, L, lds); break;
        default: gemm_phase<EPI_DOWN>(p, L, lds); break;
    }
}

__global__ void __launch_bounds__(256, 2) fwd_kernel(Params p, int ph_lo, int ph_hi) {
    __shared__ __attribute__((aligned(16))) char lds[LDS_BYTES];
    __shared__ uint4 xb_words;
    if (threadIdx.x == 0) xb_words = make_uint4(0u, 0u, 0u, 0u);
    __syncthreads();
    unsigned* bar = (unsigned*)(p.ws + OFF_XBAR);
    for (int ph = ph_lo; ph < ph_hi; ++ph) {
        run_phase(p, ph, lds);
        if (ph + 1 < ph_hi) {
            if (ph == ph_lo) cg::this_grid().sync();
            else {
                asm volatile("s_waitcnt vmcnt(0)" ::: "memory");
                __syncthreads();
                if (threadIdx.x == 0) {
                    unsigned* base = bar + ph * 640;
                    const unsigned g = blockIdx.x & 7u, G = gridDim.x;
                    const unsigned nper = (G >> 3) + ((g < (G & 7u)) ? 1u : 0u);
                    const unsigned ngrp = G < 8u ? G : 8u;
                    __builtin_amdgcn_fence(__ATOMIC_RELEASE, "agent");
                    asm volatile("s_waitcnt vmcnt(0)" ::: "memory");
                    if (__hip_atomic_fetch_add(base + g * 64, 1u, __ATOMIC_RELAXED, __HIP_MEMORY_SCOPE_AGENT) == nper - 1u) {
                        if (__hip_atomic_fetch_add(base + 8 * 64, 1u, __ATOMIC_RELAXED, __HIP_MEMORY_SCOPE_AGENT) == ngrp - 1u)
                            __hip_atomic_store(base + 9 * 64, 1u, __ATOMIC_RELAXED, __HIP_MEMORY_SCOPE_AGENT);
                    }
                    while (__hip_atomic_load(base + 9 * 64, __ATOMIC_RELAXED, __HIP_MEMORY_SCOPE_AGENT) == 0u) __builtin_amdgcn_s_sleep(1);
                    __builtin_amdgcn_fence(__ATOMIC_ACQUIRE, "agent");
                    asm volatile("s_waitcnt vmcnt(0)" ::: "memory");
                }
                __syncthreads();
            }
        }
    }
}

extern "C" void kernel_launch(void* const* d_in, const int* in_sizes, int n_in, void* d_out, int out_size, void* d_ws, size_t ws_size,
                              hipStream_t stream) {
    if (ws_size < WS_NEED) { fprintf(stderr, "workspace too small: %zu < %zu\n", ws_size, (size_t)WS_NEED); return; }
    Params p{};
    p.x = (const float*)d_in[0]; p.norm1_g = (const float*)d_in[1]; p.w_in = (const float*)d_in[2]; p.lb_logits = (const float*)d_in[3];
    p.onorm_g = (const float*)d_in[4]; p.nsa_qn_g = (const float*)d_in[5]; p.nsa_kn_g = (const float*)d_in[6]; p.cmp_pos = (const float*)d_in[7];
    p.cmp_w1 = (const float*)d_in[8]; p.cmp_w2 = (const float*)d_in[9]; p.fox_qn_g = (const float*)d_in[10]; p.fox_kn_g = (const float*)d_in[11];
    p.fox_fb = (const float*)d_in[12]; p.w_o = (const float*)d_in[13]; p.norm2_g = (const float*)d_in[14]; p.w_up = (const float*)d_in[15];
    p.w_down = (const float*)d_in[16];
    p.out = (float*)d_out; p.ws = (char*)d_ws;
#if MULTI_LAUNCH
    for (int ph = 0; ph < NPHASE; ++ph) hipLaunchKernelGGL(fwd_kernel, dim3(512), dim3(256), 0, stream, p, ph, ph + 1);
#else
    static int grid_blocks = 0;
    if (!grid_blocks) {
        int dev = 0, cus = 0, per_cu = 0;
        hipGetDevice(&dev);
        hipDeviceGetAttribute(&cus, hipDeviceAttributeMultiprocessorCount, dev);
        hipOccupancyMaxActiveBlocksPerMultiprocessor(&per_cu, fwd_kernel, 256, 0);
        per_cu = 2;
        grid_blocks = cus * per_cu;
        grid_blocks &= ~7;
    }
    int lo = 0, hi = NPHASE;
    void* args[] = {&p, &lo, &hi};
    hipError_t e = hipLaunchCooperativeKernel((void*)fwd_kernel, dim3(grid_blocks), dim3(256), args, 0, stream);
    if (e != hipSuccess) fprintf(stderr, "cooperative launch failed: %s (grid %d)\n", hipGetErrorString(e), grid_blocks);
#endif
}
```

```cpp
#include <hip/hip_runtime.h>
#include <hip/hip_cooperative_groups.h>
#include <stdint.h>
#include <cstdio>
namespace cg = cooperative_groups;

#ifndef MULTI_LAUNCH
#define MULTI_LAUNCH 0
#endif

typedef unsigned short bf16_t;
typedef short bf16x8 __attribute__((ext_vector_type(8)));
typedef float f32x4 __attribute__((ext_vector_type(4)));
typedef unsigned long long u64;
typedef __attribute__((address_space(3))) unsigned* ldsp_t;
typedef unsigned u32x16 __attribute__((ext_vector_type(16)));
typedef unsigned u32x8 __attribute__((ext_vector_type(8)));
#define DEVI __device__ __forceinline__

constexpr int T_TOK = 32768, SEQ = 4096, DM = 1024, DFF = 4096;
constexpr int PJ_LD = 3072;
constexpr int NW_IN = 3100, NW_IN_PAD = 3328;
constexpr int NPHASE = 15;

constexpr size_t OFF_WIN = 0;
constexpr size_t OFF_WO = OFF_WIN + (size_t)2 * NW_IN_PAD * 1024 * 2;
constexpr size_t OFF_WUP = OFF_WO + (size_t)2 * 1024 * 1024 * 2;
constexpr size_t OFF_WDN = OFF_WUP + (size_t)2 * 4096 * 1024 * 2;
constexpr size_t OFF_W1T = OFF_WDN + (size_t)2 * 4096 * 1024 * 2;
constexpr size_t OFF_W2T = OFF_W1T + (size_t)2 * 2 * 128 * 2048 * 2;
constexpr size_t OFF_CBIAS = OFF_W2T + (size_t)2 * 2 * 64 * 128 * 2;
constexpr size_t OFF_CTR = OFF_CBIAS + 2048;
constexpr size_t OFF_ROPE = OFF_CTR + 256;
constexpr size_t OFF_GATES = OFF_ROPE + (size_t)4096 * 16 * 4;
constexpr size_t OFF_FOXC = OFF_GATES + (size_t)T_TOK * 32 * 4;
constexpr size_t OFF_KC = OFF_FOXC + (size_t)8 * 4 * 4096 * 4;
constexpr size_t OFF_VCT = OFF_KC + (size_t)8 * 2 * 256 * 64 * 2;
constexpr size_t OFF_DECAY = OFF_VCT + (size_t)8 * 2 * 256 * 64 * 2;
constexpr size_t OFF_KVT = OFF_DECAY + (size_t)2048 * 64 * 4;
constexpr size_t OFF_ST = OFF_KVT + (size_t)2048 * 4096 * 4;
constexpr size_t OFF_ACT = OFF_ST + (size_t)2048 * 4096 * 2;
constexpr size_t OFF_BIG = OFF_ACT + (size_t)T_TOK * 1024 * 2;
constexpr size_t OFF_VT_IN_BIG = (size_t)T_TOK * PJ_LD * 2;
constexpr size_t OFF_ACT2 = OFF_BIG + (size_t)T_TOK * 4096 * 2;
constexpr size_t OFF_SSQ = OFF_ACT2 + (size_t)T_TOK * 1024 * 2;
constexpr size_t OFF_XBAR = OFF_SSQ + (size_t)T_TOK * 16 * 4;
constexpr size_t WS_NEED = OFF_XBAR + 65536;

constexpr int LDS_BYTES = 67584;

struct Params {
    const float *x, *norm1_g, *w_in, *lb_logits, *onorm_g, *nsa_qn_g, *nsa_kn_g, *cmp_pos, *cmp_w1, *cmp_w2,
        *fox_qn_g, *fox_kn_g, *fox_fb, *w_o, *norm2_g, *w_up, *w_down;
    float* out;
    char* ws;
};

DEVI unsigned pk2(float lo, float hi) { unsigned r; asm("v_cvt_pk_bf16_f32 %0, %1, %2" : "=v"(r) : "v"(lo), "v"(hi)); return r; }
DEVI bf16_t f2bf(float f) { return (bf16_t)(pk2(f, 0.f) & 0xffffu); }
DEVI float bf2f(bf16_t h) { return __uint_as_float(((unsigned)h) << 16); }
DEVI float bflo(unsigned u) { return __uint_as_float(u << 16); }
DEVI float bfhi(unsigned u) { return __uint_as_float(u & 0xffff0000u); }
DEVI f32x4 mfma(bf16x8 a, bf16x8 b, f32x4 c) { return __builtin_amdgcn_mfma_f32_16x16x32_bf16(a, b, c, 0, 0, 0); }
DEVI int otid() { int t; asm volatile("v_mov_b32 %0, %1" : "=v"(t) : "v"(threadIdx.x)); return t; }
DEVI float wave_sum(float v) {
#pragma unroll
    for (int o = 32; o >= 1; o >>= 1) v += __shfl_xor(v, o);
    return v;
}
DEVI bf16x8 mk8(unsigned a, unsigned b, unsigned c, unsigned d) {
    uint4 u = make_uint4(a, b, c, d);
    return *(bf16x8*)&u;
}
DEVI bf16x8 ld8(const bf16_t* p) { uint4 u = *(const uint4*)p; return *(bf16x8*)&u; }
DEVI bf16x8 ld4x2(const bf16_t* p0, const bf16_t* p1) {
    uint2 a = *(const uint2*)p0, b = *(const uint2*)p1;
    return mk8(a.x, a.y, b.x, b.y);
}

DEVI int win_colmap(int n) {
    if (n < 2304) return n;
    if (n < 3072) return n + 24;
    if (n < 3096) return n - 768;
    return n;
}
__device__ void transpose_tile(const float* __restrict__ src, int ld_src, bf16_t* __restrict__ dst, int ld_dst, int k0, int n0, int nvalid,
                               int colmode, float* tile) {
    const int tid = otid();
    for (int idx = tid; idx < 4096; idx += 256) {
        const int i = idx >> 6, j = idx & 63, n = n0 + j;
        float v = 0.f;
        if (n < nvalid) v = src[(size_t)(k0 + i) * ld_src + (colmode ? win_colmap(n) : n)];
        tile[i * 65 + j] = v;
    }
    __syncthreads();
    for (int idx = tid; idx < 4096; idx += 256) {
        const int j = idx >> 6, i = idx & 63;
        dst[(size_t)(n0 + j) * ld_dst + k0 + i] = f2bf(tile[i * 65 + j]);
    }
    __syncthreads();
}

__device__ void norm_phase(const float* __restrict__ xin, const float* __restrict__ g, bf16_t* __restrict__ hout) {
    const int tid = otid(); const int lane = tid & 63, w = tid >> 6;
    for (int row = blockIdx.x * 4 + w; row < T_TOK; row += gridDim.x * 4) {
        const float4* xr = (const float4*)(xin + (size_t)row * DM);
        float4 v[4]; float ss = 0.f;
#pragma unroll
        for (int i = 0; i < 4; ++i) { v[i] = xr[lane + 64 * i]; ss += v[i].x * v[i].x + v[i].y * v[i].y + v[i].z * v[i].z + v[i].w * v[i].w; }
        ss = wave_sum(ss);
        const float r = rsqrtf(ss * (1.0f / 1024.0f) + 1e-6f);
#pragma unroll
        for (int i = 0; i < 4; ++i) {
            const float4 gg = ((const float4*)g)[lane + 64 * i];
            uint2 o; o.x = pk2(v[i].x * r * gg.x, v[i].y * r * gg.y); o.y = pk2(v[i].z * r * gg.z, v[i].w * r * gg.w);
            *(uint2*)(hout + (size_t)row * DM + (lane + 64 * i) * 4) = o;
        }
    }
}

__device__ void prep_phase(const Params& p, char* lds) {
    float* tile = (float*)lds;
    if (blockIdx.x == 0 && otid() < 64) ((unsigned*)(p.ws + OFF_CTR))[otid()] = 0u;
    if (blockIdx.x == 1) { for (int i = otid(); i < 16384; i += 256) ((unsigned*)(p.ws + OFF_XBAR))[i] = 0u; }
    bf16_t* win_t = (bf16_t*)(p.ws + OFF_WIN); bf16_t* wo_t = (bf16_t*)(p.ws + OFF_WO);
    bf16_t* wup_t = (bf16_t*)(p.ws + OFF_WUP); bf16_t* wdn_t = (bf16_t*)(p.ws + OFF_WDN);
    bf16_t* w1t = (bf16_t*)(p.ws + OFF_W1T); bf16_t* w2t = (bf16_t*)(p.ws + OFF_W2T);
    const int J0 = 1664, J1 = J0 + 512, J2 = J1 + 2048, J3 = J2 + 2048, J4 = J3 + 256, J5 = J4 + 8, J6 = J5 + 128, J7 = J6 + 128;
    for (int job = blockIdx.x; job < J7; job += gridDim.x) {
        if (job < J0) { const int L = job / 832, r = job % 832, kt = r / 52, nt = r % 52;
            transpose_tile(p.w_in + (size_t)L * 1024 * NW_IN, NW_IN, win_t + (size_t)L * NW_IN_PAD * 1024, 1024, kt * 64, nt * 64, NW_IN, 1, tile);
        } else if (job < J1) { const int j = job - J0, L = j / 256, r = j % 256, kt = r / 16, nt = r % 16;
            transpose_tile(p.w_o + (size_t)L * 1024 * 1024, 1024, wo_t + (size_t)L * 1024 * 1024, 1024, kt * 64, nt * 64, 1024, 0, tile);
        } else if (job < J2) { const int j = job - J1, L = j / 1024, r = j % 1024, kt = r / 64, nt = r % 64;
            transpose_tile(p.w_up + (size_t)L * 1024 * 4096, 4096, wup_t + (size_t)L * 4096 * 1024, 1024, kt * 64, nt * 64, 4096, 0, tile);
        } else if (job < J3) { const int j = job - J2, L = j / 1024, r = j % 1024, kt = r / 16, nt = r % 16;
            transpose_tile(p.w_down + (size_t)L * 4096 * 1024, 1024, wdn_t + (size_t)L * 1024 * 4096, 4096, kt * 64, nt * 64, 1024, 0, tile);
        } else if (job < J4) { const int j = job - J3, lw = j / 64, r = j % 64, kt = r / 2, nt = r % 2;
            transpose_tile(p.cmp_w1 + (size_t)lw * 2048 * 128, 128, w1t + (size_t)lw * 128 * 2048, 2048, kt * 64, nt * 64, 128, 0, tile);
        } else if (job < J5) { const int j = job - J4, lw = j / 2, kt = j % 2;
            transpose_tile(p.cmp_w2 + (size_t)lw * 128 * 64, 64, w2t + (size_t)lw * 64 * 128, 128, kt * 64, 0, 64, 0, tile);
        } else if (job < J6) {
            const int t_ = otid(); const int o = (job - J5) * 4 + (t_ >> 6), lane = t_ & 63, lw = o >> 7, hid = o & 127;
            const float* pos = p.cmp_pos + (size_t)lw * 2048; const float* w1 = p.cmp_w1 + (size_t)lw * 2048 * 128 + hid;
            float s = 0.f;
            for (int k = lane; k < 2048; k += 64) s += pos[k] * w1[(size_t)k * 128];
            s = wave_sum(s);
            if (lane == 0) ((float*)(p.ws + OFF_CBIAS))[o] = s;
        } else {
            const int e = (job - J6) * 256 + otid(), pos = e >> 3, i = e & 7;
            const float invf[8] = {1.0f, 0.1939227432012558f, 0.03760603070259094f, 0.007292664609849453f, 0.0014142135623842478f,
                                   0.00027424818836152554f, 5.318296098266728e-05f, 1.0313386155758053e-05f};
            float fr = 1.0f;
#pragma unroll
            for (int q = 0; q < 8; ++q) if (i == q) fr = invf[q];
            const float ang = (float)pos * fr;
            const double a = (double)ang; const double n = rint(a * 0.15915494309189535); const float rr = (float)(a - n * 6.283185307179586);
            float* rt = (float*)(p.ws + OFF_ROPE);
            rt[pos * 16 + i] = __cosf(rr); rt[pos * 16 + 8 + i] = __sinf(rr);
        }
    }
    norm_phase(p.x, p.norm1_g, (bf16_t*)(p.ws + OFF_ACT));
}

enum { EPI_PROJ = 0, EPI_WO = 1, EPI_UP = 2, EPI_DOWN = 3 };

DEVI float row_rstd(const float* ssq, int m) {
    const float4 a = *(const float4*)(ssq + (size_t)m * 16), b = *(const float4*)(ssq + (size_t)m * 16 + 4), c = *(const float4*)(ssq + (size_t)m * 16 + 8), d = *(const float4*)(ssq + (size_t)m * 16 + 12);
    const float t = ((a.x + a.y) + (a.z + a.w)) + ((b.x + b.y) + (b.z + b.w)) + ((c.x + c.y) + (c.z + c.w)) + ((d.x + d.y) + (d.z + d.w));
    return rsqrtf(t * (1.0f / 1024.0f) + 1e-6f);
}

template <int CH>
DEVI void proj_epilogue(const Params& p, int L, const f32x4 (&acc)[4][8], int m0w, int cc, int lane) {
    const int quad = lane >> 4, l15 = lane & 15;
    bf16_t* proj = (bf16_t*)(p.ws + OFF_BIG); bf16_t* VT = (bf16_t*)(p.ws + OFF_BIG + OFF_VT_IN_BIG);
    float* gates = (float*)(p.ws + OFF_GATES); const float* rope = (const float*)(p.ws + OFF_ROPE);
    if (cc > 48) return;
    int kind = 0, vidx = 0; const float* gain = nullptr; float scale = 1.f; bool dorope = false;
    if (cc >= 8 && cc < 12) { kind = 5; vidx = cc - 8; }
    else if (cc >= 16 && cc < 24) { kind = 1; gain = p.nsa_qn_g + L * 64; scale = 0.125f * 1.4426950408889634f; dorope = true; }
    else if (cc == 28 || cc == 29 || cc == 32 || cc == 33) { kind = 1; gain = p.nsa_kn_g + L * 64; dorope = true; }
    else if (cc == 30 || cc == 31) { kind = 5; vidx = 4 + (cc - 30); }
    else if (cc == 34 || cc == 35) { kind = 5; vidx = 6 + (cc - 34); }
    else if (cc >= 36 && cc < 40) { kind = 1; gain = p.fox_qn_g + L * 64; scale = 0.125f * 1.4426950408889634f; }
    else if (cc >= 40 && cc < 44) { kind = 1; gain = p.fox_kn_g + L * 64; }
    else if (cc >= 44 && cc < 48) { kind = 5; vidx = 8 + (cc - 44); }
    else if (cc == 48) kind = 6;
#pragma unroll
    for (int mi = 0; mi < 4; ++mi) {
        const int token = m0w + mi * 16 + l15, pos = token & 4095, bb = token >> 12;
        const float rs = (L > 0) ? row_rstd((const float*)(p.ws + OFF_SSQ), token) : 1.0f;
        float v[4][4];
#pragma unroll
        for (int ni = 0; ni < 4; ++ni)
#pragma unroll
            for (int j = 0; j < 4; ++j) v[ni][j] = acc[mi][CH * 4 + ni][j] * rs;
        if (kind == 6) {
#pragma unroll
            for (int ni = 0; ni < 2; ++ni)
#pragma unroll
                for (int j = 0; j < 4; ++j) { const int d = ni * 16 + quad * 4 + j;
                    if (d < 24) gates[(size_t)token * 32 + d] = 1.0f / (1.0f + __expf(-v[ni][j]));
                    else if (d < 28) gates[(size_t)token * 32 + d] = v[ni][j]; }
            asm volatile("" ::: "memory");
            continue;
        }
        if (kind == 1) {
            float ss = 0.f;
#pragma unroll
            for (int ni = 0; ni < 4; ++ni)
#pragma unroll
                for (int j = 0; j < 4; ++j) ss += v[ni][j] * v[ni][j];
            ss += __shfl_xor(ss, 16); ss += __shfl_xor(ss, 32);
            const float r = rsqrtf(ss * (1.0f / 64.0f) + 1e-6f);
#pragma unroll
            for (int ni = 0; ni < 4; ++ni) { const float4 gg = *(const float4*)(gain + ni * 16 + quad * 4);
                v[ni][0] *= r * gg.x; v[ni][1] *= r * gg.y; v[ni][2] *= r * gg.z; v[ni][3] *= r * gg.w; }
            if (dorope) {
                const float4 cs = *(const float4*)(rope + pos * 16 + (quad & 1) * 4), sn = *(const float4*)(rope + pos * 16 + 8 + (quad & 1) * 4);
                const float cv[4] = {cs.x, cs.y, cs.z, cs.w}, sv[4] = {sn.x, sn.y, sn.z, sn.w};
#pragma unroll
                for (int j = 0; j < 4; ++j) { const float xx = v[0][j], pp = __shfl_xor(xx, 32);
                    v[0][j] = (quad < 2) ? (xx * cv[j] - pp * sv[j]) : (xx * cv[j] + pp * sv[j]); }
            }
#pragma unroll
            for (int ni = 0; ni < 4; ++ni)
#pragma unroll
                for (int j = 0; j < 4; ++j) v[ni][j] *= scale;
        }
        if (kind == 5) {
#pragma unroll
            for (int ni = 0; ni < 4; ++ni)
#pragma unroll
                for (int j = 0; j < 4; ++j) { const int d = ni * 16 + quad * 4 + j;
                    VT[((size_t)(vidx * 8 + bb) * 64 + d) * 4096 + pos] = f2bf(v[ni][j]); }
        } else {
#pragma unroll
            for (int ni = 0; ni < 4; ++ni) { uint2 o; o.x = pk2(v[ni][0], v[ni][1]); o.y = pk2(v[ni][2], v[ni][3]);
                *(uint2*)(proj + (size_t)token * PJ_LD + cc * 64 + ni * 16 + quad * 4) = o; }
        }
        asm volatile("" ::: "memory");
    }
}

DEVI void g_load(uint4 (&RA)[4], uint4 (&RB)[4], const bf16_t* Ap, const bf16_t* Bp, int K, int KT) {
#pragma unroll
    for (int i = 0; i < 4; ++i) { RA[i] = *(const uint4*)(Ap + (size_t)(32 * i) * K + KT * 64); RB[i] = *(const uint4*)(Bp + (size_t)(32 * i) * K + KT * 64); }
}
DEVI void g_swrite(const uint4 (&RA)[4], const uint4 (&RB)[4], char* d_) {
#pragma unroll
    for (int i = 0; i < 4; ++i) { *(uint4*)(d_ + i * 4096) = RA[i]; *(uint4*)(d_ + 16384 + i * 4096) = RB[i]; }
}
DEVI void g_compute(const char* sA, f32x4 (&acc)[4][4], int wm, int wn, int quad, int l15) {
    const char* sB = sA + 16384;
#pragma unroll
    for (int ks = 0; ks < 2; ++ks) {
        bf16x8 af[4], bfr[4]; const int ch = ks * 4 + quad;
#pragma unroll
        for (int mi = 0; mi < 4; ++mi) { const int row = wm * 64 + mi * 16 + l15; af[mi] = *(const bf16x8*)(sA + row * 128 + ((ch ^ (row & 7)) << 4)); }
#pragma unroll
        for (int ni = 0; ni < 4; ++ni) { const int row = wn * 64 + ni * 16 + l15; bfr[ni] = *(const bf16x8*)(sB + row * 128 + ((ch ^ (row & 7)) << 4)); }
#pragma unroll
        for (int mi = 0; mi < 4; ++mi)
#pragma unroll
            for (int ni = 0; ni < 4; ++ni) acc[mi][ni] = mfma(bfr[ni], af[mi], acc[mi][ni]);
    }
}

template <int EPI>
__device__ __forceinline__ void gemm_phase(const Params& p, int L, char* lds) {
    const bf16_t* A; const bf16_t* Bt; int K, nNt;
    if (EPI == EPI_PROJ) { A = (const bf16_t*)(p.ws + OFF_ACT); Bt = (const bf16_t*)(p.ws + OFF_WIN) + (size_t)L * NW_IN_PAD * 1024; K = 1024; nNt = NW_IN_PAD / 256; }
    else if (EPI == EPI_WO) { A = (const bf16_t*)(p.ws + OFF_ACT); Bt = (const bf16_t*)(p.ws + OFF_WO) + (size_t)L * 1024 * 1024; K = 1024; nNt = 4; }
    else if (EPI == EPI_UP) { A = (const bf16_t*)(p.ws + OFF_ACT2); Bt = (const bf16_t*)(p.ws + OFF_WUP) + (size_t)L * 4096 * 1024; K = 1024; nNt = 16; }
    else { A = (const bf16_t*)(p.ws + OFF_BIG); Bt = (const bf16_t*)(p.ws + OFF_WDN) + (size_t)L * 1024 * 4096; K = 4096; nNt = 4; }
    const int tid = otid(), lane = tid & 63, w = tid >> 6, quad = lane >> 4, l15 = lane & 15, wm = w >> 1, wn = w & 1;
    const int xcd = blockIdx.x & 7, loc = blockIdx.x >> 3, nloc = gridDim.x >> 3;
    const int nk = K / 32;
    const int gsw = (0x1230 >> (((l15 >> 2) & 3) * 4)) & 3;
    const int rsw = (quad ^ gsw) << 4;
    for (int it = loc; it < 32 * nNt; it += nloc) {
        const int tl = otid();
        const int lrow = tl >> 2, lc = tl & 3;
        const int woff = lrow * 64 + ((lc ^ ((0x1230 >> (((lrow >> 2) & 3) * 4)) & 3)) << 4);
        const int gsz = 8 * nNt, mloc = (it / gsz) * 8 + (it & 7), nloc_t = (it % gsz) >> 3;
        const int m0 = (xcd + 8 * mloc) * 128, n0 = nloc_t * 256;
        f32x4 acc[4][8];
#pragma unroll
        for (int a = 0; a < 4; ++a)
#pragma unroll
            for (int b = 0; b < 8; ++b) acc[a][b] = (f32x4){0.f, 0.f, 0.f, 0.f};
        u32x8 ra0, ra1; u32x16 rb0, rb1;
        const bf16_t* Ap = A + (size_t)(m0 + lrow) * K + lc * 8;
        const bf16_t* Bp = Bt + (size_t)(n0 + lrow) * K + lc * 8;
#define G_LD1(R, P, I, KT) { const uint4 t_ = *(const uint4*)((P) + (size_t)(64 * I) * K + (KT) * 32); R[4 * I] = t_.x; R[4 * I + 1] = t_.y; R[4 * I + 2] = t_.z; R[4 * I + 3] = t_.w; }
#define G_LOAD(RA, RB, KT) { G_LD1(RA, Ap, 0, KT) G_LD1(RB, Bp, 0, KT) G_LD1(RA, Ap, 1, KT) G_LD1(RB, Bp, 1, KT) G_LD1(RB, Bp, 2, KT) G_LD1(RB, Bp, 3, KT) }
#define G_SW1(R, D, I) *(uint4*)((D) + I * 4096) = make_uint4(R[4 * I], R[4 * I + 1], R[4 * I + 2], R[4 * I + 3]);
#define G_SWRITE(RA, RB, DST) { G_SW1(RA, DST, 0) G_SW1(RB, (DST) + 8192, 0) G_SW1(RA, DST, 1) G_SW1(RB, (DST) + 8192, 1) G_SW1(RB, (DST) + 8192, 2) G_SW1(RB, (DST) + 8192, 3) }
#define G_COMPUTE(BUF) { const char* sA_ = (BUF) + (wm * 64 + l15) * 64 + rsw; const char* sB_ = (BUF) + 8192 + (wn * 128 + l15) * 64 + rsw; \
            bf16x8 af[4]; \
            _Pragma("unroll") for (int i_ = 0; i_ < 4; ++i_) af[i_] = *(const bf16x8*)(sA_ + i_ * 1024); \
            _Pragma("unroll") for (int nh = 0; nh < 2; ++nh) { bf16x8 bfr[4]; \
                _Pragma("unroll") for (int i_ = 0; i_ < 4; ++i_) bfr[i_] = *(const bf16x8*)(sB_ + (nh * 4 + i_) * 1024); \
                _Pragma("unroll") for (int mi = 0; mi < 4; ++mi) _Pragma("unroll") for (int ni = 0; ni < 4; ++ni) acc[mi][nh * 4 + ni] = mfma(bfr[ni], af[mi], acc[mi][nh * 4 + ni]); } }
        G_LOAD(ra0, rb0, 0)
        G_LOAD(ra1, rb1, 1)
        G_SWRITE(ra0, rb0, lds + woff)
        __syncthreads();
#pragma unroll 1
        for (int kt = 0; kt < nk - 2; kt += 2) {
            G_LOAD(ra0, rb0, kt + 2)
            __builtin_amdgcn_sched_barrier(0);
            G_COMPUTE(lds)
            G_SWRITE(ra1, rb1, lds + 24576 + woff)
            __syncthreads();
            G_LOAD(ra1, rb1, kt + 3)
            __builtin_amdgcn_sched_barrier(0);
            G_COMPUTE(lds + 24576)
            G_SWRITE(ra0, rb0, lds + woff)
            __syncthreads();
        }
        G_COMPUTE(lds)
        G_SWRITE(ra1, rb1, lds + 24576 + woff)
        __syncthreads();
        G_COMPUTE(lds + 24576)
        __syncthreads();
#undef G_LOAD
#undef G_SWRITE
#undef G_LD1
#undef G_SW1
#undef G_COMPUTE
        const int te = otid(); const int lane_e = te & 63, quad_e = lane_e >> 4, l15_e = lane_e & 15;
        const int mw = m0 + ((te >> 7) & 1) * 64, nw = n0 + ((te >> 6) & 1) * 128;
        if (EPI == EPI_PROJ) {
            proj_epilogue<0>(p, L, acc, mw, (nw >> 6), lane_e);
            proj_epilogue<1>(p, L, acc, mw, (nw >> 6) + 1, lane_e);
        } else if (EPI == EPI_UP) {
            bf16_t* hid = (bf16_t*)(p.ws + OFF_BIG);
#pragma unroll
            for (int mi = 0; mi < 4; ++mi) { const int m = mw + mi * 16 + l15_e; const float r = row_rstd((const float*)(p.ws + OFF_SSQ), m);
#pragma unroll
                for (int ni = 0; ni < 8; ++ni) { const int n = nw + ni * 16 + quad_e * 4;
                    float a0 = fmaxf(acc[mi][ni][0] * r, 0.f), a1 = fmaxf(acc[mi][ni][1] * r, 0.f), a2 = fmaxf(acc[mi][ni][2] * r, 0.f), a3 = fmaxf(acc[mi][ni][3] * r, 0.f);
                    uint2 o; o.x = pk2(a0 * a0, a1 * a1); o.y = pk2(a2 * a2, a3 * a3);
                    *(uint2*)(hid + (size_t)m * DFF + n) = o; } }
        } else {
            const float* xin = (EPI == EPI_WO && L == 0) ? p.x : p.out;
            const bool emit = (EPI == EPI_WO) || (L + 1 < 2);
            const float* gn = (EPI == EPI_WO) ? (p.norm2_g + L * 1024) : (p.norm1_g + (L + 1 < 2 ? L + 1 : L) * 1024);
            bf16_t* hn = (bf16_t*)(p.ws + ((EPI == EPI_WO) ? OFF_ACT2 : OFF_ACT));
            float* ssq = (float*)(p.ws + OFF_SSQ);
#pragma unroll
            for (int mi = 0; mi < 4; ++mi) {
#pragma unroll
                for (int hf = 0; hf < 2; ++hf) {
                    const int t3 = otid(); const int l15_e = t3 & 15, quad_e = (t3 >> 4) & 3;
                    const int m = mw + mi * 16 + l15_e;
                    float ss = 0.f;
#pragma unroll
                    for (int n4 = 0; n4 < 4; ++n4) { const int ni = hf * 4 + n4; const int n = nw + ni * 16 + quad_e * 4;
                        float4 xv = *(const float4*)(xin + (size_t)m * DM + n);
                        xv.x += acc[mi][ni][0]; xv.y += acc[mi][ni][1]; xv.z += acc[mi][ni][2]; xv.w += acc[mi][ni][3];
                        *(float4*)(p.out + (size_t)m * DM + n) = xv;
                        if (emit) { const float4 gg = *(const float4*)(gn + n);
                            uint2 o; o.x = pk2(xv.x * gg.x, xv.y * gg.y); o.y = pk2(xv.z * gg.z, xv.w * gg.w);
                            *(uint2*)(hn + (size_t)m * DM + n) = o;
                            ss += (xv.x * xv.x + xv.y * xv.y) + (xv.z * xv.z + xv.w * xv.w); } }
                    if (emit) { ss += __shfl_xor(ss, 16); ss += __shfl_xor(ss, 32);
                        if (quad_e == 0) ssq[(size_t)m * 16 + ((nw >> 6) + hf)] = ss; }
                    asm volatile("" ::: "memory");
                }
            }
        }
    }
}

DEVI float hgrn_lb(const Params& p, int L, int hk) {
    if (L == 0) return 0.f;
    const float l0 = p.lb_logits[hk], l1 = p.lb_logits[256 + hk];
    return 1.0f / (1.0f + __expf(l0 - l1));
}

__device__ void hgrn_a_unit(const Params& p, int L, int u, char* lds) {
    const int tid = otid(), lane = tid & 63, w = tid >> 6, quad = lane >> 4, l15 = lane & 15;
    const int c = u & 63, h = (u >> 6) & 3, b = u >> 8;
    const bf16_t* proj = (const bf16_t*)(p.ws + OFF_BIG); const bf16_t* VT = (const bf16_t*)(p.ws + OFF_BIG + OFF_VT_IN_BIG);
    float* segtot = (float*)lds;
    bf16_t* KDt = (bf16_t*)(lds + 1024);
    const int k = tid & 63, seg = tid >> 6;
    const float lb = hgrn_lb(p, L, h * 64 + k);
    float gl[16], kkv[16]; float run = 0.f;
    const bf16_t* zp = proj + (size_t)(b * 4096 + c * 64 + seg * 16) * PJ_LD + 256 + h * 64 + k;
#pragma unroll
    for (int i = 0; i < 16; ++i) {
        const float z = bf2f(zp[(size_t)i * PJ_LD]);
        const float sg = 1.0f / (1.0f + __expf(-z)), sn = 1.0f / (1.0f + __expf(z));
        const float f = lb + (1.0f - lb) * sg;
        run += __logf(fmaxf(f, 1e-30f)); gl[i] = run; kkv[i] = (1.0f - lb) * sn;
    }
    segtot[seg * 64 + k] = run;
    __syncthreads();
    float off = 0.f, tot = 0.f;
#pragma unroll
    for (int s = 0; s < 4; ++s) { const float t = segtot[s * 64 + k]; tot += t; if (s < seg) off += t; }
    unsigned pkd[8];
#pragma unroll
    for (int i = 0; i < 8; ++i) {
        const float a0 = kkv[2 * i] * __expf(tot - (off + gl[2 * i])), a1 = kkv[2 * i + 1] * __expf(tot - (off + gl[2 * i + 1]));
        pkd[i] = pk2(a0, a1);
    }
    *(uint4*)(KDt + k * 72 + seg * 16) = make_uint4(pkd[0], pkd[1], pkd[2], pkd[3]);
    *(uint4*)(KDt + k * 72 + seg * 16 + 8) = make_uint4(pkd[4], pkd[5], pkd[6], pkd[7]);
    if (seg == 0) ((float*)(p.ws + OFF_DECAY))[u * 64 + k] = __expf(tot);
    __syncthreads();
    const bf16_t* vt = VT + ((size_t)(h * 8 + b) * 64) * 4096 + c * 64;
    float* kvt = (float*)(p.ws + OFF_KVT) + (size_t)u * 4096;
    bf16x8 af[2];
#pragma unroll
    for (int ks = 0; ks < 2; ++ks) af[ks] = ld8(vt + (size_t)(w * 16 + l15) * 4096 + ks * 32 + quad * 8);
#pragma unroll
    for (int kt = 0; kt < 4; ++kt) {
        f32x4 acc = (f32x4){0.f, 0.f, 0.f, 0.f};
#pragma unroll
        for (int ks = 0; ks < 2; ++ks) { const bf16x8 bfr = *(const bf16x8*)(KDt + (kt * 16 + l15) * 72 + ks * 32 + quad * 8); acc = mfma(af[ks], bfr, acc); }
#pragma unroll
        for (int j = 0; j < 4; ++j) kvt[(w * 16 + quad * 4 + j) * 64 + kt * 16 + l15] = acc[j];
    }
    __syncthreads();
}

__device__ void hgrn_scan_phase(const Params& p) {
    const float* kvt = (const float*)(p.ws + OFF_KVT); const float* dec = (const float*)(p.ws + OFF_DECAY);
    bf16_t* st = (bf16_t*)(p.ws + OFF_ST);
    for (int e = blockIdx.x * 256 + otid(); e < 32 * 4096; e += gridDim.x * 256) {
        const int bh = e >> 12, vk = e & 4095, k = vk & 63;
        float S = 0.f;
#pragma unroll 8
        for (int c = 0; c < 64; ++c) {
            const int u = bh * 64 + c;
            st[(size_t)u * 4096 + vk] = f2bf(S);
            S = S * dec[u * 64 + k] + kvt[(size_t)u * 4096 + vk];
        }
    }
}

__device__ void hgrn_c_unit(const Params& p, int L, int u, char* lds) {
    const int tid = otid(), lane = tid & 63, w = tid >> 6, quad = lane >> 4, l15 = lane & 15;
    const int c = u & 63, h = (u >> 6) & 3, b = u >> 8;
    const bf16_t* proj = (const bf16_t*)(p.ws + OFF_BIG); const bf16_t* VT = (const bf16_t*)(p.ws + OFF_BIG + OFF_VT_IN_BIG);
    float* Gs = (float*)lds; float* KKs = Gs + 64 * 65; float* Qs = KKs + 64 * 65; float* segtot = Qs + 64 * 65;
    {
        const int k = tid & 63, seg = tid >> 6;
        const float lb = hgrn_lb(p, L, h * 64 + k);
        float gl[16], kkv[16]; float run = 0.f;
        const bf16_t* zp = proj + (size_t)(b * 4096 + c * 64 + seg * 16) * PJ_LD + 256 + h * 64 + k;
#pragma unroll
        for (int i = 0; i < 16; ++i) {
            const float z = bf2f(zp[(size_t)i * PJ_LD]);
            const float sg = 1.0f / (1.0f + __expf(-z)), sn = 1.0f / (1.0f + __expf(z));
            const float f = lb + (1.0f - lb) * sg;
            run += __logf(fmaxf(f, 1e-30f)); gl[i] = run; kkv[i] = (1.0f - lb) * sn;
            Qs[(seg * 16 + i) * 65 + k] = bf2f(zp[(size_t)i * PJ_LD - 256]) * 0.125f;
        }
        segtot[seg * 64 + k] = run;
        __syncthreads();
        float off = 0.f;
#pragma unroll
        for (int s = 0; s < 4; ++s) { const float t = segtot[s * 64 + k]; if (s < seg) off += t; }
#pragma unroll
        for (int i = 0; i < 16; ++i) { Gs[(seg * 16 + i) * 65 + k] = off + gl[i]; KKs[(seg * 16 + i) * 65 + k] = kkv[i]; }
        __syncthreads();
    }
    const int I = w;
    const int tq = 16 * I + l15;
    bf16x8 qt[2], qg[2];
#pragma unroll
    for (int ks = 0; ks < 2; ++ks) {
        float a[8], g8[8];
#pragma unroll
        for (int j = 0; j < 8; ++j) {
            const int k = ks * 32 + quad * 8 + j;
            const float G = Gs[tq * 65 + k], q = Qs[tq * 65 + k];
            const float gref = (I == 0) ? 0.f : Gs[(16 * I - 1) * 65 + k];
            a[j] = q * __expf(G - gref); g8[j] = q * __expf(G);
        }
        qt[ks] = mk8(pk2(a[0], a[1]), pk2(a[2], a[3]), pk2(a[4], a[5]), pk2(a[6], a[7]));
        qg[ks] = mk8(pk2(g8[0], g8[1]), pk2(g8[2], g8[3]), pk2(g8[4], g8[5]), pk2(g8[6], g8[7]));
    }
    f32x4 O[4];
#pragma unroll
    for (int vt = 0; vt < 4; ++vt) O[vt] = (f32x4){0.f, 0.f, 0.f, 0.f};
    const bf16_t* st = (const bf16_t*)(p.ws + OFF_ST) + (size_t)u * 4096;
#pragma unroll
    for (int vt = 0; vt < 4; ++vt)
#pragma unroll
        for (int ks = 0; ks < 2; ++ks) O[vt] = mfma(ld8(st + (vt * 16 + l15) * 64 + ks * 32 + quad * 8), qg[ks], O[vt]);
    const bf16_t* vtp = VT + ((size_t)(h * 8 + b) * 64) * 4096 + c * 64;
    for (int Jp = 0; Jp <= (I >> 1); ++Jp) {
        f32x4 sc[2];
#pragma unroll
        for (int jj = 0; jj < 2; ++jj) {
            const int J = 2 * Jp + jj;
            sc[jj] = (f32x4){0.f, 0.f, 0.f, 0.f};
            if (J <= I) {
                const int s = 16 * J + l15;
#pragma unroll
                for (int ks = 0; ks < 2; ++ks) {
                    float a[8];
#pragma unroll
                    for (int j = 0; j < 8; ++j) {
                        const int k = ks * 32 + quad * 8 + j;
                        const float gref = (I == 0) ? 0.f : Gs[(16 * I - 1) * 65 + k];
                        a[j] = KKs[s * 65 + k] * __expf(gref - Gs[s * 65 + k]);
                    }
                    sc[jj] = mfma(mk8(pk2(a[0], a[1]), pk2(a[2], a[3]), pk2(a[4], a[5]), pk2(a[6], a[7])), qt[ks], sc[jj]);
                }
#pragma unroll
                for (int j = 0; j < 4; ++j) { const int s2 = 16 * J + quad * 4 + j; if (s2 > tq) sc[jj][j] = 0.f; }
            }
        }
        const bf16x8 P = mk8(pk2(sc[0][0], sc[0][1]), pk2(sc[0][2], sc[0][3]), pk2(sc[1][0], sc[1][1]), pk2(sc[1][2], sc[1][3]));
#pragma unroll
        for (int vt = 0; vt < 4; ++vt) {
            const bf16_t* r = vtp + (size_t)(vt * 16 + l15) * 4096 + 32 * Jp + quad * 4;
            O[vt] = mfma(ld4x2(r, r + 16), P, O[vt]);
        }
    }
    float ss = 0.f;
#pragma unroll
    for (int vt = 0; vt < 4; ++vt)
#pragma unroll
        for (int j = 0; j < 4; ++j) ss += O[vt][j] * O[vt][j];
    ss += __shfl_xor(ss, 16); ss += __shfl_xor(ss, 32);
    const float r = rsqrtf(ss * (1.0f / 64.0f) + 1e-6f);
    const size_t token = (size_t)b * 4096 + c * 64 + tq;
    bf16_t* mix = (bf16_t*)(p.ws + OFF_ACT);
#pragma unroll
    for (int vt = 0; vt < 4; ++vt) {
        const int v0 = vt * 16 + quad * 4;
        const float4 og = *(const float4*)(p.onorm_g + L * 64 + v0);
        const uint2 gz = *(const uint2*)(proj + token * PJ_LD + 768 + h * 64 + v0);
        const float g0 = bflo(gz.x), g1 = bfhi(gz.x), g2 = bflo(gz.y), g3 = bfhi(gz.y);
        const float o0 = O[vt][0] * r * og.x * (g0 / (1.0f + __expf(-g0))), o1 = O[vt][1] * r * og.y * (g1 / (1.0f + __expf(-g1)));
        const float o2 = O[vt][2] * r * og.z * (g2 / (1.0f + __expf(-g2))), o3 = O[vt][3] * r * og.w * (g3 / (1.0f + __expf(-g3)));
        uint2 o; o.x = pk2(o0, o1); o.y = pk2(o2, o3);
        *(uint2*)(mix + token * DM + h * 64 + v0) = o;
    }
    __syncthreads();
}

__device__ void compress_unit(const Params& p, int L, int u, char* lds) {
    const int tid = otid(), lane = tid & 63, w = tid >> 6, quad = lane >> 4, l15 = lane & 15;
    const int which = u & 1, g = (u >> 1) & 1, b = (u >> 2) & 7, ntile = u >> 5;
    const bf16_t* proj = (const bf16_t*)(p.ws + OFF_BIG);
    const bf16_t* w1t = (const bf16_t*)(p.ws + OFF_W1T) + (size_t)(L * 2 + which) * 128 * 2048;
    const bf16_t* w2t = (const bf16_t*)(p.ws + OFF_W2T) + (size_t)(L * 2 + which) * 64 * 128;
    const float* cbias = (const float*)(p.ws + OFF_CBIAS) + (L * 2 + which) * 128;
    bf16_t* Hs = (bf16_t*)lds + w * 16 * 136;
    const int nrow = ntile * 64 + w * 16 + l15;
    int tokbase = 16 * nrow; if (tokbase > 4096 - 32) tokbase = 4096 - 32;
    const bf16_t* xa = proj + ((size_t)b * 4096 + tokbase) * PJ_LD + (which ? 1664 : 1536) + g * 64;
    f32x4 acc[8];
#pragma unroll
    for (int i = 0; i < 8; ++i) acc[i] = (f32x4){0.f, 0.f, 0.f, 0.f};
#pragma unroll 2
    for (int kk = 0; kk < 64; ++kk) {
        const int l = kk >> 1, d = (kk & 1) * 32 + quad * 8;
        const bf16x8 a = ld8(xa + (size_t)l * PJ_LD + d);
#pragma unroll
        for (int ni = 0; ni < 8; ++ni) acc[ni] = mfma(a, ld8(w1t + (size_t)(ni * 16 + l15) * 2048 + kk * 32 + quad * 8), acc[ni]);
    }
#pragma unroll
    for (int ni = 0; ni < 8; ++ni) { const float bsv = cbias[ni * 16 + l15];
#pragma unroll
        for (int j = 0; j < 4; ++j) { const float x = acc[ni][j] + bsv;
            const float uu = 0.7978845608028654f * (x + 0.044715f * x * x * x);
            const float th = 1.0f - 2.0f / (1.0f + __expf(2.0f * uu));
            Hs[(quad * 4 + j) * 136 + ni * 16 + l15] = f2bf(0.5f * x * (1.0f + th)); } }
    __syncthreads();
    f32x4 o[4];
#pragma unroll
    for (int i = 0; i < 4; ++i) o[i] = (f32x4){0.f, 0.f, 0.f, 0.f};
#pragma unroll
    for (int ks = 0; ks < 4; ++ks) { const bf16x8 a = *(const bf16x8*)(Hs + l15 * 136 + ks * 32 + quad * 8);
#pragma unroll
        for (int ni = 0; ni < 4; ++ni) o[ni] = mfma(a, ld8(w2t + (size_t)(ni * 16 + l15) * 128 + ks * 32 + quad * 8), o[ni]); }
    const int nb = ntile * 64 + w * 16 + quad * 4;
    if (which == 0) {
        bf16_t* kc = (bf16_t*)(p.ws + OFF_KC) + (size_t)(b * 2 + g) * 256 * 64;
        const float* rope = (const float*)(p.ws + OFF_ROPE);
#pragma unroll
        for (int j = 0; j < 4; ++j) {
            const int n = nb + j;
            float ss = o[0][j] * o[0][j] + o[1][j] * o[1][j] + o[2][j] * o[2][j] + o[3][j] * o[3][j];
            ss += __shfl_xor(ss, 1); ss += __shfl_xor(ss, 2); ss += __shfl_xor(ss, 4); ss += __shfl_xor(ss, 8);
            const float r = rsqrtf(ss * (1.0f / 64.0f) + 1e-6f);
            float v[4];
#pragma unroll
            for (int ni = 0; ni < 4; ++ni) v[ni] = o[ni][j] * r * p.nsa_kn_g[L * 64 + ni * 16 + l15];
            int pos = 16 * n + 31; if (pos > 4095) pos = 4095;
            const float cs = rope[pos * 16 + (l15 & 7)], sn = rope[pos * 16 + 8 + (l15 & 7)];
            const float pp = __shfl_xor(v[0], 8);
            v[0] = (l15 < 8) ? (v[0] * cs - pp * sn) : (v[0] * cs + pp * sn);
#pragma unroll
            for (int ni = 0; ni < 4; ++ni) kc[(size_t)n * 64 + ni * 16 + l15] = (n < 255) ? f2bf(v[ni]) : (bf16_t)0;
        }
    } else {
        bf16_t* vct = (bf16_t*)(p.ws + OFF_VCT) + (size_t)(b * 2 + g) * 64 * 256;
#pragma unroll
        for (int ni = 0; ni < 4; ++ni) {
            float v0 = o[ni][0], v1 = o[ni][1], v2 = o[ni][2], v3 = o[ni][3];
            if (nb + 3 >= 255) v3 = 0.f;
            uint2 ov; ov.x = pk2(v0, v1); ov.y = pk2(v2, v3);
            *(uint2*)(vct + (size_t)(ni * 16 + l15) * 256 + nb) = ov;
        }
    }
    __syncthreads();
}

__device__ void foxc_job(const Params& p, int L, int bh, char* lds) {
    const int tid = otid(), lane = tid & 63, w = tid >> 6, b = bh >> 2, h = bh & 3;
    const float* gates = (const float*)(p.ws + OFF_GATES);
    float* cc = (float*)(p.ws + OFF_FOXC) + (size_t)bh * 4096;
    float* wtot = (float*)lds;
    const float fb = p.fox_fb[L * 4 + h];
    float v[16];
#pragma unroll
    for (int i = 0; i < 16; ++i) v[i] = gates[((size_t)b * 4096 + tid * 16 + i) * 32 + 24 + h] + fb;
    float run = 0.f;
#pragma unroll
    for (int i = 0; i < 16; ++i) { const float x = v[i]; run += (x >= 0.f) ? -log1pf(__expf(-x)) : (x - log1pf(__expf(x))); v[i] = run; }
    float incl = run;
#pragma unroll
    for (int o = 1; o < 64; o <<= 1) { const float t = __shfl_up(incl, o); if (lane >= o) incl += t; }
    if (lane == 63) wtot[w] = incl;
    __syncthreads();
    float pre = incl - run;
#pragma unroll
    for (int s = 0; s < 4; ++s) if (s < w) pre += wtot[s];
#pragma unroll
    for (int i = 0; i < 4; ++i) { const float k2 = 1.4426950408889634f;
        *(float4*)(cc + tid * 16 + i * 4) = make_float4((pre + v[4 * i]) * k2, (pre + v[4 * i + 1]) * k2, (pre + v[4 * i + 2]) * k2, (pre + v[4 * i + 3]) * k2); }
    __syncthreads();
}

constexpr int KV_BUF = 16384;
DEVI void tile_glds(const bf16_t* Kg, int ldk, const bf16_t* Vg, int ldv, char* buf, int tid) {
    const int w = tid >> 6, i = tid & 63;
#pragma unroll
    for (int jj = 0; jj < 2; ++jj) {
        const int j = w * 2 + jj, row = 8 * j + (i >> 3), slot = i & 7;
        const bf16_t* kp = Kg + (size_t)row * ldk + ((slot ^ (row & 7)) << 3);
        const bf16_t* vp = Vg + (size_t)row * ldv + ((slot ^ ((row >> 1) & 7)) << 3);
        __builtin_amdgcn_global_load_lds((const unsigned*)kp, (ldsp_t)(unsigned)(size_t)(buf + j * 1024), 16, 0, 0);
        __builtin_amdgcn_global_load_lds((const unsigned*)vp, (ldsp_t)(unsigned)(size_t)(buf + 8192 + j * 1024), 16, 0, 0);
    }
}
DEVI void lds_kf(const char* buf, int kh, int lane, bf16x8 (&kf)[2][2]) {
    const int quad = lane >> 4, l15 = lane & 15;
#pragma unroll
    for (int t2 = 0; t2 < 2; ++t2)
#pragma unroll
        for (int ks = 0; ks < 2; ++ks) { const int row = kh * 32 + t2 * 16 + l15, ch = ks * 4 + quad; kf[t2][ks] = *(const bf16x8*)(buf + row * 128 + ((ch ^ (row & 7)) << 4)); }
}
DEVI void lds_vf(const char* buf, int kh, int lane, bf16x8 (&vf)[4]) {
    const int quad = lane >> 4, l15 = lane & 15;
#pragma unroll
    for (int dt = 0; dt < 4; ++dt) { const int d = dt * 16 + l15, u0 = kh * 8 + quad, u1 = u0 + 4;
        const uint2 a = *(const uint2*)(buf + 8192 + d * 128 + ((u0 ^ (d & 14)) << 3)), b = *(const uint2*)(buf + 8192 + d * 128 + ((u1 ^ (d & 14)) << 3));
        vf[dt] = mk8(a.x, a.y, b.x, b.y); }
}

template <class MaskF>
DEVI void attn_block64(const char* buf, int kbase, const char* ql, int q0o, int q1o, int qstride, const float* cb, f32x4 (&O)[4][4], float (&m)[4], float (&l)[4], int lane, MaskF maskf) {
    const int quad = lane >> 4;
#pragma unroll
    for (int kh = 0; kh < 2; ++kh) {
        bf16x8 kf[2][2], vf[4];
        lds_kf(buf, kh, lane, kf); lds_vf(buf, kh, lane, vf);
        float ck[8] = {0.f, 0.f, 0.f, 0.f, 0.f, 0.f, 0.f, 0.f};
        if (cb) { const float4 c0 = *(const float4*)(cb + kbase + kh * 32 + quad * 4), c1 = *(const float4*)(cb + kbase + kh * 32 + 16 + quad * 4);
            ck[0] = c0.x; ck[1] = c0.y; ck[2] = c0.z; ck[3] = c0.w; ck[4] = c1.x; ck[5] = c1.y; ck[6] = c1.z; ck[7] = c1.w; }
#pragma unroll
        for (int nt = 0; nt < 4; ++nt) {
            f32x4 s0 = (f32x4){0.f, 0.f, 0.f, 0.f}, s1 = s0;
            { const bf16x8 qa = *(const bf16x8*)(ql + nt * qstride + q0o), qb_ = *(const bf16x8*)(ql + nt * qstride + q1o);
              s0 = mfma(kf[0][0], qa, s0); s1 = mfma(kf[1][0], qa, s1); s0 = mfma(kf[0][1], qb_, s0); s1 = mfma(kf[1][1], qb_, s1); }
            float sv[8]; bool ok[8]; float mx = -1e30f;
#pragma unroll
            for (int e = 0; e < 8; ++e) { sv[e] = (e < 4) ? s0[e & 3] : s1[e & 3]; const int key = kbase + kh * 32 + (e >> 2) * 16 + quad * 4 + (e & 3);
                ok[e] = maskf(nt, ck[e], key, sv[e]); if (ok[e]) mx = fmaxf(mx, sv[e]); }
            mx = fmaxf(mx, __shfl_xor(mx, 16)); mx = fmaxf(mx, __shfl_xor(mx, 32));
            const float mn = fmaxf(m[nt], mx), alpha = __builtin_amdgcn_exp2f(m[nt] - mn);
            float pv[8]; float rs = 0.f;
#pragma unroll
            for (int e = 0; e < 8; ++e) { pv[e] = ok[e] ? __builtin_amdgcn_exp2f(sv[e] - mn) : 0.f; rs += pv[e]; }
            rs += __shfl_xor(rs, 16); rs += __shfl_xor(rs, 32);
            l[nt] = l[nt] * alpha + rs; m[nt] = mn;
            const bf16x8 P = mk8(pk2(pv[0], pv[1]), pk2(pv[2], pv[3]), pk2(pv[4], pv[5]), pk2(pv[6], pv[7]));
#pragma unroll
            for (int dt = 0; dt < 4; ++dt) { O[dt][nt] = O[dt][nt] * alpha; O[dt][nt] = mfma(vf[dt], P, O[dt][nt]); }
        }
    }
}

template <class MaskF>
DEVI void attn_stream(u64 tiles, const bf16_t* Kbase, int ldk, const bf16_t* Vbase, int ldv, char* kvbuf, int jb_wave_min, int jb_wave_max,
                      const char* ql, int q0o, int q1o, int qstride, const float* cb, f32x4 (&O)[4][4], float (&m)[4], float (&l)[4], int tid, int lane, MaskF maskf) {
    if (tiles == 0ull) return;
    int jb = __ffsll((long long)tiles) - 1; tiles &= tiles - 1;
    tile_glds(Kbase + (size_t)jb * 64 * ldk, ldk, Vbase + jb * 64, ldv, kvbuf, tid);
    __syncthreads();
    int cur = 0;
#pragma unroll 1
    for (;;) {
        const bool more = tiles != 0ull;
        int jbn = 0;
        if (more) { jbn = __ffsll((long long)tiles) - 1; tiles &= tiles - 1; tile_glds(Kbase + (size_t)jbn * 64 * ldk, ldk, Vbase + jbn * 64, ldv, kvbuf + (cur ^ 1) * KV_BUF, tid); }
        if (jb >= jb_wave_min && jb <= jb_wave_max) attn_block64(kvbuf + cur * KV_BUF, jb * 64, ql, q0o, q1o, qstride, cb, O, m, l, lane, [&](int nt, float ckv, int key, float& s) { return maskf(nt, ckv, key, jb, s); });
        __syncthreads();
        if (!more) break;
        jb = jbn; cur ^= 1;
    }
}

DEVI void attn_store2(bf16_t* mix, size_t token0, int tokstride, int col0, int colstride, const f32x4 (&O)[4][4], const float (&sc)[4], int lane, bool accum) {
    const int quad = lane >> 4, l15 = lane & 15;
#pragma unroll
    for (int nt = 0; nt < 4; ++nt)
#pragma unroll
        for (int dt = 0; dt < 4; ++dt) {
            bf16_t* dst = mix + (token0 + nt * tokstride + l15) * DM + col0 + nt * colstride + dt * 16 + quad * 4;
            float a0 = O[dt][nt][0] * sc[nt], a1 = O[dt][nt][1] * sc[nt], a2 = O[dt][nt][2] * sc[nt], a3 = O[dt][nt][3] * sc[nt];
            if (accum) { const uint2 old = *(const uint2*)dst; a0 += bflo(old.x); a1 += bfhi(old.x); a2 += bflo(old.y); a3 += bfhi(old.y); }
            uint2 o; o.x = pk2(a0, a1); o.y = pk2(a2, a3);
            *(uint2*)dst = o;
        }
}

__device__ void nsa_unit(const Params& p, int L, int b, int g, int blk, char* lds) {
    const int tid = otid(), lane = tid & 63, w = tid >> 6, quad = lane >> 4, l15 = lane & 15;
    const bf16_t* proj = (const bf16_t*)(p.ws + OFF_BIG); const bf16_t* VT = (const bf16_t*)(p.ws + OFF_BIG + OFF_VT_IN_BIG);
    const float* gates = (const float*)(p.ws + OFF_GATES);
    bf16_t* mix = (bf16_t*)(p.ws + OFF_ACT);
    char* kvbuf = lds; float* impL = (float*)(lds + KV_BUF)  ; char* Qs = lds + 32768; u64* selm = (u64*)(lds + 65536);
    const int q0 = blk * 64; const int tq = q0 + w * 16 + l15; const size_t token = (size_t)b * 4096 + tq;
    const size_t token0 = (size_t)b * 4096 + q0 + w * 16;
    const int mixcol = 256 + g * 256;
#pragma unroll
    for (int t = 0; t < 8; ++t) { const int idx = t * 64 + lane, rr = idx >> 3, c = idx & 7, hh = rr >> 4, r16 = rr & 15;
        const uint4 v = *(const uint4*)(proj + (token0 + r16) * PJ_LD + 1024 + (g * 4 + hh) * 64 + c * 8);
        *(uint4*)(Qs + (hh * 64 + w * 16 + r16) * 128 + ((c ^ (r16 & 7)) << 4)) = v; }
    const char* ql = Qs + (w * 16 + l15) * 128; const int q0o = ((quad) ^ (l15 & 7)) << 4, q1o = ((4 + quad) ^ (l15 & 7)) << 4; const int qstride = 8192;
    __syncthreads();
    f32x4 O[4][4]; float m[4], l[4];
    const bf16_t* Kc = (const bf16_t*)(p.ws + OFF_KC) + (size_t)(b * 2 + g) * 256 * 64;
    const bf16_t* VcT = (const bf16_t*)(p.ws + OFF_VCT) + (size_t)(b * 2 + g) * 64 * 256;
    const int ncb = (4 * blk + 3 + 63) >> 6;
#pragma unroll
    for (int nt = 0; nt < 4; ++nt) { m[nt] = -1e30f; l[nt] = 0.f; }
    {
#pragma unroll 1
        for (int pass = 0; pass < 2; ++pass) {
            float inv[4]; float prevr = 0.f;
            if (pass == 1) {
#pragma unroll
                for (int nt = 0; nt < 4; ++nt) inv[nt] = 1.0f / fmaxf(l[nt], 1e-30f);
#pragma unroll
                for (int dt = 0; dt < 4; ++dt)
#pragma unroll
                    for (int nt = 0; nt < 4; ++nt) O[dt][nt] = (f32x4){0.f, 0.f, 0.f, 0.f};
            }
#pragma unroll 1
            for (int ct = 0; ct < ncb; ++ct) {
                tile_glds(Kc + (size_t)ct * 64 * 64, 64, VcT + ct * 64, 256, kvbuf, tid);
                __syncthreads();
                const char* buf = kvbuf;
#pragma unroll
                for (int kh = 0; kh < 2; ++kh) {
                    bf16x8 kf[2][2]; lds_kf(buf, kh, lane, kf);
                    if (pass == 0) {
#pragma unroll
                        for (int nt = 0; nt < 4; ++nt) {
                            f32x4 s0 = (f32x4){0.f, 0.f, 0.f, 0.f}, s1 = s0;
                            { const bf16x8 qa = *(const bf16x8*)(ql + nt * qstride + q0o), qb_ = *(const bf16x8*)(ql + nt * qstride + q1o);
                              s0 = mfma(kf[0][0], qa, s0); s1 = mfma(kf[1][0], qa, s1); s0 = mfma(kf[0][1], qb_, s0); s1 = mfma(kf[1][1], qb_, s1); }
                            float sv[8]; bool ok[8]; float mx = -1e30f;
#pragma unroll
                            for (int e = 0; e < 8; ++e) { sv[e] = (e < 4) ? s0[e & 3] : s1[e & 3]; const int n = ct * 64 + kh * 32 + (e >> 2) * 16 + quad * 4 + (e & 3);
                                ok[e] = (16 * n + 31 <= tq); if (ok[e]) mx = fmaxf(mx, sv[e]); }
                            mx = fmaxf(mx, __shfl_xor(mx, 16)); mx = fmaxf(mx, __shfl_xor(mx, 32));
                            const float mn = fmaxf(m[nt], mx), alpha = __builtin_amdgcn_exp2f(m[nt] - mn);
                            float rs = 0.f;
#pragma unroll
                            for (int e = 0; e < 8; ++e) rs += ok[e] ? __builtin_amdgcn_exp2f(sv[e] - mn) : 0.f;
                            rs += __shfl_xor(rs, 16); rs += __shfl_xor(rs, 32);
                            l[nt] = l[nt] * alpha + rs; m[nt] = mn;
                        }
                    } else {
                        bf16x8 vf[4]; lds_vf(buf, kh, lane, vf);
                        float As[2] = {0.f, 0.f}, p3[2] = {0.f, 0.f};
#pragma unroll
                        for (int nt = 0; nt < 4; ++nt) {
                            f32x4 s0 = (f32x4){0.f, 0.f, 0.f, 0.f}, s1 = s0;
                            { const bf16x8 qa = *(const bf16x8*)(ql + nt * qstride + q0o), qb_ = *(const bf16x8*)(ql + nt * qstride + q1o);
                              s0 = mfma(kf[0][0], qa, s0); s1 = mfma(kf[1][0], qa, s1); s0 = mfma(kf[0][1], qb_, s0); s1 = mfma(kf[1][1], qb_, s1); }
                            float pv[8];
#pragma unroll
                            for (int e = 0; e < 8; ++e) { const float s = (e < 4) ? s0[e & 3] : s1[e & 3]; const int n = ct * 64 + kh * 32 + (e >> 2) * 16 + quad * 4 + (e & 3);
                                pv[e] = (16 * n + 31 <= tq) ? __builtin_amdgcn_exp2f(s - m[nt]) * inv[nt] : 0.f; }
                            As[0] += (pv[0] + pv[1]) + (pv[2] + pv[3]); As[1] += (pv[4] + pv[5]) + (pv[6] + pv[7]); p3[0] += pv[3]; p3[1] += pv[7];
                            const bf16x8 P = mk8(pk2(pv[0], pv[1]), pk2(pv[2], pv[3]), pk2(pv[4], pv[5]), pk2(pv[6], pv[7]));
#pragma unroll
                            for (int dt = 0; dt < 4; ++dt) O[dt][nt] = mfma(vf[dt], P, O[dt][nt]);
                        }
                        const int qq = w * 16 + l15;
#pragma unroll
                        for (int t2 = 0; t2 < 2; ++t2) {
                            const float rr = __shfl(p3[t2], (lane + 48) & 63);
                            const float carry = (quad == 0) ? prevr : rr; prevr = rr;
                            const int jb = ct * 16 + kh * 8 + t2 * 4 + quad;
                            impL[jb * 64 + ((qq ^ jb) & 63)] = As[t2] + carry;
                        }
                    }
                }
                __syncthreads();
            }
        }
    }
    {
        const float4 gv = *(const float4*)(gates + token * 32 + 0 * 8 + g * 4);
        const float sc[4] = {gv.x, gv.y, gv.z, gv.w};
        attn_store2(mix, token0, 0, mixcol, 64, O, sc, lane, false);
    }
#pragma unroll 1
    for (int qi = 0; qi < 16; ++qi) {
        const int q = w * 16 + qi, jb = lane;
        float val = impL[jb * 64 + ((q ^ jb) & 63)];
        if (jb > blk) val = -1e30f;
        else if (jb == 0 || jb == blk || jb == blk - 1) val = 1e30f;
        int rank = 0;
        for (int jp = 0; jp < 64; ++jp) { const float vj = __shfl(val, jp); rank += ((vj > val) || (vj == val && jp < jb)) ? 1 : 0; }
        const bool sel = (rank < 16) && (val > -5e29f);
        const u64 mask = __ballot(sel);
        if (lane == 0) selm[q] = mask;
    }
    __syncthreads();
    u64 uni = 0;
    for (int q = 0; q < 64; ++q) uni |= selm[q];
    const u64 sm = selm[w * 16 + l15];
    {
#pragma unroll
        for (int nt = 0; nt < 4; ++nt) { m[nt] = -1e30f; l[nt] = 0.f; }
#pragma unroll
        for (int dt = 0; dt < 4; ++dt)
#pragma unroll
            for (int nt = 0; nt < 4; ++nt) O[dt][nt] = (f32x4){0.f, 0.f, 0.f, 0.f};
        const u64 tiles = uni & ((blk == 63) ? ~0ull : ((2ull << blk) - 1ull));
        attn_stream(tiles, proj + (size_t)b * 4096 * PJ_LD + 1792 + g * 64, PJ_LD, VT + ((size_t)((4 + g) * 8 + b) * 64) * 4096, 4096, kvbuf, 0, 63, ql, q0o, q1o, qstride, nullptr, O, m, l, tid, lane,
                    [&](int nt, float ckv, int key, int jb, float& s) { return (((sm >> jb) & 1ull) != 0) && (key <= tq); });
        const float4 gv = *(const float4*)(gates + token * 32 + 1 * 8 + g * 4);
        const float sc[4] = {gv.x / fmaxf(l[0], 1e-30f), gv.y / fmaxf(l[1], 1e-30f), gv.z / fmaxf(l[2], 1e-30f), gv.w / fmaxf(l[3], 1e-30f)};
        attn_store2(mix, token0, 0, mixcol, 64, O, sc, lane, true);
    }
    {
#pragma unroll
        for (int nt = 0; nt < 4; ++nt) { m[nt] = -1e30f; l[nt] = 0.f; }
#pragma unroll
        for (int dt = 0; dt < 4; ++dt)
#pragma unroll
            for (int nt = 0; nt < 4; ++nt) O[dt][nt] = (f32x4){0.f, 0.f, 0.f, 0.f};
        const int jlo = blk > 8 ? blk - 8 : 0;
        const u64 upto = (blk == 63) ? ~0ull : ((2ull << blk) - 1ull);
        const u64 tiles = upto & ~((1ull << jlo) - 1ull);
        attn_stream(tiles, proj + (size_t)b * 4096 * PJ_LD + 2048 + g * 64, PJ_LD, VT + ((size_t)((6 + g) * 8 + b) * 64) * 4096, 4096, kvbuf, 0, 63, ql, q0o, q1o, qstride, nullptr, O, m, l, tid, lane,
                    [&](int nt, float ckv, int key, int jb, float& s) { return (key <= tq) && (key + 512 > tq); });
        const float4 gv = *(const float4*)(gates + token * 32 + 2 * 8 + g * 4);
        const float sc[4] = {gv.x / fmaxf(l[0], 1e-30f), gv.y / fmaxf(l[1], 1e-30f), gv.z / fmaxf(l[2], 1e-30f), gv.w / fmaxf(l[3], 1e-30f)};
        attn_store2(mix, token0, 0, mixcol, 64, O, sc, lane, true);
    }
    __syncthreads();
}

__device__ void fox_unit(const Params& p, int L, int b, int h, int qb, char* lds) {
    const int tid = otid(), lane = tid & 63, w = tid >> 6, quad = lane >> 4, l15 = lane & 15;
    const bf16_t* proj = (const bf16_t*)(p.ws + OFF_BIG); const bf16_t* VT = (const bf16_t*)(p.ws + OFF_BIG + OFF_VT_IN_BIG);
    bf16_t* mix = (bf16_t*)(p.ws + OFF_ACT);
    const float* cc = (const float*)(p.ws + OFF_FOXC) + (size_t)(b * 4 + h) * 4096;
    const int q0 = qb * 256 + w * 64; const size_t token0 = (size_t)b * 4096 + q0;
    int tq[4]; float cq[4];
#pragma unroll
    for (int nt = 0; nt < 4; ++nt) { tq[nt] = q0 + nt * 16 + l15; cq[nt] = cc[tq[nt]]; }
    char* Qs = lds + 32768;
#pragma unroll
    for (int t = 0; t < 8; ++t) { const int idx = t * 64 + lane, rr = idx >> 3, c = idx & 7;
        const uint4 v = *(const uint4*)(proj + (token0 + rr) * PJ_LD + 2304 + h * 64 + c * 8);
        *(uint4*)(Qs + (w * 64 + rr) * 128 + ((c ^ (rr & 7)) << 4)) = v; }
    const char* ql = Qs + (w * 64 + l15) * 128; const int q0o = ((quad) ^ (l15 & 7)) << 4, q1o = ((4 + quad) ^ (l15 & 7)) << 4; const int qstride = 2048;
    __syncthreads();
    f32x4 O[4][4]; float m[4], l[4];
#pragma unroll
    for (int nt = 0; nt < 4; ++nt) { m[nt] = -1e30f; l[nt] = 0.f; }
#pragma unroll
    for (int dt = 0; dt < 4; ++dt)
#pragma unroll
        for (int nt = 0; nt < 4; ++nt) O[dt][nt] = (f32x4){0.f, 0.f, 0.f, 0.f};
    const int jmax = qb * 4 + 3;
    int jlo_w, jlo_b;
    { const float cq0 = cc[q0]; int lo = 0, hi = qb * 4 + w;
      while (lo < hi) { const int mid = (lo + hi) >> 1; if (cq0 - cc[mid * 64 + 63] >= -202.f) hi = mid; else lo = mid + 1; }
      jlo_w = lo; }
    { const float cq0 = cc[qb * 256]; int lo = 0, hi = qb * 4;
      while (lo < hi) { const int mid = (lo + hi) >> 1; if (cq0 - cc[mid * 64 + 63] >= -202.f) hi = mid; else lo = mid + 1; }
      jlo_b = lo; }
    const u64 tiles = ((jmax == 63) ? ~0ull : ((2ull << jmax) - 1ull)) & ~((1ull << jlo_b) - 1ull);
    attn_stream(tiles, proj + (size_t)b * 4096 * PJ_LD + 2560 + h * 64, PJ_LD, VT + ((size_t)((8 + h) * 8 + b) * 64) * 4096, 4096, lds, jlo_w, qb * 4 + w, ql, q0o, q1o, qstride, cc, O, m, l, tid, lane,
                [&](int nt, float ckv, int key, int jb, float& s) { s += cq[nt] - ckv; return key <= tq[nt]; });
    float sc[4];
#pragma unroll
    for (int nt = 0; nt < 4; ++nt) sc[nt] = 1.0f / fmaxf(l[nt], 1e-30f);
    attn_store2(mix, token0, 16, 768 + h * 64, 0, O, sc, lane, false);
}

__device__ void mixA_phase(const Params& p, int L, char* lds);
DEVI int next_unit(const Params& p, int idx, char* lds) {
    int* slot = (int*)(lds + LDS_BYTES - 16);
    const unsigned g = blockIdx.x & 7u;
    unsigned* ctr = (unsigned*)(p.ws + OFF_XBAR) + 10240 + (idx * 8 + (int)g) * 64;
    __syncthreads();
    if (otid() == 0) *slot = (int)(g + 8u * atomicAdd(ctr, 1u));
    __syncthreads();
    return *slot;
}
__device__ void mixA_phase(const Params& p, int L, char* lds) {
#pragma unroll 1
    for (;;) {
        const int job = next_unit(p, L * 4 + 3, lds); if (job >= 160 + 512) break;
        if (job < 128) compress_unit(p, L, job, lds);
        else if (job < 160) foxc_job(p, L, job - 128, lds);
        else {
#pragma unroll 1
            for (int u = (job - 160) * 4; u < (job - 160) * 4 + 4; ++u) hgrn_a_unit(p, L, u, lds);
        }
    }
}
__device__ void mixB_phase(const Params& p, int L, char* lds) {
#pragma unroll 1
    for (;;) { const int f = next_unit(p, L * 4 + 0, lds); if (f >= 512) break; const int qb = 15 - (f >> 5), bh = f & 31; fox_unit(p, L, bh >> 2, bh & 3, qb, lds); }
#pragma unroll 1
    for (;;) { const int n = next_unit(p, L * 4 + 1, lds); if (n >= 1024) break; const int blk = 63 - (n >> 4), bg = n & 15; nsa_unit(p, L, bg >> 1, bg & 1, blk, lds); }
#pragma unroll 1
    for (;;) { const int c = next_unit(p, L * 4 + 2, lds); if (c >= 1024) break;
#pragma unroll 1
        for (int u = c * 2; u < c * 2 + 2; ++u) hgrn_c_unit(p, L, u, lds); }
}


#define XB_TMO      128
#define XB_XCNT(j)  (256  + 64 * (j))
#define XB_XSUB(j)  (1280 + 64 * (j))
#define XB_XGEN(j)  (2304 + 64 * (j))
#define XB_TOP      3328
#define XB_TOPGEN   3392
#define XCD_BAR_WORDS 3456
#define XB_SPIN_CAP (1u << 18)
#define LAS __attribute__((address_space(3)))
DEVI unsigned xb_ld(unsigned* p)              { return __hip_atomic_load(p, __ATOMIC_RELAXED, __HIP_MEMORY_SCOPE_AGENT); }
DEVI unsigned xb_add(unsigned* p, unsigned v) { return __hip_atomic_fetch_add(p, v, __ATOMIC_RELAXED, __HIP_MEMORY_SCOPE_AGENT); }
DEVI unsigned xb_xcc_id() { return (unsigned)__builtin_amdgcn_s_getreg((3 << 11) | 20) & 0xFu; }
#define XB_SPIN(cond, bar) do { unsigned _sp = 0; while (cond) { __builtin_amdgcn_s_sleep(1); \
    if ((++_sp & 255u) == 0u) { if (xb_ld(&(bar)[XB_TMO])) break; if (_sp > XB_SPIN_CAP) { atomicAdd(&(bar)[XB_TMO], 1u); break; } } } } while (0)
struct XcdBarrier { unsigned* bar; unsigned x; volatile LAS unsigned* st; };
DEVI XcdBarrier xcd_barrier_post(unsigned* bar, volatile LAS unsigned* st) {
    XcdBarrier b; b.bar = bar; b.x = xb_xcc_id(); b.st = st;
    if (threadIdx.x == 0) (void)xb_add(&bar[XB_XCNT(b.x)], 1u);
    return b;
}
DEVI void xcd_barrier_complete(unsigned* bar, unsigned x, unsigned& nloc, unsigned& nx) {
    const unsigned G = gridDim.x * gridDim.y * gridDim.z;
    unsigned sum, cnt, mine, sp = 0u;
    for (;;) {
        sum = 0u; cnt = 0u; mine = 0u;
#pragma unroll
        for (unsigned j = 0; j < 16; ++j) { const unsigned c = xb_ld(&bar[XB_XCNT(j)]); sum += c; cnt += (c > 0u) ? 1u : 0u; mine = (j == x) ? c : mine; }
        if (sum == G) break;
        __builtin_amdgcn_s_sleep(1);
        if ((++sp & 255u) == 0u) { if (xb_ld(&bar[XB_TMO])) break; if (sp > XB_SPIN_CAP) { atomicAdd(&bar[XB_TMO], 1u); break; } }
    }
    nloc = mine > 0u ? mine : 1u; nx = cnt > 0u ? cnt : 1u;
}
DEVI void xcd_barrier(const XcdBarrier& b) {
    __builtin_amdgcn_fence(__ATOMIC_RELEASE, "agent");
    asm volatile("s_waitcnt vmcnt(0)" ::: "memory");
    __syncthreads();
    if (threadIdx.x == 0) {
        unsigned* bar = b.bar;
        __builtin_amdgcn_s_waitcnt(0);
        unsigned nloc = b.st[0], nx = b.st[1];
        if (nloc == 0u) { xcd_barrier_complete(bar, b.x, nloc, nx); b.st[0] = nloc; b.st[1] = nx; }
        const unsigned old = xb_add(&bar[XB_XSUB(b.x)], 1u);
        const unsigned gen = old / nloc;
        if (old + 1u == (gen + 1u) * nloc) {
            __builtin_amdgcn_fence(__ATOMIC_RELEASE, "agent");
            asm volatile("s_waitcnt vmcnt(0)" ::: "memory");
            const unsigned og = xb_add(&bar[XB_TOP], 1u);
            const unsigned tg = og / nx;
            if (og + 1u == (tg + 1u) * nx) xb_add(&bar[XB_TOPGEN], 1u);
            else XB_SPIN(xb_ld(&bar[XB_TOPGEN]) == tg, bar);
            __builtin_amdgcn_fence(__ATOMIC_ACQUIRE, "agent");
            xb_add(&bar[XB_XGEN(b.x)], 1u);
            asm volatile("s_waitcnt vmcnt(0)" ::: "memory");
        } else {
            XB_SPIN(xb_ld(&bar[XB_XGEN(b.x)]) == gen, bar);
            __builtin_amdgcn_fence(__ATOMIC_ACQUIRE, "agent");
            asm volatile("s_waitcnt vmcnt(0)" ::: "memory");
        }
    }
    __syncthreads();
    __builtin_amdgcn_fence(__ATOMIC_ACQUIRE, "agent");
    asm volatile("s_waitcnt vmcnt(0)" ::: "memory");
}

__device__ void run_phase(const Params& p, int ph, char* lds) {
    if (ph == 0) { prep_phase(p, lds); return; }
    const int L = (ph - 1) / 7, s = (ph - 1) % 7;
    switch (s) {
        case 0: gemm_phase<EPI_PROJ>(p, L, lds); break;
        case 1: mixA_phase(p, L, lds); break;
        case 2: hgrn_scan_phase(p); break;
        case 3: mixB_phase(p, L, lds); break;
        case 4: gemm_phase<EPI_WO>(p, L, lds); break;
        case 5: gemm_phase<EPI_UP>(p, L, lds); break;
        default: gemm_phase<EPI_DOWN>(p, L, lds); break;
    }
}

__global__ void __launch_bounds__(256, 2) fwd_kernel(Params p, int ph_lo, int ph_hi) {
    __shared__ __attribute__((aligned(16))) char lds[LDS_BYTES];
    __shared__ uint4 xb_words;
    if (threadIdx.x == 0) xb_words = make_uint4(0u, 0u, 0u, 0u);
    __syncthreads();
    unsigned* bar = (unsigned*)(p.ws + OFF_XBAR);
    for (int ph = ph_lo; ph < ph_hi; ++ph) {
        run_phase(p, ph, lds);
        if (ph + 1 < ph_hi) {
            if (ph == ph_lo) cg::this_grid().sync();
            else {
                asm volatile("s_waitcnt vmcnt(0)" ::: "memory");
                __syncthreads();
                if (threadIdx.x == 0) {
                    unsigned* base = bar + ph * 640;
                    const unsigned g = blockIdx.x & 7u, G = gridDim.x;
                    const unsigned nper = (G >> 3) + ((g < (G & 7u)) ? 1u : 0u);
                    const unsigned ngrp = G < 8u ? G : 8u;
                    __builtin_amdgcn_fence(__ATOMIC_RELEASE, "agent");
                    asm volatile("s_waitcnt vmcnt(0)" ::: "memory");
                    if (__hip_atomic_fetch_add(base + g * 64, 1u, __ATOMIC_RELAXED, __HIP_MEMORY_SCOPE_AGENT) == nper - 1u) {
                        if (__hip_atomic_fetch_add(base + 8 * 64, 1u, __ATOMIC_RELAXED, __HIP_MEMORY_SCOPE_AGENT) == ngrp - 1u)
                            __hip_atomic_store(base + 9 * 64, 1u, __ATOMIC_RELAXED, __HIP_MEMORY_SCOPE_AGENT);
                    }
                    while (__hip_atomic_load(base + 9 * 64, __ATOMIC_RELAXED, __HIP_MEMORY_SCOPE_AGENT) == 0u) __builtin_amdgcn_s_sleep(1);
                    __builtin_amdgcn_fence(__ATOMIC_ACQUIRE, "agent");
                    asm volatile("s_waitcnt vmcnt(0)" ::: "memory");
                }
                __syncthreads();
            }
        }
    }
}

extern "C" void kernel_launch(void* const* d_in, const int* in_sizes, int n_in, void* d_out, int out_size, void* d_ws, size_t ws_size,
                              hipStream_t stream) {
    if (ws_size < WS_NEED) { fprintf(stderr, "workspace too small: %zu < %zu\n", ws_size, (size_t)WS_NEED); return; }
    Params p{};
    p.x = (const float*)d_in[0]; p.norm1_g = (const float*)d_in[1]; p.w_in = (const float*)d_in[2]; p.lb_logits = (const float*)d_in[3];
    p.onorm_g = (const float*)d_in[4]; p.nsa_qn_g = (const float*)d_in[5]; p.nsa_kn_g = (const float*)d_in[6]; p.cmp_pos = (const float*)d_in[7];
    p.cmp_w1 = (const float*)d_in[8]; p.cmp_w2 = (const float*)d_in[9]; p.fox_qn_g = (const float*)d_in[10]; p.fox_kn_g = (const float*)d_in[11];
    p.fox_fb = (const float*)d_in[12]; p.w_o = (const float*)d_in[13]; p.norm2_g = (const float*)d_in[14]; p.w_up = (const float*)d_in[15];
    p.w_down = (const float*)d_in[16];
    p.out = (float*)d_out; p.ws = (char*)d_ws;
#if MULTI_LAUNCH
    for (int ph = 0; ph < NPHASE; ++ph) hipLaunchKernelGGL(fwd_kernel, dim3(512), dim3(256), 0, stream, p, ph, ph + 1);
#else
    static int grid_blocks = 0;
    if (!grid_blocks) {
        int dev = 0, cus = 0, per_cu = 0;
        hipGetDevice(&dev);
        hipDeviceGetAttribute(&cus, hipDeviceAttributeMultiprocessorCount, dev);
        hipOccupancyMaxActiveBlocksPerMultiprocessor(&per_cu, fwd_kernel, 256, 0);
        per_cu = 2;
        grid_blocks = cus * per_cu;
        grid_blocks &= ~7;
    }
    int lo = 0, hi = NPHASE;
    void* args[] = {&p, &lo, &hi};
    hipError_t e = hipLaunchCooperativeKernel((void*)fwd_kernel, dim3(grid_blocks), dim3(256), args, 0, stream);
    if (e != hipSuccess) fprintf(stderr, "cooperative launch failed: %s (grid %d)\n", hipGetErrorString(e), grid_blocks);
#endif
}
```

```cpp
#include <hip/hip_runtime.h>
#include <hip/hip_cooperative_groups.h>
#include <stdint.h>
#include <cstdio>
namespace cg = cooperative_groups;

#ifndef MULTI_LAUNCH
#define MULTI_LAUNCH 0
#endif

typedef unsigned short bf16_t;
typedef short bf16x8 __attribute__((ext_vector_type(8)));
typedef float f32x4 __attribute__((ext_vector_type(4)));
typedef unsigned long long u64;
typedef __attribute__((address_space(3))) unsigned* ldsp_t;
typedef unsigned u32x16 __attribute__((ext_vector_type(16)));
typedef unsigned u32x8 __attribute__((ext_vector_type(8)));
#define DEVI __device__ __forceinline__

constexpr int T_TOK = 32768, SEQ = 4096, DM = 1024, DFF = 4096;
constexpr int PJ_LD = 3072;
constexpr int NW_IN = 3100, NW_IN_PAD = 3328;
constexpr int NPHASE = 15;

constexpr size_t OFF_WIN = 0;
constexpr size_t OFF_WO = OFF_WIN + (size_t)2 * NW_IN_PAD * 1024 * 2;
constexpr size_t OFF_WUP = OFF_WO + (size_t)2 * 1024 * 1024 * 2;
constexpr size_t OFF_WDN = OFF_WUP + (size_t)2 * 4096 * 1024 * 2;
constexpr size_t OFF_W1T = OFF_WDN + (size_t)2 * 4096 * 1024 * 2;
constexpr size_t OFF_W2T = OFF_W1T + (size_t)2 * 2 * 128 * 2048 * 2;
constexpr size_t OFF_CBIAS = OFF_W2T + (size_t)2 * 2 * 64 * 128 * 2;
constexpr size_t OFF_CTR = OFF_CBIAS + 2048;
constexpr size_t OFF_ROPE = OFF_CTR + 256;
constexpr size_t OFF_GATES = OFF_ROPE + (size_t)4096 * 16 * 4;
constexpr size_t OFF_FOXC = OFF_GATES + (size_t)T_TOK * 32 * 4;
constexpr size_t OFF_KC = OFF_FOXC + (size_t)8 * 4 * 4096 * 4;
constexpr size_t OFF_VCT = OFF_KC + (size_t)8 * 2 * 256 * 64 * 2;
constexpr size_t OFF_DECAY = OFF_VCT + (size_t)8 * 2 * 256 * 64 * 2;
constexpr size_t OFF_KVT = OFF_DECAY + (size_t)2048 * 64 * 4;
constexpr size_t OFF_ST = OFF_KVT + (size_t)2048 * 4096 * 4;
constexpr size_t OFF_ACT = OFF_ST + (size_t)2048 * 4096 * 2;
constexpr size_t OFF_BIG = OFF_ACT + (size_t)T_TOK * 1024 * 2;
constexpr size_t OFF_VT_IN_BIG = (size_t)T_TOK * PJ_LD * 2;
constexpr size_t OFF_ACT2 = OFF_BIG + (size_t)T_TOK * 4096 * 2;
constexpr size_t OFF_SSQ = OFF_ACT2 + (size_t)T_TOK * 1024 * 2;
constexpr size_t OFF_XBAR = OFF_SSQ + (size_t)T_TOK * 16 * 4;
constexpr size_t WS_NEED = OFF_XBAR + 65536;

constexpr int LDS_BYTES = 67584;

struct Params {
    const float *x, *norm1_g, *w_in, *lb_logits, *onorm_g, *nsa_qn_g, *nsa_kn_g, *cmp_pos, *cmp_w1, *cmp_w2,
        *fox_qn_g, *fox_kn_g, *fox_fb, *w_o, *norm2_g, *w_up, *w_down;
    float* out;
    char* ws;
};

DEVI unsigned pk2(float lo, float hi) { unsigned r; asm("v_cvt_pk_bf16_f32 %0, %1, %2" : "=v"(r) : "v"(lo), "v"(hi)); return r; }
DEVI bf16_t f2bf(float f) { return (bf16_t)(pk2(f, 0.f) & 0xffffu); }
DEVI float bf2f(bf16_t h) { return __uint_as_float(((unsigned)h) << 16); }
DEVI float bflo(unsigned u) { return __uint_as_float(u << 16); }
DEVI float bfhi(unsigned u) { return __uint_as_float(u & 0xffff0000u); }
DEVI f32x4 mfma(bf16x8 a, bf16x8 b, f32x4 c) { return __builtin_amdgcn_mfma_f32_16x16x32_bf16(a, b, c, 0, 0, 0); }
DEVI int otid() { int t; asm volatile("v_mov_b32 %0, %1" : "=v"(t) : "v"(threadIdx.x)); return t; }
DEVI float wave_sum(float v) {
#pragma unroll
    for (int o = 32; o >= 1; o >>= 1) v += __shfl_xor(v, o);
    return v;
}
DEVI bf16x8 mk8(unsigned a, unsigned b, unsigned c, unsigned d) {
    uint4 u = make_uint4(a, b, c, d);
    return *(bf16x8*)&u;
}
DEVI bf16x8 ld8(const bf16_t* p) { uint4 u = *(const uint4*)p; return *(bf16x8*)&u; }
DEVI bf16x8 ld4x2(const bf16_t* p0, const bf16_t* p1) {
    uint2 a = *(const uint2*)p0, b = *(const uint2*)p1;
    return mk8(a.x, a.y, b.x, b.y);
}

DEVI int win_colmap(int n) {
    if (n < 2304) return n;
    if (n < 3072) return n + 24;
    if (n < 3096) return n - 768;
    return n;
}
__device__ void transpose_tile(const float* __restrict__ src, int ld_src, bf16_t* __restrict__ dst, int ld_dst, int k0, int n0, int nvalid,
                               int colmode, float* tile) {
    const int tid = otid();
    for (int idx = tid; idx < 4096; idx += 256) {
        const int i = idx >> 6, j = idx & 63, n = n0 + j;
        float v = 0.f;
        if (n < nvalid) v = src[(size_t)(k0 + i) * ld_src + (colmode ? win_colmap(n) : n)];
        tile[i * 65 + j] = v;
    }
    __syncthreads();
    for (int idx = tid; idx < 4096; idx += 256) {
        const int j = idx >> 6, i = idx & 63;
        dst[(size_t)(n0 + j) * ld_dst + k0 + i] = f2bf(tile[i * 65 + j]);
    }
    __syncthreads();
}

__device__ void norm_phase(const float* __restrict__ xin, const float* __restrict__ g, bf16_t* __restrict__ hout) {
    const int tid = otid(); const int lane = tid & 63, w = tid >> 6;
    for (int row = blockIdx.x * 4 + w; row < T_TOK; row += gridDim.x * 4) {
        const float4* xr = (const float4*)(xin + (size_t)row * DM);
        float4 v[4]; float ss = 0.f;
#pragma unroll
        for (int i = 0; i < 4; ++i) { v[i] = xr[lane + 64 * i]; ss += v[i].x * v[i].x + v[i].y * v[i].y + v[i].z * v[i].z + v[i].w * v[i].w; }
        ss = wave_sum(ss);
        const float r = rsqrtf(ss * (1.0f / 1024.0f) + 1e-6f);
#pragma unroll
        for (int i = 0; i < 4; ++i) {
            const float4 gg = ((const float4*)g)[lane + 64 * i];
            uint2 o; o.x = pk2(v[i].x * r * gg.x, v[i].y * r * gg.y); o.y = pk2(v[i].z * r * gg.z, v[i].w * r * gg.w);
            *(uint2*)(hout + (size_t)row * DM + (lane + 64 * i) * 4) = o;
        }
    }
}

__device__ void prep_phase(const Params& p, char* lds) {
    float* tile = (float*)lds;
    if (blockIdx.x == 0 && otid() < 64) ((unsigned*)(p.ws + OFF_CTR))[otid()] = 0u;
    if (blockIdx.x == 1) { for (int i = otid(); i < 16384; i += 256) ((unsigned*)(p.ws + OFF_XBAR))[i] = 0u; }
    bf16_t* win_t = (bf16_t*)(p.ws + OFF_WIN); bf16_t* wo_t = (bf16_t*)(p.ws + OFF_WO);
    bf16_t* wup_t = (bf16_t*)(p.ws + OFF_WUP); bf16_t* wdn_t = (bf16_t*)(p.ws + OFF_WDN);
    bf16_t* w1t = (bf16_t*)(p.ws + OFF_W1T); bf16_t* w2t = (bf16_t*)(p.ws + OFF_W2T);
    const int J0 = 1664, J1 = J0 + 512, J2 = J1 + 2048, J3 = J2 + 2048, J4 = J3 + 256, J5 = J4 + 8, J6 = J5 + 128, J7 = J6 + 128;
    for (int job = blockIdx.x; job < J7; job += gridDim.x) {
        if (job < J0) { const int L = job / 832, r = job % 832, kt = r / 52, nt = r % 52;
            transpose_tile(p.w_in + (size_t)L * 1024 * NW_IN, NW_IN, win_t + (size_t)L * NW_IN_PAD * 1024, 1024, kt * 64, nt * 64, NW_IN, 1, tile);
        } else if (job < J1) { const int j = job - J0, L = j / 256, r = j % 256, kt = r / 16, nt = r % 16;
            transpose_tile(p.w_o + (size_t)L * 1024 * 1024, 1024, wo_t + (size_t)L * 1024 * 1024, 1024, kt * 64, nt * 64, 1024, 0, tile);
        } else if (job < J2) { const int j = job - J1, L = j / 1024, r = j % 1024, kt = r / 64, nt = r % 64;
            transpose_tile(p.w_up + (size_t)L * 1024 * 4096, 4096, wup_t + (size_t)L * 4096 * 1024, 1024, kt * 64, nt * 64, 4096, 0, tile);
        } else if (job < J3) { const int j = job - J2, L = j / 1024, r = j % 1024, kt = r / 16, nt = r % 16;
            transpose_tile(p.w_down + (size_t)L * 4096 * 1024, 1024, wdn_t + (size_t)L * 1024 * 4096, 4096, kt * 64, nt * 64, 1024, 0, tile);
        } else if (job < J4) { const int j = job - J3, lw = j / 64, r = j % 64, kt = r / 2, nt = r % 2;
            transpose_tile(p.cmp_w1 + (size_t)lw * 2048 * 128, 128, w1t + (size_t)lw * 128 * 2048, 2048, kt * 64, nt * 64, 128, 0, tile);
        } else if (job < J5) { const int j = job - J4, lw = j / 2, kt = j % 2;
            transpose_tile(p.cmp_w2 + (size_t)lw * 128 * 64, 64, w2t + (size_t)lw * 64 * 128, 128, kt * 64, 0, 64, 0, tile);
        } else if (job < J6) {
            const int t_ = otid(); const int o = (job - J5) * 4 + (t_ >> 6), lane = t_ & 63, lw = o >> 7, hid = o & 127;
            const float* pos = p.cmp_pos + (size_t)lw * 2048; const float* w1 = p.cmp_w1 + (size_t)lw * 2048 * 128 + hid;
            float s = 0.f;
            for (int k = lane; k < 2048; k += 64) s += pos[k] * w1[(size_t)k * 128];
            s = wave_sum(s);
            if (lane == 0) ((float*)(p.ws + OFF_CBIAS))[o] = s;
        } else {
            const int e = (job - J6) * 256 + otid(), pos = e >> 3, i = e & 7;
            const float invf[8] = {1.0f, 0.1939227432012558f, 0.03760603070259094f, 0.007292664609849453f, 0.0014142135623842478f,
                                   0.00027424818836152554f, 5.318296098266728e-05f, 1.0313386155758053e-05f};
            float fr = 1.0f;
#pragma unroll
            for (int q = 0; q < 8; ++q) if (i == q) fr = invf[q];
            const float ang = (float)pos * fr;
            const double a = (double)ang; const double n = rint(a * 0.15915494309189535); const float rr = (float)(a - n * 6.283185307179586);
            float* rt = (float*)(p.ws + OFF_ROPE);
            rt[pos * 16 + i] = __cosf(rr); rt[pos * 16 + 8 + i] = __sinf(rr);
        }
    }
    norm_phase(p.x, p.norm1_g, (bf16_t*)(p.ws + OFF_ACT));
}

enum { EPI_PROJ = 0, EPI_WO = 1, EPI_UP = 2, EPI_DOWN = 3 };

DEVI float row_rstd(const float* ssq, int m) {
    const float4 a = *(const float4*)(ssq + (size_t)m * 16), b = *(const float4*)(ssq + (size_t)m * 16 + 4), c = *(const float4*)(ssq + (size_t)m * 16 + 8), d = *(const float4*)(ssq + (size_t)m * 16 + 12);
    const float t = ((a.x + a.y) + (a.z + a.w)) + ((b.x + b.y) + (b.z + b.w)) + ((c.x + c.y) + (c.z + c.w)) + ((d.x + d.y) + (d.z + d.w));
    return rsqrtf(t * (1.0f / 1024.0f) + 1e-6f);
}

template <int CH>
DEVI void proj_epilogue(const Params& p, int L, const f32x4 (&acc)[4][8], int m0w, int cc, int lane) {
    const int quad = lane >> 4, l15 = lane & 15;
    bf16_t* proj = (bf16_t*)(p.ws + OFF_BIG); bf16_t* VT = (bf16_t*)(p.ws + OFF_BIG + OFF_VT_IN_BIG);
    float* gates = (float*)(p.ws + OFF_GATES); const float* rope = (const float*)(p.ws + OFF_ROPE);
    if (cc > 48) return;
    int kind = 0, vidx = 0; const float* gain = nullptr; float scale = 1.f; bool dorope = false;
    if (cc >= 8 && cc < 12) { kind = 5; vidx = cc - 8; }
    else if (cc >= 16 && cc < 24) { kind = 1; gain = p.nsa_qn_g + L * 64; scale = 0.125f * 1.4426950408889634f; dorope = true; }
    else if (cc == 28 || cc == 29 || cc == 32 || cc == 33) { kind = 1; gain = p.nsa_kn_g + L * 64; dorope = true; }
    else if (cc == 30 || cc == 31) { kind = 5; vidx = 4 + (cc - 30); }
    else if (cc == 34 || cc == 35) { kind = 5; vidx = 6 + (cc - 34); }
    else if (cc >= 36 && cc < 40) { kind = 1; gain = p.fox_qn_g + L * 64; scale = 0.125f * 1.4426950408889634f; }
    else if (cc >= 40 && cc < 44) { kind = 1; gain = p.fox_kn_g + L * 64; }
    else if (cc >= 44 && cc < 48) { kind = 5; vidx = 8 + (cc - 44); }
    else if (cc == 48) kind = 6;
#pragma unroll
    for (int mi = 0; mi < 4; ++mi) {
        const int token = m0w + mi * 16 + l15, pos = token & 4095, bb = token >> 12;
        const float rs = (L > 0) ? row_rstd((const float*)(p.ws + OFF_SSQ), token) : 1.0f;
        float v[4][4];
#pragma unroll
        for (int ni = 0; ni < 4; ++ni)
#pragma unroll
            for (int j = 0; j < 4; ++j) v[ni][j] = acc[mi][CH * 4 + ni][j] * rs;
        if (kind == 6) {
#pragma unroll
            for (int ni = 0; ni < 2; ++ni)
#pragma unroll
                for (int j = 0; j < 4; ++j) { const int d = ni * 16 + quad * 4 + j;
                    if (d < 24) gates[(size_t)token * 32 + d] = 1.0f / (1.0f + __expf(-v[ni][j]));
                    else if (d < 28) gates[(size_t)token * 32 + d] = v[ni][j]; }
            asm volatile("" ::: "memory");
            continue;
        }
        if (kind == 1) {
            float ss = 0.f;
#pragma unroll
            for (int ni = 0; ni < 4; ++ni)
#pragma unroll
                for (int j = 0; j < 4; ++j) ss += v[ni][j] * v[ni][j];
            ss += __shfl_xor(ss, 16); ss += __shfl_xor(ss, 32);
            const float r = rsqrtf(ss * (1.0f / 64.0f) + 1e-6f);
#pragma unroll
            for (int ni = 0; ni < 4; ++ni) { const float4 gg = *(const float4*)(gain + ni * 16 + quad * 4);
                v[ni][0] *= r * gg.x; v[ni][1] *= r * gg.y; v[ni][2] *= r * gg.z; v[ni][3] *= r * gg.w; }
            if (dorope) {
                const float4 cs = *(const float4*)(rope + pos * 16 + (quad & 1) * 4), sn = *(const float4*)(rope + pos * 16 + 8 + (quad & 1) * 4);
                const float cv[4] = {cs.x, cs.y, cs.z, cs.w}, sv[4] = {sn.x, sn.y, sn.z, sn.w};
#pragma unroll
                for (int j = 0; j < 4; ++j) { const float xx = v[0][j], pp = __shfl_xor(xx, 32);
                    v[0][j] = (quad < 2) ? (xx * cv[j] - pp * sv[j]) : (xx * cv[j] + pp * sv[j]); }
            }
#pragma unroll
            for (int ni = 0; ni < 4; ++ni)
#pragma unroll
                for (int j = 0; j < 4; ++j) v[ni][j] *= scale;
        }
        if (kind == 5) {
#pragma unroll
            for (int ni = 0; ni < 4; ++ni)
#pragma unroll
                for (int j = 0; j < 4; ++j) { const int d = ni * 16 + quad * 4 + j;
                    VT[((size_t)(vidx * 8 + bb) * 64 + d) * 4096 + pos] = f2bf(v[ni][j]); }
        } else {
#pragma unroll
            for (int ni = 0; ni < 4; ++ni) { uint2 o; o.x = pk2(v[ni][0], v[ni][1]); o.y = pk2(v[ni][2], v[ni][3]);
                *(uint2*)(proj + (size_t)token * PJ_LD + cc * 64 + ni * 16 + quad * 4) = o; }
        }
        asm volatile("" ::: "memory");
    }
}

DEVI void g_load(uint4 (&RA)[4], uint4 (&RB)[4], const bf16_t* Ap, const bf16_t* Bp, int K, int KT) {
#pragma unroll
    for (int i = 0; i < 4; ++i) { RA[i] = *(const uint4*)(Ap + (size_t)(32 * i) * K + KT * 64); RB[i] = *(const uint4*)(Bp + (size_t)(32 * i) * K + KT * 64); }
}
DEVI void g_swrite(const uint4 (&RA)[4], const uint4 (&RB)[4], char* d_) {
#pragma unroll
    for (int i = 0; i < 4; ++i) { *(uint4*)(d_ + i * 4096) = RA[i]; *(uint4*)(d_ + 16384 + i * 4096) = RB[i]; }
}
DEVI void g_compute(const char* sA, f32x4 (&acc)[4][4], int wm, int wn, int quad, int l15) {
    const char* sB = sA + 16384;
#pragma unroll
    for (int ks = 0; ks < 2; ++ks) {
        bf16x8 af[4], bfr[4]; const int ch = ks * 4 + quad;
#pragma unroll
        for (int mi = 0; mi < 4; ++mi) { const int row = wm * 64 + mi * 16 + l15; af[mi] = *(const bf16x8*)(sA + row * 128 + ((ch ^ (row & 7)) << 4)); }
#pragma unroll
        for (int ni = 0; ni < 4; ++ni) { const int row = wn * 64 + ni * 16 + l15; bfr[ni] = *(const bf16x8*)(sB + row * 128 + ((ch ^ (row & 7)) << 4)); }
#pragma unroll
        for (int mi = 0; mi < 4; ++mi)
#pragma unroll
            for (int ni = 0; ni < 4; ++ni) acc[mi][ni] = mfma(bfr[ni], af[mi], acc[mi][ni]);
    }
}

template <int EPI>
__device__ __forceinline__ void gemm_phase(const Params& p, int L, char* lds) {
    const bf16_t* A; const bf16_t* Bt; int K, nNt;
    if (EPI == EPI_PROJ) { A = (const bf16_t*)(p.ws + OFF_ACT); Bt = (const bf16_t*)(p.ws + OFF_WIN) + (size_t)L * NW_IN_PAD * 1024; K = 1024; nNt = NW_IN_PAD / 256; }
    else if (EPI == EPI_WO) { A = (const bf16_t*)(p.ws + OFF_ACT); Bt = (const bf16_t*)(p.ws + OFF_WO) + (size_t)L * 1024 * 1024; K = 1024; nNt = 4; }
    else if (EPI == EPI_UP) { A = (const bf16_t*)(p.ws + OFF_ACT2); Bt = (const bf16_t*)(p.ws + OFF_WUP) + (size_t)L * 4096 * 1024; K = 1024; nNt = 16; }
    else { A = (const bf16_t*)(p.ws + OFF_BIG); Bt = (const bf16_t*)(p.ws + OFF_WDN) + (size_t)L * 1024 * 4096; K = 4096; nNt = 4; }
    const int tid = otid(), lane = tid & 63, w = tid >> 6, quad = lane >> 4, l15 = lane & 15, wm = w >> 1, wn = w & 1;
    const int xcd = blockIdx.x & 7, loc = blockIdx.x >> 3, nloc = gridDim.x >> 3;
    const int nk = K / 32;
    const int gsw = (0x1230 >> (((l15 >> 2) & 3) * 4)) & 3;
    const int rsw = (quad ^ gsw) << 4;
    for (int it = loc; it < 32 * nNt; it += nloc) {
        const int tl = otid();
        const int lrow = tl >> 2, lc = tl & 3;
        const int woff = lrow * 64 + ((lc ^ ((0x1230 >> (((lrow >> 2) & 3) * 4)) & 3)) << 4);
        const int gsz = 8 * nNt, mloc = (it / gsz) * 8 + (it & 7), nloc_t = (it % gsz) >> 3;
        const int m0 = (xcd + 8 * mloc) * 128, n0 = nloc_t * 256;
        f32x4 acc[4][8];
#pragma unroll
        for (int a = 0; a < 4; ++a)
#pragma unroll
            for (int b = 0; b < 8; ++b) acc[a][b] = (f32x4){0.f, 0.f, 0.f, 0.f};
        u32x8 ra0, ra1; u32x16 rb0, rb1;
        const bf16_t* Ap = A + (size_t)(m0 + lrow) * K + lc * 8;
        const bf16_t* Bp = Bt + (size_t)(n0 + lrow) * K + lc * 8;
#define G_LD1(R, P, I, KT) { const uint4 t_ = *(const uint4*)((P) + (size_t)(64 * I) * K + (KT) * 32); R[4 * I] = t_.x; R[4 * I + 1] = t_.y; R[4 * I + 2] = t_.z; R[4 * I + 3] = t_.w; }
#define G_LOAD(RA, RB, KT) { G_LD1(RA, Ap, 0, KT) G_LD1(RB, Bp, 0, KT) G_LD1(RA, Ap, 1, KT) G_LD1(RB, Bp, 1, KT) G_LD1(RB, Bp, 2, KT) G_LD1(RB, Bp, 3, KT) }
#define G_SW1(R, D, I) *(uint4*)((D) + I * 4096) = make_uint4(R[4 * I], R[4 * I + 1], R[4 * I + 2], R[4 * I + 3]);
#define G_SWRITE(RA, RB, DST) { G_SW1(RA, DST, 0) G_SW1(RB, (DST) + 8192, 0) G_SW1(RA, DST, 1) G_SW1(RB, (DST) + 8192, 1) G_SW1(RB, (DST) + 8192, 2) G_SW1(RB, (DST) + 8192, 3) }
#define G_COMPUTE(BUF) { const char* sA_ = (BUF) + (wm * 64 + l15) * 64 + rsw; const char* sB_ = (BUF) + 8192 + (wn * 128 + l15) * 64 + rsw; \
            bf16x8 af[4]; \
            _Pragma("unroll") for (int i_ = 0; i_ < 4; ++i_) af[i_] = *(const bf16x8*)(sA_ + i_ * 1024); \
            _Pragma("unroll") for (int nh = 0; nh < 2; ++nh) { bf16x8 bfr[4]; \
                _Pragma("unroll") for (int i_ = 0; i_ < 4; ++i_) bfr[i_] = *(const bf16x8*)(sB_ + (nh * 4 + i_) * 1024); \
                _Pragma("unroll") for (int mi = 0; mi < 4; ++mi) _Pragma("unroll") for (int ni = 0; ni < 4; ++ni) acc[mi][nh * 4 + ni] = mfma(bfr[ni], af[mi], acc[mi][nh * 4 + ni]); } }
        G_LOAD(ra0, rb0, 0)
        G_LOAD(ra1, rb1, 1)
        G_SWRITE(ra0, rb0, lds + woff)
        __syncthreads();
#pragma unroll 1
        for (int kt = 0; kt < nk - 2; kt += 2) {
            G_LOAD(ra0, rb0, kt + 2)
            __builtin_amdgcn_sched_barrier(0);
            G_COMPUTE(lds)
            G_SWRITE(ra1, rb1, lds + 24576 + woff)
            __syncthreads();
            G_LOAD(ra1, rb1, kt + 3)
            __builtin_amdgcn_sched_barrier(0);
            G_COMPUTE(lds + 24576)
            G_SWRITE(ra0, rb0, lds + woff)
            __syncthreads();
        }
        G_COMPUTE(lds)
        G_SWRITE(ra1, rb1, lds + 24576 + woff)
        __syncthreads();
        G_COMPUTE(lds + 24576)
        __syncthreads();
#undef G_LOAD
#undef G_SWRITE
#undef G_LD1
#undef G_SW1
#undef G_COMPUTE
        const int te = otid(); const int lane_e = te & 63, quad_e = lane_e >> 4, l15_e = lane_e & 15;
        const int mw = m0 + ((te >> 7) & 1) * 64, nw = n0 + ((te >> 6) & 1) * 128;
        if (EPI == EPI_PROJ) {
            proj_epilogue<0>(p, L, acc, mw, (nw >> 6), lane_e);
            proj_epilogue<1>(p, L, acc, mw, (nw >> 6) + 1, lane_e);
        } else if (EPI == EPI_UP) {
            bf16_t* hid = (bf16_t*)(p.ws + OFF_BIG);
#pragma unroll
            for (int mi = 0; mi < 4; ++mi) { const int m = mw + mi * 16 + l15_e; const float r = row_rstd((const float*)(p.ws + OFF_SSQ), m);
#pragma unroll
                for (int ni = 0; ni < 8; ++ni) { const int n = nw + ni * 16 + quad_e * 4;
                    float a0 = fmaxf(acc[mi][ni][0] * r, 0.f), a1 = fmaxf(acc[mi][ni][1] * r, 0.f), a2 = fmaxf(acc[mi][ni][2] * r, 0.f), a3 = fmaxf(acc[mi][ni][3] * r, 0.f);
                    uint2 o; o.x = pk2(a0 * a0, a1 * a1); o.y = pk2(a2 * a2, a3 * a3);
                    *(uint2*)(hid + (size_t)m * DFF + n) = o; } }
        } else {
            const float* xin = (EPI == EPI_WO && L == 0) ? p.x : p.out;
            const bool emit = (EPI == EPI_WO) || (L + 1 < 2);
            const float* gn = (EPI == EPI_WO) ? (p.norm2_g + L * 1024) : (p.norm1_g + (L + 1 < 2 ? L + 1 : L) * 1024);
            bf16_t* hn = (bf16_t*)(p.ws + ((EPI == EPI_WO) ? OFF_ACT2 : OFF_ACT));
            float* ssq = (float*)(p.ws + OFF_SSQ);
#pragma unroll
            for (int mi = 0; mi < 4; ++mi) {
#pragma unroll
                for (int hf = 0; hf < 2; ++hf) {
                    const int t3 = otid(); const int l15_e = t3 & 15, quad_e = (t3 >> 4) & 3;
                    const int m = mw + mi * 16 + l15_e;
                    float ss = 0.f;
#pragma unroll
                    for (int n4 = 0; n4 < 4; ++n4) { const int ni = hf * 4 + n4; const int n = nw + ni * 16 + quad_e * 4;
                        float4 xv = *(const float4*)(xin + (size_t)m * DM + n);
                        xv.x += acc[mi][ni][0]; xv.y += acc[mi][ni][1]; xv.z += acc[mi][ni][2]; xv.w += acc[mi][ni][3];
                        *(float4*)(p.out + (size_t)m * DM + n) = xv;
                        if (emit) { const float4 gg = *(const float4*)(gn + n);
                            uint2 o; o.x = pk2(xv.x * gg.x, xv.y * gg.y); o.y = pk2(xv.z * gg.z, xv.w * gg.w);
                            *(uint2*)(hn + (size_t)m * DM + n) = o;
                            ss += (xv.x * xv.x + xv.y * xv.y) + (xv.z * xv.z + xv.w * xv.w); } }
                    if (emit) { ss += __shfl_xor(ss, 16); ss += __shfl_xor(ss, 32);
                        if (quad_e == 0) ssq[(size_t)m * 16 + ((nw >> 6) + hf)] = ss; }
                    asm volatile("" ::: "memory");
                }
            }
        }
    }
}

DEVI float hgrn_lb(const Params& p, int L, int hk) {
    if (L == 0) return 0.f;
    const float l0 = p.lb_logits[hk], l1 = p.lb_logits[256 + hk];
    return 1.0f / (1.0f + __expf(l0 - l1));
}

__device__ void hgrn_a_unit(const Params& p, int L, int u, char* lds) {
    const int tid = otid(), lane = tid & 63, w = tid >> 6, quad = lane >> 4, l15 = lane & 15;
    const int c = u & 63, h = (u >> 6) & 3, b = u >> 8;
    const bf16_t* proj = (const bf16_t*)(p.ws + OFF_BIG); const bf16_t* VT = (const bf16_t*)(p.ws + OFF_BIG + OFF_VT_IN_BIG);
    float* segtot = (float*)lds;
    bf16_t* KDt = (bf16_t*)(lds + 1024);
    const int k = tid & 63, seg = tid >> 6;
    const float lb = hgrn_lb(p, L, h * 64 + k);
    float gl[16], kkv[16]; float run = 0.f;
    const bf16_t* zp = proj + (size_t)(b * 4096 + c * 64 + seg * 16) * PJ_LD + 256 + h * 64 + k;
#pragma unroll
    for (int i = 0; i < 16; ++i) {
        const float z = bf2f(zp[(size_t)i * PJ_LD]);
        const float sg = 1.0f / (1.0f + __expf(-z)), sn = 1.0f / (1.0f + __expf(z));
        const float f = lb + (1.0f - lb) * sg;
        run += __logf(fmaxf(f, 1e-30f)); gl[i] = run; kkv[i] = (1.0f - lb) * sn;
    }
    segtot[seg * 64 + k] = run;
    __syncthreads();
    float off = 0.f, tot = 0.f;
#pragma unroll
    for (int s = 0; s < 4; ++s) { const float t = segtot[s * 64 + k]; tot += t; if (s < seg) off += t; }
    unsigned pkd[8];
#pragma unroll
    for (int i = 0; i < 8; ++i) {
        const float a0 = kkv[2 * i] * __expf(tot - (off + gl[2 * i])), a1 = kkv[2 * i + 1] * __expf(tot - (off + gl[2 * i + 1]));
        pkd[i] = pk2(a0, a1);
    }
    *(uint4*)(KDt + k * 72 + seg * 16) = make_uint4(pkd[0], pkd[1], pkd[2], pkd[3]);
    *(uint4*)(KDt + k * 72 + seg * 16 + 8) = make_uint4(pkd[4], pkd[5], pkd[6], pkd[7]);
    if (seg == 0) ((float*)(p.ws + OFF_DECAY))[u * 64 + k] = __expf(tot);
    __syncthreads();
    const bf16_t* vt = VT + ((size_t)(h * 8 + b) * 64) * 4096 + c * 64;
    float* kvt = (float*)(p.ws + OFF_KVT) + (size_t)u * 4096;
    bf16x8 af[2];
#pragma unroll
    for (int ks = 0; ks < 2; ++ks) af[ks] = ld8(vt + (size_t)(w * 16 + l15) * 4096 + ks * 32 + quad * 8);
#pragma unroll
    for (int kt = 0; kt < 4; ++kt) {
        f32x4 acc = (f32x4){0.f, 0.f, 0.f, 0.f};
#pragma unroll
        for (int ks = 0; ks < 2; ++ks) { const bf16x8 bfr = *(const bf16x8*)(KDt + (kt * 16 + l15) * 72 + ks * 32 + quad * 8); acc = mfma(af[ks], bfr, acc); }
#pragma unroll
        for (int j = 0; j < 4; ++j) kvt[(w * 16 + quad * 4 + j) * 64 + kt * 16 + l15] = acc[j];
    }
    __syncthreads();
}

__device__ void hgrn_scan_phase(const Params& p) {
    const float* kvt = (const float*)(p.ws + OFF_KVT); const float* dec = (const float*)(p.ws + OFF_DECAY);
    bf16_t* st = (bf16_t*)(p.ws + OFF_ST);
    for (int e = blockIdx.x * 256 + otid(); e < 32 * 4096; e += gridDim.x * 256) {
        const int bh = e >> 12, vk = e & 4095, k = vk & 63;
        float S = 0.f;
#pragma unroll 8
        for (int c = 0; c < 64; ++c) {
            const int u = bh * 64 + c;
            st[(size_t)u * 4096 + vk] = f2bf(S);
            S = S * dec[u * 64 + k] + kvt[(size_t)u * 4096 + vk];
        }
    }
}

__device__ void hgrn_c_unit(const Params& p, int L, int u, char* lds) {
    const int tid = otid(), lane = tid & 63, w = tid >> 6, quad = lane >> 4, l15 = lane & 15;
    const int c = u & 63, h = (u >> 6) & 3, b = u >> 8;
    const bf16_t* proj = (const bf16_t*)(p.ws + OFF_BIG); const bf16_t* VT = (const bf16_t*)(p.ws + OFF_BIG + OFF_VT_IN_BIG);
    float* Gs = (float*)lds; float* KKs = Gs + 64 * 65; float* Qs = KKs + 64 * 65; float* segtot = Qs + 64 * 65;
    {
        const int k = tid & 63, seg = tid >> 6;
        const float lb = hgrn_lb(p, L, h * 64 + k);
        float gl[16], kkv[16]; float run = 0.f;
        const bf16_t* zp = proj + (size_t)(b * 4096 + c * 64 + seg * 16) * PJ_LD + 256 + h * 64 + k;
#pragma unroll
        for (int i = 0; i < 16; ++i) {
            const float z = bf2f(zp[(size_t)i * PJ_LD]);
            const float sg = 1.0f / (1.0f + __expf(-z)), sn = 1.0f / (1.0f + __expf(z));
            const float f = lb + (1.0f - lb) * sg;
            run += __logf(fmaxf(f, 1e-30f)); gl[i] = run; kkv[i] = (1.0f - lb) * sn;
            Qs[(seg * 16 + i) * 65 + k] = bf2f(zp[(size_t)i * PJ_LD - 256]) * 0.125f;
        }
        segtot[seg * 64 + k] = run;
        __syncthreads();
        float off = 0.f;
#pragma unroll
        for (int s = 0; s < 4; ++s) { const float t = segtot[s * 64 + k]; if (s < seg) off += t; }
#pragma unroll
        for (int i = 0; i < 16; ++i) { Gs[(seg * 16 + i) * 65 + k] = off + gl[i]; KKs[(seg * 16 + i) * 65 + k] = kkv[i]; }
        __syncthreads();
    }
    const int I = w;
    const int tq = 16 * I + l15;
    bf16x8 qt[2], qg[2];
#pragma unroll
    for (int ks = 0; ks < 2; ++ks) {
        float a[8], g8[8];
#pragma unroll
        for (int j = 0; j < 8; ++j) {
            const int k = ks * 32 + quad * 8 + j;
            const float G = Gs[tq * 65 + k], q = Qs[tq * 65 + k];
            const float gref = (I == 0) ? 0.f : Gs[(16 * I - 1) * 65 + k];
            a[j] = q * __expf(G - gref); g8[j] = q * __expf(G);
        }
        qt[ks] = mk8(pk2(a[0], a[1]), pk2(a[2], a[3]), pk2(a[4], a[5]), pk2(a[6], a[7]));
        qg[ks] = mk8(pk2(g8[0], g8[1]), pk2(g8[2], g8[3]), pk2(g8[4], g8[5]), pk2(g8[6], g8[7]));
    }
    f32x4 O[4];
#pragma unroll
    for (int vt = 0; vt < 4; ++vt) O[vt] = (f32x4){0.f, 0.f, 0.f, 0.f};
    const bf16_t* st = (const bf16_t*)(p.ws + OFF_ST) + (size_t)u * 4096;
#pragma unroll
    for (int vt = 0; vt < 4; ++vt)
#pragma unroll
        for (int ks = 0; ks < 2; ++ks) O[vt] = mfma(ld8(st + (vt * 16 + l15) * 64 + ks * 32 + quad * 8), qg[ks], O[vt]);
    const bf16_t* vtp = VT + ((size_t)(h * 8 + b) * 64) * 4096 + c * 64;
    for (int Jp = 0; Jp <= (I >> 1); ++Jp) {
        f32x4 sc[2];
#pragma unroll
        for (int jj = 0; jj < 2; ++jj) {
            const int J = 2 * Jp + jj;
            sc[jj] = (f32x4){0.f, 0.f, 0.f, 0.f};
            if (J <= I) {
                const int s = 16 * J + l15;
#pragma unroll
                for (int ks = 0; ks < 2; ++ks) {
                    float a[8];
#pragma unroll
                    for (int j = 0; j < 8; ++j) {
                        const int k = ks * 32 + quad * 8 + j;
                        const float gref = (I == 0) ? 0.f : Gs[(16 * I - 1) * 65 + k];
                        a[j] = KKs[s * 65 + k] * __expf(gref - Gs[s * 65 + k]);
                    }
                    sc[jj] = mfma(mk8(pk2(a[0], a[1]), pk2(a[2], a[3]), pk2(a[4], a[5]), pk2(a[6], a[7])), qt[ks], sc[jj]);
                }
#pragma unroll
                for (int j = 0; j < 4; ++j) { const int s2 = 16 * J + quad * 4 + j; if (s2 > tq) sc[jj][j] = 0.f; }
            }
        }
        const bf16x8 P = mk8(pk2(sc[0][0], sc[0][1]), pk2(sc[0][2], sc[0][3]), pk2(sc[1][0], sc[1][1]), pk2(sc[1][2], sc[1][3]));
#pragma unroll
        for (int vt = 0; vt < 4; ++vt) {
            const bf16_t* r = vtp + (size_t)(vt * 16 + l15) * 4096 + 32 * Jp + quad * 4;
            O[vt] = mfma(ld4x2(r, r + 16), P, O[vt]);
        }
    }
    float ss = 0.f;
#pragma unroll
    for (int vt = 0; vt < 4; ++vt)
#pragma unroll
        for (int j = 0; j < 4; ++j) ss += O[vt][j] * O[vt][j];
    ss += __shfl_xor(ss, 16); ss += __shfl_xor(ss, 32);
    const float r = rsqrtf(ss * (1.0f / 64.0f) + 1e-6f);
    const size_t token = (size_t)b * 4096 + c * 64 + tq;
    bf16_t* mix = (bf16_t*)(p.ws + OFF_ACT);
#pragma unroll
    for (int vt = 0; vt < 4; ++vt) {
        const int v0 = vt * 16 + quad * 4;
        const float4 og = *(const float4*)(p.onorm_g + L * 64 + v0);
        const uint2 gz = *(const uint2*)(proj + token * PJ_LD + 768 + h * 64 + v0);
        const float g0 = bflo(gz.x), g1 = bfhi(gz.x), g2 = bflo(gz.y), g3 = bfhi(gz.y);
        const float o0 = O[vt][0] * r * og.x * (g0 / (1.0f + __expf(-g0))), o1 = O[vt][1] * r * og.y * (g1 / (1.0f + __expf(-g1)));
        const float o2 = O[vt][2] * r * og.z * (g2 / (1.0f + __expf(-g2))), o3 = O[vt][3] * r * og.w * (g3 / (1.0f + __expf(-g3)));
        uint2 o; o.x = pk2(o0, o1); o.y = pk2(o2, o3);
        *(uint2*)(mix + token * DM + h * 64 + v0) = o;
    }
    __syncthreads();
}

__device__ void compress_unit(const Params& p, int L, int u, char* lds) {
    const int tid = otid(), lane = tid & 63, w = tid >> 6, quad = lane >> 4, l15 = lane & 15;
    const int which = u & 1, g = (u >> 1) & 1, b = (u >> 2) & 7, ntile = u >> 5;
    const bf16_t* proj = (const bf16_t*)(p.ws + OFF_BIG);
    const bf16_t* w1t = (const bf16_t*)(p.ws + OFF_W1T) + (size_t)(L * 2 + which) * 128 * 2048;
    const bf16_t* w2t = (const bf16_t*)(p.ws + OFF_W2T) + (size_t)(L * 2 + which) * 64 * 128;
    const float* cbias = (const float*)(p.ws + OFF_CBIAS) + (L * 2 + which) * 128;
    bf16_t* Hs = (bf16_t*)lds + w * 16 * 136;
    const int nrow = ntile * 64 + w * 16 + l15;
    int tokbase = 16 * nrow; if (tokbase > 4096 - 32) tokbase = 4096 - 32;
    const bf16_t* xa = proj + ((size_t)b * 4096 + tokbase) * PJ_LD + (which ? 1664 : 1536) + g * 64;
    f32x4 acc[8];
#pragma unroll
    for (int i = 0; i < 8; ++i) acc[i] = (f32x4){0.f, 0.f, 0.f, 0.f};
#pragma unroll 2
    for (int kk = 0; kk < 64; ++kk) {
        const int l = kk >> 1, d = (kk & 1) * 32 + quad * 8;
        const bf16x8 a = ld8(xa + (size_t)l * PJ_LD + d);
#pragma unroll
        for (int ni = 0; ni < 8; ++ni) acc[ni] = mfma(a, ld8(w1t + (size_t)(ni * 16 + l15) * 2048 + kk * 32 + quad * 8), acc[ni]);
    }
#pragma unroll
    for (int ni = 0; ni < 8; ++ni) { const float bsv = cbias[ni * 16 + l15];
#pragma unroll
        for (int j = 0; j < 4; ++j) { const float x = acc[ni][j] + bsv;
            const float uu = 0.7978845608028654f * (x + 0.044715f * x * x * x);
            const float th = 1.0f - 2.0f / (1.0f + __expf(2.0f * uu));
            Hs[(quad * 4 + j) * 136 + ni * 16 + l15] = f2bf(0.5f * x * (1.0f + th)); } }
    __syncthreads();
    f32x4 o[4];
#pragma unroll
    for (int i = 0; i < 4; ++i) o[i] = (f32x4){0.f, 0.f, 0.f, 0.f};
#pragma unroll
    for (int ks = 0; ks < 4; ++ks) { const bf16x8 a = *(const bf16x8*)(Hs + l15 * 136 + ks * 32 + quad * 8);
#pragma unroll
        for (int ni = 0; ni < 4; ++ni) o[ni] = mfma(a, ld8(w2t + (size_t)(ni * 16 + l15) * 128 + ks * 32 + quad * 8), o[ni]); }
    const int nb = ntile * 64 + w * 16 + quad * 4;
    if (which == 0) {
        bf16_t* kc = (bf16_t*)(p.ws + OFF_KC) + (size_t)(b * 2 + g) * 256 * 64;
        const float* rope = (const float*)(p.ws + OFF_ROPE);
#pragma unroll
        for (int j = 0; j < 4; ++j) {
            const int n = nb + j;
            float ss = o[0][j] * o[0][j] + o[1][j] * o[1][j] + o[2][j] * o[2][j] + o[3][j] * o[3][j];
            ss += __shfl_xor(ss, 1); ss += __shfl_xor(ss, 2); ss += __shfl_xor(ss, 4); ss += __shfl_xor(ss, 8);
            const float r = rsqrtf(ss * (1.0f / 64.0f) + 1e-6f);
            float v[4];
#pragma unroll
            for (int ni = 0; ni < 4; ++ni) v[ni] = o[ni][j] * r * p.nsa_kn_g[L * 64 + ni * 16 + l15];
            int pos = 16 * n + 31; if (pos > 4095) pos = 4095;
            const float cs = rope[pos * 16 + (l15 & 7)], sn = rope[pos * 16 + 8 + (l15 & 7)];
            const float pp = __shfl_xor(v[0], 8);
            v[0] = (l15 < 8) ? (v[0] * cs - pp * sn) : (v[0] * cs + pp * sn);
#pragma unroll
            for (int ni = 0; ni < 4; ++ni) kc[(size_t)n * 64 + ni * 16 + l15] = (n < 255) ? f2bf(v[ni]) : (bf16_t)0;
        }
    } else {
        bf16_t* vct = (bf16_t*)(p.ws + OFF_VCT) + (size_t)(b * 2 + g) * 64 * 256;
#pragma unroll
        for (int ni = 0; ni < 4; ++ni) {
            float v0 = o[ni][0], v1 = o[ni][1], v2 = o[ni][2], v3 = o[ni][3];
            if (nb + 3 >= 255) v3 = 0.f;
            uint2 ov; ov.x = pk2(v0, v1); ov.y = pk2(v2, v3);
            *(uint2*)(vct + (size_t)(ni * 16 + l15) * 256 + nb) = ov;
        }
    }
    __syncthreads();
}

__device__ void foxc_job(const Params& p, int L, int bh, char* lds) {
    const int tid = otid(), lane = tid & 63, w = tid >> 6, b = bh >> 2, h = bh & 3;
    const float* gates = (const float*)(p.ws + OFF_GATES);
    float* cc = (float*)(p.ws + OFF_FOXC) + (size_t)bh * 4096;
    float* wtot = (float*)lds;
    const float fb = p.fox_fb[L * 4 + h];
    float v[16];
#pragma unroll
    for (int i = 0; i < 16; ++i) v[i] = gates[((size_t)b * 4096 + tid * 16 + i) * 32 + 24 + h] + fb;
    float run = 0.f;
#pragma unroll
    for (int i = 0; i < 16; ++i) { const float x = v[i]; run += (x >= 0.f) ? -log1pf(__expf(-x)) : (x - log1pf(__expf(x))); v[i] = run; }
    float incl = run;
#pragma unroll
    for (int o = 1; o < 64; o <<= 1) { const float t = __shfl_up(incl, o); if (lane >= o) incl += t; }
    if (lane == 63) wtot[w] = incl;
    __syncthreads();
    float pre = incl - run;
#pragma unroll
    for (int s = 0; s < 4; ++s) if (s < w) pre += wtot[s];
#pragma unroll
    for (int i = 0; i < 4; ++i) { const float k2 = 1.4426950408889634f;
        *(float4*)(cc + tid * 16 + i * 4) = make_float4((pre + v[4 * i]) * k2, (pre + v[4 * i + 1]) * k2, (pre + v[4 * i + 2]) * k2, (pre + v[4 * i + 3]) * k2); }
    __syncthreads();
}

constexpr int KV_BUF = 16384;
DEVI void tile_glds(const bf16_t* Kg, int ldk, const bf16_t* Vg, int ldv, char* buf, int tid) {
    const int w = tid >> 6, i = tid & 63;
#pragma unroll
    for (int jj = 0; jj < 2; ++jj) {
        const int j = w * 2 + jj, row = 8 * j + (i >> 3), slot = i & 7;
        const bf16_t* kp = Kg + (size_t)row * ldk + ((slot ^ (row & 7)) << 3);
        const bf16_t* vp = Vg + (size_t)row * ldv + ((slot ^ ((row >> 1) & 7)) << 3);
        __builtin_amdgcn_global_load_lds((const unsigned*)kp, (ldsp_t)(unsigned)(size_t)(buf + j * 1024), 16, 0, 0);
        __builtin_amdgcn_global_load_lds((const unsigned*)vp, (ldsp_t)(unsigned)(size_t)(buf + 8192 + j * 1024), 16, 0, 0);
    }
}
DEVI void lds_kf(const char* buf, int kh, int lane, bf16x8 (&kf)[2][2]) {
    const int quad = lane >> 4, l15 = lane & 15;
#pragma unroll
    for (int t2 = 0; t2 < 2; ++t2)
#pragma unroll
        for (int ks = 0; ks < 2; ++ks) { const int row = kh * 32 + t2 * 16 + l15, ch = ks * 4 + quad; kf[t2][ks] = *(const bf16x8*)(buf + row * 128 + ((ch ^ (row & 7)) << 4)); }
}
DEVI void lds_vf(const char* buf, int kh, int lane, bf16x8 (&vf)[4]) {
    const int quad = lane >> 4, l15 = lane & 15;
#pragma unroll
    for (int dt = 0; dt < 4; ++dt) { const int d = dt * 16 + l15, u0 = kh * 8 + quad, u1 = u0 + 4;
        const uint2 a = *(const uint2*)(buf + 8192 + d * 128 + ((u0 ^ (d & 14)) << 3)), b = *(const uint2*)(buf + 8192 + d * 128 + ((u1 ^ (d & 14)) << 3));
        vf[dt] = mk8(a.x, a.y, b.x, b.y); }
}

template <class MaskF>
DEVI void attn_block64(const char* buf, int kbase, const char* ql, int q0o, int q1o, int qstride, const float* cb, f32x4 (&O)[4][4], float (&m)[4], float (&l)[4], int lane, MaskF maskf) {
    const int quad = lane >> 4;
#pragma unroll
    for (int kh = 0; kh < 2; ++kh) {
        bf16x8 kf[2][2], vf[4];
        lds_kf(buf, kh, lane, kf); lds_vf(buf, kh, lane, vf);
        float ck[8] = {0.f, 0.f, 0.f, 0.f, 0.f, 0.f, 0.f, 0.f};
        if (cb) { const float4 c0 = *(const float4*)(cb + kbase + kh * 32 + quad * 4), c1 = *(const float4*)(cb + kbase + kh * 32 + 16 + quad * 4);
            ck[0] = c0.x; ck[1] = c0.y; ck[2] = c0.z; ck[3] = c0.w; ck[4] = c1.x; ck[5] = c1.y; ck[6] = c1.z; ck[7] = c1.w; }
#pragma unroll
        for (int nt = 0; nt < 4; ++nt) {
            f32x4 s0 = (f32x4){0.f, 0.f, 0.f, 0.f}, s1 = s0;
            { const bf16x8 qa = *(const bf16x8*)(ql + nt * qstride + q0o), qb_ = *(const bf16x8*)(ql + nt * qstride + q1o);
              s0 = mfma(kf[0][0], qa, s0); s1 = mfma(kf[1][0], qa, s1); s0 = mfma(kf[0][1], qb_, s0); s1 = mfma(kf[1][1], qb_, s1); }
            float sv[8]; float mx = -1e30f;
#pragma unroll
            for (int e = 0; e < 8; ++e) { sv[e] = (e < 4) ? s0[e & 3] : s1[e & 3]; const int key = kbase + kh * 32 + (e >> 2) * 16 + quad * 4 + (e & 3);
                const bool ok = maskf(nt, ck[e], key, sv[e]); sv[e] = ok ? sv[e] : -__builtin_huge_valf(); mx = fmaxf(mx, sv[e]); }
            mx = fmaxf(mx, __shfl_xor(mx, 16)); mx = fmaxf(mx, __shfl_xor(mx, 32));
            const float mn = fmaxf(m[nt], mx), alpha = __builtin_amdgcn_exp2f(m[nt] - mn);
            float pv[8]; float rs = 0.f;
#pragma unroll
            for (int e = 0; e < 8; ++e) { pv[e] = __builtin_amdgcn_exp2f(sv[e] - mn); rs += pv[e]; }
            rs += __shfl_xor(rs, 16); rs += __shfl_xor(rs, 32);
            l[nt] = l[nt] * alpha + rs; m[nt] = mn;
            const bf16x8 P = mk8(pk2(pv[0], pv[1]), pk2(pv[2], pv[3]), pk2(pv[4], pv[5]), pk2(pv[6], pv[7]));
#pragma unroll
            for (int dt = 0; dt < 4; ++dt) { O[dt][nt] = O[dt][nt] * alpha; O[dt][nt] = mfma(vf[dt], P, O[dt][nt]); }
        }
    }
}

template <class MaskF>
DEVI void attn_stream(u64 tiles, const bf16_t* Kbase, int ldk, const bf16_t* Vbase, int ldv, char* kvbuf, int jb_wave_min, int jb_wave_max,
                      const char* ql, int q0o, int q1o, int qstride, const float* cb, f32x4 (&O)[4][4], float (&m)[4], float (&l)[4], int tid, int lane, MaskF maskf) {
    if (tiles == 0ull) return;
    int jb = __ffsll((long long)tiles) - 1; tiles &= tiles - 1;
    tile_glds(Kbase + (size_t)jb * 64 * ldk, ldk, Vbase + jb * 64, ldv, kvbuf, tid);
    __syncthreads();
    int cur = 0;
#pragma unroll 1
    for (;;) {
        const bool more = tiles != 0ull;
        int jbn = 0;
        if (more) { jbn = __ffsll((long long)tiles) - 1; tiles &= tiles - 1; tile_glds(Kbase + (size_t)jbn * 64 * ldk, ldk, Vbase + jbn * 64, ldv, kvbuf + (cur ^ 1) * KV_BUF, tid); }
        if (jb >= jb_wave_min && jb <= jb_wave_max) attn_block64(kvbuf + cur * KV_BUF, jb * 64, ql, q0o, q1o, qstride, cb, O, m, l, lane, [&](int nt, float ckv, int key, float& s) { return maskf(nt, ckv, key, jb, s); });
        __syncthreads();
        if (!more) break;
        jb = jbn; cur ^= 1;
    }
}

DEVI void attn_store2(bf16_t* mix, size_t token0, int tokstride, int col0, int colstride, const f32x4 (&O)[4][4], const float (&sc)[4], int lane, bool accum) {
    const int quad = lane >> 4, l15 = lane & 15;
#pragma unroll
    for (int nt = 0; nt < 4; ++nt)
#pragma unroll
        for (int dt = 0; dt < 4; ++dt) {
            bf16_t* dst = mix + (token0 + nt * tokstride + l15) * DM + col0 + nt * colstride + dt * 16 + quad * 4;
            float a0 = O[dt][nt][0] * sc[nt], a1 = O[dt][nt][1] * sc[nt], a2 = O[dt][nt][2] * sc[nt], a3 = O[dt][nt][3] * sc[nt];
            if (accum) { const uint2 old = *(const uint2*)dst; a0 += bflo(old.x); a1 += bfhi(old.x); a2 += bflo(old.y); a3 += bfhi(old.y); }
            uint2 o; o.x = pk2(a0, a1); o.y = pk2(a2, a3);
            *(uint2*)dst = o;
        }
}

__device__ void nsa_unit(const Params& p, int L, int b, int g, int blk, char* lds) {
    const int tid = otid(), lane = tid & 63, w = tid >> 6, quad = lane >> 4, l15 = lane & 15;
    const bf16_t* proj = (const bf16_t*)(p.ws + OFF_BIG); const bf16_t* VT = (const bf16_t*)(p.ws + OFF_BIG + OFF_VT_IN_BIG);
    const float* gates = (const float*)(p.ws + OFF_GATES);
    bf16_t* mix = (bf16_t*)(p.ws + OFF_ACT);
    char* kvbuf = lds; float* impL = (float*)(lds + KV_BUF)  ; char* Qs = lds + 32768; u64* selm = (u64*)(lds + 65536);
    const int q0 = blk * 64; const int tq = q0 + w * 16 + l15; const size_t token = (size_t)b * 4096 + tq;
    const size_t token0 = (size_t)b * 4096 + q0 + w * 16;
    const int mixcol = 256 + g * 256;
#pragma unroll
    for (int t = 0; t < 8; ++t) { const int idx = t * 64 + lane, rr = idx >> 3, c = idx & 7, hh = rr >> 4, r16 = rr & 15;
        const uint4 v = *(const uint4*)(proj + (token0 + r16) * PJ_LD + 1024 + (g * 4 + hh) * 64 + c * 8);
        *(uint4*)(Qs + (hh * 64 + w * 16 + r16) * 128 + ((c ^ (r16 & 7)) << 4)) = v; }
    const char* ql = Qs + (w * 16 + l15) * 128; const int q0o = ((quad) ^ (l15 & 7)) << 4, q1o = ((4 + quad) ^ (l15 & 7)) << 4; const int qstride = 8192;
    __syncthreads();
    f32x4 O[4][4]; float m[4], l[4];
    const bf16_t* Kc = (const bf16_t*)(p.ws + OFF_KC) + (size_t)(b * 2 + g) * 256 * 64;
    const bf16_t* VcT = (const bf16_t*)(p.ws + OFF_VCT) + (size_t)(b * 2 + g) * 64 * 256;
    const int ncb = (4 * blk + 3 + 63) >> 6;
#pragma unroll
    for (int nt = 0; nt < 4; ++nt) { m[nt] = -1e30f; l[nt] = 0.f; }
    {
#pragma unroll 1
        for (int pass = 0; pass < 2; ++pass) {
            float inv[4]; float prevr = 0.f;
            if (pass == 1) {
#pragma unroll
                for (int nt = 0; nt < 4; ++nt) inv[nt] = 1.0f / fmaxf(l[nt], 1e-30f);
#pragma unroll
                for (int dt = 0; dt < 4; ++dt)
#pragma unroll
                    for (int nt = 0; nt < 4; ++nt) O[dt][nt] = (f32x4){0.f, 0.f, 0.f, 0.f};
            }
#pragma unroll 1
            for (int ct = 0; ct < ncb; ++ct) {
                tile_glds(Kc + (size_t)ct * 64 * 64, 64, VcT + ct * 64, 256, kvbuf, tid);
                __syncthreads();
                const char* buf = kvbuf;
#pragma unroll
                for (int kh = 0; kh < 2; ++kh) {
                    bf16x8 kf[2][2]; lds_kf(buf, kh, lane, kf);
                    if (pass == 0) {
#pragma unroll
                        for (int nt = 0; nt < 4; ++nt) {
                            f32x4 s0 = (f32x4){0.f, 0.f, 0.f, 0.f}, s1 = s0;
                            { const bf16x8 qa = *(const bf16x8*)(ql + nt * qstride + q0o), qb_ = *(const bf16x8*)(ql + nt * qstride + q1o);
                              s0 = mfma(kf[0][0], qa, s0); s1 = mfma(kf[1][0], qa, s1); s0 = mfma(kf[0][1], qb_, s0); s1 = mfma(kf[1][1], qb_, s1); }
                            float sv[8]; bool ok[8]; float mx = -1e30f;
#pragma unroll
                            for (int e = 0; e < 8; ++e) { sv[e] = (e < 4) ? s0[e & 3] : s1[e & 3]; const int n = ct * 64 + kh * 32 + (e >> 2) * 16 + quad * 4 + (e & 3);
                                ok[e] = (16 * n + 31 <= tq); if (ok[e]) mx = fmaxf(mx, sv[e]); }
                            mx = fmaxf(mx, __shfl_xor(mx, 16)); mx = fmaxf(mx, __shfl_xor(mx, 32));
                            const float mn = fmaxf(m[nt], mx), alpha = __builtin_amdgcn_exp2f(m[nt] - mn);
                            float rs = 0.f;
#pragma unroll
                            for (int e = 0; e < 8; ++e) rs += ok[e] ? __builtin_amdgcn_exp2f(sv[e] - mn) : 0.f;
                            rs += __shfl_xor(rs, 16); rs += __shfl_xor(rs, 32);
                            l[nt] = l[nt] * alpha + rs; m[nt] = mn;
                        }
                    } else {
                        bf16x8 vf[4]; lds_vf(buf, kh, lane, vf);
                        float As[2] = {0.f, 0.f}, p3[2] = {0.f, 0.f};
#pragma unroll
                        for (int nt = 0; nt < 4; ++nt) {
                            f32x4 s0 = (f32x4){0.f, 0.f, 0.f, 0.f}, s1 = s0;
                            { const bf16x8 qa = *(const bf16x8*)(ql + nt * qstride + q0o), qb_ = *(const bf16x8*)(ql + nt * qstride + q1o);
                              s0 = mfma(kf[0][0], qa, s0); s1 = mfma(kf[1][0], qa, s1); s0 = mfma(kf[0][1], qb_, s0); s1 = mfma(kf[1][1], qb_, s1); }
                            float pv[8];
#pragma unroll
                            for (int e = 0; e < 8; ++e) { const float s = (e < 4) ? s0[e & 3] : s1[e & 3]; const int n = ct * 64 + kh * 32 + (e >> 2) * 16 + quad * 4 + (e & 3);
                                pv[e] = (16 * n + 31 <= tq) ? __builtin_amdgcn_exp2f(s - m[nt]) * inv[nt] : 0.f; }
                            As[0] += (pv[0] + pv[1]) + (pv[2] + pv[3]); As[1] += (pv[4] + pv[5]) + (pv[6] + pv[7]); p3[0] += pv[3]; p3[1] += pv[7];
                            const bf16x8 P = mk8(pk2(pv[0], pv[1]), pk2(pv[2], pv[3]), pk2(pv[4], pv[5]), pk2(pv[6], pv[7]));
#pragma unroll
                            for (int dt = 0; dt < 4; ++dt) O[dt][nt] = mfma(vf[dt], P, O[dt][nt]);
                        }
                        const int qq = w * 16 + l15;
#pragma unroll
                        for (int t2 = 0; t2 < 2; ++t2) {
                            const float rr = __shfl(p3[t2], (lane + 48) & 63);
                            const float carry = (quad == 0) ? prevr : rr; prevr = rr;
                            const int jb = ct * 16 + kh * 8 + t2 * 4 + quad;
                            impL[jb * 64 + ((qq ^ jb) & 63)] = As[t2] + carry;
                        }
                    }
                }
                __syncthreads();
            }
        }
    }
    {
        const float4 gv = *(const float4*)(gates + token * 32 + 0 * 8 + g * 4);
        const float sc[4] = {gv.x, gv.y, gv.z, gv.w};
        attn_store2(mix, token0, 0, mixcol, 64, O, sc, lane, false);
    }
#pragma unroll 1
    for (int qi = 0; qi < 16; ++qi) {
        const int q = w * 16 + qi, jb = lane;
        float val = impL[jb * 64 + ((q ^ jb) & 63)];
        if (jb > blk) val = -1e30f;
        else if (jb == 0 || jb == blk || jb == blk - 1) val = 1e30f;
        int rank = 0;
        for (int jp = 0; jp < 64; ++jp) { const float vj = __shfl(val, jp); rank += ((vj > val) || (vj == val && jp < jb)) ? 1 : 0; }
        const bool sel = (rank < 16) && (val > -5e29f);
        const u64 mask = __ballot(sel);
        if (lane == 0) selm[q] = mask;
    }
    __syncthreads();
    u64 uni = 0;
    for (int q = 0; q < 64; ++q) uni |= selm[q];
    const u64 sm = selm[w * 16 + l15];
    {
#pragma unroll
        for (int nt = 0; nt < 4; ++nt) { m[nt] = -1e30f; l[nt] = 0.f; }
#pragma unroll
        for (int dt = 0; dt < 4; ++dt)
#pragma unroll
            for (int nt = 0; nt < 4; ++nt) O[dt][nt] = (f32x4){0.f, 0.f, 0.f, 0.f};
        const u64 tiles = uni & ((blk == 63) ? ~0ull : ((2ull << blk) - 1ull));
        attn_stream(tiles, proj + (size_t)b * 4096 * PJ_LD + 1792 + g * 64, PJ_LD, VT + ((size_t)((4 + g) * 8 + b) * 64) * 4096, 4096, kvbuf, 0, 63, ql, q0o, q1o, qstride, nullptr, O, m, l, tid, lane,
                    [&](int nt, float ckv, int key, int jb, float& s) { return (((sm >> jb) & 1ull) != 0) && (key <= tq); });
        const float4 gv = *(const float4*)(gates + token * 32 + 1 * 8 + g * 4);
        const float sc[4] = {gv.x / fmaxf(l[0], 1e-30f), gv.y / fmaxf(l[1], 1e-30f), gv.z / fmaxf(l[2], 1e-30f), gv.w / fmaxf(l[3], 1e-30f)};
        attn_store2(mix, token0, 0, mixcol, 64, O, sc, lane, true);
    }
    {
#pragma unroll
        for (int nt = 0; nt < 4; ++nt) { m[nt] = -1e30f; l[nt] = 0.f; }
#pragma unroll
        for (int dt = 0; dt < 4; ++dt)
#pragma unroll
            for (int nt = 0; nt < 4; ++nt) O[dt][nt] = (f32x4){0.f, 0.f, 0.f, 0.f};
        const int jlo = blk > 8 ? blk - 8 : 0;
        const u64 upto = (blk == 63) ? ~0ull : ((2ull << blk) - 1ull);
        const u64 tiles = upto & ~((1ull << jlo) - 1ull);
        attn_stream(tiles, proj + (size_t)b * 4096 * PJ_LD + 2048 + g * 64, PJ_LD, VT + ((size_t)((6 + g) * 8 + b) * 64) * 4096, 4096, kvbuf, 0, 63, ql, q0o, q1o, qstride, nullptr, O, m, l, tid, lane,
                    [&](int nt, float ckv, int key, int jb, float& s) { return (key <= tq) && (key + 512 > tq); });
        const float4 gv = *(const float4*)(gates + token * 32 + 2 * 8 + g * 4);
        const float sc[4] = {gv.x / fmaxf(l[0], 1e-30f), gv.y / fmaxf(l[1], 1e-30f), gv.z / fmaxf(l[2], 1e-30f), gv.w / fmaxf(l[3], 1e-30f)};
        attn_store2(mix, token0, 0, mixcol, 64, O, sc, lane, true);
    }
    __syncthreads();
}

__device__ void fox_unit(const Params& p, int L, int b, int h, int qb, char* lds) {
    const int tid = otid(), lane = tid & 63, w = tid >> 6, quad = lane >> 4, l15 = lane & 15;
    const bf16_t* proj = (const bf16_t*)(p.ws + OFF_BIG); const bf16_t* VT = (const bf16_t*)(p.ws + OFF_BIG + OFF_VT_IN_BIG);
    bf16_t* mix = (bf16_t*)(p.ws + OFF_ACT);
    const float* cc = (const float*)(p.ws + OFF_FOXC) + (size_t)(b * 4 + h) * 4096;
    const int q0 = qb * 256 + w * 64; const size_t token0 = (size_t)b * 4096 + q0;
    int tq[4]; float cq[4];
#pragma unroll
    for (int nt = 0; nt < 4; ++nt) { tq[nt] = q0 + nt * 16 + l15; cq[nt] = cc[tq[nt]]; }
    char* Qs = lds + 32768;
#pragma unroll
    for (int t = 0; t < 8; ++t) { const int idx = t * 64 + lane, rr = idx >> 3, c = idx & 7;
        const uint4 v = *(const uint4*)(proj + (token0 + rr) * PJ_LD + 2304 + h * 64 + c * 8);
        *(uint4*)(Qs + (w * 64 + rr) * 128 + ((c ^ (rr & 7)) << 4)) = v; }
    const char* ql = Qs + (w * 64 + l15) * 128; const int q0o = ((quad) ^ (l15 & 7)) << 4, q1o = ((4 + quad) ^ (l15 & 7)) << 4; const int qstride = 2048;
    __syncthreads();
    f32x4 O[4][4]; float m[4], l[4];
#pragma unroll
    for (int nt = 0; nt < 4; ++nt) { m[nt] = -1e30f; l[nt] = 0.f; }
#pragma unroll
    for (int dt = 0; dt < 4; ++dt)
#pragma unroll
        for (int nt = 0; nt < 4; ++nt) O[dt][nt] = (f32x4){0.f, 0.f, 0.f, 0.f};
    const int jmax = qb * 4 + 3;
    int jlo_w, jlo_b;
    { const float cq0 = cc[q0]; int lo = 0, hi = qb * 4 + w;
      while (lo < hi) { const int mid = (lo + hi) >> 1; if (cq0 - cc[mid * 64 + 63] >= -202.f) hi = mid; else lo = mid + 1; }
      jlo_w = lo; }
    { const float cq0 = cc[qb * 256]; int lo = 0, hi = qb * 4;
      while (lo < hi) { const int mid = (lo + hi) >> 1; if (cq0 - cc[mid * 64 + 63] >= -202.f) hi = mid; else lo = mid + 1; }
      jlo_b = lo; }
    const u64 tiles = ((jmax == 63) ? ~0ull : ((2ull << jmax) - 1ull)) & ~((1ull << jlo_b) - 1ull);
    attn_stream(tiles, proj + (size_t)b * 4096 * PJ_LD + 2560 + h * 64, PJ_LD, VT + ((size_t)((8 + h) * 8 + b) * 64) * 4096, 4096, lds, jlo_w, qb * 4 + w, ql, q0o, q1o, qstride, cc, O, m, l, tid, lane,
                [&](int nt, float ckv, int key, int jb, float& s) { s += cq[nt] - ckv; return key <= tq[nt]; });
    float sc[4];
#pragma unroll
    for (int nt = 0; nt < 4; ++nt) sc[nt] = 1.0f / fmaxf(l[nt], 1e-30f);
    attn_store2(mix, token0, 16, 768 + h * 64, 0, O, sc, lane, false);
}

__device__ void mixA_phase(const Params& p, int L, char* lds);
DEVI int next_unit(const Params& p, int idx, char* lds) {
    int* slot = (int*)(lds + LDS_BYTES - 16);
    const unsigned g = blockIdx.x & 7u;
    unsigned* ctr = (unsigned*)(p.ws + OFF_XBAR) + 10240 + (idx * 8 + (int)g) * 64;
    __syncthreads();
    if (otid() == 0) *slot = (int)(g + 8u * atomicAdd(ctr, 1u));
    __syncthreads();
    return *slot;
}
__device__ void mixA_phase(const Params& p, int L, char* lds) {
#pragma unroll 1
    for (;;) {
        const int job = next_unit(p, L * 4 + 3, lds); if (job >= 160 + 512) break;
        if (job < 128) compress_unit(p, L, job, lds);
        else if (job < 160) foxc_job(p, L, job - 128, lds);
        else {
#pragma unroll 1
            for (int u = (job - 160) * 4; u < (job - 160) * 4 + 4; ++u) hgrn_a_unit(p, L, u, lds);
        }
    }
}
__device__ void mixB_phase(const Params& p, int L, char* lds) {
#pragma unroll 1
    for (;;) { const int f = next_unit(p, L * 4 + 0, lds); if (f >= 512) break; const int qb = 15 - (f >> 5), bh = f & 31; fox_unit(p, L, bh >> 2, bh & 3, qb, lds); }
#pragma unroll 1
    for (;;) { const int n = next_unit(p, L * 4 + 1, lds); if (n >= 1024) break; const int blk = 63 - (n >> 4), bg = n & 15; nsa_unit(p, L, bg >> 1, bg & 1, blk, lds); }
#pragma unroll 1
    for (;;) { const int c = next_unit(p, L * 4 + 2, lds); if (c >= 1024) break;
#pragma unroll 1
        for (int u = c * 2; u < c * 2 + 2; ++u) hgrn_c_unit(p, L, u, lds); }
}


#define XB_TMO      128
#define XB_XCNT(j)  (256  + 64 * (j))
#define XB_XSUB(j)  (1280 + 64 * (j))
#define XB_XGEN(j)  (2304 + 64 * (j))
#define XB_TOP      3328
#define XB_TOPGEN   3392
#define XCD_BAR_WORDS 3456
#define XB_SPIN_CAP (1u << 18)
#define LAS __attribute__((address_space(3)))
DEVI unsigned xb_ld(unsigned* p)              { return __hip_atomic_load(p, __ATOMIC_RELAXED, __HIP_MEMORY_SCOPE_AGENT); }
DEVI unsigned xb_add(unsigned* p, unsigned v) { return __hip_atomic_fetch_add(p, v, __ATOMIC_RELAXED, __HIP_MEMORY_SCOPE_AGENT); }
DEVI unsigned xb_xcc_id() { return (unsigned)__builtin_amdgcn_s_getreg((3 << 11) | 20) & 0xFu; }
#define XB_SPIN(cond, bar) do { unsigned _sp = 0; while (cond) { __builtin_amdgcn_s_sleep(1); \
    if ((++_sp & 255u) == 0u) { if (xb_ld(&(bar)[XB_TMO])) break; if (_sp > XB_SPIN_CAP) { atomicAdd(&(bar)[XB_TMO], 1u); break; } } } } while (0)
struct XcdBarrier { unsigned* bar; unsigned x; volatile LAS unsigned* st; };
DEVI XcdBarrier xcd_barrier_post(unsigned* bar, volatile LAS unsigned* st) {
    XcdBarrier b; b.bar = bar; b.x = xb_xcc_id(); b.st = st;
    if (threadIdx.x == 0) (void)xb_add(&bar[XB_XCNT(b.x)], 1u);
    return b;
}
DEVI void xcd_barrier_complete(unsigned* bar, unsigned x, unsigned& nloc, unsigned& nx) {
    const unsigned G = gridDim.x * gridDim.y * gridDim.z;
    unsigned sum, cnt, mine, sp = 0u;
    for (;;) {
        sum = 0u; cnt = 0u; mine = 0u;
#pragma unroll
        for (unsigned j = 0; j < 16; ++j) { const unsigned c = xb_ld(&bar[XB_XCNT(j)]); sum += c; cnt += (c > 0u) ? 1u : 0u; mine = (j == x) ? c : mine; }
        if (sum == G) break;
        __builtin_amdgcn_s_sleep(1);
        if ((++sp & 255u) == 0u) { if (xb_ld(&bar[XB_TMO])) break; if (sp > XB_SPIN_CAP) { atomicAdd(&bar[XB_TMO], 1u); break; } }
    }
    nloc = mine > 0u ? mine : 1u; nx = cnt > 0u ? cnt : 1u;
}
DEVI void xcd_barrier(const XcdBarrier& b) {
    __builtin_amdgcn_fence(__ATOMIC_RELEASE, "agent");
    asm volatile("s_waitcnt vmcnt(0)" ::: "memory");
    __syncthreads();
    if (threadIdx.x == 0) {
        unsigned* bar = b.bar;
        __builtin_amdgcn_s_waitcnt(0);
        unsigned nloc = b.st[0], nx = b.st[1];
        if (nloc == 0u) { xcd_barrier_complete(bar, b.x, nloc, nx); b.st[0] = nloc; b.st[1] = nx; }
        const unsigned old = xb_add(&bar[XB_XSUB(b.x)], 1u);
        const unsigned gen = old / nloc;
        if (old + 1u == (gen + 1u) * nloc) {
            __builtin_amdgcn_fence(__ATOMIC_RELEASE, "agent");
            asm volatile("s_waitcnt vmcnt(0)" ::: "memory");
            const unsigned og = xb_add(&bar[XB_TOP], 1u);
            const unsigned tg = og / nx;
            if (og + 1u == (tg + 1u) * nx) xb_add(&bar[XB_TOPGEN], 1u);
            else XB_SPIN(xb_ld(&bar[XB_TOPGEN]) == tg, bar);
            __builtin_amdgcn_fence(__ATOMIC_ACQUIRE, "agent");
            xb_add(&bar[XB_XGEN(b.x)], 1u);
            asm volatile("s_waitcnt vmcnt(0)" ::: "memory");
        } else {
            XB_SPIN(xb_ld(&bar[XB_XGEN(b.x)]) == gen, bar);
            __builtin_amdgcn_fence(__ATOMIC_ACQUIRE, "agent");
            asm volatile("s_waitcnt vmcnt(0)" ::: "memory");
        }
    }
    __syncthreads();
    __builtin_amdgcn_fence(__ATOMIC_ACQUIRE, "agent");
    asm volatile("s_waitcnt vmcnt(0)" ::: "memory");
}

__device__ void run_phase(const Params& p, int ph, char* lds) {
    if (ph == 0) { prep_phase(p, lds); return; }
    const int L = (ph - 1) / 7, s = (ph - 1) % 7;
    switch (s) {
        case 0: gemm_phase<EPI_PROJ>(p, L, lds); break;
        case 1: mixA_phase(p, L, lds); break;
        case 2: hgrn_scan_phase(p); break;
        case 3: mixB_phase(p, L, lds); break;
        case 4: gemm_phase<EPI_WO>(p, L, lds); break;
        case 5: gemm_phase<EPI_UP>(p, L, lds); break;
        default: gemm_phase<EPI_DOWN>(p, L, lds); break;
    }
}

__global__ void __launch_bounds__(256, 2) fwd_kernel(Params p, int ph_lo, int ph_hi) {
    __shared__ __attribute__((aligned(16))) char lds[LDS_BYTES];
    __shared__ uint4 xb_words;
    if (threadIdx.x == 0) xb_words = make_uint4(0u, 0u, 0u, 0u);
    __syncthreads();
    unsigned* bar = (unsigned*)(p.ws + OFF_XBAR);
    for (int ph = ph_lo; ph < ph_hi; ++ph) {
        run_phase(p, ph, lds);
        if (ph + 1 < ph_hi) {
            if (ph == ph_lo) cg::this_grid().sync();
            else {
                asm volatile("s_waitcnt vmcnt(0)" ::: "memory");
                __syncthreads();
                if (threadIdx.x == 0) {
                    unsigned* base = bar + ph * 640;
                    const unsigned g = blockIdx.x & 7u, G = gridDim.x;
                    const unsigned nper = (G >> 3) + ((g < (G & 7u)) ? 1u : 0u);
                    const unsigned ngrp = G < 8u ? G : 8u;
                    __builtin_amdgcn_fence(__ATOMIC_RELEASE, "agent");
                    asm volatile("s_waitcnt vmcnt(0)" ::: "memory");
                    if (__hip_atomic_fetch_add(base + g * 64, 1u, __ATOMIC_RELAXED, __HIP_MEMORY_SCOPE_AGENT) == nper - 1u) {
                        if (__hip_atomic_fetch_add(base + 8 * 64, 1u, __ATOMIC_RELAXED, __HIP_MEMORY_SCOPE_AGENT) == ngrp - 1u)
                            __hip_atomic_store(base + 9 * 64, 1u, __ATOMIC_RELAXED, __HIP_MEMORY_SCOPE_AGENT);
                    }
                    while (__hip_atomic_load(base + 9 * 64, __ATOMIC_RELAXED, __HIP_MEMORY_SCOPE_AGENT) == 0u) __builtin_amdgcn_s_sleep(1);
                    __builtin_amdgcn_fence(__ATOMIC_ACQUIRE, "agent");
                    asm volatile("s_waitcnt vmcnt(0)" ::: "memory");
                }
                __syncthreads();
            }
        }
    }
}

extern "C" void kernel_launch(void* const* d_in, const int* in_sizes, int n_in, void* d_out, int out_size, void* d_ws, size_t ws_size,
                              hipStream_t stream) {
    if (ws_size < WS_NEED) { fprintf(stderr, "workspace too small: %zu < %zu\n", ws_size, (size_t)WS_NEED); return; }
    Params p{};
    p.x = (const float*)d_in[0]; p.norm1_g = (const float*)d_in[1]; p.w_in = (const float*)d_in[2]; p.lb_logits = (const float*)d_in[3];
    p.onorm_g = (const float*)d_in[4]; p.nsa_qn_g = (const float*)d_in[5]; p.nsa_kn_g = (const float*)d_in[6]; p.cmp_pos = (const float*)d_in[7];
    p.cmp_w1 = (const float*)d_in[8]; p.cmp_w2 = (const float*)d_in[9]; p.fox_qn_g = (const float*)d_in[10]; p.fox_kn_g = (const float*)d_in[11];
    p.fox_fb = (const float*)d_in[12]; p.w_o = (const float*)d_in[13]; p.norm2_g = (const float*)d_in[14]; p.w_up = (const float*)d_in[15];
    p.w_down = (const float*)d_in[16];
    p.out = (float*)d_out; p.ws = (char*)d_ws;
#if MULTI_LAUNCH
    for (int ph = 0; ph < NPHASE; ++ph) hipLaunchKernelGGL(fwd_kernel, dim3(512), dim3(256), 0, stream, p, ph, ph + 1);
#else
    static int grid_blocks = 0;
    if (!grid_blocks) {
        int dev = 0, cus = 0, per_cu = 0;
        hipGetDevice(&dev);
        hipDeviceGetAttribute(&cus, hipDeviceAttributeMultiprocessorCount, dev);
        hipOccupancyMaxActiveBlocksPerMultiprocessor(&per_cu, fwd_kernel, 256, 0);
        per_cu = 2;
        grid_blocks = cus * per_cu;
        grid_blocks &= ~7;
    }
    int lo = 0, hi = NPHASE;
    void* args[] = {&p, &lo, &hi};
    hipError_t e = hipLaunchCooperativeKernel((void*)fwd_kernel, dim3(grid_blocks), dim3(256), args, 0, stream);
    if (e != hipSuccess) fprintf(stderr, "cooperative launch failed: %s (grid %d)\n", hipGetErrorString(e), grid_blocks);
#endif
}
```

```cpp
#include <hip/hip_runtime.h>
#include <hip/hip_cooperative_groups.h>
#include <stdint.h>
#include <cstdio>
namespace cg = cooperative_groups;

#ifndef MULTI_LAUNCH
#define MULTI_LAUNCH 0
#endif

typedef unsigned short bf16_t;
typedef short bf16x8 __attribute__((ext_vector_type(8)));
typedef float f32x4 __attribute__((ext_vector_type(4)));
typedef unsigned long long u64;
typedef __attribute__((address_space(3))) unsigned* ldsp_t;
typedef unsigned u32x16 __attribute__((ext_vector_type(16)));
typedef unsigned u32x8 __attribute__((ext_vector_type(8)));
#define DEVI __device__ __forceinline__

constexpr int T_TOK = 32768, SEQ = 4096, DM = 1024, DFF = 4096;
constexpr int PJ_LD = 3072;
constexpr int NW_IN = 3100, NW_IN_PAD = 3328;
constexpr int NPHASE = 15;

constexpr size_t OFF_WIN = 0;
constexpr size_t OFF_WO = OFF_WIN + (size_t)2 * NW_IN_PAD * 1024 * 2;
constexpr size_t OFF_WUP = OFF_WO + (size_t)2 * 1024 * 1024 * 2;
constexpr size_t OFF_WDN = OFF_WUP + (size_t)2 * 4096 * 1024 * 2;
constexpr size_t OFF_W1T = OFF_WDN + (size_t)2 * 4096 * 1024 * 2;
constexpr size_t OFF_W2T = OFF_W1T + (size_t)2 * 2 * 128 * 2048 * 2;
constexpr size_t OFF_CBIAS = OFF_W2T + (size_t)2 * 2 * 64 * 128 * 2;
constexpr size_t OFF_CTR = OFF_CBIAS + 2048;
constexpr size_t OFF_ROPE = OFF_CTR + 256;
constexpr size_t OFF_GATES = OFF_ROPE + (size_t)4096 * 16 * 4;
constexpr size_t OFF_FOXC = OFF_GATES + (size_t)T_TOK * 32 * 4;
constexpr size_t OFF_KC = OFF_FOXC + (size_t)8 * 4 * 4096 * 4;
constexpr size_t OFF_VCT = OFF_KC + (size_t)8 * 2 * 256 * 64 * 2;
constexpr size_t OFF_DECAY = OFF_VCT + (size_t)8 * 2 * 256 * 64 * 2;
constexpr size_t OFF_KVT = OFF_DECAY + (size_t)2048 * 64 * 4;
constexpr size_t OFF_ST = OFF_KVT + (size_t)2048 * 4096 * 4;
constexpr size_t OFF_ACT = OFF_ST + (size_t)2048 * 4096 * 2;
constexpr size_t OFF_BIG = OFF_ACT + (size_t)T_TOK * 1024 * 2;
constexpr size_t OFF_VT_IN_BIG = (size_t)T_TOK * PJ_LD * 2;
constexpr size_t OFF_ACT2 = OFF_BIG + (size_t)T_TOK * 4096 * 2;
constexpr size_t OFF_SSQ = OFF_ACT2 + (size_t)T_TOK * 1024 * 2;
constexpr size_t OFF_XBAR = OFF_SSQ + (size_t)T_TOK * 16 * 4;
constexpr size_t WS_NEED = OFF_XBAR + 65536;

constexpr int LDS_BYTES = 67584;

struct Params {
    const float *x, *norm1_g, *w_in, *lb_logits, *onorm_g, *nsa_qn_g, *nsa_kn_g, *cmp_pos, *cmp_w1, *cmp_w2,
        *fox_qn_g, *fox_kn_g, *fox_fb, *w_o, *norm2_g, *w_up, *w_down;
    float* out;
    char* ws;
};

DEVI unsigned pk2(float lo, float hi) { unsigned r; asm("v_cvt_pk_bf16_f32 %0, %1, %2" : "=v"(r) : "v"(lo), "v"(hi)); return r; }
DEVI bf16_t f2bf(float f) { return (bf16_t)(pk2(f, 0.f) & 0xffffu); }
DEVI float bf2f(bf16_t h) { return __uint_as_float(((unsigned)h) << 16); }
DEVI float bflo(unsigned u) { return __uint_as_float(u << 16); }
DEVI float bfhi(unsigned u) { return __uint_as_float(u & 0xffff0000u); }
DEVI f32x4 mfma(bf16x8 a, bf16x8 b, f32x4 c) { return __builtin_amdgcn_mfma_f32_16x16x32_bf16(a, b, c, 0, 0, 0); }
DEVI int otid() { int t; asm volatile("v_mov_b32 %0, %1" : "=v"(t) : "v"(threadIdx.x)); return t; }
DEVI float wave_sum(float v) {
#pragma unroll
    for (int o = 32; o >= 1; o >>= 1) v += __shfl_xor(v, o);
    return v;
}
DEVI bf16x8 mk8(unsigned a, unsigned b, unsigned c, unsigned d) {
    uint4 u = make_uint4(a, b, c, d);
    return *(bf16x8*)&u;
}
DEVI bf16x8 ld8(const bf16_t* p) { uint4 u = *(const uint4*)p; return *(bf16x8*)&u; }
DEVI bf16x8 ld4x2(const bf16_t* p0, const bf16_t* p1) {
    uint2 a = *(const uint2*)p0, b = *(const uint2*)p1;
    return mk8(a.x, a.y, b.x, b.y);
}

DEVI int win_colmap(int n) {
    if (n < 2304) return n;
    if (n < 3072) return n + 24;
    if (n < 3096) return n - 768;
    return n;
}
__device__ void transpose_tile(const float* __restrict__ src, int ld_src, bf16_t* __restrict__ dst, int ld_dst, int k0, int n0, int nvalid,
                               int colmode, float* tile) {
    const int tid = otid();
    for (int idx = tid; idx < 4096; idx += 256) {
        const int i = idx >> 6, j = idx & 63, n = n0 + j;
        float v = 0.f;
        if (n < nvalid) v = src[(size_t)(k0 + i) * ld_src + (colmode ? win_colmap(n) : n)];
        tile[i * 65 + j] = v;
    }
    __syncthreads();
    for (int idx = tid; idx < 4096; idx += 256) {
        const int j = idx >> 6, i = idx & 63;
        dst[(size_t)(n0 + j) * ld_dst + k0 + i] = f2bf(tile[i * 65 + j]);
    }
    __syncthreads();
}

__device__ void norm_phase(const float* __restrict__ xin, const float* __restrict__ g, bf16_t* __restrict__ hout) {
    const int tid = otid(); const int lane = tid & 63, w = tid >> 6;
    for (int row = blockIdx.x * 4 + w; row < T_TOK; row += gridDim.x * 4) {
        const float4* xr = (const float4*)(xin + (size_t)row * DM);
        float4 v[4]; float ss = 0.f;
#pragma unroll
        for (int i = 0; i < 4; ++i) { v[i] = xr[lane + 64 * i]; ss += v[i].x * v[i].x + v[i].y * v[i].y + v[i].z * v[i].z + v[i].w * v[i].w; }
        ss = wave_sum(ss);
        const float r = rsqrtf(ss * (1.0f / 1024.0f) + 1e-6f);
#pragma unroll
        for (int i = 0; i < 4; ++i) {
            const float4 gg = ((const float4*)g)[lane + 64 * i];
            uint2 o; o.x = pk2(v[i].x * r * gg.x, v[i].y * r * gg.y); o.y = pk2(v[i].z * r * gg.z, v[i].w * r * gg.w);
            *(uint2*)(hout + (size_t)row * DM + (lane + 64 * i) * 4) = o;
        }
    }
}

__device__ void prep_phase(const Params& p, char* lds) {
    float* tile = (float*)lds;
    if (blockIdx.x == 0 && otid() < 64) ((unsigned*)(p.ws + OFF_CTR))[otid()] = 0u;
    if (blockIdx.x == 1) { for (int i = otid(); i < 16384; i += 256) ((unsigned*)(p.ws + OFF_XBAR))[i] = 0u; }
    bf16_t* win_t = (bf16_t*)(p.ws + OFF_WIN); bf16_t* wo_t = (bf16_t*)(p.ws + OFF_WO);
    bf16_t* wup_t = (bf16_t*)(p.ws + OFF_WUP); bf16_t* wdn_t = (bf16_t*)(p.ws + OFF_WDN);
    bf16_t* w1t = (bf16_t*)(p.ws + OFF_W1T); bf16_t* w2t = (bf16_t*)(p.ws + OFF_W2T);
    const int J0 = 1664, J1 = J0 + 512, J2 = J1 + 2048, J3 = J2 + 2048, J4 = J3 + 256, J5 = J4 + 8, J6 = J5 + 128, J7 = J6 + 128;
    for (int job = blockIdx.x; job < J7; job += gridDim.x) {
        if (job < J0) { const int L = job / 832, r = job % 832, kt = r / 52, nt = r % 52;
            transpose_tile(p.w_in + (size_t)L * 1024 * NW_IN, NW_IN, win_t + (size_t)L * NW_IN_PAD * 1024, 1024, kt * 64, nt * 64, NW_IN, 1, tile);
        } else if (job < J1) { const int j = job - J0, L = j / 256, r = j % 256, kt = r / 16, nt = r % 16;
            transpose_tile(p.w_o + (size_t)L * 1024 * 1024, 1024, wo_t + (size_t)L * 1024 * 1024, 1024, kt * 64, nt * 64, 1024, 0, tile);
        } else if (job < J2) { const int j = job - J1, L = j / 1024, r = j % 1024, kt = r / 64, nt = r % 64;
            transpose_tile(p.w_up + (size_t)L * 1024 * 4096, 4096, wup_t + (size_t)L * 4096 * 1024, 1024, kt * 64, nt * 64, 4096, 0, tile);
        } else if (job < J3) { const int j = job - J2, L = j / 1024, r = j % 1024, kt = r / 16, nt = r % 16;
            transpose_tile(p.w_down + (size_t)L * 4096 * 1024, 1024, wdn_t + (size_t)L * 1024 * 4096, 4096, kt * 64, nt * 64, 1024, 0, tile);
        } else if (job < J4) { const int j = job - J3, lw = j / 64, r = j % 64, kt = r / 2, nt = r % 2;
            transpose_tile(p.cmp_w1 + (size_t)lw * 2048 * 128, 128, w1t + (size_t)lw * 128 * 2048, 2048, kt * 64, nt * 64, 128, 0, tile);
        } else if (job < J5) { const int j = job - J4, lw = j / 2, kt = j % 2;
            transpose_tile(p.cmp_w2 + (size_t)lw * 128 * 64, 64, w2t + (size_t)lw * 64 * 128, 128, kt * 64, 0, 64, 0, tile);
        } else if (job < J6) {
            const int t_ = otid(); const int o = (job - J5) * 4 + (t_ >> 6), lane = t_ & 63, lw = o >> 7, hid = o & 127;
            const float* pos = p.cmp_pos + (size_t)lw * 2048; const float* w1 = p.cmp_w1 + (size_t)lw * 2048 * 128 + hid;
            float s = 0.f;
            for (int k = lane; k < 2048; k += 64) s += pos[k] * w1[(size_t)k * 128];
            s = wave_sum(s);
            if (lane == 0) ((float*)(p.ws + OFF_CBIAS))[o] = s;
        } else {
            const int e = (job - J6) * 256 + otid(), pos = e >> 3, i = e & 7;
            const float invf[8] = {1.0f, 0.1939227432012558f, 0.03760603070259094f, 0.007292664609849453f, 0.0014142135623842478f,
                                   0.00027424818836152554f, 5.318296098266728e-05f, 1.0313386155758053e-05f};
            float fr = 1.0f;
#pragma unroll
            for (int q = 0; q < 8; ++q) if (i == q) fr = invf[q];
            const float ang = (float)pos * fr;
            const double a = (double)ang; const double n = rint(a * 0.15915494309189535); const float rr = (float)(a - n * 6.283185307179586);
            float* rt = (float*)(p.ws + OFF_ROPE);
            rt[pos * 16 + i] = __cosf(rr); rt[pos * 16 + 8 + i] = __sinf(rr);
        }
    }
    norm_phase(p.x, p.norm1_g, (bf16_t*)(p.ws + OFF_ACT));
}

enum { EPI_PROJ = 0, EPI_WO = 1, EPI_UP = 2, EPI_DOWN = 3 };

DEVI float row_rstd(const float* ssq, int m) {
    const float4 a = *(const float4*)(ssq + (size_t)m * 16), b = *(const float4*)(ssq + (size_t)m * 16 + 4), c = *(const float4*)(ssq + (size_t)m * 16 + 8), d = *(const float4*)(ssq + (size_t)m * 16 + 12);
    const float t = ((a.x + a.y) + (a.z + a.w)) + ((b.x + b.y) + (b.z + b.w)) + ((c.x + c.y) + (c.z + c.w)) + ((d.x + d.y) + (d.z + d.w));
    return rsqrtf(t * (1.0f / 1024.0f) + 1e-6f);
}

template <int CH>
DEVI void proj_epilogue(const Params& p, int L, const f32x4 (&acc)[4][8], int m0w, int cc, int lane) {
    const int quad = lane >> 4, l15 = lane & 15;
    bf16_t* proj = (bf16_t*)(p.ws + OFF_BIG); bf16_t* VT = (bf16_t*)(p.ws + OFF_BIG + OFF_VT_IN_BIG);
    float* gates = (float*)(p.ws + OFF_GATES); const float* rope = (const float*)(p.ws + OFF_ROPE);
    if (cc > 48) return;
    int kind = 0, vidx = 0; const float* gain = nullptr; float scale = 1.f; bool dorope = false;
    if (cc >= 8 && cc < 12) { kind = 5; vidx = cc - 8; }
    else if (cc >= 16 && cc < 24) { kind = 1; gain = p.nsa_qn_g + L * 64; scale = 0.125f * 1.4426950408889634f; dorope = true; }
    else if (cc == 28 || cc == 29 || cc == 32 || cc == 33) { kind = 1; gain = p.nsa_kn_g + L * 64; dorope = true; }
    else if (cc == 30 || cc == 31) { kind = 5; vidx = 4 + (cc - 30); }
    else if (cc == 34 || cc == 35) { kind = 5; vidx = 6 + (cc - 34); }
    else if (cc >= 36 && cc < 40) { kind = 1; gain = p.fox_qn_g + L * 64; scale = 0.125f * 1.4426950408889634f; }
    else if (cc >= 40 && cc < 44) { kind = 1; gain = p.fox_kn_g + L * 64; }
    else if (cc >= 44 && cc < 48) { kind = 5; vidx = 8 + (cc - 44); }
    else if (cc == 48) kind = 6;
#pragma unroll
    for (int mi = 0; mi < 4; ++mi) {
        const int token = m0w + mi * 16 + l15, pos = token & 4095, bb = token >> 12;
        const float rs = (L > 0) ? row_rstd((const float*)(p.ws + OFF_SSQ), token) : 1.0f;
        float v[4][4];
#pragma unroll
        for (int ni = 0; ni < 4; ++ni)
#pragma unroll
            for (int j = 0; j < 4; ++j) v[ni][j] = acc[mi][CH * 4 + ni][j] * rs;
        if (kind == 6) {
#pragma unroll
            for (int ni = 0; ni < 2; ++ni)
#pragma unroll
                for (int j = 0; j < 4; ++j) { const int d = ni * 16 + quad * 4 + j;
                    if (d < 24) gates[(size_t)token * 32 + d] = 1.0f / (1.0f + __expf(-v[ni][j]));
                    else if (d < 28) gates[(size_t)token * 32 + d] = v[ni][j]; }
            asm volatile("" ::: "memory");
            continue;
        }
        if (kind == 1) {
            float ss = 0.f;
#pragma unroll
            for (int ni = 0; ni < 4; ++ni)
#pragma unroll
                for (int j = 0; j < 4; ++j) ss += v[ni][j] * v[ni][j];
            ss += __shfl_xor(ss, 16); ss += __shfl_xor(ss, 32);
            const float r = rsqrtf(ss * (1.0f / 64.0f) + 1e-6f);
#pragma unroll
            for (int ni = 0; ni < 4; ++ni) { const float4 gg = *(const float4*)(gain + ni * 16 + quad * 4);
                v[ni][0] *= r * gg.x; v[ni][1] *= r * gg.y; v[ni][2] *= r * gg.z; v[ni][3] *= r * gg.w; }
            if (dorope) {
                const float4 cs = *(const float4*)(rope + pos * 16 + (quad & 1) * 4), sn = *(const float4*)(rope + pos * 16 + 8 + (quad & 1) * 4);
                const float cv[4] = {cs.x, cs.y, cs.z, cs.w}, sv[4] = {sn.x, sn.y, sn.z, sn.w};
#pragma unroll
                for (int j = 0; j < 4; ++j) { const float xx = v[0][j], pp = __shfl_xor(xx, 32);
                    v[0][j] = (quad < 2) ? (xx * cv[j] - pp * sv[j]) : (xx * cv[j] + pp * sv[j]); }
            }
#pragma unroll
            for (int ni = 0; ni < 4; ++ni)
#pragma unroll
                for (int j = 0; j < 4; ++j) v[ni][j] *= scale;
        }
        if (kind == 5) {
#pragma unroll
            for (int ni = 0; ni < 4; ++ni)
#pragma unroll
                for (int j = 0; j < 4; ++j) { const int d = ni * 16 + quad * 4 + j;
                    VT[((size_t)(vidx * 8 + bb) * 64 + d) * 4096 + pos] = f2bf(v[ni][j]); }
        } else {
#pragma unroll
            for (int ni = 0; ni < 4; ++ni) { uint2 o; o.x = pk2(v[ni][0], v[ni][1]); o.y = pk2(v[ni][2], v[ni][3]);
                *(uint2*)(proj + (size_t)token * PJ_LD + cc * 64 + ni * 16 + quad * 4) = o; }
        }
        asm volatile("" ::: "memory");
    }
}

DEVI void g_load(uint4 (&RA)[4], uint4 (&RB)[4], const bf16_t* Ap, const bf16_t* Bp, int K, int KT) {
#pragma unroll
    for (int i = 0; i < 4; ++i) { RA[i] = *(const uint4*)(Ap + (size_t)(32 * i) * K + KT * 64); RB[i] = *(const uint4*)(Bp + (size_t)(32 * i) * K + KT * 64); }
}
DEVI void g_swrite(const uint4 (&RA)[4], const uint4 (&RB)[4], char* d_) {
#pragma unroll
    for (int i = 0; i < 4; ++i) { *(uint4*)(d_ + i * 4096) = RA[i]; *(uint4*)(d_ + 16384 + i * 4096) = RB[i]; }
}
DEVI void g_compute(const char* sA, f32x4 (&acc)[4][4], int wm, int wn, int quad, int l15) {
    const char* sB = sA + 16384;
#pragma unroll
    for (int ks = 0; ks < 2; ++ks) {
        bf16x8 af[4], bfr[4]; const int ch = ks * 4 + quad;
#pragma unroll
        for (int mi = 0; mi < 4; ++mi) { const int row = wm * 64 + mi * 16 + l15; af[mi] = *(const bf16x8*)(sA + row * 128 + ((ch ^ (row & 7)) << 4)); }
#pragma unroll
        for (int ni = 0; ni < 4; ++ni) { const int row = wn * 64 + ni * 16 + l15; bfr[ni] = *(const bf16x8*)(sB + row * 128 + ((ch ^ (row & 7)) << 4)); }
#pragma unroll
        for (int mi = 0; mi < 4; ++mi)
#pragma unroll
            for (int ni = 0; ni < 4; ++ni) acc[mi][ni] = mfma(bfr[ni], af[mi], acc[mi][ni]);
    }
}

template <int EPI>
__device__ __forceinline__ void gemm_phase(const Params& p, int L, char* lds) {
    const bf16_t* A; const bf16_t* Bt; int K, nNt;
    if (EPI == EPI_PROJ) { A = (const bf16_t*)(p.ws + OFF_ACT); Bt = (const bf16_t*)(p.ws + OFF_WIN) + (size_t)L * NW_IN_PAD * 1024; K = 1024; nNt = NW_IN_PAD / 256; }
    else if (EPI == EPI_WO) { A = (const bf16_t*)(p.ws + OFF_ACT); Bt = (const bf16_t*)(p.ws + OFF_WO) + (size_t)L * 1024 * 1024; K = 1024; nNt = 4; }
    else if (EPI == EPI_UP) { A = (const bf16_t*)(p.ws + OFF_ACT2); Bt = (const bf16_t*)(p.ws + OFF_WUP) + (size_t)L * 4096 * 1024; K = 1024; nNt = 16; }
    else { A = (const bf16_t*)(p.ws + OFF_BIG); Bt = (const bf16_t*)(p.ws + OFF_WDN) + (size_t)L * 1024 * 4096; K = 4096; nNt = 4; }
    const int tid = otid(), lane = tid & 63, w = tid >> 6, quad = lane >> 4, l15 = lane & 15, wm = w >> 1, wn = w & 1;
    const int xcd = blockIdx.x & 7, loc = blockIdx.x >> 3, nloc = gridDim.x >> 3;
    const int nk = K / 32;
    const int gsw = (0x1230 >> (((l15 >> 2) & 3) * 4)) & 3;
    const int rsw = (quad ^ gsw) << 4;
    for (int it = loc; it < 32 * nNt; it += nloc) {
        const int tl = otid();
        const int lrow = tl >> 2, lc = tl & 3;
        const int woff = lrow * 64 + ((lc ^ ((0x1230 >> (((lrow >> 2) & 3) * 4)) & 3)) << 4);
        const int gsz = 8 * nNt, mloc = (it / gsz) * 8 + (it & 7), nloc_t = (it % gsz) >> 3;
        const int m0 = (xcd + 8 * mloc) * 128, n0 = nloc_t * 256;
        f32x4 acc[4][8];
#pragma unroll
        for (int a = 0; a < 4; ++a)
#pragma unroll
            for (int b = 0; b < 8; ++b) acc[a][b] = (f32x4){0.f, 0.f, 0.f, 0.f};
        u32x8 ra0, ra1; u32x16 rb0, rb1;
        const bf16_t* Ap = A + (size_t)(m0 + lrow) * K + lc * 8;
        const bf16_t* Bp = Bt + (size_t)(n0 + lrow) * K + lc * 8;
#define G_LD1(R, P, I, KT) { const uint4 t_ = *(const uint4*)((P) + (size_t)(64 * I) * K + (KT) * 32); R[4 * I] = t_.x; R[4 * I + 1] = t_.y; R[4 * I + 2] = t_.z; R[4 * I + 3] = t_.w; }
#define G_LOAD(RA, RB, KT) { G_LD1(RA, Ap, 0, KT) G_LD1(RB, Bp, 0, KT) G_LD1(RA, Ap, 1, KT) G_LD1(RB, Bp, 1, KT) G_LD1(RB, Bp, 2, KT) G_LD1(RB, Bp, 3, KT) }
#define G_SW1(R, D, I) *(uint4*)((D) + I * 4096) = make_uint4(R[4 * I], R[4 * I + 1], R[4 * I + 2], R[4 * I + 3]);
#define G_SWRITE(RA, RB, DST) { G_SW1(RA, DST, 0) G_SW1(RB, (DST) + 8192, 0) G_SW1(RA, DST, 1) G_SW1(RB, (DST) + 8192, 1) G_SW1(RB, (DST) + 8192, 2) G_SW1(RB, (DST) + 8192, 3) }
#define G_COMPUTE(BUF) { const char* sA_ = (BUF) + (wm * 64 + l15) * 64 + rsw; const char* sB_ = (BUF) + 8192 + (wn * 128 + l15) * 64 + rsw; \
            bf16x8 af[4]; \
            _Pragma("unroll") for (int i_ = 0; i_ < 4; ++i_) af[i_] = *(const bf16x8*)(sA_ + i_ * 1024); \
            _Pragma("unroll") for (int nh = 0; nh < 2; ++nh) { bf16x8 bfr[4]; \
                _Pragma("unroll") for (int i_ = 0; i_ < 4; ++i_) bfr[i_] = *(const bf16x8*)(sB_ + (nh * 4 + i_) * 1024); \
                _Pragma("unroll") for (int mi = 0; mi < 4; ++mi) _Pragma("unroll") for (int ni = 0; ni < 4; ++ni) acc[mi][nh * 4 + ni] = mfma(bfr[ni], af[mi], acc[mi][nh * 4 + ni]); } }
        G_LOAD(ra0, rb0, 0)
        G_LOAD(ra1, rb1, 1)
        G_SWRITE(ra0, rb0, lds + woff)
        __syncthreads();
#pragma unroll 1
        for (int kt = 0; kt < nk - 2; kt += 2) {
            G_LOAD(ra0, rb0, kt + 2)
            __builtin_amdgcn_sched_barrier(0);
            G_COMPUTE(lds)
            G_SWRITE(ra1, rb1, lds + 24576 + woff)
            __syncthreads();
            G_LOAD(ra1, rb1, kt + 3)
            __builtin_amdgcn_sched_barrier(0);
            G_COMPUTE(lds + 24576)
            G_SWRITE(ra0, rb0, lds + woff)
            __syncthreads();
        }
        G_COMPUTE(lds)
        G_SWRITE(ra1, rb1, lds + 24576 + woff)
        __syncthreads();
        G_COMPUTE(lds + 24576)
        __syncthreads();
#undef G_LOAD
#undef G_SWRITE
#undef G_LD1
#undef G_SW1
#undef G_COMPUTE
        const int te = otid(); const int lane_e = te & 63, quad_e = lane_e >> 4, l15_e = lane_e & 15;
        const int mw = m0 + ((te >> 7) & 1) * 64, nw = n0 + ((te >> 6) & 1) * 128;
        if (EPI == EPI_PROJ) {
            proj_epilogue<0>(p, L, acc, mw, (nw >> 6), lane_e);
            proj_epilogue<1>(p, L, acc, mw, (nw >> 6) + 1, lane_e);
        } else if (EPI == EPI_UP) {
            bf16_t* hid = (bf16_t*)(p.ws + OFF_BIG);
#pragma unroll
            for (int mi = 0; mi < 4; ++mi) { const int m = mw + mi * 16 + l15_e; const float r = row_rstd((const float*)(p.ws + OFF_SSQ), m);
#pragma unroll
                for (int ni = 0; ni < 8; ++ni) { const int n = nw + ni * 16 + quad_e * 4;
                    float a0 = fmaxf(acc[mi][ni][0] * r, 0.f), a1 = fmaxf(acc[mi][ni][1] * r, 0.f), a2 = fmaxf(acc[mi][ni][2] * r, 0.f), a3 = fmaxf(acc[mi][ni][3] * r, 0.f);
                    uint2 o; o.x = pk2(a0 * a0, a1 * a1); o.y = pk2(a2 * a2, a3 * a3);
                    *(uint2*)(hid + (size_t)m * DFF + n) = o; } }
        } else {
            const float* xin = (EPI == EPI_WO && L == 0) ? p.x : p.out;
            const bool emit = (EPI == EPI_WO) || (L + 1 < 2);
            const float* gn = (EPI == EPI_WO) ? (p.norm2_g + L * 1024) : (p.norm1_g + (L + 1 < 2 ? L + 1 : L) * 1024);
            bf16_t* hn = (bf16_t*)(p.ws + ((EPI == EPI_WO) ? OFF_ACT2 : OFF_ACT));
            float* ssq = (float*)(p.ws + OFF_SSQ);
#pragma unroll
            for (int mi = 0; mi < 4; ++mi) {
#pragma unroll
                for (int hf = 0; hf < 2; ++hf) {
                    const int t3 = otid(); const int l15_e = t3 & 15, quad_e = (t3 >> 4) & 3;
                    const int m = mw + mi * 16 + l15_e;
                    float ss = 0.f;
#pragma unroll
                    for (int n4 = 0; n4 < 4; ++n4) { const int ni = hf * 4 + n4; const int n = nw + ni * 16 + quad_e * 4;
                        float4 xv = *(const float4*)(xin + (size_t)m * DM + n);
                        xv.x += acc[mi][ni][0]; xv.y += acc[mi][ni][1]; xv.z += acc[mi][ni][2]; xv.w += acc[mi][ni][3];
                        *(float4*)(p.out + (size_t)m * DM + n) = xv;
                        if (emit) { const float4 gg = *(const float4*)(gn + n);
                            uint2 o; o.x = pk2(xv.x * gg.x, xv.y * gg.y); o.y = pk2(xv.z * gg.z, xv.w * gg.w);
                            *(uint2*)(hn + (size_t)m * DM + n) = o;
                            ss += (xv.x * xv.x + xv.y * xv.y) + (xv.z * xv.z + xv.w * xv.w); } }
                    if (emit) { ss += __shfl_xor(ss, 16); ss += __shfl_xor(ss, 32);
                        if (quad_e == 0) ssq[(size_t)m * 16 + ((nw >> 6) + hf)] = ss; }
                    asm volatile("" ::: "memory");
                }
            }
        }
    }
}

DEVI float hgrn_lb(const Params& p, int L, int hk) {
    if (L == 0) return 0.f;
    const float l0 = p.lb_logits[hk], l1 = p.lb_logits[256 + hk];
    return 1.0f / (1.0f + __expf(l0 - l1));
}

__device__ void hgrn_a_unit(const Params& p, int L, int u, char* lds) {
    const int tid = otid(), lane = tid & 63, w = tid >> 6, quad = lane >> 4, l15 = lane & 15;
    const int c = u & 63, h = (u >> 6) & 3, b = u >> 8;
    const bf16_t* proj = (const bf16_t*)(p.ws + OFF_BIG); const bf16_t* VT = (const bf16_t*)(p.ws + OFF_BIG + OFF_VT_IN_BIG);
    float* segtot = (float*)lds;
    bf16_t* KDt = (bf16_t*)(lds + 1024);
    const int k = tid & 63, seg = tid >> 6;
    const float lb = hgrn_lb(p, L, h * 64 + k);
    float gl[16], kkv[16]; float run = 0.f;
    const bf16_t* zp = proj + (size_t)(b * 4096 + c * 64 + seg * 16) * PJ_LD + 256 + h * 64 + k;
#pragma unroll
    for (int i = 0; i < 16; ++i) {
        const float z = bf2f(zp[(size_t)i * PJ_LD]);
        const float sg = 1.0f / (1.0f + __expf(-z)), sn = 1.0f / (1.0f + __expf(z));
        const float f = lb + (1.0f - lb) * sg;
        run += __logf(fmaxf(f, 1e-30f)); gl[i] = run; kkv[i] = (1.0f - lb) * sn;
    }
    segtot[seg * 64 + k] = run;
    __syncthreads();
    float off = 0.f, tot = 0.f;
#pragma unroll
    for (int s = 0; s < 4; ++s) { const float t = segtot[s * 64 + k]; tot += t; if (s < seg) off += t; }
    unsigned pkd[8];
#pragma unroll
    for (int i = 0; i < 8; ++i) {
        const float a0 = kkv[2 * i] * __expf(tot - (off + gl[2 * i])), a1 = kkv[2 * i + 1] * __expf(tot - (off + gl[2 * i + 1]));
        pkd[i] = pk2(a0, a1);
    }
    *(uint4*)(KDt + k * 72 + seg * 16) = make_uint4(pkd[0], pkd[1], pkd[2], pkd[3]);
    *(uint4*)(KDt + k * 72 + seg * 16 + 8) = make_uint4(pkd[4], pkd[5], pkd[6], pkd[7]);
    if (seg == 0) ((float*)(p.ws + OFF_DECAY))[u * 64 + k] = __expf(tot);
    __syncthreads();
    const bf16_t* vt = VT + ((size_t)(h * 8 + b) * 64) * 4096 + c * 64;
    float* kvt = (float*)(p.ws + OFF_KVT) + (size_t)u * 4096;
    bf16x8 af[2];
#pragma unroll
    for (int ks = 0; ks < 2; ++ks) af[ks] = ld8(vt + (size_t)(w * 16 + l15) * 4096 + ks * 32 + quad * 8);
#pragma unroll
    for (int kt = 0; kt < 4; ++kt) {
        f32x4 acc = (f32x4){0.f, 0.f, 0.f, 0.f};
#pragma unroll
        for (int ks = 0; ks < 2; ++ks) { const bf16x8 bfr = *(const bf16x8*)(KDt + (kt * 16 + l15) * 72 + ks * 32 + quad * 8); acc = mfma(af[ks], bfr, acc); }
#pragma unroll
        for (int j = 0; j < 4; ++j) kvt[(w * 16 + quad * 4 + j) * 64 + kt * 16 + l15] = acc[j];
    }
    __syncthreads();
}

__device__ void hgrn_scan_phase(const Params& p) {
    const float* kvt = (const float*)(p.ws + OFF_KVT); const float* dec = (const float*)(p.ws + OFF_DECAY);
    bf16_t* st = (bf16_t*)(p.ws + OFF_ST);
    for (int e = blockIdx.x * 256 + otid(); e < 32 * 4096; e += gridDim.x * 256) {
        const int bh = e >> 12, vk = e & 4095, k = vk & 63;
        float S = 0.f;
#pragma unroll 8
        for (int c = 0; c < 64; ++c) {
            const int u = bh * 64 + c;
            st[(size_t)u * 4096 + vk] = f2bf(S);
            S = S * dec[u * 64 + k] + kvt[(size_t)u * 4096 + vk];
        }
    }
}

__device__ void hgrn_c_unit(const Params& p, int L, int u, char* lds) {
    const int tid = otid(), lane = tid & 63, w = tid >> 6, quad = lane >> 4, l15 = lane & 15;
    const int c = u & 63, h = (u >> 6) & 3, b = u >> 8;
    const bf16_t* proj = (const bf16_t*)(p.ws + OFF_BIG); const bf16_t* VT = (const bf16_t*)(p.ws + OFF_BIG + OFF_VT_IN_BIG);
    float* Gs = (float*)lds; float* KKs = Gs + 64 * 65; float* Qs = KKs + 64 * 65; float* segtot = Qs + 64 * 65;
    {
        const int k = tid & 63, seg = tid >> 6;
        const float lb = hgrn_lb(p, L, h * 64 + k);
        float gl[16], kkv[16]; float run = 0.f;
        const bf16_t* zp = proj + (size_t)(b * 4096 + c * 64 + seg * 16) * PJ_LD + 256 + h * 64 + k;
#pragma unroll
        for (int i = 0; i < 16; ++i) {
            const float z = bf2f(zp[(size_t)i * PJ_LD]);
            const float sg = 1.0f / (1.0f + __expf(-z)), sn = 1.0f / (1.0f + __expf(z));
            const float f = lb + (1.0f - lb) * sg;
            run += __logf(fmaxf(f, 1e-30f)); gl[i] = run; kkv[i] = (1.0f - lb) * sn;
            Qs[(seg * 16 + i) * 65 + k] = bf2f(zp[(size_t)i * PJ_LD - 256]) * 0.125f;
        }
        segtot[seg * 64 + k] = run;
        __syncthreads();
        float off = 0.f;
#pragma unroll
        for (int s = 0; s < 4; ++s) { const float t = segtot[s * 64 + k]; if (s < seg) off += t; }
#pragma unroll
        for (int i = 0; i < 16; ++i) { Gs[(seg * 16 + i) * 65 + k] = off + gl[i]; KKs[(seg * 16 + i) * 65 + k] = kkv[i]; }
        __syncthreads();
    }
    const int I = w;
    const int tq = 16 * I + l15;
    bf16x8 qt[2], qg[2];
#pragma unroll
    for (int ks = 0; ks < 2; ++ks) {
        float a[8], g8[8];
#pragma unroll
        for (int j = 0; j < 8; ++j) {
            const int k = ks * 32 + quad * 8 + j;
            const float G = Gs[tq * 65 + k], q = Qs[tq * 65 + k];
            const float gref = (I == 0) ? 0.f : Gs[(16 * I - 1) * 65 + k];
            a[j] = q * __expf(G - gref); g8[j] = q * __expf(G);
        }
        qt[ks] = mk8(pk2(a[0], a[1]), pk2(a[2], a[3]), pk2(a[4], a[5]), pk2(a[6], a[7]));
        qg[ks] = mk8(pk2(g8[0], g8[1]), pk2(g8[2], g8[3]), pk2(g8[4], g8[5]), pk2(g8[6], g8[7]));
    }
    f32x4 O[4];
#pragma unroll
    for (int vt = 0; vt < 4; ++vt) O[vt] = (f32x4){0.f, 0.f, 0.f, 0.f};
    const bf16_t* st = (const bf16_t*)(p.ws + OFF_ST) + (size_t)u * 4096;
#pragma unroll
    for (int vt = 0; vt < 4; ++vt)
#pragma unroll
        for (int ks = 0; ks < 2; ++ks) O[vt] = mfma(ld8(st + (vt * 16 + l15) * 64 + ks * 32 + quad * 8), qg[ks], O[vt]);
    const bf16_t* vtp = VT + ((size_t)(h * 8 + b) * 64) * 4096 + c * 64;
    for (int Jp = 0; Jp <= (I >> 1); ++Jp) {
        f32x4 sc[2];
#pragma unroll
        for (int jj = 0; jj < 2; ++jj) {
            const int J = 2 * Jp + jj;
            sc[jj] = (f32x4){0.f, 0.f, 0.f, 0.f};
            if (J <= I) {
                const int s = 16 * J + l15;
#pragma unroll
                for (int ks = 0; ks < 2; ++ks) {
                    float a[8];
#pragma unroll
                    for (int j = 0; j < 8; ++j) {
                        const int k = ks * 32 + quad * 8 + j;
                        const float gref = (I == 0) ? 0.f : Gs[(16 * I - 1) * 65 + k];
                        a[j] = KKs[s * 65 + k] * __expf(gref - Gs[s * 65 + k]);
                    }
                    sc[jj] = mfma(mk8(pk2(a[0], a[1]), pk2(a[2], a[3]), pk2(a[4], a[5]), pk2(a[6], a[7])), qt[ks], sc[jj]);
                }
#pragma unroll
                for (int j = 0; j < 4; ++j) { const int s2 = 16 * J + quad * 4 + j; if (s2 > tq) sc[jj][j] = 0.f; }
            }
        }
        const bf16x8 P = mk8(pk2(sc[0][0], sc[0][1]), pk2(sc[0][2], sc[0][3]), pk2(sc[1][0], sc[1][1]), pk2(sc[1][2], sc[1][3]));
#pragma unroll
        for (int vt = 0; vt < 4; ++vt) {
            const bf16_t* r = vtp + (size_t)(vt * 16 + l15) * 4096 + 32 * Jp + quad * 4;
            O[vt] = mfma(ld4x2(r, r + 16), P, O[vt]);
        }
    }
    float ss = 0.f;
#pragma unroll
    for (int vt = 0; vt < 4; ++vt)
#pragma unroll
        for (int j = 0; j < 4; ++j) ss += O[vt][j] * O[vt][j];
    ss += __shfl_xor(ss, 16); ss += __shfl_xor(ss, 32);
    const float r = rsqrtf(ss * (1.0f / 64.0f) + 1e-6f);
    const size_t token = (size_t)b * 4096 + c * 64 + tq;
    bf16_t* mix = (bf16_t*)(p.ws + OFF_ACT);
#pragma unroll
    for (int vt = 0; vt < 4; ++vt) {
        const int v0 = vt * 16 + quad * 4;
        const float4 og = *(const float4*)(p.onorm_g + L * 64 + v0);
        const uint2 gz = *(const uint2*)(proj + token * PJ_LD + 768 + h * 64 + v0);
        const float g0 = bflo(gz.x), g1 = bfhi(gz.x), g2 = bflo(gz.y), g3 = bfhi(gz.y);
        const float o0 = O[vt][0] * r * og.x * (g0 / (1.0f + __expf(-g0))), o1 = O[vt][1] * r * og.y * (g1 / (1.0f + __expf(-g1)));
        const float o2 = O[vt][2] * r * og.z * (g2 / (1.0f + __expf(-g2))), o3 = O[vt][3] * r * og.w * (g3 / (1.0f + __expf(-g3)));
        uint2 o; o.x = pk2(o0, o1); o.y = pk2(o2, o3);
        *(uint2*)(mix + token * DM + h * 64 + v0) = o;
    }
    __syncthreads();
}

__device__ void compress_unit(const Params& p, int L, int u, char* lds) {
    const int tid = otid(), lane = tid & 63, w = tid >> 6, quad = lane >> 4, l15 = lane & 15;
    const int which = u & 1, g = (u >> 1) & 1, b = (u >> 2) & 7, rt = u >> 5;
    const bf16_t* proj = (const bf16_t*)(p.ws + OFF_BIG);
    const bf16_t* w1t = (const bf16_t*)(p.ws + OFF_W1T) + (size_t)(L * 2 + which) * 128 * 2048;
    const bf16_t* w2t = (const bf16_t*)(p.ws + OFF_W2T) + (size_t)(L * 2 + which) * 64 * 128;
    const float* cbias = (const float*)(p.ws + OFF_CBIAS) + (L * 2 + which) * 128;
    float* red = (float*)lds;
    bf16_t* Hs = (bf16_t*)(lds + 32768);
    float* outb = (float*)(lds + 40960);
    const int nrow = rt * 16 + l15;
    int tokbase = 16 * nrow; if (tokbase > 4096 - 32) tokbase = 4096 - 32;
    const bf16_t* xa = proj + ((size_t)b * 4096 + tokbase) * PJ_LD + (which ? 1664 : 1536) + g * 64;
    f32x4 acc[8];
#pragma unroll
    for (int i = 0; i < 8; ++i) acc[i] = (f32x4){0.f, 0.f, 0.f, 0.f};
#pragma unroll 2
    for (int kq = 0; kq < 16; ++kq) {
        const int kk = w * 16 + kq, l = kk >> 1, d = (kk & 1) * 32 + quad * 8;
        const bf16x8 a = ld8(xa + (size_t)l * PJ_LD + d);
#pragma unroll
        for (int ni = 0; ni < 8; ++ni) acc[ni] = mfma(a, ld8(w1t + (size_t)(ni * 16 + l15) * 2048 + kk * 32 + quad * 8), acc[ni]);
    }
#pragma unroll
    for (int ni = 0; ni < 8; ++ni)
#pragma unroll
        for (int j = 0; j < 4; ++j) red[(w * 16 + quad * 4 + j) * 128 + ni * 16 + l15] = acc[ni][j];
    __syncthreads();
    {
        const int row = tid >> 4, c0 = (tid & 15) * 8;
        float x[8];
#pragma unroll
        for (int i = 0; i < 8; ++i) x[i] = cbias[c0 + i];
#pragma unroll
        for (int ww = 0; ww < 4; ++ww) { const float4 a0 = *(const float4*)(red + (ww * 16 + row) * 128 + c0), a1 = *(const float4*)(red + (ww * 16 + row) * 128 + c0 + 4);
            x[0] += a0.x; x[1] += a0.y; x[2] += a0.z; x[3] += a0.w; x[4] += a1.x; x[5] += a1.y; x[6] += a1.z; x[7] += a1.w; }
        unsigned pk[4];
#pragma unroll
        for (int i = 0; i < 4; ++i) { float y[2];
#pragma unroll
            for (int t = 0; t < 2; ++t) { const float xv = x[2 * i + t]; const float uu = 0.7978845608028654f * (xv + 0.044715f * xv * xv * xv);
                const float th = 1.0f - 2.0f / (1.0f + __expf(2.0f * uu)); y[t] = 0.5f * xv * (1.0f + th); }
            pk[i] = pk2(y[0], y[1]); }
        *(uint4*)(Hs + row * 136 + c0) = make_uint4(pk[0], pk[1], pk[2], pk[3]);
    }
    __syncthreads();
    {
        f32x4 o = (f32x4){0.f, 0.f, 0.f, 0.f};
#pragma unroll
        for (int ks = 0; ks < 4; ++ks) o = mfma(*(const bf16x8*)(Hs + l15 * 136 + ks * 32 + quad * 8), ld8(w2t + (size_t)(w * 16 + l15) * 128 + ks * 32 + quad * 8), o);
#pragma unroll
        for (int j = 0; j < 4; ++j) outb[(quad * 4 + j) * 64 + w * 16 + l15] = o[j];
    }
    __syncthreads();
    if (which == 0) {
        bf16_t* kc = (bf16_t*)(p.ws + OFF_KC) + (size_t)(b * 2 + g) * 256 * 64;
        const float* rope = (const float*)(p.ws + OFF_ROPE);
        const int row = tid >> 4, c4 = tid & 15, n = rt * 16 + row;
        const float4 xv = *(const float4*)(outb + row * 64 + c4 * 4);
        float ss = (xv.x * xv.x + xv.y * xv.y) + (xv.z * xv.z + xv.w * xv.w);
        ss += __shfl_xor(ss, 1); ss += __shfl_xor(ss, 2); ss += __shfl_xor(ss, 4); ss += __shfl_xor(ss, 8);
        const float r = rsqrtf(ss * (1.0f / 64.0f) + 1e-6f);
        const float4 gg = *(const float4*)(p.nsa_kn_g + L * 64 + c4 * 4);
        float v[4] = {xv.x * r * gg.x, xv.y * r * gg.y, xv.z * r * gg.z, xv.w * r * gg.w};
        int pos = 16 * n + 31; if (pos > 4095) pos = 4095;
        const float4 cs = *(const float4*)(rope + pos * 16 + (c4 & 1) * 4), sn = *(const float4*)(rope + pos * 16 + 8 + (c4 & 1) * 4);
        const float csv[4] = {cs.x, cs.y, cs.z, cs.w}, snv[4] = {sn.x, sn.y, sn.z, sn.w};
#pragma unroll
        for (int i = 0; i < 4; ++i) { const float pp = __shfl_xor(v[i], 2);
            if (c4 < 4) v[i] = (c4 < 2) ? (v[i] * csv[i] - pp * snv[i]) : (v[i] * csv[i] + pp * snv[i]); }
        uint2 ov; ov.x = pk2(v[0], v[1]); ov.y = pk2(v[2], v[3]);
        if (n >= 255) { ov.x = 0u; ov.y = 0u; }
        *(uint2*)(kc + (size_t)n * 64 + c4 * 4) = ov;
    } else {
        bf16_t* vct = (bf16_t*)(p.ws + OFF_VCT) + (size_t)(b * 2 + g) * 64 * 256;
        const int d = tid >> 2, r0 = (tid & 3) * 4, nb = rt * 16 + r0;
        float v0 = outb[(r0 + 0) * 64 + d], v1 = outb[(r0 + 1) * 64 + d], v2 = outb[(r0 + 2) * 64 + d], v3 = outb[(r0 + 3) * 64 + d];
        if (nb + 3 >= 255) v3 = 0.f;
        uint2 ov; ov.x = pk2(v0, v1); ov.y = pk2(v2, v3);
        *(uint2*)(vct + (size_t)d * 256 + nb) = ov;
    }
    __syncthreads();
}

__device__ void foxc_job(const Params& p, int L, int bh, char* lds) {
    const int tid = otid(), lane = tid & 63, w = tid >> 6, b = bh >> 2, h = bh & 3;
    const float* gates = (const float*)(p.ws + OFF_GATES);
    float* cc = (float*)(p.ws + OFF_FOXC) + (size_t)bh * 4096;
    float* wtot = (float*)lds;
    const float fb = p.fox_fb[L * 4 + h];
    float v[16];
#pragma unroll
    for (int i = 0; i < 16; ++i) v[i] = gates[((size_t)b * 4096 + tid * 16 + i) * 32 + 24 + h] + fb;
    float run = 0.f;
#pragma unroll
    for (int i = 0; i < 16; ++i) { const float x = v[i]; run += (x >= 0.f) ? -log1pf(__expf(-x)) : (x - log1pf(__expf(x))); v[i] = run; }
    float incl = run;
#pragma unroll
    for (int o = 1; o < 64; o <<= 1) { const float t = __shfl_up(incl, o); if (lane >= o) incl += t; }
    if (lane == 63) wtot[w] = incl;
    __syncthreads();
    float pre = incl - run;
#pragma unroll
    for (int s = 0; s < 4; ++s) if (s < w) pre += wtot[s];
#pragma unroll
    for (int i = 0; i < 4; ++i) { const float k2 = 1.4426950408889634f;
        *(float4*)(cc + tid * 16 + i * 4) = make_float4((pre + v[4 * i]) * k2, (pre + v[4 * i + 1]) * k2, (pre + v[4 * i + 2]) * k2, (pre + v[4 * i + 3]) * k2); }
    __syncthreads();
}

constexpr int KV_BUF = 16384;
DEVI void tile_glds(const bf16_t* Kg, int ldk, const bf16_t* Vg, int ldv, char* buf, int tid) {
    const int w = tid >> 6, i = tid & 63;
#pragma unroll
    for (int jj = 0; jj < 2; ++jj) {
        const int j = w * 2 + jj, row = 8 * j + (i >> 3), slot = i & 7;
        const bf16_t* kp = Kg + (size_t)row * ldk + ((slot ^ (row & 7)) << 3);
        const bf16_t* vp = Vg + (size_t)row * ldv + ((slot ^ ((row >> 1) & 7)) << 3);
        __builtin_amdgcn_global_load_lds((const unsigned*)kp, (ldsp_t)(unsigned)(size_t)(buf + j * 1024), 16, 0, 0);
        __builtin_amdgcn_global_load_lds((const unsigned*)vp, (ldsp_t)(unsigned)(size_t)(buf + 8192 + j * 1024), 16, 0, 0);
    }
}
DEVI void lds_kf(const char* buf, int kh, int lane, bf16x8 (&kf)[2][2]) {
    const int quad = lane >> 4, l15 = lane & 15;
#pragma unroll
    for (int t2 = 0; t2 < 2; ++t2)
#pragma unroll
        for (int ks = 0; ks < 2; ++ks) { const int row = kh * 32 + t2 * 16 + l15, ch = ks * 4 + quad; kf[t2][ks] = *(const bf16x8*)(buf + row * 128 + ((ch ^ (row & 7)) << 4)); }
}
DEVI void lds_vf(const char* buf, int kh, int lane, bf16x8 (&vf)[4]) {
    const int quad = lane >> 4, l15 = lane & 15;
#pragma unroll
    for (int dt = 0; dt < 4; ++dt) { const int d = dt * 16 + l15, u0 = kh * 8 + quad, u1 = u0 + 4;
        const uint2 a = *(const uint2*)(buf + 8192 + d * 128 + ((u0 ^ (d & 14)) << 3)), b = *(const uint2*)(buf + 8192 + d * 128 + ((u1 ^ (d & 14)) << 3));
        vf[dt] = mk8(a.x, a.y, b.x, b.y); }
}

template <class MaskF>
DEVI void attn_block64(const char* buf, int kbase, const char* ql, int q0o, int q1o, int qstride, const float* cb, f32x4 (&O)[4][4], float (&m)[4], float (&l)[4], int lane, MaskF maskf) {
    const int quad = lane >> 4;
#pragma unroll
    for (int kh = 0; kh < 2; ++kh) {
        bf16x8 kf[2][2], vf[4];
        lds_kf(buf, kh, lane, kf); lds_vf(buf, kh, lane, vf);
        float ck[8] = {0.f, 0.f, 0.f, 0.f, 0.f, 0.f, 0.f, 0.f};
        if (cb) { const float4 c0 = *(const float4*)(cb + kbase + kh * 32 + quad * 4), c1 = *(const float4*)(cb + kbase + kh * 32 + 16 + quad * 4);
            ck[0] = c0.x; ck[1] = c0.y; ck[2] = c0.z; ck[3] = c0.w; ck[4] = c1.x; ck[5] = c1.y; ck[6] = c1.z; ck[7] = c1.w; }
#pragma unroll
        for (int nt = 0; nt < 4; ++nt) {
            f32x4 s0 = (f32x4){0.f, 0.f, 0.f, 0.f}, s1 = s0;
            { const bf16x8 qa = *(const bf16x8*)(ql + nt * qstride + q0o), qb_ = *(const bf16x8*)(ql + nt * qstride + q1o);
              s0 = mfma(kf[0][0], qa, s0); s1 = mfma(kf[1][0], qa, s1); s0 = mfma(kf[0][1], qb_, s0); s1 = mfma(kf[1][1], qb_, s1); }
            float sv[8]; float mx = -1e30f;
#pragma unroll
            for (int e = 0; e < 8; ++e) { sv[e] = (e < 4) ? s0[e & 3] : s1[e & 3]; const int key = kbase + kh * 32 + (e >> 2) * 16 + quad * 4 + (e & 3);
                const bool ok = maskf(nt, ck[e], key, sv[e]); sv[e] = ok ? sv[e] : -__builtin_huge_valf(); mx = fmaxf(mx, sv[e]); }
            mx = fmaxf(mx, __shfl_xor(mx, 16)); mx = fmaxf(mx, __shfl_xor(mx, 32));
            const float mn = fmaxf(m[nt], mx), alpha = __builtin_amdgcn_exp2f(m[nt] - mn);
            float pv[8]; float rs = 0.f;
#pragma unroll
            for (int e = 0; e < 8; ++e) { pv[e] = __builtin_amdgcn_exp2f(sv[e] - mn); rs += pv[e]; }
            rs += __shfl_xor(rs, 16); rs += __shfl_xor(rs, 32);
            l[nt] = l[nt] * alpha + rs; m[nt] = mn;
            const bf16x8 P = mk8(pk2(pv[0], pv[1]), pk2(pv[2], pv[3]), pk2(pv[4], pv[5]), pk2(pv[6], pv[7]));
#pragma unroll
            for (int dt = 0; dt < 4; ++dt) { O[dt][nt] = O[dt][nt] * alpha; O[dt][nt] = mfma(vf[dt], P, O[dt][nt]); }
        }
    }
}

template <class MaskF>
DEVI void attn_stream(u64 tiles, const bf16_t* Kbase, int ldk, const bf16_t* Vbase, int ldv, char* kvbuf, int jb_wave_min, int jb_wave_max,
                      const char* ql, int q0o, int q1o, int qstride, const float* cb, f32x4 (&O)[4][4], float (&m)[4], float (&l)[4], int tid, int lane, MaskF maskf) {
    if (tiles == 0ull) return;
    int jb = __ffsll((long long)tiles) - 1; tiles &= tiles - 1;
    tile_glds(Kbase + (size_t)jb * 64 * ldk, ldk, Vbase + jb * 64, ldv, kvbuf, tid);
    __syncthreads();
    int cur = 0;
#pragma unroll 1
    for (;;) {
        const bool more = tiles != 0ull;
        int jbn = 0;
        if (more) { jbn = __ffsll((long long)tiles) - 1; tiles &= tiles - 1; tile_glds(Kbase + (size_t)jbn * 64 * ldk, ldk, Vbase + jbn * 64, ldv, kvbuf + (cur ^ 1) * KV_BUF, tid); }
        if (jb >= jb_wave_min && jb <= jb_wave_max) attn_block64(kvbuf + cur * KV_BUF, jb * 64, ql, q0o, q1o, qstride, cb, O, m, l, lane, [&](int nt, float ckv, int key, float& s) { return maskf(nt, ckv, key, jb, s); });
        __syncthreads();
        if (!more) break;
        jb = jbn; cur ^= 1;
    }
}

DEVI void attn_store2(bf16_t* mix, size_t token0, int tokstride, int col0, int colstride, const f32x4 (&O)[4][4], const float (&sc)[4], int lane, bool accum) {
    const int quad = lane >> 4, l15 = lane & 15;
#pragma unroll
    for (int nt = 0; nt < 4; ++nt)
#pragma unroll
        for (int dt = 0; dt < 4; ++dt) {
            bf16_t* dst = mix + (token0 + nt * tokstride + l15) * DM + col0 + nt * colstride + dt * 16 + quad * 4;
            float a0 = O[dt][nt][0] * sc[nt], a1 = O[dt][nt][1] * sc[nt], a2 = O[dt][nt][2] * sc[nt], a3 = O[dt][nt][3] * sc[nt];
            if (accum) { const uint2 old = *(const uint2*)dst; a0 += bflo(old.x); a1 += bfhi(old.x); a2 += bflo(old.y); a3 += bfhi(old.y); }
            uint2 o; o.x = pk2(a0, a1); o.y = pk2(a2, a3);
            *(uint2*)dst = o;
        }
}

__device__ void nsa_unit(const Params& p, int L, int b, int g, int blk, char* lds) {
    const int tid = otid(), lane = tid & 63, w = tid >> 6, quad = lane >> 4, l15 = lane & 15;
    const bf16_t* proj = (const bf16_t*)(p.ws + OFF_BIG); const bf16_t* VT = (const bf16_t*)(p.ws + OFF_BIG + OFF_VT_IN_BIG);
    const float* gates = (const float*)(p.ws + OFF_GATES);
    bf16_t* mix = (bf16_t*)(p.ws + OFF_ACT);
    char* kvbuf = lds; float* impL = (float*)(lds + KV_BUF)  ; char* Qs = lds + 32768; u64* selm = (u64*)(lds + 65536);
    const int q0 = blk * 64; const int tq = q0 + w * 16 + l15; const size_t token = (size_t)b * 4096 + tq;
    const size_t token0 = (size_t)b * 4096 + q0 + w * 16;
    const int mixcol = 256 + g * 256;
#pragma unroll
    for (int t = 0; t < 8; ++t) { const int idx = t * 64 + lane, rr = idx >> 3, c = idx & 7, hh = rr >> 4, r16 = rr & 15;
        const uint4 v = *(const uint4*)(proj + (token0 + r16) * PJ_LD + 1024 + (g * 4 + hh) * 64 + c * 8);
        *(uint4*)(Qs + (hh * 64 + w * 16 + r16) * 128 + ((c ^ (r16 & 7)) << 4)) = v; }
    const char* ql = Qs + (w * 16 + l15) * 128; const int q0o = ((quad) ^ (l15 & 7)) << 4, q1o = ((4 + quad) ^ (l15 & 7)) << 4; const int qstride = 8192;
    __syncthreads();
    f32x4 O[4][4]; float m[4], l[4];
    const bf16_t* Kc = (const bf16_t*)(p.ws + OFF_KC) + (size_t)(b * 2 + g) * 256 * 64;
    const bf16_t* VcT = (const bf16_t*)(p.ws + OFF_VCT) + (size_t)(b * 2 + g) * 64 * 256;
    const int ncb = (4 * blk + 3 + 63) >> 6;
#pragma unroll
    for (int nt = 0; nt < 4; ++nt) { m[nt] = -1e30f; l[nt] = 0.f; }
    {
#pragma unroll 1
        for (int pass = 0; pass < 2; ++pass) {
            float inv[4]; float prevr = 0.f;
            if (pass == 1) {
#pragma unroll
                for (int nt = 0; nt < 4; ++nt) inv[nt] = 1.0f / fmaxf(l[nt], 1e-30f);
#pragma unroll
                for (int dt = 0; dt < 4; ++dt)
#pragma unroll
                    for (int nt = 0; nt < 4; ++nt) O[dt][nt] = (f32x4){0.f, 0.f, 0.f, 0.f};
            }
#pragma unroll 1
            for (int ct = 0; ct < ncb; ++ct) {
                tile_glds(Kc + (size_t)ct * 64 * 64, 64, VcT + ct * 64, 256, kvbuf, tid);
                __syncthreads();
                const char* buf = kvbuf;
#pragma unroll
                for (int kh = 0; kh < 2; ++kh) {
                    bf16x8 kf[2][2]; lds_kf(buf, kh, lane, kf);
                    if (pass == 0) {
#pragma unroll
                        for (int nt = 0; nt < 4; ++nt) {
                            f32x4 s0 = (f32x4){0.f, 0.f, 0.f, 0.f}, s1 = s0;
                            { const bf16x8 qa = *(const bf16x8*)(ql + nt * qstride + q0o), qb_ = *(const bf16x8*)(ql + nt * qstride + q1o);
                              s0 = mfma(kf[0][0], qa, s0); s1 = mfma(kf[1][0], qa, s1); s0 = mfma(kf[0][1], qb_, s0); s1 = mfma(kf[1][1], qb_, s1); }
                            float sv[8]; bool ok[8]; float mx = -1e30f;
#pragma unroll
                            for (int e = 0; e < 8; ++e) { sv[e] = (e < 4) ? s0[e & 3] : s1[e & 3]; const int n = ct * 64 + kh * 32 + (e >> 2) * 16 + quad * 4 + (e & 3);
                                ok[e] = (16 * n + 31 <= tq); if (ok[e]) mx = fmaxf(mx, sv[e]); }
                            mx = fmaxf(mx, __shfl_xor(mx, 16)); mx = fmaxf(mx, __shfl_xor(mx, 32));
                            const float mn = fmaxf(m[nt], mx), alpha = __builtin_amdgcn_exp2f(m[nt] - mn);
                            float rs = 0.f;
#pragma unroll
                            for (int e = 0; e < 8; ++e) rs += ok[e] ? __builtin_amdgcn_exp2f(sv[e] - mn) : 0.f;
                            rs += __shfl_xor(rs, 16); rs += __shfl_xor(rs, 32);
                            l[nt] = l[nt] * alpha + rs; m[nt] = mn;
                        }
                    } else {
                        bf16x8 vf[4]; lds_vf(buf, kh, lane, vf);
                        float As[2] = {0.f, 0.f}, p3[2] = {0.f, 0.f};
#pragma unroll
                        for (int nt = 0; nt < 4; ++nt) {
                            f32x4 s0 = (f32x4){0.f, 0.f, 0.f, 0.f}, s1 = s0;
                            { const bf16x8 qa = *(const bf16x8*)(ql + nt * qstride + q0o), qb_ = *(const bf16x8*)(ql + nt * qstride + q1o);
                              s0 = mfma(kf[0][0], qa, s0); s1 = mfma(kf[1][0], qa, s1); s0 = mfma(kf[0][1], qb_, s0); s1 = mfma(kf[1][1], qb_, s1); }
                            float pv[8];
#pragma unroll
                            for (int e = 0; e < 8; ++e) { const float s = (e < 4) ? s0[e & 3] : s1[e & 3]; const int n = ct * 64 + kh * 32 + (e >> 2) * 16 + quad * 4 + (e & 3);
                                pv[e] = (16 * n + 31 <= tq) ? __builtin_amdgcn_exp2f(s - m[nt]) * inv[nt] : 0.f; }
                            As[0] += (pv[0] + pv[1]) + (pv[2] + pv[3]); As[1] += (pv[4] + pv[5]) + (pv[6] + pv[7]); p3[0] += pv[3]; p3[1] += pv[7];
                            const bf16x8 P = mk8(pk2(pv[0], pv[1]), pk2(pv[2], pv[3]), pk2(pv[4], pv[5]), pk2(pv[6], pv[7]));
#pragma unroll
                            for (int dt = 0; dt < 4; ++dt) O[dt][nt] = mfma(vf[dt], P, O[dt][nt]);
                        }
                        const int qq = w * 16 + l15;
#pragma unroll
                        for (int t2 = 0; t2 < 2; ++t2) {
                            const float rr = __shfl(p3[t2], (lane + 48) & 63);
                            const float carry = (quad == 0) ? prevr : rr; prevr = rr;
                            const int jb = ct * 16 + kh * 8 + t2 * 4 + quad;
                            impL[jb * 64 + ((qq ^ jb) & 63)] = As[t2] + carry;
                        }
                    }
                }
                __syncthreads();
            }
        }
    }
    {
        const float4 gv = *(const float4*)(gates + token * 32 + 0 * 8 + g * 4);
        const float sc[4] = {gv.x, gv.y, gv.z, gv.w};
        attn_store2(mix, token0, 0, mixcol, 64, O, sc, lane, false);
    }
#pragma unroll 1
    for (int qi = 0; qi < 16; ++qi) {
        const int q = w * 16 + qi, jb = lane;
        float val = impL[jb * 64 + ((q ^ jb) & 63)];
        if (jb > blk) val = -1e30f;
        else if (jb == 0 || jb == blk || jb == blk - 1) val = 1e30f;
        int rank = 0;
        for (int jp = 0; jp < 64; ++jp) { const float vj = __shfl(val, jp); rank += ((vj > val) || (vj == val && jp < jb)) ? 1 : 0; }
        const bool sel = (rank < 16) && (val > -5e29f);
        const u64 mask = __ballot(sel);
        if (lane == 0) selm[q] = mask;
    }
    __syncthreads();
    u64 uni = 0;
    for (int q = 0; q < 64; ++q) uni |= selm[q];
    const u64 sm = selm[w * 16 + l15];
    {
#pragma unroll
        for (int nt = 0; nt < 4; ++nt) { m[nt] = -1e30f; l[nt] = 0.f; }
#pragma unroll
        for (int dt = 0; dt < 4; ++dt)
#pragma unroll
            for (int nt = 0; nt < 4; ++nt) O[dt][nt] = (f32x4){0.f, 0.f, 0.f, 0.f};
        const u64 tiles = uni & ((blk == 63) ? ~0ull : ((2ull << blk) - 1ull));
        attn_stream(tiles, proj + (size_t)b * 4096 * PJ_LD + 1792 + g * 64, PJ_LD, VT + ((size_t)((4 + g) * 8 + b) * 64) * 4096, 4096, kvbuf, 0, 63, ql, q0o, q1o, qstride, nullptr, O, m, l, tid, lane,
                    [&](int nt, float ckv, int key, int jb, float& s) { return (((sm >> jb) & 1ull) != 0) && (key <= tq); });
        const float4 gv = *(const float4*)(gates + token * 32 + 1 * 8 + g * 4);
        const float sc[4] = {gv.x / fmaxf(l[0], 1e-30f), gv.y / fmaxf(l[1], 1e-30f), gv.z / fmaxf(l[2], 1e-30f), gv.w / fmaxf(l[3], 1e-30f)};
        attn_store2(mix, token0, 0, mixcol, 64, O, sc, lane, true);
    }
    {
#pragma unroll
        for (int nt = 0; nt < 4; ++nt) { m[nt] = -1e30f; l[nt] = 0.f; }
#pragma unroll
        for (int dt = 0; dt < 4; ++dt)
#pragma unroll
            for (int nt = 0; nt < 4; ++nt) O[dt][nt] = (f32x4){0.f, 0.f, 0.f, 0.f};
        const int jlo = blk > 8 ? blk - 8 : 0;
        const u64 upto = (blk == 63) ? ~0ull : ((2ull << blk) - 1ull);
        const u64 tiles = upto & ~((1ull << jlo) - 1ull);
        attn_stream(tiles, proj + (size_t)b * 4096 * PJ_LD + 2048 + g * 64, PJ_LD, VT + ((size_t)((6 + g) * 8 + b) * 64) * 4096, 4096, kvbuf, 0, 63, ql, q0o, q1o, qstride, nullptr, O, m, l, tid, lane,
                    [&](int nt, float ckv, int key, int jb, float& s) { return (key <= tq) && (key + 512 > tq); });
        const float4 gv = *(const float4*)(gates + token * 32 + 2 * 8 + g * 4);
        const float sc[4] = {gv.x / fmaxf(l[0], 1e-30f), gv.y / fmaxf(l[1], 1e-30f), gv.z / fmaxf(l[2], 1e-30f), gv.w / fmaxf(l[3], 1e-30f)};
        attn_store2(mix, token0, 0, mixcol, 64, O, sc, lane, true);
    }
    __syncthreads();
}

__device__ void fox_unit(const Params& p, int L, int b, int h, int qb, char* lds) {
    const int tid = otid(), lane = tid & 63, w = tid >> 6, quad = lane >> 4, l15 = lane & 15;
    const bf16_t* proj = (const bf16_t*)(p.ws + OFF_BIG); const bf16_t* VT = (const bf16_t*)(p.ws + OFF_BIG + OFF_VT_IN_BIG);
    bf16_t* mix = (bf16_t*)(p.ws + OFF_ACT);
    const float* cc = (const float*)(p.ws + OFF_FOXC) + (size_t)(b * 4 + h) * 4096;
    const int q0 = qb * 256 + w * 64; const size_t token0 = (size_t)b * 4096 + q0;
    int tq[4]; float cq[4];
#pragma unroll
    for (int nt = 0; nt < 4; ++nt) { tq[nt] = q0 + nt * 16 + l15; cq[nt] = cc[tq[nt]]; }
    char* Qs = lds + 32768;
#pragma unroll
    for (int t = 0; t < 8; ++t) { const int idx = t * 64 + lane, rr = idx >> 3, c = idx & 7;
        const uint4 v = *(const uint4*)(proj + (token0 + rr) * PJ_LD + 2304 + h * 64 + c * 8);
        *(uint4*)(Qs + (w * 64 + rr) * 128 + ((c ^ (rr & 7)) << 4)) = v; }
    const char* ql = Qs + (w * 64 + l15) * 128; const int q0o = ((quad) ^ (l15 & 7)) << 4, q1o = ((4 + quad) ^ (l15 & 7)) << 4; const int qstride = 2048;
    __syncthreads();
    f32x4 O[4][4]; float m[4], l[4];
#pragma unroll
    for (int nt = 0; nt < 4; ++nt) { m[nt] = -1e30f; l[nt] = 0.f; }
#pragma unroll
    for (int dt = 0; dt < 4; ++dt)
#pragma unroll
        for (int nt = 0; nt < 4; ++nt) O[dt][nt] = (f32x4){0.f, 0.f, 0.f, 0.f};
    const int jmax = qb * 4 + 3;
    int jlo_w, jlo_b;
    { const float cq0 = cc[q0]; int lo = 0, hi = qb * 4 + w;
      while (lo < hi) { const int mid = (lo + hi) >> 1; if (cq0 - cc[mid * 64 + 63] >= -202.f) hi = mid; else lo = mid + 1; }
      jlo_w = lo; }
    { const float cq0 = cc[qb * 256]; int lo = 0, hi = qb * 4;
      while (lo < hi) { const int mid = (lo + hi) >> 1; if (cq0 - cc[mid * 64 + 63] >= -202.f) hi = mid; else lo = mid + 1; }
      jlo_b = lo; }
    const u64 tiles = ((jmax == 63) ? ~0ull : ((2ull << jmax) - 1ull)) & ~((1ull << jlo_b) - 1ull);
    attn_stream(tiles, proj + (size_t)b * 4096 * PJ_LD + 2560 + h * 64, PJ_LD, VT + ((size_t)((8 + h) * 8 + b) * 64) * 4096, 4096, lds, jlo_w, qb * 4 + w, ql, q0o, q1o, qstride, cc, O, m, l, tid, lane,
                [&](int nt, float ckv, int key, int jb, float& s) { s += cq[nt] - ckv; return key <= tq[nt]; });
    float sc[4];
#pragma unroll
    for (int nt = 0; nt < 4; ++nt) sc[nt] = 1.0f / fmaxf(l[nt], 1e-30f);
    attn_store2(mix, token0, 16, 768 + h * 64, 0, O, sc, lane, false);
}

__device__ void mixA_phase(const Params& p, int L, char* lds);
DEVI int next_unit(const Params& p, int idx, char* lds) {
    int* slot = (int*)(lds + LDS_BYTES - 16);
    const unsigned g = blockIdx.x & 7u;
    unsigned* ctr = (unsigned*)(p.ws + OFF_XBAR) + 10240 + (idx * 8 + (int)g) * 64;
    __syncthreads();
    if (otid() == 0) *slot = (int)(g + 8u * atomicAdd(ctr, 1u));
    __syncthreads();
    return *slot;
}
__device__ void mixA_phase(const Params& p, int L, char* lds) {
#pragma unroll 1
    for (;;) {
        const int job = next_unit(p, L * 4 + 3, lds); if (job >= 544 + 512) break;
        if (job < 512) compress_unit(p, L, job, lds);
        else if (job < 544) foxc_job(p, L, job - 512, lds);
        else {
#pragma unroll 1
            for (int u = (job - 544) * 4; u < (job - 544) * 4 + 4; ++u) hgrn_a_unit(p, L, u, lds);
        }
    }
}
__device__ void mixB_phase(const Params& p, int L, char* lds) {
#pragma unroll 1
    for (;;) { const int f = next_unit(p, L * 4 + 0, lds); if (f >= 512) break; const int qb = 15 - (f >> 5), bh = f & 31; fox_unit(p, L, bh >> 2, bh & 3, qb, lds); }
#pragma unroll 1
    for (;;) { const int n = next_unit(p, L * 4 + 1, lds); if (n >= 1024) break; const int blk = 63 - (n >> 4), bg = n & 15; nsa_unit(p, L, bg >> 1, bg & 1, blk, lds); }
#pragma unroll 1
    for (;;) { const int c = next_unit(p, L * 4 + 2, lds); if (c >= 1024) break;
#pragma unroll 1
        for (int u = c * 2; u < c * 2 + 2; ++u) hgrn_c_unit(p, L, u, lds); }
}


#define XB_TMO      128
#define XB_XCNT(j)  (256  + 64 * (j))
#define XB_XSUB(j)  (1280 + 64 * (j))
#define XB_XGEN(j)  (2304 + 64 * (j))
#define XB_TOP      3328
#define XB_TOPGEN   3392
#define XCD_BAR_WORDS 3456
#define XB_SPIN_CAP (1u << 18)
#define LAS __attribute__((address_space(3)))
DEVI unsigned xb_ld(unsigned* p)              { return __hip_atomic_load(p, __ATOMIC_RELAXED, __HIP_MEMORY_SCOPE_AGENT); }
DEVI unsigned xb_add(unsigned* p, unsigned v) { return __hip_atomic_fetch_add(p, v, __ATOMIC_RELAXED, __HIP_MEMORY_SCOPE_AGENT); }
DEVI unsigned xb_xcc_id() { return (unsigned)__builtin_amdgcn_s_getreg((3 << 11) | 20) & 0xFu; }
#define XB_SPIN(cond, bar) do { unsigned _sp = 0; while (cond) { __builtin_amdgcn_s_sleep(1); \
    if ((++_sp & 255u) == 0u) { if (xb_ld(&(bar)[XB_TMO])) break; if (_sp > XB_SPIN_CAP) { atomicAdd(&(bar)[XB_TMO], 1u); break; } } } } while (0)
struct XcdBarrier { unsigned* bar; unsigned x; volatile LAS unsigned* st; };
DEVI XcdBarrier xcd_barrier_post(unsigned* bar, volatile LAS unsigned* st) {
    XcdBarrier b; b.bar = bar; b.x = xb_xcc_id(); b.st = st;
    if (threadIdx.x == 0) (void)xb_add(&bar[XB_XCNT(b.x)], 1u);
    return b;
}
DEVI void xcd_barrier_complete(unsigned* bar, unsigned x, unsigned& nloc, unsigned& nx) {
    const unsigned G = gridDim.x * gridDim.y * gridDim.z;
    unsigned sum, cnt, mine, sp = 0u;
    for (;;) {
        sum = 0u; cnt = 0u; mine = 0u;
#pragma unroll
        for (unsigned j = 0; j < 16; ++j) { const unsigned c = xb_ld(&bar[XB_XCNT(j)]); sum += c; cnt += (c > 0u) ? 1u : 0u; mine = (j == x) ? c : mine; }
        if (sum == G) break;
        __builtin_amdgcn_s_sleep(1);
        if ((++sp & 255u) == 0u) { if (xb_ld(&bar[XB_TMO])) break; if (sp > XB_SPIN_CAP) { atomicAdd(&bar[XB_TMO], 1u); break; } }
    }
    nloc = mine > 0u ? mine : 1u; nx = cnt > 0u ? cnt : 1u;
}
DEVI void xcd_barrier(const XcdBarrier& b) {
    __builtin_amdgcn_fence(__ATOMIC_RELEASE, "agent");
    asm volatile("s_waitcnt vmcnt(0)" ::: "memory");
    __syncthreads();
    if (threadIdx.x == 0) {
        unsigned* bar = b.bar;
        __builtin_amdgcn_s_waitcnt(0);
        unsigned nloc = b.st[0], nx = b.st[1];
        if (nloc == 0u) { xcd_barrier_complete(bar, b.x, nloc, nx); b.st[0] = nloc; b.st[1] = nx; }
        const unsigned old = xb_add(&bar[XB_XSUB(b.x)], 1u);
        const unsigned gen = old / nloc;
        if (old + 1u == (gen + 1u) * nloc) {
            __builtin_amdgcn_fence(__ATOMIC_RELEASE, "agent");
            asm volatile("s_waitcnt vmcnt(0)" ::: "memory");
            const unsigned og = xb_add(&bar[XB_TOP], 1u);
            const unsigned tg = og / nx;
            if (og + 1u == (tg + 1u) * nx) xb_add(&bar[XB_TOPGEN], 1u);
            else XB_SPIN(xb_ld(&bar[XB_TOPGEN]) == tg, bar);
            __builtin_amdgcn_fence(__ATOMIC_ACQUIRE, "agent");
            xb_add(&bar[XB_XGEN(b.x)], 1u);
            asm volatile("s_waitcnt vmcnt(0)" ::: "memory");
        } else {
            XB_SPIN(xb_ld(&bar[XB_XGEN(b.x)]) == gen, bar);
            __builtin_amdgcn_fence(__ATOMIC_ACQUIRE, "agent");
            asm volatile("s_waitcnt vmcnt(0)" ::: "memory");
        }
    }
    __syncthreads();
    __builtin_amdgcn_fence(__ATOMIC_ACQUIRE, "agent");
    asm volatile("s_waitcnt vmcnt(0)" ::: "memory");
}

__device__ void run_phase(const Params& p, int ph, char* lds) {
    if (ph == 0) { prep_phase(p, lds); return; }
    const int L = (ph - 1) / 7, s = (ph - 1) % 7;
    switch (s) {
        case 0: gemm_phase<EPI_PROJ>(p, L, lds); break;
        case 1: mixA_phase(p, L, lds); break;
        case 2: hgrn_scan_phase(p); break;
        case 3: mixB_phase(p, L, lds); break;
        case 4: gemm_phase<EPI_WO>(p, L, lds); break;
        case 5: gemm_phase<EPI_UP>(p, L, lds); break;
        default: gemm_phase<EPI_DOWN>(p, L, lds); break;
    }
}

__global__ void __launch_bounds__(256, 2) fwd_kernel(Params p, int ph_lo, int ph_hi) {
    __shared__ __attribute__((aligned(16))) char lds[LDS_BYTES];
    __shared__ uint4 xb_words;
    if (threadIdx.x == 0) xb_words = make_uint4(0u, 0u, 0u, 0u);
    __syncthreads();
    unsigned* bar = (unsigned*)(p.ws + OFF_XBAR);
    for (int ph = ph_lo; ph < ph_hi; ++ph) {
        run_phase(p, ph, lds);
        if (ph + 1 < ph_hi) {
            if (ph == ph_lo) cg::this_grid().sync();
            else {
                asm volatile("s_waitcnt vmcnt(0)" ::: "memory");
                __syncthreads();
                if (threadIdx.x == 0) {
                    unsigned* base = bar + ph * 640;
                    const unsigned g = blockIdx.x & 7u, G = gridDim.x;
                    const unsigned nper = (G >> 3) + ((g < (G & 7u)) ? 1u : 0u);
                    const unsigned ngrp = G < 8u ? G : 8u;
                    __builtin_amdgcn_fence(__ATOMIC_RELEASE, "agent");
                    asm volatile("s_waitcnt vmcnt(0)" ::: "memory");
                    if (__hip_atomic_fetch_add(base + g * 64, 1u, __ATOMIC_RELAXED, __HIP_MEMORY_SCOPE_AGENT) == nper - 1u) {
                        if (__hip_atomic_fetch_add(base + 8 * 64, 1u, __ATOMIC_RELAXED, __HIP_MEMORY_SCOPE_AGENT) == ngrp - 1u)
                            __hip_atomic_store(base + 9 * 64, 1u, __ATOMIC_RELAXED, __HIP_MEMORY_SCOPE_AGENT);
                    }
                    while (__hip_atomic_load(base + 9 * 64, __ATOMIC_RELAXED, __HIP_MEMORY_SCOPE_AGENT) == 0u) __builtin_amdgcn_s_sleep(1);
                    __builtin_amdgcn_fence(__ATOMIC_ACQUIRE, "agent");
                    asm volatile("s_waitcnt vmcnt(0)" ::: "memory");
                }
                __syncthreads();
            }
        }
    }
}

extern "C" void kernel_launch(void* const* d_in, const int* in_sizes, int n_in, void* d_out, int out_size, void* d_ws, size_t ws_size,
                              hipStream_t stream) {
    if (ws_size < WS_NEED) { fprintf(stderr, "workspace too small: %zu < %zu\n", ws_size, (size_t)WS_NEED); return; }
    Params p{};
    p.x = (const float*)d_in[0]; p.norm1_g = (const float*)d_in[1]; p.w_in = (const float*)d_in[2]; p.lb_logits = (const float*)d_in[3];
    p.onorm_g = (const float*)d_in[4]; p.nsa_qn_g = (const float*)d_in[5]; p.nsa_kn_g = (const float*)d_in[6]; p.cmp_pos = (const float*)d_in[7];
    p.cmp_w1 = (const float*)d_in[8]; p.cmp_w2 = (const float*)d_in[9]; p.fox_qn_g = (const float*)d_in[10]; p.fox_kn_g = (const float*)d_in[11];
    p.fox_fb = (const float*)d_in[12]; p.w_o = (const float*)d_in[13]; p.norm2_g = (const float*)d_in[14]; p.w_up = (const float*)d_in[15];
    p.w_down = (const float*)d_in[16];
    p.out = (float*)d_out; p.ws = (char*)d_ws;
#if MULTI_LAUNCH
    for (int ph = 0; ph < NPHASE; ++ph) hipLaunchKernelGGL(fwd_kernel, dim3(512), dim3(256), 0, stream, p, ph, ph + 1);
#else
    static int grid_blocks = 0;
    if (!grid_blocks) {
        int dev = 0, cus = 0, per_cu = 0;
        hipGetDevice(&dev);
        hipDeviceGetAttribute(&cus, hipDeviceAttributeMultiprocessorCount, dev);
        hipOccupancyMaxActiveBlocksPerMultiprocessor(&per_cu, fwd_kernel, 256, 0);
        per_cu = 2;
        grid_blocks = cus * per_cu;
        grid_blocks &= ~7;
    }
    int lo = 0, hi = NPHASE;
    void* args[] = {&p, &lo, &hi};
    hipError_t e = hipLaunchCooperativeKernel((void*)fwd_kernel, dim3(grid_blocks), dim3(256), args, 0, stream);
    if (e != hipSuccess) fprintf(stderr, "cooperative launch failed: %s (grid %d)\n", hipGetErrorString(e), grid_blocks);
#endif
}
```

```cpp
#include <hip/hip_runtime.h>
#include <hip/hip_cooperative_groups.h>
#include <stdint.h>
#include <cstdio>
namespace cg = cooperative_groups;

#ifndef MULTI_LAUNCH
#define MULTI_LAUNCH 0
#endif

typedef unsigned short bf16_t;
typedef short bf16x8 __attribute__((ext_vector_type(8)));
typedef float f32x4 __attribute__((ext_vector_type(4)));
typedef unsigned long long u64;
typedef __attribute__((address_space(3))) unsigned* ldsp_t;
typedef unsigned u32x16 __attribute__((ext_vector_type(16)));
typedef unsigned u32x8 __attribute__((ext_vector_type(8)));
#define DEVI __device__ __forceinline__

constexpr int T_TOK = 32768, SEQ = 4096, DM = 1024, DFF = 4096;
constexpr int PJ_LD = 3072;
constexpr int NW_IN = 3100, NW_IN_PAD = 3328;
constexpr int NPHASE = 15;

constexpr size_t OFF_WIN = 0;
constexpr size_t OFF_WO = OFF_WIN + (size_t)2 * NW_IN_PAD * 1024 * 2;
constexpr size_t OFF_WUP = OFF_WO + (size_t)2 * 1024 * 1024 * 2;
constexpr size_t OFF_WDN = OFF_WUP + (size_t)2 * 4096 * 1024 * 2;
constexpr size_t OFF_W1T = OFF_WDN + (size_t)2 * 4096 * 1024 * 2;
constexpr size_t OFF_W2T = OFF_W1T + (size_t)2 * 2 * 128 * 2048 * 2;
constexpr size_t OFF_CBIAS = OFF_W2T + (size_t)2 * 2 * 64 * 128 * 2;
constexpr size_t OFF_CTR = OFF_CBIAS + 2048;
constexpr size_t OFF_ROPE = OFF_CTR + 256;
constexpr size_t OFF_GATES = OFF_ROPE + (size_t)4096 * 16 * 4;
constexpr size_t OFF_FOXC = OFF_GATES + (size_t)T_TOK * 32 * 4;
constexpr size_t OFF_KC = OFF_FOXC + (size_t)8 * 4 * 4096 * 4;
constexpr size_t OFF_VCT = OFF_KC + (size_t)8 * 2 * 256 * 64 * 2;
constexpr size_t OFF_DECAY = OFF_VCT + (size_t)8 * 2 * 256 * 64 * 2;
constexpr size_t OFF_KVT = OFF_DECAY + (size_t)2048 * 64 * 4;
constexpr size_t OFF_ST = OFF_KVT + (size_t)2048 * 4096 * 4;
constexpr size_t OFF_ACT = OFF_ST + (size_t)2048 * 4096 * 2;
constexpr size_t OFF_BIG = OFF_ACT + (size_t)T_TOK * 1024 * 2;
constexpr size_t OFF_VT_IN_BIG = (size_t)T_TOK * PJ_LD * 2;
constexpr size_t OFF_ACT2 = OFF_BIG + (size_t)T_TOK * 4096 * 2;
constexpr size_t OFF_SSQ = OFF_ACT2 + (size_t)T_TOK * 1024 * 2;
constexpr size_t OFF_XBAR = OFF_SSQ + (size_t)T_TOK * 16 * 4;
constexpr size_t WS_NEED = OFF_XBAR + 65536;

constexpr int LDS_BYTES = 67584;

struct Params {
    const float *x, *norm1_g, *w_in, *lb_logits, *onorm_g, *nsa_qn_g, *nsa_kn_g, *cmp_pos, *cmp_w1, *cmp_w2,
        *fox_qn_g, *fox_kn_g, *fox_fb, *w_o, *norm2_g, *w_up, *w_down;
    float* out;
    char* ws;
};

DEVI unsigned pk2(float lo, float hi) { unsigned r; asm("v_cvt_pk_bf16_f32 %0, %1, %2" : "=v"(r) : "v"(lo), "v"(hi)); return r; }
DEVI bf16_t f2bf(float f) { return (bf16_t)(pk2(f, 0.f) & 0xffffu); }
DEVI float bf2f(bf16_t h) { return __uint_as_float(((unsigned)h) << 16); }
DEVI float bflo(unsigned u) { return __uint_as_float(u << 16); }
DEVI float bfhi(unsigned u) { return __uint_as_float(u & 0xffff0000u); }
DEVI f32x4 mfma(bf16x8 a, bf16x8 b, f32x4 c) { return __builtin_amdgcn_mfma_f32_16x16x32_bf16(a, b, c, 0, 0, 0); }
DEVI int otid() { int t; asm volatile("v_mov_b32 %0, %1" : "=v"(t) : "v"(threadIdx.x)); return t; }
DEVI float wave_sum(float v) {
#pragma unroll
    for (int o = 32; o >= 1; o >>= 1) v += __shfl_xor(v, o);
    return v;
}
DEVI bf16x8 mk8(unsigned a, unsigned b, unsigned c, unsigned d) {
    uint4 u = make_uint4(a, b, c, d);
    return *(bf16x8*)&u;
}
DEVI bf16x8 ld8(const bf16_t* p) { uint4 u = *(const uint4*)p; return *(bf16x8*)&u; }
DEVI bf16x8 ld4x2(const bf16_t* p0, const bf16_t* p1) {
    uint2 a = *(const uint2*)p0, b = *(const uint2*)p1;
    return mk8(a.x, a.y, b.x, b.y);
}

DEVI int win_colmap(int n) {
    if (n < 2304) return n;
    if (n < 3072) return n + 24;
    if (n < 3096) return n - 768;
    return n;
}
__device__ void transpose_tile(const float* __restrict__ src, int ld_src, bf16_t* __restrict__ dst, int ld_dst, int k0, int n0, int nvalid,
                               int colmode, float* tile) {
    const int tid = otid();
    {
        const int i = tid >> 2, jb = (tid & 3) * 16;
        const float* rowp = src + (size_t)(k0 + i) * ld_src;
        float4 v[4];
#pragma unroll
        for (int c = 0; c < 4; ++c) { const int n = n0 + jb + c * 4;
            v[c] = (n < nvalid) ? *(const float4*)(rowp + (colmode ? win_colmap(n) : n)) : make_float4(0.f, 0.f, 0.f, 0.f); }
#pragma unroll
        for (int c = 0; c < 4; ++c) { const int j = jb + c * 4;
            tile[(j + 0) * 65 + i] = v[c].x; tile[(j + 1) * 65 + i] = v[c].y; tile[(j + 2) * 65 + i] = v[c].z; tile[(j + 3) * 65 + i] = v[c].w; }
    }
    __syncthreads();
    {
        const int j = tid >> 2, ib = (tid & 3) * 16;
        const float* tp = tile + j * 65 + ib;
        unsigned pk[8];
#pragma unroll
        for (int e = 0; e < 8; ++e) pk[e] = pk2(tp[2 * e], tp[2 * e + 1]);
        bf16_t* dp = dst + (size_t)(n0 + j) * ld_dst + k0 + ib;
        *(uint4*)dp = make_uint4(pk[0], pk[1], pk[2], pk[3]);
        *(uint4*)(dp + 8) = make_uint4(pk[4], pk[5], pk[6], pk[7]);
    }
    __syncthreads();
}

__device__ void norm_phase(const float* __restrict__ xin, const float* __restrict__ g, bf16_t* __restrict__ hout) {
    const int tid = otid(); const int lane = tid & 63, w = tid >> 6;
    for (int row = blockIdx.x * 4 + w; row < T_TOK; row += gridDim.x * 4) {
        const float4* xr = (const float4*)(xin + (size_t)row * DM);
        float4 v[4]; float ss = 0.f;
#pragma unroll
        for (int i = 0; i < 4; ++i) { v[i] = xr[lane + 64 * i]; ss += v[i].x * v[i].x + v[i].y * v[i].y + v[i].z * v[i].z + v[i].w * v[i].w; }
        ss = wave_sum(ss);
        const float r = rsqrtf(ss * (1.0f / 1024.0f) + 1e-6f);
#pragma unroll
        for (int i = 0; i < 4; ++i) {
            const float4 gg = ((const float4*)g)[lane + 64 * i];
            uint2 o; o.x = pk2(v[i].x * r * gg.x, v[i].y * r * gg.y); o.y = pk2(v[i].z * r * gg.z, v[i].w * r * gg.w);
            *(uint2*)(hout + (size_t)row * DM + (lane + 64 * i) * 4) = o;
        }
    }
}

__device__ void prep_phase(const Params& p, char* lds) {
    float* tile = (float*)lds;
    if (blockIdx.x == 0 && otid() < 64) ((unsigned*)(p.ws + OFF_CTR))[otid()] = 0u;
    if (blockIdx.x == 1) { for (int i = otid(); i < 16384; i += 256) ((unsigned*)(p.ws + OFF_XBAR))[i] = 0u; }
    bf16_t* win_t = (bf16_t*)(p.ws + OFF_WIN); bf16_t* wo_t = (bf16_t*)(p.ws + OFF_WO);
    bf16_t* wup_t = (bf16_t*)(p.ws + OFF_WUP); bf16_t* wdn_t = (bf16_t*)(p.ws + OFF_WDN);
    bf16_t* w1t = (bf16_t*)(p.ws + OFF_W1T); bf16_t* w2t = (bf16_t*)(p.ws + OFF_W2T);
    const int J0 = 1664, J1 = J0 + 512, J2 = J1 + 2048, J3 = J2 + 2048, J4 = J3 + 256, J5 = J4 + 8, J6 = J5 + 128, J7 = J6 + 128;
    for (int job = blockIdx.x; job < J7; job += gridDim.x) {
        if (job < J0) { const int L = job / 832, r = job % 832, kt = r / 52, nt = r % 52;
            transpose_tile(p.w_in + (size_t)L * 1024 * NW_IN, NW_IN, win_t + (size_t)L * NW_IN_PAD * 1024, 1024, kt * 64, nt * 64, NW_IN, 1, tile);
        } else if (job < J1) { const int j = job - J0, L = j / 256, r = j % 256, kt = r / 16, nt = r % 16;
            transpose_tile(p.w_o + (size_t)L * 1024 * 1024, 1024, wo_t + (size_t)L * 1024 * 1024, 1024, kt * 64, nt * 64, 1024, 0, tile);
        } else if (job < J2) { const int j = job - J1, L = j / 1024, r = j % 1024, kt = r / 64, nt = r % 64;
            transpose_tile(p.w_up + (size_t)L * 1024 * 4096, 4096, wup_t + (size_t)L * 4096 * 1024, 1024, kt * 64, nt * 64, 4096, 0, tile);
        } else if (job < J3) { const int j = job - J2, L = j / 1024, r = j % 1024, kt = r / 16, nt = r % 16;
            transpose_tile(p.w_down + (size_t)L * 4096 * 1024, 1024, wdn_t + (size_t)L * 1024 * 4096, 4096, kt * 64, nt * 64, 1024, 0, tile);
        } else if (job < J4) { const int j = job - J3, lw = j / 64, r = j % 64, kt = r / 2, nt = r % 2;
            transpose_tile(p.cmp_w1 + (size_t)lw * 2048 * 128, 128, w1t + (size_t)lw * 128 * 2048, 2048, kt * 64, nt * 64, 128, 0, tile);
        } else if (job < J5) { const int j = job - J4, lw = j / 2, kt = j % 2;
            transpose_tile(p.cmp_w2 + (size_t)lw * 128 * 64, 64, w2t + (size_t)lw * 64 * 128, 128, kt * 64, 0, 64, 0, tile);
        } else if (job < J6) {
            const int t_ = otid(); const int o = (job - J5) * 4 + (t_ >> 6), lane = t_ & 63, lw = o >> 7, hid = o & 127;
            const float* pos = p.cmp_pos + (size_t)lw * 2048; const float* w1 = p.cmp_w1 + (size_t)lw * 2048 * 128 + hid;
            float s = 0.f;
            for (int k = lane; k < 2048; k += 64) s += pos[k] * w1[(size_t)k * 128];
            s = wave_sum(s);
            if (lane == 0) ((float*)(p.ws + OFF_CBIAS))[o] = s;
        } else {
            const int e = (job - J6) * 256 + otid(), pos = e >> 3, i = e & 7;
            const float invf[8] = {1.0f, 0.1939227432012558f, 0.03760603070259094f, 0.007292664609849453f, 0.0014142135623842478f,
                                   0.00027424818836152554f, 5.318296098266728e-05f, 1.0313386155758053e-05f};
            float fr = 1.0f;
#pragma unroll
            for (int q = 0; q < 8; ++q) if (i == q) fr = invf[q];
            const float ang = (float)pos * fr;
            const double a = (double)ang; const double n = rint(a * 0.15915494309189535); const float rr = (float)(a - n * 6.283185307179586);
            float* rt = (float*)(p.ws + OFF_ROPE);
            rt[pos * 16 + i] = __cosf(rr); rt[pos * 16 + 8 + i] = __sinf(rr);
        }
    }
    norm_phase(p.x, p.norm1_g, (bf16_t*)(p.ws + OFF_ACT));
}

enum { EPI_PROJ = 0, EPI_WO = 1, EPI_UP = 2, EPI_DOWN = 3 };

DEVI float row_rstd(const float* ssq, int m) {
    const float4 a = *(const float4*)(ssq + (size_t)m * 16), b = *(const float4*)(ssq + (size_t)m * 16 + 4), c = *(const float4*)(ssq + (size_t)m * 16 + 8), d = *(const float4*)(ssq + (size_t)m * 16 + 12);
    const float t = ((a.x + a.y) + (a.z + a.w)) + ((b.x + b.y) + (b.z + b.w)) + ((c.x + c.y) + (c.z + c.w)) + ((d.x + d.y) + (d.z + d.w));
    return rsqrtf(t * (1.0f / 1024.0f) + 1e-6f);
}

template <int CH>
DEVI void proj_epilogue(const Params& p, int L, const f32x4 (&acc)[4][8], int m0w, int cc, int lane) {
    const int quad = lane >> 4, l15 = lane & 15;
    bf16_t* proj = (bf16_t*)(p.ws + OFF_BIG); bf16_t* VT = (bf16_t*)(p.ws + OFF_BIG + OFF_VT_IN_BIG);
    float* gates = (float*)(p.ws + OFF_GATES); const float* rope = (const float*)(p.ws + OFF_ROPE);
    if (cc > 48) return;
    int kind = 0, vidx = 0; const float* gain = nullptr; float scale = 1.f; bool dorope = false;
    if (cc >= 8 && cc < 12) { kind = 5; vidx = cc - 8; }
    else if (cc >= 16 && cc < 24) { kind = 1; gain = p.nsa_qn_g + L * 64; scale = 0.125f * 1.4426950408889634f; dorope = true; }
    else if (cc == 28 || cc == 29 || cc == 32 || cc == 33) { kind = 1; gain = p.nsa_kn_g + L * 64; dorope = true; }
    else if (cc == 30 || cc == 31) { kind = 5; vidx = 4 + (cc - 30); }
    else if (cc == 34 || cc == 35) { kind = 5; vidx = 6 + (cc - 34); }
    else if (cc >= 36 && cc < 40) { kind = 1; gain = p.fox_qn_g + L * 64; scale = 0.125f * 1.4426950408889634f; }
    else if (cc >= 40 && cc < 44) { kind = 1; gain = p.fox_kn_g + L * 64; }
    else if (cc >= 44 && cc < 48) { kind = 5; vidx = 8 + (cc - 44); }
    else if (cc == 48) kind = 6;
#pragma unroll
    for (int mi = 0; mi < 4; ++mi) {
        const int token = m0w + mi * 16 + l15, pos = token & 4095, bb = token >> 12;
        const float rs = (L > 0) ? row_rstd((const float*)(p.ws + OFF_SSQ), token) : 1.0f;
        float v[4][4];
#pragma unroll
        for (int ni = 0; ni < 4; ++ni)
#pragma unroll
            for (int j = 0; j < 4; ++j) v[ni][j] = acc[mi][CH * 4 + ni][j] * rs;
        if (kind == 6) {
#pragma unroll
            for (int ni = 0; ni < 2; ++ni)
#pragma unroll
                for (int j = 0; j < 4; ++j) { const int d = ni * 16 + quad * 4 + j;
                    if (d < 24) gates[(size_t)token * 32 + d] = 1.0f / (1.0f + __expf(-v[ni][j]));
                    else if (d < 28) gates[(size_t)token * 32 + d] = v[ni][j]; }
            asm volatile("" ::: "memory");
            continue;
        }
        if (kind == 1) {
            float ss = 0.f;
#pragma unroll
            for (int ni = 0; ni < 4; ++ni)
#pragma unroll
                for (int j = 0; j < 4; ++j) ss += v[ni][j] * v[ni][j];
            ss += __shfl_xor(ss, 16); ss += __shfl_xor(ss, 32);
            const float r = rsqrtf(ss * (1.0f / 64.0f) + 1e-6f);
#pragma unroll
            for (int ni = 0; ni < 4; ++ni) { const float4 gg = *(const float4*)(gain + ni * 16 + quad * 4);
                v[ni][0] *= r * gg.x; v[ni][1] *= r * gg.y; v[ni][2] *= r * gg.z; v[ni][3] *= r * gg.w; }
            if (dorope) {
                const float4 cs = *(const float4*)(rope + pos * 16 + (quad & 1) * 4), sn = *(const float4*)(rope + pos * 16 + 8 + (quad & 1) * 4);
                const float cv[4] = {cs.x, cs.y, cs.z, cs.w}, sv[4] = {sn.x, sn.y, sn.z, sn.w};
#pragma unroll
                for (int j = 0; j < 4; ++j) { const float xx = v[0][j], pp = __shfl_xor(xx, 32);
                    v[0][j] = (quad < 2) ? (xx * cv[j] - pp * sv[j]) : (xx * cv[j] + pp * sv[j]); }
            }
#pragma unroll
            for (int ni = 0; ni < 4; ++ni)
#pragma unroll
                for (int j = 0; j < 4; ++j) v[ni][j] *= scale;
        }
        if (kind == 5) {
#pragma unroll
            for (int ni = 0; ni < 4; ++ni)
#pragma unroll
                for (int j = 0; j < 4; ++j) { const int d = ni * 16 + quad * 4 + j;
                    VT[((size_t)(vidx * 8 + bb) * 64 + d) * 4096 + pos] = f2bf(v[ni][j]); }
        } else {
#pragma unroll
            for (int ni = 0; ni < 4; ++ni) { uint2 o; o.x = pk2(v[ni][0], v[ni][1]); o.y = pk2(v[ni][2], v[ni][3]);
                *(uint2*)(proj + (size_t)token * PJ_LD + cc * 64 + ni * 16 + quad * 4) = o; }
        }
        asm volatile("" ::: "memory");
    }
}

DEVI void g_load(uint4 (&RA)[4], uint4 (&RB)[4], const bf16_t* Ap, const bf16_t* Bp, int K, int KT) {
#pragma unroll
    for (int i = 0; i < 4; ++i) { RA[i] = *(const uint4*)(Ap + (size_t)(32 * i) * K + KT * 64); RB[i] = *(const uint4*)(Bp + (size_t)(32 * i) * K + KT * 64); }
}
DEVI void g_swrite(const uint4 (&RA)[4], const uint4 (&RB)[4], char* d_) {
#pragma unroll
    for (int i = 0; i < 4; ++i) { *(uint4*)(d_ + i * 4096) = RA[i]; *(uint4*)(d_ + 16384 + i * 4096) = RB[i]; }
}
DEVI void g_compute(const char* sA, f32x4 (&acc)[4][4], int wm, int wn, int quad, int l15) {
    const char* sB = sA + 16384;
#pragma unroll
    for (int ks = 0; ks < 2; ++ks) {
        bf16x8 af[4], bfr[4]; const int ch = ks * 4 + quad;
#pragma unroll
        for (int mi = 0; mi < 4; ++mi) { const int row = wm * 64 + mi * 16 + l15; af[mi] = *(const bf16x8*)(sA + row * 128 + ((ch ^ (row & 7)) << 4)); }
#pragma unroll
        for (int ni = 0; ni < 4; ++ni) { const int row = wn * 64 + ni * 16 + l15; bfr[ni] = *(const bf16x8*)(sB + row * 128 + ((ch ^ (row & 7)) << 4)); }
#pragma unroll
        for (int mi = 0; mi < 4; ++mi)
#pragma unroll
            for (int ni = 0; ni < 4; ++ni) acc[mi][ni] = mfma(bfr[ni], af[mi], acc[mi][ni]);
    }
}

template <int EPI>
__device__ __forceinline__ void gemm_phase(const Params& p, int L, char* lds) {
    const bf16_t* A; const bf16_t* Bt; int K, nNt;
    if (EPI == EPI_PROJ) { A = (const bf16_t*)(p.ws + OFF_ACT); Bt = (const bf16_t*)(p.ws + OFF_WIN) + (size_t)L * NW_IN_PAD * 1024; K = 1024; nNt = NW_IN_PAD / 256; }
    else if (EPI == EPI_WO) { A = (const bf16_t*)(p.ws + OFF_ACT); Bt = (const bf16_t*)(p.ws + OFF_WO) + (size_t)L * 1024 * 1024; K = 1024; nNt = 4; }
    else if (EPI == EPI_UP) { A = (const bf16_t*)(p.ws + OFF_ACT2); Bt = (const bf16_t*)(p.ws + OFF_WUP) + (size_t)L * 4096 * 1024; K = 1024; nNt = 16; }
    else { A = (const bf16_t*)(p.ws + OFF_BIG); Bt = (const bf16_t*)(p.ws + OFF_WDN) + (size_t)L * 1024 * 4096; K = 4096; nNt = 4; }
    const int tid = otid(), lane = tid & 63, w = tid >> 6, quad = lane >> 4, l15 = lane & 15, wm = w >> 1, wn = w & 1;
    const int xcd = blockIdx.x & 7, loc = blockIdx.x >> 3, nloc = gridDim.x >> 3;
    const int nk = K / 32;
    const int gsw = (0x1230 >> (((l15 >> 2) & 3) * 4)) & 3;
    const int rsw = (quad ^ gsw) << 4;
    for (int it = loc; it < 32 * nNt; it += nloc) {
        const int tl = otid();
        const int lrow = tl >> 2, lc = tl & 3;
        const int woff = lrow * 64 + ((lc ^ ((0x1230 >> (((lrow >> 2) & 3) * 4)) & 3)) << 4);
        const int gsz = 8 * nNt, mloc = (it / gsz) * 8 + (it & 7), nloc_t = (it % gsz) >> 3;
        const int m0 = (xcd + 8 * mloc) * 128, n0 = nloc_t * 256;
        f32x4 acc[4][8];
#pragma unroll
        for (int a = 0; a < 4; ++a)
#pragma unroll
            for (int b = 0; b < 8; ++b) acc[a][b] = (f32x4){0.f, 0.f, 0.f, 0.f};
        u32x8 ra0, ra1; u32x16 rb0, rb1;
        const bf16_t* Ap = A + (size_t)(m0 + lrow) * K + lc * 8;
        const bf16_t* Bp = Bt + (size_t)(n0 + lrow) * K + lc * 8;
#define G_LD1(R, P, I, KT) { const uint4 t_ = *(const uint4*)((P) + (size_t)(64 * I) * K + (KT) * 32); R[4 * I] = t_.x; R[4 * I + 1] = t_.y; R[4 * I + 2] = t_.z; R[4 * I + 3] = t_.w; }
#define G_LOAD(RA, RB, KT) { G_LD1(RA, Ap, 0, KT) G_LD1(RB, Bp, 0, KT) G_LD1(RA, Ap, 1, KT) G_LD1(RB, Bp, 1, KT) G_LD1(RB, Bp, 2, KT) G_LD1(RB, Bp, 3, KT) }
#define G_SW1(R, D, I) *(uint4*)((D) + I * 4096) = make_uint4(R[4 * I], R[4 * I + 1], R[4 * I + 2], R[4 * I + 3]);
#define G_SWRITE(RA, RB, DST) { G_SW1(RA, DST, 0) G_SW1(RB, (DST) + 8192, 0) G_SW1(RA, DST, 1) G_SW1(RB, (DST) + 8192, 1) G_SW1(RB, (DST) + 8192, 2) G_SW1(RB, (DST) + 8192, 3) }
#define G_COMPUTE(BUF) { const char* sA_ = (BUF) + (wm * 64 + l15) * 64 + rsw; const char* sB_ = (BUF) + 8192 + (wn * 128 + l15) * 64 + rsw; \
            bf16x8 af[4]; \
            _Pragma("unroll") for (int i_ = 0; i_ < 4; ++i_) af[i_] = *(const bf16x8*)(sA_ + i_ * 1024); \
            _Pragma("unroll") for (int nh = 0; nh < 2; ++nh) { bf16x8 bfr[4]; \
                _Pragma("unroll") for (int i_ = 0; i_ < 4; ++i_) bfr[i_] = *(const bf16x8*)(sB_ + (nh * 4 + i_) * 1024); \
                _Pragma("unroll") for (int mi = 0; mi < 4; ++mi) _Pragma("unroll") for (int ni = 0; ni < 4; ++ni) acc[mi][nh * 4 + ni] = mfma(bfr[ni], af[mi], acc[mi][nh * 4 + ni]); } }
        G_LOAD(ra0, rb0, 0)
        G_LOAD(ra1, rb1, 1)
        G_SWRITE(ra0, rb0, lds + woff)
        __syncthreads();
#pragma unroll 1
        for (int kt = 0; kt < nk - 2; kt += 2) {
            G_LOAD(ra0, rb0, kt + 2)
            __builtin_amdgcn_sched_barrier(0);
            G_COMPUTE(lds)
            G_SWRITE(ra1, rb1, lds + 24576 + woff)
            __syncthreads();
            G_LOAD(ra1, rb1, kt + 3)
            __builtin_amdgcn_sched_barrier(0);
            G_COMPUTE(lds + 24576)
            G_SWRITE(ra0, rb0, lds + woff)
            __syncthreads();
        }
        G_COMPUTE(lds)
        G_SWRITE(ra1, rb1, lds + 24576 + woff)
        __syncthreads();
        G_COMPUTE(lds + 24576)
        __syncthreads();
#undef G_LOAD
#undef G_SWRITE
#undef G_LD1
#undef G_SW1
#undef G_COMPUTE
        const int te = otid(); const int lane_e = te & 63, quad_e = lane_e >> 4, l15_e = lane_e & 15;
        const int mw = m0 + ((te >> 7) & 1) * 64, nw = n0 + ((te >> 6) & 1) * 128;
        if (EPI == EPI_PROJ) {
            proj_epilogue<0>(p, L, acc, mw, (nw >> 6), lane_e);
            proj_epilogue<1>(p, L, acc, mw, (nw >> 6) + 1, lane_e);
        } else if (EPI == EPI_UP) {
            bf16_t* hid = (bf16_t*)(p.ws + OFF_BIG);
#pragma unroll
            for (int mi = 0; mi < 4; ++mi) { const int m = mw + mi * 16 + l15_e; const float r = row_rstd((const float*)(p.ws + OFF_SSQ), m);
#pragma unroll
                for (int ni = 0; ni < 8; ++ni) { const int n = nw + ni * 16 + quad_e * 4;
                    float a0 = fmaxf(acc[mi][ni][0] * r, 0.f), a1 = fmaxf(acc[mi][ni][1] * r, 0.f), a2 = fmaxf(acc[mi][ni][2] * r, 0.f), a3 = fmaxf(acc[mi][ni][3] * r, 0.f);
                    uint2 o; o.x = pk2(a0 * a0, a1 * a1); o.y = pk2(a2 * a2, a3 * a3);
                    *(uint2*)(hid + (size_t)m * DFF + n) = o; } }
        } else {
            const float* xin = (EPI == EPI_WO && L == 0) ? p.x : p.out;
            const bool emit = (EPI == EPI_WO) || (L + 1 < 2);
            const float* gn = (EPI == EPI_WO) ? (p.norm2_g + L * 1024) : (p.norm1_g + (L + 1 < 2 ? L + 1 : L) * 1024);
            bf16_t* hn = (bf16_t*)(p.ws + ((EPI == EPI_WO) ? OFF_ACT2 : OFF_ACT));
            float* ssq = (float*)(p.ws + OFF_SSQ);
#pragma unroll
            for (int mi = 0; mi < 4; ++mi) {
#pragma unroll
                for (int hf = 0; hf < 2; ++hf) {
                    const int t3 = otid(); const int l15_e = t3 & 15, quad_e = (t3 >> 4) & 3;
                    const int m = mw + mi * 16 + l15_e;
                    float ss = 0.f;
#pragma unroll
                    for (int n4 = 0; n4 < 4; ++n4) { const int ni = hf * 4 + n4; const int n = nw + ni * 16 + quad_e * 4;
                        float4 xv = *(const float4*)(xin + (size_t)m * DM + n);
                        xv.x += acc[mi][ni][0]; xv.y += acc[mi][ni][1]; xv.z += acc[mi][ni][2]; xv.w += acc[mi][ni][3];
                        *(float4*)(p.out + (size_t)m * DM + n) = xv;
                        if (emit) { const float4 gg = *(const float4*)(gn + n);
                            uint2 o; o.x = pk2(xv.x * gg.x, xv.y * gg.y); o.y = pk2(xv.z * gg.z, xv.w * gg.w);
                            *(uint2*)(hn + (size_t)m * DM + n) = o;
                            ss += (xv.x * xv.x + xv.y * xv.y) + (xv.z * xv.z + xv.w * xv.w); } }
                    if (emit) { ss += __shfl_xor(ss, 16); ss += __shfl_xor(ss, 32);
                        if (quad_e == 0) ssq[(size_t)m * 16 + ((nw >> 6) + hf)] = ss; }
                    asm volatile("" ::: "memory");
                }
            }
        }
    }
}

DEVI float hgrn_lb(const Params& p, int L, int hk) {
    if (L == 0) return 0.f;
    const float l0 = p.lb_logits[hk], l1 = p.lb_logits[256 + hk];
    return 1.0f / (1.0f + __expf(l0 - l1));
}

__device__ void hgrn_a_unit(const Params& p, int L, int u, char* lds) {
    const int tid = otid(), lane = tid & 63, w = tid >> 6, quad = lane >> 4, l15 = lane & 15;
    const int c = u & 63, h = (u >> 6) & 3, b = u >> 8;
    const bf16_t* proj = (const bf16_t*)(p.ws + OFF_BIG); const bf16_t* VT = (const bf16_t*)(p.ws + OFF_BIG + OFF_VT_IN_BIG);
    float* segtot = (float*)lds;
    bf16_t* KDt = (bf16_t*)(lds + 1024);
    const int k = tid & 63, seg = tid >> 6;
    const float lb = hgrn_lb(p, L, h * 64 + k);
    float gl[16], kkv[16]; float run = 0.f;
    const bf16_t* zp = proj + (size_t)(b * 4096 + c * 64 + seg * 16) * PJ_LD + 256 + h * 64 + k;
#pragma unroll
    for (int i = 0; i < 16; ++i) {
        const float z = bf2f(zp[(size_t)i * PJ_LD]);
        const float sg = 1.0f / (1.0f + __expf(-z)), sn = 1.0f / (1.0f + __expf(z));
        const float f = lb + (1.0f - lb) * sg;
        run += __logf(fmaxf(f, 1e-30f)); gl[i] = run; kkv[i] = (1.0f - lb) * sn;
    }
    segtot[seg * 64 + k] = run;
    __syncthreads();
    float off = 0.f, tot = 0.f;
#pragma unroll
    for (int s = 0; s < 4; ++s) { const float t = segtot[s * 64 + k]; tot += t; if (s < seg) off += t; }
    unsigned pkd[8];
#pragma unroll
    for (int i = 0; i < 8; ++i) {
        const float a0 = kkv[2 * i] * __expf(tot - (off + gl[2 * i])), a1 = kkv[2 * i + 1] * __expf(tot - (off + gl[2 * i + 1]));
        pkd[i] = pk2(a0, a1);
    }
    *(uint4*)(KDt + k * 72 + seg * 16) = make_uint4(pkd[0], pkd[1], pkd[2], pkd[3]);
    *(uint4*)(KDt + k * 72 + seg * 16 + 8) = make_uint4(pkd[4], pkd[5], pkd[6], pkd[7]);
    if (seg == 0) ((float*)(p.ws + OFF_DECAY))[u * 64 + k] = __expf(tot);
    __syncthreads();
    const bf16_t* vt = VT + ((size_t)(h * 8 + b) * 64) * 4096 + c * 64;
    float* kvt = (float*)(p.ws + OFF_KVT) + (size_t)u * 4096;
    bf16x8 af[2];
#pragma unroll
    for (int ks = 0; ks < 2; ++ks) af[ks] = ld8(vt + (size_t)(w * 16 + l15) * 4096 + ks * 32 + quad * 8);
#pragma unroll
    for (int kt = 0; kt < 4; ++kt) {
        f32x4 acc = (f32x4){0.f, 0.f, 0.f, 0.f};
#pragma unroll
        for (int ks = 0; ks < 2; ++ks) { const bf16x8 bfr = *(const bf16x8*)(KDt + (kt * 16 + l15) * 72 + ks * 32 + quad * 8); acc = mfma(af[ks], bfr, acc); }
#pragma unroll
        for (int j = 0; j < 4; ++j) kvt[(w * 16 + quad * 4 + j) * 64 + kt * 16 + l15] = acc[j];
    }
    __syncthreads();
}

__device__ void hgrn_scan_phase(const Params& p) {
    const float* kvt = (const float*)(p.ws + OFF_KVT); const float* dec = (const float*)(p.ws + OFF_DECAY);
    bf16_t* st = (bf16_t*)(p.ws + OFF_ST);
    for (int e = blockIdx.x * 256 + otid(); e < 32 * 4096; e += gridDim.x * 256) {
        const int bh = e >> 12, vk = e & 4095, k = vk & 63;
        float S = 0.f;
#pragma unroll 8
        for (int c = 0; c < 64; ++c) {
            const int u = bh * 64 + c;
            st[(size_t)u * 4096 + vk] = f2bf(S);
            S = S * dec[u * 64 + k] + kvt[(size_t)u * 4096 + vk];
        }
    }
}

__device__ void hgrn_c_unit(const Params& p, int L, int u, char* lds) {
    const int tid = otid(), lane = tid & 63, w = tid >> 6, quad = lane >> 4, l15 = lane & 15;
    const int c = u & 63, h = (u >> 6) & 3, b = u >> 8;
    const bf16_t* proj = (const bf16_t*)(p.ws + OFF_BIG); const bf16_t* VT = (const bf16_t*)(p.ws + OFF_BIG + OFF_VT_IN_BIG);
    float* Gs = (float*)lds; float* KKs = Gs + 64 * 65; float* Qs = KKs + 64 * 65; float* segtot = Qs + 64 * 65;
    {
        const int k = tid & 63, seg = tid >> 6;
        const float lb = hgrn_lb(p, L, h * 64 + k);
        float gl[16], kkv[16]; float run = 0.f;
        const bf16_t* zp = proj + (size_t)(b * 4096 + c * 64 + seg * 16) * PJ_LD + 256 + h * 64 + k;
#pragma unroll
        for (int i = 0; i < 16; ++i) {
            const float z = bf2f(zp[(size_t)i * PJ_LD]);
            const float sg = 1.0f / (1.0f + __expf(-z)), sn = 1.0f / (1.0f + __expf(z));
            const float f = lb + (1.0f - lb) * sg;
            run += __logf(fmaxf(f, 1e-30f)); gl[i] = run; kkv[i] = (1.0f - lb) * sn;
            Qs[(seg * 16 + i) * 65 + k] = bf2f(zp[(size_t)i * PJ_LD - 256]) * 0.125f;
        }
        segtot[seg * 64 + k] = run;
        __syncthreads();
        float off = 0.f;
#pragma unroll
        for (int s = 0; s < 4; ++s) { const float t = segtot[s * 64 + k]; if (s < seg) off += t; }
#pragma unroll
        for (int i = 0; i < 16; ++i) { Gs[(seg * 16 + i) * 65 + k] = off + gl[i]; KKs[(seg * 16 + i) * 65 + k] = kkv[i]; }
        __syncthreads();
    }
    const int I = w;
    const int tq = 16 * I + l15;
    bf16x8 qt[2], qg[2];
#pragma unroll
    for (int ks = 0; ks < 2; ++ks) {
        float a[8], g8[8];
#pragma unroll
        for (int j = 0; j < 8; ++j) {
            const int k = ks * 32 + quad * 8 + j;
            const float G = Gs[tq * 65 + k], q = Qs[tq * 65 + k];
            const float gref = (I == 0) ? 0.f : Gs[(16 * I - 1) * 65 + k];
            a[j] = q * __expf(G - gref); g8[j] = q * __expf(G);
        }
        qt[ks] = mk8(pk2(a[0], a[1]), pk2(a[2], a[3]), pk2(a[4], a[5]), pk2(a[6], a[7]));
        qg[ks] = mk8(pk2(g8[0], g8[1]), pk2(g8[2], g8[3]), pk2(g8[4], g8[5]), pk2(g8[6], g8[7]));
    }
    f32x4 O[4];
#pragma unroll
    for (int vt = 0; vt < 4; ++vt) O[vt] = (f32x4){0.f, 0.f, 0.f, 0.f};
    const bf16_t* st = (const bf16_t*)(p.ws + OFF_ST) + (size_t)u * 4096;
#pragma unroll
    for (int vt = 0; vt < 4; ++vt)
#pragma unroll
        for (int ks = 0; ks < 2; ++ks) O[vt] = mfma(ld8(st + (vt * 16 + l15) * 64 + ks * 32 + quad * 8), qg[ks], O[vt]);
    const bf16_t* vtp = VT + ((size_t)(h * 8 + b) * 64) * 4096 + c * 64;
    for (int Jp = 0; Jp <= (I >> 1); ++Jp) {
        f32x4 sc[2];
#pragma unroll
        for (int jj = 0; jj < 2; ++jj) {
            const int J = 2 * Jp + jj;
            sc[jj] = (f32x4){0.f, 0.f, 0.f, 0.f};
            if (J <= I) {
                const int s = 16 * J + l15;
#pragma unroll
                for (int ks = 0; ks < 2; ++ks) {
                    float a[8];
#pragma unroll
                    for (int j = 0; j < 8; ++j) {
                        const int k = ks * 32 + quad * 8 + j;
                        const float gref = (I == 0) ? 0.f : Gs[(16 * I - 1) * 65 + k];
                        a[j] = KKs[s * 65 + k] * __expf(gref - Gs[s * 65 + k]);
                    }
                    sc[jj] = mfma(mk8(pk2(a[0], a[1]), pk2(a[2], a[3]), pk2(a[4], a[5]), pk2(a[6], a[7])), qt[ks], sc[jj]);
                }
#pragma unroll
                for (int j = 0; j < 4; ++j) { const int s2 = 16 * J + quad * 4 + j; if (s2 > tq) sc[jj][j] = 0.f; }
            }
        }
        const bf16x8 P = mk8(pk2(sc[0][0], sc[0][1]), pk2(sc[0][2], sc[0][3]), pk2(sc[1][0], sc[1][1]), pk2(sc[1][2], sc[1][3]));
#pragma unroll
        for (int vt = 0; vt < 4; ++vt) {
            const bf16_t* r = vtp + (size_t)(vt * 16 + l15) * 4096 + 32 * Jp + quad * 4;
            O[vt] = mfma(ld4x2(r, r + 16), P, O[vt]);
        }
    }
    float ss = 0.f;
#pragma unroll
    for (int vt = 0; vt < 4; ++vt)
#pragma unroll
        for (int j = 0; j < 4; ++j) ss += O[vt][j] * O[vt][j];
    ss += __shfl_xor(ss, 16); ss += __shfl_xor(ss, 32);
    const float r = rsqrtf(ss * (1.0f / 64.0f) + 1e-6f);
    const size_t token = (size_t)b * 4096 + c * 64 + tq;
    bf16_t* mix = (bf16_t*)(p.ws + OFF_ACT);
#pragma unroll
    for (int vt = 0; vt < 4; ++vt) {
        const int v0 = vt * 16 + quad * 4;
        const float4 og = *(const float4*)(p.onorm_g + L * 64 + v0);
        const uint2 gz = *(const uint2*)(proj + token * PJ_LD + 768 + h * 64 + v0);
        const float g0 = bflo(gz.x), g1 = bfhi(gz.x), g2 = bflo(gz.y), g3 = bfhi(gz.y);
        const float o0 = O[vt][0] * r * og.x * (g0 / (1.0f + __expf(-g0))), o1 = O[vt][1] * r * og.y * (g1 / (1.0f + __expf(-g1)));
        const float o2 = O[vt][2] * r * og.z * (g2 / (1.0f + __expf(-g2))), o3 = O[vt][3] * r * og.w * (g3 / (1.0f + __expf(-g3)));
        uint2 o; o.x = pk2(o0, o1); o.y = pk2(o2, o3);
        *(uint2*)(mix + token * DM + h * 64 + v0) = o;
    }
    __syncthreads();
}

__device__ void compress_unit(const Params& p, int L, int u, char* lds) {
    const int tid = otid(), lane = tid & 63, w = tid >> 6, quad = lane >> 4, l15 = lane & 15;
    const int which = u & 1, g = (u >> 1) & 1, b = (u >> 2) & 7, rt = u >> 5;
    const bf16_t* proj = (const bf16_t*)(p.ws + OFF_BIG);
    const bf16_t* w1t = (const bf16_t*)(p.ws + OFF_W1T) + (size_t)(L * 2 + which) * 128 * 2048;
    const bf16_t* w2t = (const bf16_t*)(p.ws + OFF_W2T) + (size_t)(L * 2 + which) * 64 * 128;
    const float* cbias = (const float*)(p.ws + OFF_CBIAS) + (L * 2 + which) * 128;
    float* red = (float*)lds;
    bf16_t* Hs = (bf16_t*)(lds + 32768);
    float* outb = (float*)(lds + 40960);
    const int nrow = rt * 16 + l15;
    int tokbase = 16 * nrow; if (tokbase > 4096 - 32) tokbase = 4096 - 32;
    const bf16_t* xa = proj + ((size_t)b * 4096 + tokbase) * PJ_LD + (which ? 1664 : 1536) + g * 64;
    f32x4 acc[8];
#pragma unroll
    for (int i = 0; i < 8; ++i) acc[i] = (f32x4){0.f, 0.f, 0.f, 0.f};
#pragma unroll 2
    for (int kq = 0; kq < 16; ++kq) {
        const int kk = w * 16 + kq, l = kk >> 1, d = (kk & 1) * 32 + quad * 8;
        const bf16x8 a = ld8(xa + (size_t)l * PJ_LD + d);
#pragma unroll
        for (int ni = 0; ni < 8; ++ni) acc[ni] = mfma(a, ld8(w1t + (size_t)(ni * 16 + l15) * 2048 + kk * 32 + quad * 8), acc[ni]);
    }
#pragma unroll
    for (int ni = 0; ni < 8; ++ni)
#pragma unroll
        for (int j = 0; j < 4; ++j) red[(w * 16 + quad * 4 + j) * 128 + ni * 16 + l15] = acc[ni][j];
    __syncthreads();
    {
        const int row = tid >> 4, c0 = (tid & 15) * 8;
        float x[8];
#pragma unroll
        for (int i = 0; i < 8; ++i) x[i] = cbias[c0 + i];
#pragma unroll
        for (int ww = 0; ww < 4; ++ww) { const float4 a0 = *(const float4*)(red + (ww * 16 + row) * 128 + c0), a1 = *(const float4*)(red + (ww * 16 + row) * 128 + c0 + 4);
            x[0] += a0.x; x[1] += a0.y; x[2] += a0.z; x[3] += a0.w; x[4] += a1.x; x[5] += a1.y; x[6] += a1.z; x[7] += a1.w; }
        unsigned pk[4];
#pragma unroll
        for (int i = 0; i < 4; ++i) { float y[2];
#pragma unroll
            for (int t = 0; t < 2; ++t) { const float xv = x[2 * i + t]; const float uu = 0.7978845608028654f * (xv + 0.044715f * xv * xv * xv);
                const float th = 1.0f - 2.0f / (1.0f + __expf(2.0f * uu)); y[t] = 0.5f * xv * (1.0f + th); }
            pk[i] = pk2(y[0], y[1]); }
        *(uint4*)(Hs + row * 136 + c0) = make_uint4(pk[0], pk[1], pk[2], pk[3]);
    }
    __syncthreads();
    {
        f32x4 o = (f32x4){0.f, 0.f, 0.f, 0.f};
#pragma unroll
        for (int ks = 0; ks < 4; ++ks) o = mfma(*(const bf16x8*)(Hs + l15 * 136 + ks * 32 + quad * 8), ld8(w2t + (size_t)(w * 16 + l15) * 128 + ks * 32 + quad * 8), o);
#pragma unroll
        for (int j = 0; j < 4; ++j) outb[(quad * 4 + j) * 64 + w * 16 + l15] = o[j];
    }
    __syncthreads();
    if (which == 0) {
        bf16_t* kc = (bf16_t*)(p.ws + OFF_KC) + (size_t)(b * 2 + g) * 256 * 64;
        const float* rope = (const float*)(p.ws + OFF_ROPE);
        const int row = tid >> 4, c4 = tid & 15, n = rt * 16 + row;
        const float4 xv = *(const float4*)(outb + row * 64 + c4 * 4);
        float ss = (xv.x * xv.x + xv.y * xv.y) + (xv.z * xv.z + xv.w * xv.w);
        ss += __shfl_xor(ss, 1); ss += __shfl_xor(ss, 2); ss += __shfl_xor(ss, 4); ss += __shfl_xor(ss, 8);
        const float r = rsqrtf(ss * (1.0f / 64.0f) + 1e-6f);
        const float4 gg = *(const float4*)(p.nsa_kn_g + L * 64 + c4 * 4);
        float v[4] = {xv.x * r * gg.x, xv.y * r * gg.y, xv.z * r * gg.z, xv.w * r * gg.w};
        int pos = 16 * n + 31; if (pos > 4095) pos = 4095;
        const float4 cs = *(const float4*)(rope + pos * 16 + (c4 & 1) * 4), sn = *(const float4*)(rope + pos * 16 + 8 + (c4 & 1) * 4);
        const float csv[4] = {cs.x, cs.y, cs.z, cs.w}, snv[4] = {sn.x, sn.y, sn.z, sn.w};
#pragma unroll
        for (int i = 0; i < 4; ++i) { const float pp = __shfl_xor(v[i], 2);
            if (c4 < 4) v[i] = (c4 < 2) ? (v[i] * csv[i] - pp * snv[i]) : (v[i] * csv[i] + pp * snv[i]); }
        uint2 ov; ov.x = pk2(v[0], v[1]); ov.y = pk2(v[2], v[3]);
        if (n >= 255) { ov.x = 0u; ov.y = 0u; }
        *(uint2*)(kc + (size_t)n * 64 + c4 * 4) = ov;
    } else {
        bf16_t* vct = (bf16_t*)(p.ws + OFF_VCT) + (size_t)(b * 2 + g) * 64 * 256;
        const int d = tid >> 2, r0 = (tid & 3) * 4, nb = rt * 16 + r0;
        float v0 = outb[(r0 + 0) * 64 + d], v1 = outb[(r0 + 1) * 64 + d], v2 = outb[(r0 + 2) * 64 + d], v3 = outb[(r0 + 3) * 64 + d];
        if (nb + 3 >= 255) v3 = 0.f;
        uint2 ov; ov.x = pk2(v0, v1); ov.y = pk2(v2, v3);
        *(uint2*)(vct + (size_t)d * 256 + nb) = ov;
    }
    __syncthreads();
}

__device__ void foxc_job(const Params& p, int L, int bh, char* lds) {
    const int tid = otid(), lane = tid & 63, w = tid >> 6, b = bh >> 2, h = bh & 3;
    const float* gates = (const float*)(p.ws + OFF_GATES);
    float* cc = (float*)(p.ws + OFF_FOXC) + (size_t)bh * 4096;
    float* wtot = (float*)lds;
    const float fb = p.fox_fb[L * 4 + h];
    float v[16];
#pragma unroll
    for (int i = 0; i < 16; ++i) v[i] = gates[((size_t)b * 4096 + tid * 16 + i) * 32 + 24 + h] + fb;
    float run = 0.f;
#pragma unroll
    for (int i = 0; i < 16; ++i) { const float x = v[i]; run += (x >= 0.f) ? -log1pf(__expf(-x)) : (x - log1pf(__expf(x))); v[i] = run; }
    float incl = run;
#pragma unroll
    for (int o = 1; o < 64; o <<= 1) { const float t = __shfl_up(incl, o); if (lane >= o) incl += t; }
    if (lane == 63) wtot[w] = incl;
    __syncthreads();
    float pre = incl - run;
#pragma unroll
    for (int s = 0; s < 4; ++s) if (s < w) pre += wtot[s];
#pragma unroll
    for (int i = 0; i < 4; ++i) { const float k2 = 1.4426950408889634f;
        *(float4*)(cc + tid * 16 + i * 4) = make_float4((pre + v[4 * i]) * k2, (pre + v[4 * i + 1]) * k2, (pre + v[4 * i + 2]) * k2, (pre + v[4 * i + 3]) * k2); }
    __syncthreads();
}

constexpr int KV_BUF = 16384;
DEVI void tile_glds(const bf16_t* Kg, int ldk, const bf16_t* Vg, int ldv, char* buf, int tid) {
    const int w = tid >> 6, i = tid & 63;
#pragma unroll
    for (int jj = 0; jj < 2; ++jj) {
        const int j = w * 2 + jj, row = 8 * j + (i >> 3), slot = i & 7;
        const bf16_t* kp = Kg + (size_t)row * ldk + ((slot ^ (row & 7)) << 3);
        const bf16_t* vp = Vg + (size_t)row * ldv + ((slot ^ ((row >> 1) & 7)) << 3);
        __builtin_amdgcn_global_load_lds((const unsigned*)kp, (ldsp_t)(unsigned)(size_t)(buf + j * 1024), 16, 0, 0);
        __builtin_amdgcn_global_load_lds((const unsigned*)vp, (ldsp_t)(unsigned)(size_t)(buf + 8192 + j * 1024), 16, 0, 0);
    }
}
DEVI void lds_kf(const char* buf, int kh, int lane, bf16x8 (&kf)[2][2]) {
    const int quad = lane >> 4, l15 = lane & 15;
#pragma unroll
    for (int t2 = 0; t2 < 2; ++t2)
#pragma unroll
        for (int ks = 0; ks < 2; ++ks) { const int row = kh * 32 + t2 * 16 + l15, ch = ks * 4 + quad; kf[t2][ks] = *(const bf16x8*)(buf + row * 128 + ((ch ^ (row & 7)) << 4)); }
}
DEVI void lds_vf(const char* buf, int kh, int lane, bf16x8 (&vf)[4]) {
    const int quad = lane >> 4, l15 = lane & 15;
#pragma unroll
    for (int dt = 0; dt < 4; ++dt) { const int d = dt * 16 + l15, u0 = kh * 8 + quad, u1 = u0 + 4;
        const uint2 a = *(const uint2*)(buf + 8192 + d * 128 + ((u0 ^ (d & 14)) << 3)), b = *(const uint2*)(buf + 8192 + d * 128 + ((u1 ^ (d & 14)) << 3));
        vf[dt] = mk8(a.x, a.y, b.x, b.y); }
}

template <class MaskF>
DEVI void attn_block64(const char* buf, int kbase, const char* ql, int q0o, int q1o, int qstride, const float* cb, f32x4 (&O)[4][4], float (&m)[4], float (&l)[4], int lane, MaskF maskf) {
    const int quad = lane >> 4;
#pragma unroll
    for (int kh = 0; kh < 2; ++kh) {
        bf16x8 kf[2][2], vf[4];
        lds_kf(buf, kh, lane, kf); lds_vf(buf, kh, lane, vf);
        float ck[8] = {0.f, 0.f, 0.f, 0.f, 0.f, 0.f, 0.f, 0.f};
        if (cb) { const float4 c0 = *(const float4*)(cb + kbase + kh * 32 + quad * 4), c1 = *(const float4*)(cb + kbase + kh * 32 + 16 + quad * 4);
            ck[0] = c0.x; ck[1] = c0.y; ck[2] = c0.z; ck[3] = c0.w; ck[4] = c1.x; ck[5] = c1.y; ck[6] = c1.z; ck[7] = c1.w; }
#pragma unroll
        for (int nt = 0; nt < 4; ++nt) {
            f32x4 s0 = (f32x4){0.f, 0.f, 0.f, 0.f}, s1 = s0;
            { const bf16x8 qa = *(const bf16x8*)(ql + nt * qstride + q0o), qb_ = *(const bf16x8*)(ql + nt * qstride + q1o);
              s0 = mfma(kf[0][0], qa, s0); s1 = mfma(kf[1][0], qa, s1); s0 = mfma(kf[0][1], qb_, s0); s1 = mfma(kf[1][1], qb_, s1); }
            float sv[8]; float mx = -1e30f;
#pragma unroll
            for (int e = 0; e < 8; ++e) { sv[e] = (e < 4) ? s0[e & 3] : s1[e & 3]; const int key = kbase + kh * 32 + (e >> 2) * 16 + quad * 4 + (e & 3);
                const bool ok = maskf(nt, ck[e], key, sv[e]); sv[e] = ok ? sv[e] : -__builtin_huge_valf(); mx = fmaxf(mx, sv[e]); }
            mx = fmaxf(mx, __shfl_xor(mx, 16)); mx = fmaxf(mx, __shfl_xor(mx, 32));
            const float mn = fmaxf(m[nt], mx), alpha = __builtin_amdgcn_exp2f(m[nt] - mn);
            float pv[8]; float rs = 0.f;
#pragma unroll
            for (int e = 0; e < 8; ++e) { pv[e] = __builtin_amdgcn_exp2f(sv[e] - mn); rs += pv[e]; }
            rs += __shfl_xor(rs, 16); rs += __shfl_xor(rs, 32);
            l[nt] = l[nt] * alpha + rs; m[nt] = mn;
            const bf16x8 P = mk8(pk2(pv[0], pv[1]), pk2(pv[2], pv[3]), pk2(pv[4], pv[5]), pk2(pv[6], pv[7]));
#pragma unroll
            for (int dt = 0; dt < 4; ++dt) { O[dt][nt] = O[dt][nt] * alpha; O[dt][nt] = mfma(vf[dt], P, O[dt][nt]); }
        }
    }
}

template <class MaskF>
DEVI void attn_stream(u64 tiles, const bf16_t* Kbase, int ldk, const bf16_t* Vbase, int ldv, char* kvbuf, int jb_wave_min, int jb_wave_max,
                      const char* ql, int q0o, int q1o, int qstride, const float* cb, f32x4 (&O)[4][4], float (&m)[4], float (&l)[4], int tid, int lane, MaskF maskf) {
    if (tiles == 0ull) return;
    int jb = __ffsll((long long)tiles) - 1; tiles &= tiles - 1;
    tile_glds(Kbase + (size_t)jb * 64 * ldk, ldk, Vbase + jb * 64, ldv, kvbuf, tid);
    __syncthreads();
    int cur = 0;
#pragma unroll 1
    for (;;) {
        const bool more = tiles != 0ull;
        int jbn = 0;
        if (more) { jbn = __ffsll((long long)tiles) - 1; tiles &= tiles - 1; tile_glds(Kbase + (size_t)jbn * 64 * ldk, ldk, Vbase + jbn * 64, ldv, kvbuf + (cur ^ 1) * KV_BUF, tid); }
        if (jb >= jb_wave_min && jb <= jb_wave_max) attn_block64(kvbuf + cur * KV_BUF, jb * 64, ql, q0o, q1o, qstride, cb, O, m, l, lane, [&](int nt, float ckv, int key, float& s) { return maskf(nt, ckv, key, jb, s); });
        __syncthreads();
        if (!more) break;
        jb = jbn; cur ^= 1;
    }
}

DEVI void attn_store2(bf16_t* mix, size_t token0, int tokstride, int col0, int colstride, const f32x4 (&O)[4][4], const float (&sc)[4], int lane, bool accum) {
    const int quad = lane >> 4, l15 = lane & 15;
#pragma unroll
    for (int nt = 0; nt < 4; ++nt)
#pragma unroll
        for (int dt = 0; dt < 4; ++dt) {
            bf16_t* dst = mix + (token0 + nt * tokstride + l15) * DM + col0 + nt * colstride + dt * 16 + quad * 4;
            float a0 = O[dt][nt][0] * sc[nt], a1 = O[dt][nt][1] * sc[nt], a2 = O[dt][nt][2] * sc[nt], a3 = O[dt][nt][3] * sc[nt];
            if (accum) { const uint2 old = *(const uint2*)dst; a0 += bflo(old.x); a1 += bfhi(old.x); a2 += bflo(old.y); a3 += bfhi(old.y); }
            uint2 o; o.x = pk2(a0, a1); o.y = pk2(a2, a3);
            *(uint2*)dst = o;
        }
}

__device__ void nsa_unit(const Params& p, int L, int b, int g, int blk, char* lds) {
    const int tid = otid(), lane = tid & 63, w = tid >> 6, quad = lane >> 4, l15 = lane & 15;
    const bf16_t* proj = (const bf16_t*)(p.ws + OFF_BIG); const bf16_t* VT = (const bf16_t*)(p.ws + OFF_BIG + OFF_VT_IN_BIG);
    const float* gates = (const float*)(p.ws + OFF_GATES);
    bf16_t* mix = (bf16_t*)(p.ws + OFF_ACT);
    char* kvbuf = lds; float* impL = (float*)(lds + KV_BUF)  ; char* Qs = lds + 32768; u64* selm = (u64*)(lds + 65536);
    const int q0 = blk * 64; const int tq = q0 + w * 16 + l15; const size_t token = (size_t)b * 4096 + tq;
    const size_t token0 = (size_t)b * 4096 + q0 + w * 16;
    const int mixcol = 256 + g * 256;
#pragma unroll
    for (int t = 0; t < 8; ++t) { const int idx = t * 64 + lane, rr = idx >> 3, c = idx & 7, hh = rr >> 4, r16 = rr & 15;
        const uint4 v = *(const uint4*)(proj + (token0 + r16) * PJ_LD + 1024 + (g * 4 + hh) * 64 + c * 8);
        *(uint4*)(Qs + (hh * 64 + w * 16 + r16) * 128 + ((c ^ (r16 & 7)) << 4)) = v; }
    const char* ql = Qs + (w * 16 + l15) * 128; const int q0o = ((quad) ^ (l15 & 7)) << 4, q1o = ((4 + quad) ^ (l15 & 7)) << 4; const int qstride = 8192;
    __syncthreads();
    f32x4 O[4][4]; float m[4], l[4];
    const bf16_t* Kc = (const bf16_t*)(p.ws + OFF_KC) + (size_t)(b * 2 + g) * 256 * 64;
    const bf16_t* VcT = (const bf16_t*)(p.ws + OFF_VCT) + (size_t)(b * 2 + g) * 64 * 256;
    const int ncb = (4 * blk + 3 + 63) >> 6;
#pragma unroll
    for (int nt = 0; nt < 4; ++nt) { m[nt] = -1e30f; l[nt] = 0.f; }
    {
#pragma unroll 1
        for (int pass = 0; pass < 2; ++pass) {
            float inv[4]; float prevr = 0.f;
            if (pass == 1) {
#pragma unroll
                for (int nt = 0; nt < 4; ++nt) inv[nt] = 1.0f / fmaxf(l[nt], 1e-30f);
#pragma unroll
                for (int dt = 0; dt < 4; ++dt)
#pragma unroll
                    for (int nt = 0; nt < 4; ++nt) O[dt][nt] = (f32x4){0.f, 0.f, 0.f, 0.f};
            }
#pragma unroll 1
            for (int ct = 0; ct < ncb; ++ct) {
                tile_glds(Kc + (size_t)ct * 64 * 64, 64, VcT + ct * 64, 256, kvbuf, tid);
                __syncthreads();
                const char* buf = kvbuf;
#pragma unroll
                for (int kh = 0; kh < 2; ++kh) {
                    bf16x8 kf[2][2]; lds_kf(buf, kh, lane, kf);
                    if (pass == 0) {
#pragma unroll
                        for (int nt = 0; nt < 4; ++nt) {
                            f32x4 s0 = (f32x4){0.f, 0.f, 0.f, 0.f}, s1 = s0;
                            { const bf16x8 qa = *(const bf16x8*)(ql + nt * qstride + q0o), qb_ = *(const bf16x8*)(ql + nt * qstride + q1o);
                              s0 = mfma(kf[0][0], qa, s0); s1 = mfma(kf[1][0], qa, s1); s0 = mfma(kf[0][1], qb_, s0); s1 = mfma(kf[1][1], qb_, s1); }
                            float sv[8]; bool ok[8]; float mx = -1e30f;
#pragma unroll
                            for (int e = 0; e < 8; ++e) { sv[e] = (e < 4) ? s0[e & 3] : s1[e & 3]; const int n = ct * 64 + kh * 32 + (e >> 2) * 16 + quad * 4 + (e & 3);
                                ok[e] = (16 * n + 31 <= tq); if (ok[e]) mx = fmaxf(mx, sv[e]); }
                            mx = fmaxf(mx, __shfl_xor(mx, 16)); mx = fmaxf(mx, __shfl_xor(mx, 32));
                            const float mn = fmaxf(m[nt], mx), alpha = __builtin_amdgcn_exp2f(m[nt] - mn);
                            float rs = 0.f;
#pragma unroll
                            for (int e = 0; e < 8; ++e) rs += ok[e] ? __builtin_amdgcn_exp2f(sv[e] - mn) : 0.f;
                            rs += __shfl_xor(rs, 16); rs += __shfl_xor(rs, 32);
                            l[nt] = l[nt] * alpha + rs; m[nt] = mn;
                        }
                    } else {
                        bf16x8 vf[4]; lds_vf(buf, kh, lane, vf);
                        float As[2] = {0.f, 0.f}, p3[2] = {0.f, 0.f};
#pragma unroll
                        for (int nt = 0; nt < 4; ++nt) {
                            f32x4 s0 = (f32x4){0.f, 0.f, 0.f, 0.f}, s1 = s0;
                            { const bf16x8 qa = *(const bf16x8*)(ql + nt * qstride + q0o), qb_ = *(const bf16x8*)(ql + nt * qstride + q1o);
                              s0 = mfma(kf[0][0], qa, s0); s1 = mfma(kf[1][0], qa, s1); s0 = mfma(kf[0][1], qb_, s0); s1 = mfma(kf[1][1], qb_, s1); }
                            float pv[8];
#pragma unroll
                            for (int e = 0; e < 8; ++e) { const float s = (e < 4) ? s0[e & 3] : s1[e & 3]; const int n = ct * 64 + kh * 32 + (e >> 2) * 16 + quad * 4 + (e & 3);
                                pv[e] = (16 * n + 31 <= tq) ? __builtin_amdgcn_exp2f(s - m[nt]) * inv[nt] : 0.f; }
                            As[0] += (pv[0] + pv[1]) + (pv[2] + pv[3]); As[1] += (pv[4] + pv[5]) + (pv[6] + pv[7]); p3[0] += pv[3]; p3[1] += pv[7];
                            const bf16x8 P = mk8(pk2(pv[0], pv[1]), pk2(pv[2], pv[3]), pk2(pv[4], pv[5]), pk2(pv[6], pv[7]));
#pragma unroll
                            for (int dt = 0; dt < 4; ++dt) O[dt][nt] = mfma(vf[dt], P, O[dt][nt]);
                        }
                        const int qq = w * 16 + l15;
#pragma unroll
                        for (int t2 = 0; t2 < 2; ++t2) {
                            const float rr = __shfl(p3[t2], (lane + 48) & 63);
                            const float carry = (quad == 0) ? prevr : rr; prevr = rr;
                            const int jb = ct * 16 + kh * 8 + t2 * 4 + quad;
                            impL[jb * 64 + ((qq ^ jb) & 63)] = As[t2] + carry;
                        }
                    }
                }
                __syncthreads();
            }
        }
    }
    {
        const float4 gv = *(const float4*)(gates + token * 32 + 0 * 8 + g * 4);
        const float sc[4] = {gv.x, gv.y, gv.z, gv.w};
        attn_store2(mix, token0, 0, mixcol, 64, O, sc, lane, false);
    }
#pragma unroll 1
    for (int qi = 0; qi < 16; ++qi) {
        const int q = w * 16 + qi, jb = lane;
        float val = impL[jb * 64 + ((q ^ jb) & 63)];
        if (jb > blk) val = -1e30f;
        else if (jb == 0 || jb == blk || jb == blk - 1) val = 1e30f;
        int rank = 0;
        for (int jp = 0; jp < 64; ++jp) { const float vj = __shfl(val, jp); rank += ((vj > val) || (vj == val && jp < jb)) ? 1 : 0; }
        const bool sel = (rank < 16) && (val > -5e29f);
        const u64 mask = __ballot(sel);
        if (lane == 0) selm[q] = mask;
    }
    __syncthreads();
    u64 uni = 0;
    for (int q = 0; q < 64; ++q) uni |= selm[q];
    const u64 sm = selm[w * 16 + l15];
    {
#pragma unroll
        for (int nt = 0; nt < 4; ++nt) { m[nt] = -1e30f; l[nt] = 0.f; }
#pragma unroll
        for (int dt = 0; dt < 4; ++dt)
#pragma unroll
            for (int nt = 0; nt < 4; ++nt) O[dt][nt] = (f32x4){0.f, 0.f, 0.f, 0.f};
        const u64 tiles = uni & ((blk == 63) ? ~0ull : ((2ull << blk) - 1ull));
        attn_stream(tiles, proj + (size_t)b * 4096 * PJ_LD + 1792 + g * 64, PJ_LD, VT + ((size_t)((4 + g) * 8 + b) * 64) * 4096, 4096, kvbuf, 0, 63, ql, q0o, q1o, qstride, nullptr, O, m, l, tid, lane,
                    [&](int nt, float ckv, int key, int jb, float& s) { return (((sm >> jb) & 1ull) != 0) && (key <= tq); });
        const float4 gv = *(const float4*)(gates + token * 32 + 1 * 8 + g * 4);
        const float sc[4] = {gv.x / fmaxf(l[0], 1e-30f), gv.y / fmaxf(l[1], 1e-30f), gv.z / fmaxf(l[2], 1e-30f), gv.w / fmaxf(l[3], 1e-30f)};
        attn_store2(mix, token0, 0, mixcol, 64, O, sc, lane, true);
    }
    {
#pragma unroll
        for (int nt = 0; nt < 4; ++nt) { m[nt] = -1e30f; l[nt] = 0.f; }
#pragma unroll
        for (int dt = 0; dt < 4; ++dt)
#pragma unroll
            for (int nt = 0; nt < 4; ++nt) O[dt][nt] = (f32x4){0.f, 0.f, 0.f, 0.f};
        const int jlo = blk > 8 ? blk - 8 : 0;
        const u64 upto = (blk == 63) ? ~0ull : ((2ull << blk) - 1ull);
        const u64 tiles = upto & ~((1ull << jlo) - 1ull);
        attn_stream(tiles, proj + (size_t)b * 4096 * PJ_LD + 2048 + g * 64, PJ_LD, VT + ((size_t)((6 + g) * 8 + b) * 64) * 4096, 4096, kvbuf, 0, 63, ql, q0o, q1o, qstride, nullptr, O, m, l, tid, lane,
                    [&](int nt, float ckv, int key, int jb, float& s) { return (key <= tq) && (key + 512 > tq); });
        const float4 gv = *(const float4*)(gates + token * 32 + 2 * 8 + g * 4);
        const float sc[4] = {gv.x / fmaxf(l[0], 1e-30f), gv.y / fmaxf(l[1], 1e-30f), gv.z / fmaxf(l[2], 1e-30f), gv.w / fmaxf(l[3], 1e-30f)};
        attn_store2(mix, token0, 0, mixcol, 64, O, sc, lane, true);
    }
    __syncthreads();
}

__device__ void fox_unit(const Params& p, int L, int b, int h, int qb, char* lds) {
    const int tid = otid(), lane = tid & 63, w = tid >> 6, quad = lane >> 4, l15 = lane & 15;
    const bf16_t* proj = (const bf16_t*)(p.ws + OFF_BIG); const bf16_t* VT = (const bf16_t*)(p.ws + OFF_BIG + OFF_VT_IN_BIG);
    bf16_t* mix = (bf16_t*)(p.ws + OFF_ACT);
    const float* cc = (const float*)(p.ws + OFF_FOXC) + (size_t)(b * 4 + h) * 4096;
    const int q0 = qb * 256 + w * 64; const size_t token0 = (size_t)b * 4096 + q0;
    int tq[4]; float cq[4];
#pragma unroll
    for (int nt = 0; nt < 4; ++nt) { tq[nt] = q0 + nt * 16 + l15; cq[nt] = cc[tq[nt]]; }
    char* Qs = lds + 32768;
#pragma unroll
    for (int t = 0; t < 8; ++t) { const int idx = t * 64 + lane, rr = idx >> 3, c = idx & 7;
        const uint4 v = *(const uint4*)(proj + (token0 + rr) * PJ_LD + 2304 + h * 64 + c * 8);
        *(uint4*)(Qs + (w * 64 + rr) * 128 + ((c ^ (rr & 7)) << 4)) = v; }
    const char* ql = Qs + (w * 64 + l15) * 128; const int q0o = ((quad) ^ (l15 & 7)) << 4, q1o = ((4 + quad) ^ (l15 & 7)) << 4; const int qstride = 2048;
    __syncthreads();
    f32x4 O[4][4]; float m[4], l[4];
#pragma unroll
    for (int nt = 0; nt < 4; ++nt) { m[nt] = -1e30f; l[nt] = 0.f; }
#pragma unroll
    for (int dt = 0; dt < 4; ++dt)
#pragma unroll
        for (int nt = 0; nt < 4; ++nt) O[dt][nt] = (f32x4){0.f, 0.f, 0.f, 0.f};
    const int jmax = qb * 4 + 3;
    int jlo_w, jlo_b;
    { const float cq0 = cc[q0]; int lo = 0, hi = qb * 4 + w;
      while (lo < hi) { const int mid = (lo + hi) >> 1; if (cq0 - cc[mid * 64 + 63] >= -202.f) hi = mid; else lo = mid + 1; }
      jlo_w = lo; }
    { const float cq0 = cc[qb * 256]; int lo = 0, hi = qb * 4;
      while (lo < hi) { const int mid = (lo + hi) >> 1; if (cq0 - cc[mid * 64 + 63] >= -202.f) hi = mid; else lo = mid + 1; }
      jlo_b = lo; }
    const u64 tiles = ((jmax == 63) ? ~0ull : ((2ull << jmax) - 1ull)) & ~((1ull << jlo_b) - 1ull);
    attn_stream(tiles, proj + (size_t)b * 4096 * PJ_LD + 2560 + h * 64, PJ_LD, VT + ((size_t)((8 + h) * 8 + b) * 64) * 4096, 4096, lds, jlo_w, qb * 4 + w, ql, q0o, q1o, qstride, cc, O, m, l, tid, lane,
                [&](int nt, float ckv, int key, int jb, float& s) { s += cq[nt] - ckv; return key <= tq[nt]; });
    float sc[4];
#pragma unroll
    for (int nt = 0; nt < 4; ++nt) sc[nt] = 1.0f / fmaxf(l[nt], 1e-30f);
    attn_store2(mix, token0, 16, 768 + h * 64, 0, O, sc, lane, false);
}

__device__ void mixA_phase(const Params& p, int L, char* lds);
DEVI int next_unit(const Params& p, int idx, char* lds) {
    int* slot = (int*)(lds + LDS_BYTES - 16);
    const unsigned g = blockIdx.x & 7u;
    unsigned* ctr = (unsigned*)(p.ws + OFF_XBAR) + 10240 + (idx * 8 + (int)g) * 64;
    __syncthreads();
    if (otid() == 0) *slot = (int)(g + 8u * atomicAdd(ctr, 1u));
    __syncthreads();
    return *slot;
}
__device__ void mixA_phase(const Params& p, int L, char* lds) {
#pragma unroll 1
    for (;;) {
        const int job = next_unit(p, L * 4 + 3, lds); if (job >= 544 + 1024) break;
        if (job < 512) compress_unit(p, L, job, lds);
        else if (job < 544) foxc_job(p, L, job - 512, lds);
        else {
#pragma unroll 1
            for (int u = (job - 544) * 2; u < (job - 544) * 2 + 2; ++u) hgrn_a_unit(p, L, u, lds);
        }
    }
}
__device__ void mixB_phase(const Params& p, int L, char* lds) {
#pragma unroll 1
    for (;;) { const int f = next_unit(p, L * 4 + 0, lds); if (f >= 512) break; const int qb = 15 - (f >> 5), bh = f & 31; fox_unit(p, L, bh >> 2, bh & 3, qb, lds); }
#pragma unroll 1
    for (;;) { const int n = next_unit(p, L * 4 + 1, lds); if (n >= 1024) break; const int blk = 63 - (n >> 4), bg = n & 15; nsa_unit(p, L, bg >> 1, bg & 1, blk, lds); }
#pragma unroll 1
    for (;;) { const int c = next_unit(p, L * 4 + 2, lds); if (c >= 1024) break;
#pragma unroll 1
        for (int u = c * 2; u < c * 2 + 2; ++u) hgrn_c_unit(p, L, u, lds); }
}


#define XB_TMO      128
#define XB_XCNT(j)  (256  + 64 * (j))
#define XB_XSUB(j)  (1280 + 64 * (j))
#define XB_XGEN(j)  (2304 + 64 * (j))
#define XB_TOP      3328
#define XB_TOPGEN   3392
#define XCD_BAR_WORDS 3456
#define XB_SPIN_CAP (1u << 18)
#define LAS __attribute__((address_space(3)))
DEVI unsigned xb_ld(unsigned* p)              { return __hip_atomic_load(p, __ATOMIC_RELAXED, __HIP_MEMORY_SCOPE_AGENT); }
DEVI unsigned xb_add(unsigned* p, unsigned v) { return __hip_atomic_fetch_add(p, v, __ATOMIC_RELAXED, __HIP_MEMORY_SCOPE_AGENT); }
DEVI unsigned xb_xcc_id() { return (unsigned)__builtin_amdgcn_s_getreg((3 << 11) | 20) & 0xFu; }
#define XB_SPIN(cond, bar) do { unsigned _sp = 0; while (cond) { __builtin_amdgcn_s_sleep(1); \
    if ((++_sp & 255u) == 0u) { if (xb_ld(&(bar)[XB_TMO])) break; if (_sp > XB_SPIN_CAP) { atomicAdd(&(bar)[XB_TMO], 1u); break; } } } } while (0)
struct XcdBarrier { unsigned* bar; unsigned x; volatile LAS unsigned* st; };
DEVI XcdBarrier xcd_barrier_post(unsigned* bar, volatile LAS unsigned* st) {
    XcdBarrier b; b.bar = bar; b.x = xb_xcc_id(); b.st = st;
    if (threadIdx.x == 0) (void)xb_add(&bar[XB_XCNT(b.x)], 1u);
    return b;
}
DEVI void xcd_barrier_complete(unsigned* bar, unsigned x, unsigned& nloc, unsigned& nx) {
    const unsigned G = gridDim.x * gridDim.y * gridDim.z;
    unsigned sum, cnt, mine, sp = 0u;
    for (;;) {
        sum = 0u; cnt = 0u; mine = 0u;
#pragma unroll
        for (unsigned j = 0; j < 16; ++j) { const unsigned c = xb_ld(&bar[XB_XCNT(j)]); sum += c; cnt += (c > 0u) ? 1u : 0u; mine = (j == x) ? c : mine; }
        if (sum == G) break;
        __builtin_amdgcn_s_sleep(1);
        if ((++sp & 255u) == 0u) { if (xb_ld(&bar[XB_TMO])) break; if (sp > XB_SPIN_CAP) { atomicAdd(&bar[XB_TMO], 1u); break; } }
    }
    nloc = mine > 0u ? mine : 1u; nx = cnt > 0u ? cnt : 1u;
}
DEVI void xcd_barrier(const XcdBarrier& b) {
    __builtin_amdgcn_fence(__ATOMIC_RELEASE, "agent");
    asm volatile("s_waitcnt vmcnt(0)" ::: "memory");
    __syncthreads();
    if (threadIdx.x == 0) {
        unsigned* bar = b.bar;
        __builtin_amdgcn_s_waitcnt(0);
        unsigned nloc = b.st[0], nx = b.st[1];
        if (nloc == 0u) { xcd_barrier_complete(bar, b.x, nloc, nx); b.st[0] = nloc; b.st[1] = nx; }
        const unsigned old = xb_add(&bar[XB_XSUB(b.x)], 1u);
        const unsigned gen = old / nloc;
        if (old + 1u == (gen + 1u) * nloc) {
            __builtin_amdgcn_fence(__ATOMIC_RELEASE, "agent");
            asm volatile("s_waitcnt vmcnt(0)" ::: "memory");
            const unsigned og = xb_add(&bar[XB_TOP], 1u);
            const unsigned tg = og / nx;
            if (og + 1u == (tg + 1u) * nx) xb_add(&bar[XB_TOPGEN], 1u);
            else XB_SPIN(xb_ld(&bar[XB_TOPGEN]) == tg, bar);
            __builtin_amdgcn_fence(__ATOMIC_ACQUIRE, "agent");
            xb_add(&bar[XB_XGEN(b.x)], 1u);
            asm volatile("s_waitcnt vmcnt(0)" ::: "memory");
        } else {
            XB_SPIN(xb_ld(&bar[XB_XGEN(b.x)]) == gen, bar);
            __builtin_amdgcn_fence(__ATOMIC_ACQUIRE, "agent");
            asm volatile("s_waitcnt vmcnt(0)" ::: "memory");
        }
    }
    __syncthreads();
    __builtin_amdgcn_fence(__ATOMIC_ACQUIRE, "agent");
    asm volatile("s_waitcnt vmcnt(0)" ::: "memory");
}

__device__ void run_phase(const Params& p, int ph, char* lds) {
    if (ph == 0) { prep_phase(p, lds); return; }
    const int L = (ph - 1) / 7, s = (ph - 1) % 7;
    switch (s) {
        case 0: gemm_phase<EPI_PROJ>(p, L, lds); break;
        case 1: mixA_phase(p, L, lds); break;
        case 2: hgrn_scan_phase(p); break;
        case 3: mixB_phase(p, L, lds); break;
        case 4: gemm_phase<EPI_WO>(p, L, lds); break;
        case 5: gemm_phase<EPI_UP>(p, L, lds); break;
        default: gemm_phase<EPI_DOWN>(p, L, lds); break;
    }
}

__global__ void __launch_bounds__(256, 2) fwd_kernel(Params p, int ph_lo, int ph_hi) {
    __shared__ __attribute__((aligned(16))) char lds[LDS_BYTES];
    __shared__ uint4 xb_words;
    if (threadIdx.x == 0) xb_words = make_uint4(0u, 0u, 0u, 0u);
    __syncthreads();
    unsigned* bar = (unsigned*)(p.ws + OFF_XBAR);
    for (int ph = ph_lo; ph < ph_hi; ++ph) {
        run_phase(p, ph, lds);
        if (ph + 1 < ph_hi) {
            if (ph == ph_lo) cg::this_grid().sync();
            else {
                asm volatile("s_waitcnt vmcnt(0)" ::: "memory");
                __syncthreads();
                if (threadIdx.x == 0) {
                    unsigned* base = bar + ph * 640;
                    const unsigned g = blockIdx.x & 7u, G = gridDim.x;
                    const unsigned nper = (G >> 3) + ((g < (G & 7u)) ? 1u : 0u);
                    const unsigned ngrp = G < 8u ? G : 8u;
                    __builtin_amdgcn_fence(__ATOMIC_RELEASE, "agent");
                    asm volatile("s_waitcnt vmcnt(0)" ::: "memory");
                    if (__hip_atomic_fetch_add(base + g * 64, 1u, __ATOMIC_RELAXED, __HIP_MEMORY_SCOPE_AGENT) == nper - 1u) {
                        if (__hip_atomic_fetch_add(base + 8 * 64, 1u, __ATOMIC_RELAXED, __HIP_MEMORY_SCOPE_AGENT) == ngrp - 1u)
                            __hip_atomic_store(base + 9 * 64, 1u, __ATOMIC_RELAXED, __HIP_MEMORY_SCOPE_AGENT);
                    }
                    while (__hip_atomic_load(base + 9 * 64, __ATOMIC_RELAXED, __HIP_MEMORY_SCOPE_AGENT) == 0u) __builtin_amdgcn_s_sleep(1);
                    __builtin_amdgcn_fence(__ATOMIC_ACQUIRE, "agent");
                    asm volatile("s_waitcnt vmcnt(0)" ::: "memory");
                }
                __syncthreads();
            }
        }
    }
}

extern "C" void kernel_launch(void* const* d_in, const int* in_sizes, int n_in, void* d_out, int out_size, void* d_ws, size_t ws_size,
                              hipStream_t stream) {
    if (ws_size < WS_NEED) { fprintf(stderr, "workspace too small: %zu < %zu\n", ws_size, (size_t)WS_NEED); return; }
    Params p{};
    p.x = (const float*)d_in[0]; p.norm1_g = (const float*)d_in[1]; p.w_in = (const float*)d_in[2]; p.lb_logits = (const float*)d_in[3];
    p.onorm_g = (const float*)d_in[4]; p.nsa_qn_g = (const float*)d_in[5]; p.nsa_kn_g = (const float*)d_in[6]; p.cmp_pos = (const float*)d_in[7];
    p.cmp_w1 = (const float*)d_in[8]; p.cmp_w2 = (const float*)d_in[9]; p.fox_qn_g = (const float*)d_in[10]; p.fox_kn_g = (const float*)d_in[11];
    p.fox_fb = (const float*)d_in[12]; p.w_o = (const float*)d_in[13]; p.norm2_g = (const float*)d_in[14]; p.w_up = (const float*)d_in[15];
    p.w_down = (const float*)d_in[16];
    p.out = (float*)d_out; p.ws = (char*)d_ws;
#if MULTI_LAUNCH
    for (int ph = 0; ph < NPHASE; ++ph) hipLaunchKernelGGL(fwd_kernel, dim3(512), dim3(256), 0, stream, p, ph, ph + 1);
#else
    static int grid_blocks = 0;
    if (!grid_blocks) {
        int dev = 0, cus = 0, per_cu = 0;
        hipGetDevice(&dev);
        hipDeviceGetAttribute(&cus, hipDeviceAttributeMultiprocessorCount, dev);
        hipOccupancyMaxActiveBlocksPerMultiprocessor(&per_cu, fwd_kernel, 256, 0);
        per_cu = 2;
        grid_blocks = cus * per_cu;
        grid_blocks &= ~7;
    }
    int lo = 0, hi = NPHASE;
    void* args[] = {&p, &lo, &hi};
    hipError_t e = hipLaunchCooperativeKernel((void*)fwd_kernel, dim3(grid_blocks), dim3(256), args, 0, stream);
    if (e != hipSuccess) fprintf(stderr, "cooperative launch failed: %s (grid %d)\n", hipGetErrorString(e), grid_blocks);
#endif
}
```

```cpp
#include <hip/hip_runtime.h>
#include <hip/hip_cooperative_groups.h>
#include <stdint.h>
#include <cstdio>
namespace cg = cooperative_groups;

#ifndef MULTI_LAUNCH
#define MULTI_LAUNCH 0
#endif

typedef unsigned short bf16_t;
typedef short bf16x8 __attribute__((ext_vector_type(8)));
typedef float f32x4 __attribute__((ext_vector_type(4)));
typedef unsigned long long u64;
typedef __attribute__((address_space(3))) unsigned* ldsp_t;
typedef unsigned u32x16 __attribute__((ext_vector_type(16)));
typedef unsigned u32x8 __attribute__((ext_vector_type(8)));
#define DEVI __device__ __forceinline__

constexpr int T_TOK = 32768, SEQ = 4096, DM = 1024, DFF = 4096;
constexpr int PJ_LD = 3072;
constexpr int NW_IN = 3100, NW_IN_PAD = 3328;
constexpr int NPHASE = 15;

constexpr size_t OFF_WIN = 0;
constexpr size_t OFF_WO = OFF_WIN + (size_t)2 * NW_IN_PAD * 1024 * 2;
constexpr size_t OFF_WUP = OFF_WO + (size_t)2 * 1024 * 1024 * 2;
constexpr size_t OFF_WDN = OFF_WUP + (size_t)2 * 4096 * 1024 * 2;
constexpr size_t OFF_W1T = OFF_WDN + (size_t)2 * 4096 * 1024 * 2;
constexpr size_t OFF_W2T = OFF_W1T + (size_t)2 * 2 * 128 * 2048 * 2;
constexpr size_t OFF_CBIAS = OFF_W2T + (size_t)2 * 2 * 64 * 128 * 2;
constexpr size_t OFF_CTR = OFF_CBIAS + 2048;
constexpr size_t OFF_ROPE = OFF_CTR + 256;
constexpr size_t OFF_GATES = OFF_ROPE + (size_t)4096 * 16 * 4;
constexpr size_t OFF_FOXC = OFF_GATES + (size_t)T_TOK * 32 * 4;
constexpr size_t OFF_KC = OFF_FOXC + (size_t)8 * 4 * 4096 * 4;
constexpr size_t OFF_VCT = OFF_KC + (size_t)8 * 2 * 256 * 64 * 2;
constexpr size_t OFF_DECAY = OFF_VCT + (size_t)8 * 2 * 256 * 64 * 2;
constexpr size_t OFF_KVT = OFF_DECAY + (size_t)2048 * 64 * 4;
constexpr size_t OFF_ST = OFF_KVT + (size_t)2048 * 4096 * 4;
constexpr size_t OFF_ACT = OFF_ST + (size_t)2048 * 4096 * 2;
constexpr size_t OFF_BIG = OFF_ACT + (size_t)T_TOK * 1024 * 2;
constexpr size_t OFF_VT_IN_BIG = (size_t)T_TOK * PJ_LD * 2;
constexpr size_t OFF_ACT2 = OFF_BIG + (size_t)T_TOK * 4096 * 2;
constexpr size_t OFF_SSQ = OFF_ACT2 + (size_t)T_TOK * 1024 * 2;
constexpr size_t OFF_XBAR = OFF_SSQ + (size_t)T_TOK * 16 * 4;
constexpr size_t WS_NEED = OFF_XBAR + 65536;

constexpr int LDS_BYTES = 67584;

struct Params {
    const float *x, *norm1_g, *w_in, *lb_logits, *onorm_g, *nsa_qn_g, *nsa_kn_g, *cmp_pos, *cmp_w1, *cmp_w2,
        *fox_qn_g, *fox_kn_g, *fox_fb, *w_o, *norm2_g, *w_up, *w_down;
    float* out;
    char* ws;
};

DEVI unsigned pk2(float lo, float hi) { unsigned r; asm("v_cvt_pk_bf16_f32 %0, %1, %2" : "=v"(r) : "v"(lo), "v"(hi)); return r; }
DEVI bf16_t f2bf(float f) { return (bf16_t)(pk2(f, 0.f) & 0xffffu); }
DEVI float bf2f(bf16_t h) { return __uint_as_float(((unsigned)h) << 16); }
DEVI float bflo(unsigned u) { return __uint_as_float(u << 16); }
DEVI float bfhi(unsigned u) { return __uint_as_float(u & 0xffff0000u); }
DEVI f32x4 mfma(bf16x8 a, bf16x8 b, f32x4 c) { return __builtin_amdgcn_mfma_f32_16x16x32_bf16(a, b, c, 0, 0, 0); }
DEVI int otid() { int t; asm volatile("v_mov_b32 %0, %1" : "=v"(t) : "v"(threadIdx.x)); return t; }
DEVI float wave_sum(float v) {
#pragma unroll
    for (int o = 32; o >= 1; o >>= 1) v += __shfl_xor(v, o);
    return v;
}
DEVI bf16x8 mk8(unsigned a, unsigned b, unsigned c, unsigned d) {
    uint4 u = make_uint4(a, b, c, d);
    return *(bf16x8*)&u;
}
DEVI bf16x8 ld8(const bf16_t* p) { uint4 u = *(const uint4*)p; return *(bf16x8*)&u; }
DEVI bf16x8 ld4x2(const bf16_t* p0, const bf16_t* p1) {
    uint2 a = *(const uint2*)p0, b = *(const uint2*)p1;
    return mk8(a.x, a.y, b.x, b.y);
}

DEVI int win_colmap(int n) {
    if (n < 2304) return n;
    if (n < 3072) return n + 24;
    if (n < 3096) return n - 768;
    return n;
}
__device__ void transpose_tile(const float* __restrict__ src, int ld_src, bf16_t* __restrict__ dst, int ld_dst, int k0, int n0, int nvalid,
                               int colmode, float* tile) {
    const int tid = otid();
    {
        const int i = tid >> 2, jb = (tid & 3) * 16;
        const float* rowp = src + (size_t)(k0 + i) * ld_src;
        float4 v[4];
#pragma unroll
        for (int c = 0; c < 4; ++c) { const int n = n0 + jb + c * 4;
            v[c] = (n < nvalid) ? *(const float4*)(rowp + (colmode ? win_colmap(n) : n)) : make_float4(0.f, 0.f, 0.f, 0.f); }
#pragma unroll
        for (int c = 0; c < 4; ++c) { const int j = jb + c * 4;
            tile[(j + 0) * 65 + i] = v[c].x; tile[(j + 1) * 65 + i] = v[c].y; tile[(j + 2) * 65 + i] = v[c].z; tile[(j + 3) * 65 + i] = v[c].w; }
    }
    __syncthreads();
    {
        const int j = tid >> 2, ib = (tid & 3) * 16;
        const float* tp = tile + j * 65 + ib;
        unsigned pk[8];
#pragma unroll
        for (int e = 0; e < 8; ++e) pk[e] = pk2(tp[2 * e], tp[2 * e + 1]);
        bf16_t* dp = dst + (size_t)(n0 + j) * ld_dst + k0 + ib;
        *(uint4*)dp = make_uint4(pk[0], pk[1], pk[2], pk[3]);
        *(uint4*)(dp + 8) = make_uint4(pk[4], pk[5], pk[6], pk[7]);
    }
    __syncthreads();
}

__device__ void norm_phase(const float* __restrict__ xin, const float* __restrict__ g, bf16_t* __restrict__ hout) {
    const int tid = otid(); const int lane = tid & 63, w = tid >> 6;
    for (int row = blockIdx.x * 4 + w; row < T_TOK; row += gridDim.x * 4) {
        const float4* xr = (const float4*)(xin + (size_t)row * DM);
        float4 v[4]; float ss = 0.f;
#pragma unroll
        for (int i = 0; i < 4; ++i) { v[i] = xr[lane + 64 * i]; ss += v[i].x * v[i].x + v[i].y * v[i].y + v[i].z * v[i].z + v[i].w * v[i].w; }
        ss = wave_sum(ss);
        const float r = rsqrtf(ss * (1.0f / 1024.0f) + 1e-6f);
#pragma unroll
        for (int i = 0; i < 4; ++i) {
            const float4 gg = ((const float4*)g)[lane + 64 * i];
            uint2 o; o.x = pk2(v[i].x * r * gg.x, v[i].y * r * gg.y); o.y = pk2(v[i].z * r * gg.z, v[i].w * r * gg.w);
            *(uint2*)(hout + (size_t)row * DM + (lane + 64 * i) * 4) = o;
        }
    }
}

__device__ void prep_phase(const Params& p, char* lds) {
    float* tile = (float*)lds;
    if (blockIdx.x == 0 && otid() < 64) ((unsigned*)(p.ws + OFF_CTR))[otid()] = 0u;
    if (blockIdx.x == 1) { for (int i = otid(); i < 16384; i += 256) ((unsigned*)(p.ws + OFF_XBAR))[i] = 0u; }
    bf16_t* win_t = (bf16_t*)(p.ws + OFF_WIN); bf16_t* wo_t = (bf16_t*)(p.ws + OFF_WO);
    bf16_t* wup_t = (bf16_t*)(p.ws + OFF_WUP); bf16_t* wdn_t = (bf16_t*)(p.ws + OFF_WDN);
    bf16_t* w1t = (bf16_t*)(p.ws + OFF_W1T); bf16_t* w2t = (bf16_t*)(p.ws + OFF_W2T);
    const int J0 = 1664, J1 = J0 + 512, J2 = J1 + 2048, J3 = J2 + 2048, J4 = J3 + 256, J5 = J4 + 8, J6 = J5 + 128, J7 = J6 + 128;
    for (int job = blockIdx.x; job < J7; job += gridDim.x) {
        if (job < J0) { const int L = job / 832, r = job % 832, kt = r / 52, nt = r % 52;
            transpose_tile(p.w_in + (size_t)L * 1024 * NW_IN, NW_IN, win_t + (size_t)L * NW_IN_PAD * 1024, 1024, kt * 64, nt * 64, NW_IN, 1, tile);
        } else if (job < J1) { const int j = job - J0, L = j / 256, r = j % 256, kt = r / 16, nt = r % 16;
            transpose_tile(p.w_o + (size_t)L * 1024 * 1024, 1024, wo_t + (size_t)L * 1024 * 1024, 1024, kt * 64, nt * 64, 1024, 0, tile);
        } else if (job < J2) { const int j = job - J1, L = j / 1024, r = j % 1024, kt = r / 64, nt = r % 64;
            transpose_tile(p.w_up + (size_t)L * 1024 * 4096, 4096, wup_t + (size_t)L * 4096 * 1024, 1024, kt * 64, nt * 64, 4096, 0, tile);
        } else if (job < J3) { const int j = job - J2, L = j / 1024, r = j % 1024, kt = r / 16, nt = r % 16;
            transpose_tile(p.w_down + (size_t)L * 4096 * 1024, 1024, wdn_t + (size_t)L * 1024 * 4096, 4096, kt * 64, nt * 64, 1024, 0, tile);
        } else if (job < J4) { const int j = job - J3, lw = j / 64, r = j % 64, kt = r / 2, nt = r % 2;
            transpose_tile(p.cmp_w1 + (size_t)lw * 2048 * 128, 128, w1t + (size_t)lw * 128 * 2048, 2048, kt * 64, nt * 64, 128, 0, tile);
        } else if (job < J5) { const int j = job - J4, lw = j / 2, kt = j % 2;
            transpose_tile(p.cmp_w2 + (size_t)lw * 128 * 64, 64, w2t + (size_t)lw * 64 * 128, 128, kt * 64, 0, 64, 0, tile);
        } else if (job < J6) {
            const int t_ = otid(); const int o = (job - J5) * 4 + (t_ >> 6), lane = t_ & 63, lw = o >> 7, hid = o & 127;
            const float* pos = p.cmp_pos + (size_t)lw * 2048; const float* w1 = p.cmp_w1 + (size_t)lw * 2048 * 128 + hid;
            float s = 0.f;
            for (int k = lane; k < 2048; k += 64) s += pos[k] * w1[(size_t)k * 128];
            s = wave_sum(s);
            if (lane == 0) ((float*)(p.ws + OFF_CBIAS))[o] = s;
        } else {
            const int e = (job - J6) * 256 + otid(), pos = e >> 3, i = e & 7;
            const float invf[8] = {1.0f, 0.1939227432012558f, 0.03760603070259094f, 0.007292664609849453f, 0.0014142135623842478f,
                                   0.00027424818836152554f, 5.318296098266728e-05f, 1.0313386155758053e-05f};
            float fr = 1.0f;
#pragma unroll
            for (int q = 0; q < 8; ++q) if (i == q) fr = invf[q];
            const float ang = (float)pos * fr;
            const double a = (double)ang; const double n = rint(a * 0.15915494309189535); const float rr = (float)(a - n * 6.283185307179586);
            float* rt = (float*)(p.ws + OFF_ROPE);
            rt[pos * 16 + i] = __cosf(rr); rt[pos * 16 + 8 + i] = __sinf(rr);
        }
    }
    norm_phase(p.x, p.norm1_g, (bf16_t*)(p.ws + OFF_ACT));
}

enum { EPI_PROJ = 0, EPI_WO = 1, EPI_UP = 2, EPI_DOWN = 3 };

DEVI float row_rstd(const float* ssq, int m) {
    const float4 a = *(const float4*)(ssq + (size_t)m * 16), b = *(const float4*)(ssq + (size_t)m * 16 + 4), c = *(const float4*)(ssq + (size_t)m * 16 + 8), d = *(const float4*)(ssq + (size_t)m * 16 + 12);
    const float t = ((a.x + a.y) + (a.z + a.w)) + ((b.x + b.y) + (b.z + b.w)) + ((c.x + c.y) + (c.z + c.w)) + ((d.x + d.y) + (d.z + d.w));
    return rsqrtf(t * (1.0f / 1024.0f) + 1e-6f);
}

template <int CH>
DEVI void proj_epilogue(const Params& p, int L, const f32x4 (&acc)[4][8], int m0w, int cc, int lane) {
    const int quad = lane >> 4, l15 = lane & 15;
    bf16_t* proj = (bf16_t*)(p.ws + OFF_BIG); bf16_t* VT = (bf16_t*)(p.ws + OFF_BIG + OFF_VT_IN_BIG);
    float* gates = (float*)(p.ws + OFF_GATES); const float* rope = (const float*)(p.ws + OFF_ROPE);
    if (cc > 48) return;
    int kind = 0, vidx = 0; const float* gain = nullptr; float scale = 1.f; bool dorope = false;
    if (cc >= 8 && cc < 12) { kind = 5; vidx = cc - 8; }
    else if (cc >= 16 && cc < 24) { kind = 1; gain = p.nsa_qn_g + L * 64; scale = 0.125f * 1.4426950408889634f; dorope = true; }
    else if (cc == 28 || cc == 29 || cc == 32 || cc == 33) { kind = 1; gain = p.nsa_kn_g + L * 64; dorope = true; }
    else if (cc == 30 || cc == 31) { kind = 5; vidx = 4 + (cc - 30); }
    else if (cc == 34 || cc == 35) { kind = 5; vidx = 6 + (cc - 34); }
    else if (cc >= 36 && cc < 40) { kind = 1; gain = p.fox_qn_g + L * 64; scale = 0.125f * 1.4426950408889634f; }
    else if (cc >= 40 && cc < 44) { kind = 1; gain = p.fox_kn_g + L * 64; }
    else if (cc >= 44 && cc < 48) { kind = 5; vidx = 8 + (cc - 44); }
    else if (cc == 48) kind = 6;
#pragma unroll
    for (int mi = 0; mi < 4; ++mi) {
        const int token = m0w + mi * 16 + l15, pos = token & 4095, bb = token >> 12;
        const float rs = (L > 0) ? row_rstd((const float*)(p.ws + OFF_SSQ), token) : 1.0f;
        float v[4][4];
#pragma unroll
        for (int ni = 0; ni < 4; ++ni)
#pragma unroll
            for (int j = 0; j < 4; ++j) v[ni][j] = acc[mi][CH * 4 + ni][j] * rs;
        if (kind == 6) {
#pragma unroll
            for (int ni = 0; ni < 2; ++ni)
#pragma unroll
                for (int j = 0; j < 4; ++j) { const int d = ni * 16 + quad * 4 + j;
                    if (d < 24) gates[(size_t)token * 32 + d] = 1.0f / (1.0f + __expf(-v[ni][j]));
                    else if (d < 28) gates[(size_t)token * 32 + d] = v[ni][j]; }
            asm volatile("" ::: "memory");
            continue;
        }
        if (kind == 1) {
            float ss = 0.f;
#pragma unroll
            for (int ni = 0; ni < 4; ++ni)
#pragma unroll
                for (int j = 0; j < 4; ++j) ss += v[ni][j] * v[ni][j];
            ss += __shfl_xor(ss, 16); ss += __shfl_xor(ss, 32);
            const float r = rsqrtf(ss * (1.0f / 64.0f) + 1e-6f);
#pragma unroll
            for (int ni = 0; ni < 4; ++ni) { const float4 gg = *(const float4*)(gain + ni * 16 + quad * 4);
                v[ni][0] *= r * gg.x; v[ni][1] *= r * gg.y; v[ni][2] *= r * gg.z; v[ni][3] *= r * gg.w; }
            if (dorope) {
                const float4 cs = *(const float4*)(rope + pos * 16 + (quad & 1) * 4), sn = *(const float4*)(rope + pos * 16 + 8 + (quad & 1) * 4);
                const float cv[4] = {cs.x, cs.y, cs.z, cs.w}, sv[4] = {sn.x, sn.y, sn.z, sn.w};
#pragma unroll
                for (int j = 0; j < 4; ++j) { const float xx = v[0][j], pp = __shfl_xor(xx, 32);
                    v[0][j] = (quad < 2) ? (xx * cv[j] - pp * sv[j]) : (xx * cv[j] + pp * sv[j]); }
            }
#pragma unroll
            for (int ni = 0; ni < 4; ++ni)
#pragma unroll
                for (int j = 0; j < 4; ++j) v[ni][j] *= scale;
        }
        if (kind == 5) {
#pragma unroll
            for (int ni = 0; ni < 4; ++ni)
#pragma unroll
                for (int j = 0; j < 4; ++j) { const int d = ni * 16 + quad * 4 + j;
                    VT[((size_t)(vidx * 8 + bb) * 64 + d) * 4096 + pos] = f2bf(v[ni][j]); }
        } else {
#pragma unroll
            for (int ni = 0; ni < 4; ++ni) { uint2 o; o.x = pk2(v[ni][0], v[ni][1]); o.y = pk2(v[ni][2], v[ni][3]);
                *(uint2*)(proj + (size_t)token * PJ_LD + cc * 64 + ni * 16 + quad * 4) = o; }
        }
        asm volatile("" ::: "memory");
    }
}

DEVI void g_load(uint4 (&RA)[4], uint4 (&RB)[4], const bf16_t* Ap, const bf16_t* Bp, int K, int KT) {
#pragma unroll
    for (int i = 0; i < 4; ++i) { RA[i] = *(const uint4*)(Ap + (size_t)(32 * i) * K + KT * 64); RB[i] = *(const uint4*)(Bp + (size_t)(32 * i) * K + KT * 64); }
}
DEVI void g_swrite(const uint4 (&RA)[4], const uint4 (&RB)[4], char* d_) {
#pragma unroll
    for (int i = 0; i < 4; ++i) { *(uint4*)(d_ + i * 4096) = RA[i]; *(uint4*)(d_ + 16384 + i * 4096) = RB[i]; }
}
DEVI void g_compute(const char* sA, f32x4 (&acc)[4][4], int wm, int wn, int quad, int l15) {
    const char* sB = sA + 16384;
#pragma unroll
    for (int ks = 0; ks < 2; ++ks) {
        bf16x8 af[4], bfr[4]; const int ch = ks * 4 + quad;
#pragma unroll
        for (int mi = 0; mi < 4; ++mi) { const int row = wm * 64 + mi * 16 + l15; af[mi] = *(const bf16x8*)(sA + row * 128 + ((ch ^ (row & 7)) << 4)); }
#pragma unroll
        for (int ni = 0; ni < 4; ++ni) { const int row = wn * 64 + ni * 16 + l15; bfr[ni] = *(const bf16x8*)(sB + row * 128 + ((ch ^ (row & 7)) << 4)); }
#pragma unroll
        for (int mi = 0; mi < 4; ++mi)
#pragma unroll
            for (int ni = 0; ni < 4; ++ni) acc[mi][ni] = mfma(bfr[ni], af[mi], acc[mi][ni]);
    }
}

template <int EPI>
__device__ __forceinline__ void gemm_phase(const Params& p, int L, char* lds) {
    const bf16_t* A; const bf16_t* Bt; int K, nNt;
    if (EPI == EPI_PROJ) { A = (const bf16_t*)(p.ws + OFF_ACT); Bt = (const bf16_t*)(p.ws + OFF_WIN) + (size_t)L * NW_IN_PAD * 1024; K = 1024; nNt = NW_IN_PAD / 256; }
    else if (EPI == EPI_WO) { A = (const bf16_t*)(p.ws + OFF_ACT); Bt = (const bf16_t*)(p.ws + OFF_WO) + (size_t)L * 1024 * 1024; K = 1024; nNt = 4; }
    else if (EPI == EPI_UP) { A = (const bf16_t*)(p.ws + OFF_ACT2); Bt = (const bf16_t*)(p.ws + OFF_WUP) + (size_t)L * 4096 * 1024; K = 1024; nNt = 16; }
    else { A = (const bf16_t*)(p.ws + OFF_BIG); Bt = (const bf16_t*)(p.ws + OFF_WDN) + (size_t)L * 1024 * 4096; K = 4096; nNt = 4; }
    const int tid = otid(), lane = tid & 63, w = tid >> 6, quad = lane >> 4, l15 = lane & 15, wm = w >> 1, wn = w & 1;
    const int xcd = blockIdx.x & 7, loc = blockIdx.x >> 3, nloc = gridDim.x >> 3;
    const int nk = K / 32;
    const int gsw = (0x1230 >> (((l15 >> 2) & 3) * 4)) & 3;
    const int rsw = (quad ^ gsw) << 4;
    for (int it = loc; it < 32 * nNt; it += nloc) {
        const int tl = otid();
        const int lrow = tl >> 2, lc = tl & 3;
        const int woff = lrow * 64 + ((lc ^ ((0x1230 >> (((lrow >> 2) & 3) * 4)) & 3)) << 4);
        const int gsz = 8 * nNt, mloc = (it / gsz) * 8 + (it & 7), nloc_t = (it % gsz) >> 3;
        const int m0 = (xcd + 8 * mloc) * 128, n0 = nloc_t * 256;
        f32x4 acc[4][8];
#pragma unroll
        for (int a = 0; a < 4; ++a)
#pragma unroll
            for (int b = 0; b < 8; ++b) acc[a][b] = (f32x4){0.f, 0.f, 0.f, 0.f};
        u32x8 ra0, ra1; u32x16 rb0, rb1;
        const bf16_t* Ap = A + (size_t)(m0 + lrow) * K + lc * 8;
        const bf16_t* Bp = Bt + (size_t)(n0 + lrow) * K + lc * 8;
#define G_LD1(R, P, I, KT) { const uint4 t_ = *(const uint4*)((P) + (size_t)(64 * I) * K + (KT) * 32); R[4 * I] = t_.x; R[4 * I + 1] = t_.y; R[4 * I + 2] = t_.z; R[4 * I + 3] = t_.w; }
#define G_LOAD(RA, RB, KT) { G_LD1(RA, Ap, 0, KT) G_LD1(RB, Bp, 0, KT) G_LD1(RA, Ap, 1, KT) G_LD1(RB, Bp, 1, KT) G_LD1(RB, Bp, 2, KT) G_LD1(RB, Bp, 3, KT) }
#define G_SW1(R, D, I) *(uint4*)((D) + I * 4096) = make_uint4(R[4 * I], R[4 * I + 1], R[4 * I + 2], R[4 * I + 3]);
#define G_SWRITE(RA, RB, DST) { G_SW1(RA, DST, 0) G_SW1(RB, (DST) + 8192, 0) G_SW1(RA, DST, 1) G_SW1(RB, (DST) + 8192, 1) G_SW1(RB, (DST) + 8192, 2) G_SW1(RB, (DST) + 8192, 3) }
#define G_COMPUTE(BUF) { const char* sA_ = (BUF) + (wm * 64 + l15) * 64 + rsw; const char* sB_ = (BUF) + 8192 + (wn * 128 + l15) * 64 + rsw; \
            bf16x8 af[4]; \
            _Pragma("unroll") for (int i_ = 0; i_ < 4; ++i_) af[i_] = *(const bf16x8*)(sA_ + i_ * 1024); \
            _Pragma("unroll") for (int nh = 0; nh < 2; ++nh) { bf16x8 bfr[4]; \
                _Pragma("unroll") for (int i_ = 0; i_ < 4; ++i_) bfr[i_] = *(const bf16x8*)(sB_ + (nh * 4 + i_) * 1024); \
                _Pragma("unroll") for (int mi = 0; mi < 4; ++mi) _Pragma("unroll") for (int ni = 0; ni < 4; ++ni) acc[mi][nh * 4 + ni] = mfma(bfr[ni], af[mi], acc[mi][nh * 4 + ni]); } }
        G_LOAD(ra0, rb0, 0)
        G_LOAD(ra1, rb1, 1)
        G_SWRITE(ra0, rb0, lds + woff)
        __syncthreads();
#pragma unroll 1
        for (int kt = 0; kt < nk - 2; kt += 2) {
            G_LOAD(ra0, rb0, kt + 2)
            __builtin_amdgcn_sched_barrier(0);
            G_COMPUTE(lds)
            G_SWRITE(ra1, rb1, lds + 24576 + woff)
            __syncthreads();
            G_LOAD(ra1, rb1, kt + 3)
            __builtin_amdgcn_sched_barrier(0);
            G_COMPUTE(lds + 24576)
            G_SWRITE(ra0, rb0, lds + woff)
            __syncthreads();
        }
        G_COMPUTE(lds)
        G_SWRITE(ra1, rb1, lds + 24576 + woff)
        __syncthreads();
        G_COMPUTE(lds + 24576)
        __syncthreads();
#undef G_LOAD
#undef G_SWRITE
#undef G_LD1
#undef G_SW1
#undef G_COMPUTE
        const int te = otid(); const int lane_e = te & 63, quad_e = lane_e >> 4, l15_e = lane_e & 15;
        const int mw = m0 + ((te >> 7) & 1) * 64, nw = n0 + ((te >> 6) & 1) * 128;
        if (EPI == EPI_PROJ) {
            proj_epilogue<0>(p, L, acc, mw, (nw >> 6), lane_e);
            proj_epilogue<1>(p, L, acc, mw, (nw >> 6) + 1, lane_e);
        } else if (EPI == EPI_UP) {
            bf16_t* hid = (bf16_t*)(p.ws + OFF_BIG);
#pragma unroll
            for (int mi = 0; mi < 4; ++mi) { const int m = mw + mi * 16 + l15_e; const float r = row_rstd((const float*)(p.ws + OFF_SSQ), m);
#pragma unroll
                for (int ni = 0; ni < 8; ++ni) { const int n = nw + ni * 16 + quad_e * 4;
                    float a0 = fmaxf(acc[mi][ni][0] * r, 0.f), a1 = fmaxf(acc[mi][ni][1] * r, 0.f), a2 = fmaxf(acc[mi][ni][2] * r, 0.f), a3 = fmaxf(acc[mi][ni][3] * r, 0.f);
                    uint2 o; o.x = pk2(a0 * a0, a1 * a1); o.y = pk2(a2 * a2, a3 * a3);
                    *(uint2*)(hid + (size_t)m * DFF + n) = o; } }
        } else {
            const float* xin = (EPI == EPI_WO && L == 0) ? p.x : p.out;
            const bool emit = (EPI == EPI_WO) || (L + 1 < 2);
            const float* gn = (EPI == EPI_WO) ? (p.norm2_g + L * 1024) : (p.norm1_g + (L + 1 < 2 ? L + 1 : L) * 1024);
            bf16_t* hn = (bf16_t*)(p.ws + ((EPI == EPI_WO) ? OFF_ACT2 : OFF_ACT));
            float* ssq = (float*)(p.ws + OFF_SSQ);
#pragma unroll
            for (int mi = 0; mi < 4; ++mi) {
#pragma unroll
                for (int hf = 0; hf < 2; ++hf) {
                    const int t3 = otid(); const int l15_e = t3 & 15, quad_e = (t3 >> 4) & 3;
                    const int m = mw + mi * 16 + l15_e;
                    float ss = 0.f;
#pragma unroll
                    for (int n4 = 0; n4 < 4; ++n4) { const int ni = hf * 4 + n4; const int n = nw + ni * 16 + quad_e * 4;
                        float4 xv = *(const float4*)(xin + (size_t)m * DM + n);
                        xv.x += acc[mi][ni][0]; xv.y += acc[mi][ni][1]; xv.z += acc[mi][ni][2]; xv.w += acc[mi][ni][3];
                        *(float4*)(p.out + (size_t)m * DM + n) = xv;
                        if (emit) { const float4 gg = *(const float4*)(gn + n);
                            uint2 o; o.x = pk2(xv.x * gg.x, xv.y * gg.y); o.y = pk2(xv.z * gg.z, xv.w * gg.w);
                            *(uint2*)(hn + (size_t)m * DM + n) = o;
                            ss += (xv.x * xv.x + xv.y * xv.y) + (xv.z * xv.z + xv.w * xv.w); } }
                    if (emit) { ss += __shfl_xor(ss, 16); ss += __shfl_xor(ss, 32);
                        if (quad_e == 0) ssq[(size_t)m * 16 + ((nw >> 6) + hf)] = ss; }
                    asm volatile("" ::: "memory");
                }
            }
        }
    }
}

DEVI float hgrn_lb(const Params& p, int L, int hk) {
    if (L == 0) return 0.f;
    const float l0 = p.lb_logits[hk], l1 = p.lb_logits[256 + hk];
    return 1.0f / (1.0f + __expf(l0 - l1));
}

__device__ void hgrn_a_unit(const Params& p, int L, int u, char* lds) {
    const int tid = otid(), lane = tid & 63, w = tid >> 6, quad = lane >> 4, l15 = lane & 15;
    const int c = u & 63, h = (u >> 6) & 3, b = u >> 8;
    const bf16_t* proj = (const bf16_t*)(p.ws + OFF_BIG); const bf16_t* VT = (const bf16_t*)(p.ws + OFF_BIG + OFF_VT_IN_BIG);
    float* segtot = (float*)lds;
    bf16_t* KDt = (bf16_t*)(lds + 1024);
    const int k = tid & 63, seg = tid >> 6;
    const float lb = hgrn_lb(p, L, h * 64 + k);
    float gl[16], kkv[16]; float run = 0.f;
    const bf16_t* zp = proj + (size_t)(b * 4096 + c * 64 + seg * 16) * PJ_LD + 256 + h * 64 + k;
#pragma unroll
    for (int i = 0; i < 16; ++i) {
        const float z = bf2f(zp[(size_t)i * PJ_LD]);
        const float sg = 1.0f / (1.0f + __expf(-z)), sn = 1.0f / (1.0f + __expf(z));
        const float f = lb + (1.0f - lb) * sg;
        run += __builtin_amdgcn_logf(fmaxf(f, 1e-30f));        gl[i] = run; kkv[i] = (1.0f - lb) * sn;
    }
    segtot[seg * 64 + k] = run;
    __syncthreads();
    float off = 0.f, tot = 0.f;
#pragma unroll
    for (int s = 0; s < 4; ++s) { const float t = segtot[s * 64 + k]; tot += t; if (s < seg) off += t; }
    unsigned pkd[8];
#pragma unroll
    for (int i = 0; i < 8; ++i) {
        const float a0 = kkv[2 * i] * __builtin_amdgcn_exp2f(tot - (off + gl[2 * i])), a1 = kkv[2 * i + 1] * __builtin_amdgcn_exp2f(tot - (off + gl[2 * i + 1]));
        pkd[i] = pk2(a0, a1);
    }
    *(uint4*)(KDt + k * 72 + seg * 16) = make_uint4(pkd[0], pkd[1], pkd[2], pkd[3]);
    *(uint4*)(KDt + k * 72 + seg * 16 + 8) = make_uint4(pkd[4], pkd[5], pkd[6], pkd[7]);
    if (seg == 0) ((float*)(p.ws + OFF_DECAY))[u * 64 + k] = __builtin_amdgcn_exp2f(tot);
    __syncthreads();
    const bf16_t* vt = VT + ((size_t)(h * 8 + b) * 64) * 4096 + c * 64;
    float* kvt = (float*)(p.ws + OFF_KVT) + (size_t)u * 4096;
    bf16x8 af[2];
#pragma unroll
    for (int ks = 0; ks < 2; ++ks) af[ks] = ld8(vt + (size_t)(w * 16 + l15) * 4096 + ks * 32 + quad * 8);
#pragma unroll
    for (int kt = 0; kt < 4; ++kt) {
        f32x4 acc = (f32x4){0.f, 0.f, 0.f, 0.f};
#pragma unroll
        for (int ks = 0; ks < 2; ++ks) { const bf16x8 bfr = *(const bf16x8*)(KDt + (kt * 16 + l15) * 72 + ks * 32 + quad * 8); acc = mfma(af[ks], bfr, acc); }
#pragma unroll
        for (int j = 0; j < 4; ++j) kvt[(w * 16 + quad * 4 + j) * 64 + kt * 16 + l15] = acc[j];
    }
    __syncthreads();
}

__device__ void hgrn_scan_phase(const Params& p) {
    const float* kvt = (const float*)(p.ws + OFF_KVT); const float* dec = (const float*)(p.ws + OFF_DECAY);
    bf16_t* st = (bf16_t*)(p.ws + OFF_ST);
    for (int e = blockIdx.x * 256 + otid(); e < 32 * 4096; e += gridDim.x * 256) {
        const int bh = e >> 12, vk = e & 4095, k = vk & 63;
        float S = 0.f;
#pragma unroll 8
        for (int c = 0; c < 64; ++c) {
            const int u = bh * 64 + c;
            st[(size_t)u * 4096 + vk] = f2bf(S);
            S = S * dec[u * 64 + k] + kvt[(size_t)u * 4096 + vk];
        }
    }
}

__device__ void hgrn_c_unit(const Params& p, int L, int u, char* lds) {
    const int tid = otid(), lane = tid & 63, w = tid >> 6, quad = lane >> 4, l15 = lane & 15;
    const int c = u & 63, h = (u >> 6) & 3, b = u >> 8;
    const bf16_t* proj = (const bf16_t*)(p.ws + OFF_BIG); const bf16_t* VT = (const bf16_t*)(p.ws + OFF_BIG + OFF_VT_IN_BIG);
    float* Gs = (float*)lds; float* KKs = Gs + 64 * 65; float* Qs = KKs + 64 * 65; float* segtot = Qs + 64 * 65;
    {
        const int k = tid & 63, seg = tid >> 6;
        const float lb = hgrn_lb(p, L, h * 64 + k);
        float gl[16], kkv[16]; float run = 0.f;
        const bf16_t* zp = proj + (size_t)(b * 4096 + c * 64 + seg * 16) * PJ_LD + 256 + h * 64 + k;
#pragma unroll
        for (int i = 0; i < 16; ++i) {
            const float z = bf2f(zp[(size_t)i * PJ_LD]);
            const float sg = 1.0f / (1.0f + __expf(-z)), sn = 1.0f / (1.0f + __expf(z));
            const float f = lb + (1.0f - lb) * sg;
            run += __builtin_amdgcn_logf(fmaxf(f, 1e-30f));        gl[i] = run; kkv[i] = (1.0f - lb) * sn;
            Qs[(seg * 16 + i) * 65 + k] = bf2f(zp[(size_t)i * PJ_LD - 256]) * 0.125f;
        }
        segtot[seg * 64 + k] = run;
        __syncthreads();
        float off = 0.f;
#pragma unroll
        for (int s = 0; s < 4; ++s) { const float t = segtot[s * 64 + k]; if (s < seg) off += t; }
#pragma unroll
        for (int i = 0; i < 16; ++i) { Gs[(seg * 16 + i) * 65 + k] = off + gl[i]; KKs[(seg * 16 + i) * 65 + k] = kkv[i]; }
        __syncthreads();
    }
    const int I = w;
    const int tq = 16 * I + l15;
    bf16x8 qt[2], qg[2];
#pragma unroll
    for (int ks = 0; ks < 2; ++ks) {
        float a[8], g8[8];
#pragma unroll
        for (int j = 0; j < 8; ++j) {
            const int k = ks * 32 + quad * 8 + j;
            const float G = Gs[tq * 65 + k], q = Qs[tq * 65 + k];
            const float gref = (I == 0) ? 0.f : Gs[(16 * I - 1) * 65 + k];
            a[j] = q * __builtin_amdgcn_exp2f(G - gref); g8[j] = q * __builtin_amdgcn_exp2f(G);
        }
        qt[ks] = mk8(pk2(a[0], a[1]), pk2(a[2], a[3]), pk2(a[4], a[5]), pk2(a[6], a[7]));
        qg[ks] = mk8(pk2(g8[0], g8[1]), pk2(g8[2], g8[3]), pk2(g8[4], g8[5]), pk2(g8[6], g8[7]));
    }
    f32x4 O[4];
#pragma unroll
    for (int vt = 0; vt < 4; ++vt) O[vt] = (f32x4){0.f, 0.f, 0.f, 0.f};
    const bf16_t* st = (const bf16_t*)(p.ws + OFF_ST) + (size_t)u * 4096;
#pragma unroll
    for (int vt = 0; vt < 4; ++vt)
#pragma unroll
        for (int ks = 0; ks < 2; ++ks) O[vt] = mfma(ld8(st + (vt * 16 + l15) * 64 + ks * 32 + quad * 8), qg[ks], O[vt]);
    const bf16_t* vtp = VT + ((size_t)(h * 8 + b) * 64) * 4096 + c * 64;
    for (int Jp = 0; Jp <= (I >> 1); ++Jp) {
        f32x4 sc[2];
#pragma unroll
        for (int jj = 0; jj < 2; ++jj) {
            const int J = 2 * Jp + jj;
            sc[jj] = (f32x4){0.f, 0.f, 0.f, 0.f};
            if (J <= I) {
                const int s = 16 * J + l15;
#pragma unroll
                for (int ks = 0; ks < 2; ++ks) {
                    float a[8];
#pragma unroll
                    for (int j = 0; j < 8; ++j) {
                        const int k = ks * 32 + quad * 8 + j;
                        const float gref = (I == 0) ? 0.f : Gs[(16 * I - 1) * 65 + k];
                        a[j] = KKs[s * 65 + k] * __builtin_amdgcn_exp2f(gref - Gs[s * 65 + k]);
                    }
                    sc[jj] = mfma(mk8(pk2(a[0], a[1]), pk2(a[2], a[3]), pk2(a[4], a[5]), pk2(a[6], a[7])), qt[ks], sc[jj]);
                }
#pragma unroll
                for (int j = 0; j < 4; ++j) { const int s2 = 16 * J + quad * 4 + j; if (s2 > tq) sc[jj][j] = 0.f; }
            }
        }
        const bf16x8 P = mk8(pk2(sc[0][0], sc[0][1]), pk2(sc[0][2], sc[0][3]), pk2(sc[1][0], sc[1][1]), pk2(sc[1][2], sc[1][3]));
#pragma unroll
        for (int vt = 0; vt < 4; ++vt) {
            const bf16_t* r = vtp + (size_t)(vt * 16 + l15) * 4096 + 32 * Jp + quad * 4;
            O[vt] = mfma(ld4x2(r, r + 16), P, O[vt]);
        }
    }
    float ss = 0.f;
#pragma unroll
    for (int vt = 0; vt < 4; ++vt)
#pragma unroll
        for (int j = 0; j < 4; ++j) ss += O[vt][j] * O[vt][j];
    ss += __shfl_xor(ss, 16); ss += __shfl_xor(ss, 32);
    const float r = rsqrtf(ss * (1.0f / 64.0f) + 1e-6f);
    const size_t token = (size_t)b * 4096 + c * 64 + tq;
    bf16_t* mix = (bf16_t*)(p.ws + OFF_ACT);
#pragma unroll
    for (int vt = 0; vt < 4; ++vt) {
        const int v0 = vt * 16 + quad * 4;
        const float4 og = *(const float4*)(p.onorm_g + L * 64 + v0);
        const uint2 gz = *(const uint2*)(proj + token * PJ_LD + 768 + h * 64 + v0);
        const float g0 = bflo(gz.x), g1 = bfhi(gz.x), g2 = bflo(gz.y), g3 = bfhi(gz.y);
        const float o0 = O[vt][0] * r * og.x * (g0 / (1.0f + __expf(-g0))), o1 = O[vt][1] * r * og.y * (g1 / (1.0f + __expf(-g1)));
        const float o2 = O[vt][2] * r * og.z * (g2 / (1.0f + __expf(-g2))), o3 = O[vt][3] * r * og.w * (g3 / (1.0f + __expf(-g3)));
        uint2 o; o.x = pk2(o0, o1); o.y = pk2(o2, o3);
        *(uint2*)(mix + token * DM + h * 64 + v0) = o;
    }
    __syncthreads();
}

__device__ void compress_unit(const Params& p, int L, int u, char* lds) {
    const int tid = otid(), lane = tid & 63, w = tid >> 6, quad = lane >> 4, l15 = lane & 15;
    const int which = u & 1, g = (u >> 1) & 1, b = (u >> 2) & 7, rt = u >> 5;
    const bf16_t* proj = (const bf16_t*)(p.ws + OFF_BIG);
    const bf16_t* w1t = (const bf16_t*)(p.ws + OFF_W1T) + (size_t)(L * 2 + which) * 128 * 2048;
    const bf16_t* w2t = (const bf16_t*)(p.ws + OFF_W2T) + (size_t)(L * 2 + which) * 64 * 128;
    const float* cbias = (const float*)(p.ws + OFF_CBIAS) + (L * 2 + which) * 128;
    float* red = (float*)lds;
    bf16_t* Hs = (bf16_t*)(lds + 32768);
    float* outb = (float*)(lds + 40960);
    const int nrow = rt * 16 + l15;
    int tokbase = 16 * nrow; if (tokbase > 4096 - 32) tokbase = 4096 - 32;
    const bf16_t* xa = proj + ((size_t)b * 4096 + tokbase) * PJ_LD + (which ? 1664 : 1536) + g * 64;
    f32x4 acc[8];
#pragma unroll
    for (int i = 0; i < 8; ++i) acc[i] = (f32x4){0.f, 0.f, 0.f, 0.f};
#pragma unroll 2
    for (int kq = 0; kq < 16; ++kq) {
        const int kk = w * 16 + kq, l = kk >> 1, d = (kk & 1) * 32 + quad * 8;
        const bf16x8 a = ld8(xa + (size_t)l * PJ_LD + d);
#pragma unroll
        for (int ni = 0; ni < 8; ++ni) acc[ni] = mfma(a, ld8(w1t + (size_t)(ni * 16 + l15) * 2048 + kk * 32 + quad * 8), acc[ni]);
    }
#pragma unroll
    for (int ni = 0; ni < 8; ++ni)
#pragma unroll
        for (int j = 0; j < 4; ++j) red[(w * 16 + quad * 4 + j) * 128 + ni * 16 + l15] = acc[ni][j];
    __syncthreads();
    {
        const int row = tid >> 4, c0 = (tid & 15) * 8;
        float x[8];
#pragma unroll
        for (int i = 0; i < 8; ++i) x[i] = cbias[c0 + i];
#pragma unroll
        for (int ww = 0; ww < 4; ++ww) { const float4 a0 = *(const float4*)(red + (ww * 16 + row) * 128 + c0), a1 = *(const float4*)(red + (ww * 16 + row) * 128 + c0 + 4);
            x[0] += a0.x; x[1] += a0.y; x[2] += a0.z; x[3] += a0.w; x[4] += a1.x; x[5] += a1.y; x[6] += a1.z; x[7] += a1.w; }
        unsigned pk[4];
#pragma unroll
        for (int i = 0; i < 4; ++i) { float y[2];
#pragma unroll
            for (int t = 0; t < 2; ++t) { const float xv = x[2 * i + t]; const float uu = 0.7978845608028654f * (xv + 0.044715f * xv * xv * xv);
                const float th = 1.0f - 2.0f / (1.0f + __expf(2.0f * uu)); y[t] = 0.5f * xv * (1.0f + th); }
            pk[i] = pk2(y[0], y[1]); }
        *(uint4*)(Hs + row * 136 + c0) = make_uint4(pk[0], pk[1], pk[2], pk[3]);
    }
    __syncthreads();
    {
        f32x4 o = (f32x4){0.f, 0.f, 0.f, 0.f};
#pragma unroll
        for (int ks = 0; ks < 4; ++ks) o = mfma(*(const bf16x8*)(Hs + l15 * 136 + ks * 32 + quad * 8), ld8(w2t + (size_t)(w * 16 + l15) * 128 + ks * 32 + quad * 8), o);
#pragma unroll
        for (int j = 0; j < 4; ++j) outb[(quad * 4 + j) * 64 + w * 16 + l15] = o[j];
    }
    __syncthreads();
    if (which == 0) {
        bf16_t* kc = (bf16_t*)(p.ws + OFF_KC) + (size_t)(b * 2 + g) * 256 * 64;
        const float* rope = (const float*)(p.ws + OFF_ROPE);
        const int row = tid >> 4, c4 = tid & 15, n = rt * 16 + row;
        const float4 xv = *(const float4*)(outb + row * 64 + c4 * 4);
        float ss = (xv.x * xv.x + xv.y * xv.y) + (xv.z * xv.z + xv.w * xv.w);
        ss += __shfl_xor(ss, 1); ss += __shfl_xor(ss, 2); ss += __shfl_xor(ss, 4); ss += __shfl_xor(ss, 8);
        const float r = rsqrtf(ss * (1.0f / 64.0f) + 1e-6f);
        const float4 gg = *(const float4*)(p.nsa_kn_g + L * 64 + c4 * 4);
        float v[4] = {xv.x * r * gg.x, xv.y * r * gg.y, xv.z * r * gg.z, xv.w * r * gg.w};
        int pos = 16 * n + 31; if (pos > 4095) pos = 4095;
        const float4 cs = *(const float4*)(rope + pos * 16 + (c4 & 1) * 4), sn = *(const float4*)(rope + pos * 16 + 8 + (c4 & 1) * 4);
        const float csv[4] = {cs.x, cs.y, cs.z, cs.w}, snv[4] = {sn.x, sn.y, sn.z, sn.w};
#pragma unroll
        for (int i = 0; i < 4; ++i) { const float pp = __shfl_xor(v[i], 2);
            if (c4 < 4) v[i] = (c4 < 2) ? (v[i] * csv[i] - pp * snv[i]) : (v[i] * csv[i] + pp * snv[i]); }
        uint2 ov; ov.x = pk2(v[0], v[1]); ov.y = pk2(v[2], v[3]);
        if (n >= 255) { ov.x = 0u; ov.y = 0u; }
        *(uint2*)(kc + (size_t)n * 64 + c4 * 4) = ov;
    } else {
        bf16_t* vct = (bf16_t*)(p.ws + OFF_VCT) + (size_t)(b * 2 + g) * 64 * 256;
        const int d = tid >> 2, r0 = (tid & 3) * 4, nb = rt * 16 + r0;
        float v0 = outb[(r0 + 0) * 64 + d], v1 = outb[(r0 + 1) * 64 + d], v2 = outb[(r0 + 2) * 64 + d], v3 = outb[(r0 + 3) * 64 + d];
        if (nb + 3 >= 255) v3 = 0.f;
        uint2 ov; ov.x = pk2(v0, v1); ov.y = pk2(v2, v3);
        *(uint2*)(vct + (size_t)d * 256 + nb) = ov;
    }
    __syncthreads();
}

__device__ void foxc_job(const Params& p, int L, int bh, char* lds) {
    const int tid = otid(), lane = tid & 63, w = tid >> 6, b = bh >> 2, h = bh & 3;
    const float* gates = (const float*)(p.ws + OFF_GATES);
    float* cc = (float*)(p.ws + OFF_FOXC) + (size_t)bh * 4096;
    float* wtot = (float*)lds;
    const float fb = p.fox_fb[L * 4 + h];
    float v[16];
#pragma unroll
    for (int i = 0; i < 16; ++i) v[i] = gates[((size_t)b * 4096 + tid * 16 + i) * 32 + 24 + h] + fb;
    float run = 0.f;
#pragma unroll
    for (int i = 0; i < 16; ++i) { const float x = v[i]; run += (x >= 0.f) ? -log1pf(__expf(-x)) : (x - log1pf(__expf(x))); v[i] = run; }
    float incl = run;
#pragma unroll
    for (int o = 1; o < 64; o <<= 1) { const float t = __shfl_up(incl, o); if (lane >= o) incl += t; }
    if (lane == 63) wtot[w] = incl;
    __syncthreads();
    float pre = incl - run;
#pragma unroll
    for (int s = 0; s < 4; ++s) if (s < w) pre += wtot[s];
#pragma unroll
    for (int i = 0; i < 4; ++i) { const float k2 = 1.4426950408889634f;
        *(float4*)(cc + tid * 16 + i * 4) = make_float4((pre + v[4 * i]) * k2, (pre + v[4 * i + 1]) * k2, (pre + v[4 * i + 2]) * k2, (pre + v[4 * i + 3]) * k2); }
    __syncthreads();
}

constexpr int KV_BUF = 16384;
DEVI void tile_glds(const bf16_t* Kg, int ldk, const bf16_t* Vg, int ldv, char* buf, int tid) {
    const int w = tid >> 6, i = tid & 63;
#pragma unroll
    for (int jj = 0; jj < 2; ++jj) {
        const int j = w * 2 + jj, row = 8 * j + (i >> 3), slot = i & 7;
        const bf16_t* kp = Kg + (size_t)row * ldk + ((slot ^ (row & 7)) << 3);
        const bf16_t* vp = Vg + (size_t)row * ldv + ((slot ^ ((row >> 1) & 7)) << 3);
        __builtin_amdgcn_global_load_lds((const unsigned*)kp, (ldsp_t)(unsigned)(size_t)(buf + j * 1024), 16, 0, 0);
        __builtin_amdgcn_global_load_lds((const unsigned*)vp, (ldsp_t)(unsigned)(size_t)(buf + 8192 + j * 1024), 16, 0, 0);
    }
}
DEVI void lds_kf(const char* buf, int kh, int lane, bf16x8 (&kf)[2][2]) {
    const int quad = lane >> 4, l15 = lane & 15;
#pragma unroll
    for (int t2 = 0; t2 < 2; ++t2)
#pragma unroll
        for (int ks = 0; ks < 2; ++ks) { const int row = kh * 32 + t2 * 16 + l15, ch = ks * 4 + quad; kf[t2][ks] = *(const bf16x8*)(buf + row * 128 + ((ch ^ (row & 7)) << 4)); }
}
DEVI void lds_vf(const char* buf, int kh, int lane, bf16x8 (&vf)[4]) {
    const int quad = lane >> 4, l15 = lane & 15;
#pragma unroll
    for (int dt = 0; dt < 4; ++dt) { const int d = dt * 16 + l15, u0 = kh * 8 + quad, u1 = u0 + 4;
        const uint2 a = *(const uint2*)(buf + 8192 + d * 128 + ((u0 ^ (d & 14)) << 3)), b = *(const uint2*)(buf + 8192 + d * 128 + ((u1 ^ (d & 14)) << 3));
        vf[dt] = mk8(a.x, a.y, b.x, b.y); }
}

template <class MaskF>
DEVI void attn_block64(const char* buf, int kbase, const char* ql, int q0o, int q1o, int qstride, const float* cb, f32x4 (&O)[4][4], float (&m)[4], float (&l)[4], int lane, MaskF maskf) {
    const int quad = lane >> 4;
#pragma unroll
    for (int kh = 0; kh < 2; ++kh) {
        bf16x8 kf[2][2], vf[4];
        lds_kf(buf, kh, lane, kf); lds_vf(buf, kh, lane, vf);
        float ck[8] = {0.f, 0.f, 0.f, 0.f, 0.f, 0.f, 0.f, 0.f};
        if (cb) { const float4 c0 = *(const float4*)(cb + kbase + kh * 32 + quad * 4), c1 = *(const float4*)(cb + kbase + kh * 32 + 16 + quad * 4);
            ck[0] = c0.x; ck[1] = c0.y; ck[2] = c0.z; ck[3] = c0.w; ck[4] = c1.x; ck[5] = c1.y; ck[6] = c1.z; ck[7] = c1.w; }
#pragma unroll
        for (int nt = 0; nt < 4; ++nt) {
            f32x4 s0 = (f32x4){0.f, 0.f, 0.f, 0.f}, s1 = s0;
            { const bf16x8 qa = *(const bf16x8*)(ql + nt * qstride + q0o), qb_ = *(const bf16x8*)(ql + nt * qstride + q1o);
              s0 = mfma(kf[0][0], qa, s0); s1 = mfma(kf[1][0], qa, s1); s0 = mfma(kf[0][1], qb_, s0); s1 = mfma(kf[1][1], qb_, s1); }
            float sv[8]; float mx = -1e30f;
#pragma unroll
            for (int e = 0; e < 8; ++e) { sv[e] = (e < 4) ? s0[e & 3] : s1[e & 3]; const int key = kbase + kh * 32 + (e >> 2) * 16 + quad * 4 + (e & 3);
                const bool ok = maskf(nt, ck[e], key, sv[e]); sv[e] = ok ? sv[e] : -__builtin_huge_valf(); mx = fmaxf(mx, sv[e]); }
            mx = fmaxf(mx, __shfl_xor(mx, 16)); mx = fmaxf(mx, __shfl_xor(mx, 32));
            const float mn = fmaxf(m[nt], mx), alpha = __builtin_amdgcn_exp2f(m[nt] - mn);
            float pv[8]; float rs = 0.f;
#pragma unroll
            for (int e = 0; e < 8; ++e) { pv[e] = __builtin_amdgcn_exp2f(sv[e] - mn); rs += pv[e]; }
            rs += __shfl_xor(rs, 16); rs += __shfl_xor(rs, 32);
            l[nt] = l[nt] * alpha + rs; m[nt] = mn;
            const bf16x8 P = mk8(pk2(pv[0], pv[1]), pk2(pv[2], pv[3]), pk2(pv[4], pv[5]), pk2(pv[6], pv[7]));
#pragma unroll
            for (int dt = 0; dt < 4; ++dt) { O[dt][nt] = O[dt][nt] * alpha; O[dt][nt] = mfma(vf[dt], P, O[dt][nt]); }
        }
    }
}

template <class MaskF>
DEVI void attn_stream(u64 tiles, const bf16_t* Kbase, int ldk, const bf16_t* Vbase, int ldv, char* kvbuf, int jb_wave_min, int jb_wave_max,
                      const char* ql, int q0o, int q1o, int qstride, const float* cb, f32x4 (&O)[4][4], float (&m)[4], float (&l)[4], int tid, int lane, MaskF maskf) {
    if (tiles == 0ull) return;
    int jb = __ffsll((long long)tiles) - 1; tiles &= tiles - 1;
    tile_glds(Kbase + (size_t)jb * 64 * ldk, ldk, Vbase + jb * 64, ldv, kvbuf, tid);
    __syncthreads();
    int cur = 0;
#pragma unroll 1
    for (;;) {
        const bool more = tiles != 0ull;
        int jbn = 0;
        if (more) { jbn = __ffsll((long long)tiles) - 1; tiles &= tiles - 1; tile_glds(Kbase + (size_t)jbn * 64 * ldk, ldk, Vbase + jbn * 64, ldv, kvbuf + (cur ^ 1) * KV_BUF, tid); }
        if (jb >= jb_wave_min && jb <= jb_wave_max) attn_block64(kvbuf + cur * KV_BUF, jb * 64, ql, q0o, q1o, qstride, cb, O, m, l, lane, [&](int nt, float ckv, int key, float& s) { return maskf(nt, ckv, key, jb, s); });
        __syncthreads();
        if (!more) break;
        jb = jbn; cur ^= 1;
    }
}

DEVI void attn_store2(bf16_t* mix, size_t token0, int tokstride, int col0, int colstride, const f32x4 (&O)[4][4], const float (&sc)[4], int lane, bool accum) {
    const int quad = lane >> 4, l15 = lane & 15;
#pragma unroll
    for (int nt = 0; nt < 4; ++nt)
#pragma unroll
        for (int dt = 0; dt < 4; ++dt) {
            bf16_t* dst = mix + (token0 + nt * tokstride + l15) * DM + col0 + nt * colstride + dt * 16 + quad * 4;
            float a0 = O[dt][nt][0] * sc[nt], a1 = O[dt][nt][1] * sc[nt], a2 = O[dt][nt][2] * sc[nt], a3 = O[dt][nt][3] * sc[nt];
            if (accum) { const uint2 old = *(const uint2*)dst; a0 += bflo(old.x); a1 += bfhi(old.x); a2 += bflo(old.y); a3 += bfhi(old.y); }
            uint2 o; o.x = pk2(a0, a1); o.y = pk2(a2, a3);
            *(uint2*)dst = o;
        }
}

__device__ void nsa_unit(const Params& p, int L, int b, int g, int blk, char* lds) {
    const int tid = otid(), lane = tid & 63, w = tid >> 6, quad = lane >> 4, l15 = lane & 15;
    const bf16_t* proj = (const bf16_t*)(p.ws + OFF_BIG); const bf16_t* VT = (const bf16_t*)(p.ws + OFF_BIG + OFF_VT_IN_BIG);
    const float* gates = (const float*)(p.ws + OFF_GATES);
    bf16_t* mix = (bf16_t*)(p.ws + OFF_ACT);
    char* kvbuf = lds; float* impL = (float*)(lds + KV_BUF)  ; char* Qs = lds + 32768; u64* selm = (u64*)(lds + 65536);
    const int q0 = blk * 64; const int tq = q0 + w * 16 + l15; const size_t token = (size_t)b * 4096 + tq;
    const size_t token0 = (size_t)b * 4096 + q0 + w * 16;
    const int mixcol = 256 + g * 256;
#pragma unroll
    for (int t = 0; t < 8; ++t) { const int idx = t * 64 + lane, rr = idx >> 3, c = idx & 7, hh = rr >> 4, r16 = rr & 15;
        const uint4 v = *(const uint4*)(proj + (token0 + r16) * PJ_LD + 1024 + (g * 4 + hh) * 64 + c * 8);
        *(uint4*)(Qs + (hh * 64 + w * 16 + r16) * 128 + ((c ^ (r16 & 7)) << 4)) = v; }
    const char* ql = Qs + (w * 16 + l15) * 128; const int q0o = ((quad) ^ (l15 & 7)) << 4, q1o = ((4 + quad) ^ (l15 & 7)) << 4; const int qstride = 8192;
    __syncthreads();
    f32x4 O[4][4]; float m[4], l[4];
    const bf16_t* Kc = (const bf16_t*)(p.ws + OFF_KC) + (size_t)(b * 2 + g) * 256 * 64;
    const bf16_t* VcT = (const bf16_t*)(p.ws + OFF_VCT) + (size_t)(b * 2 + g) * 64 * 256;
    const int ncb = (4 * blk + 3 + 63) >> 6;
#pragma unroll
    for (int nt = 0; nt < 4; ++nt) { m[nt] = -1e30f; l[nt] = 0.f; }
    {
#pragma unroll 1
        for (int pass = 0; pass < 2; ++pass) {
            float inv[4]; float prevr = 0.f;
            if (pass == 1) {
#pragma unroll
                for (int nt = 0; nt < 4; ++nt) inv[nt] = 1.0f / fmaxf(l[nt], 1e-30f);
#pragma unroll
                for (int dt = 0; dt < 4; ++dt)
#pragma unroll
                    for (int nt = 0; nt < 4; ++nt) O[dt][nt] = (f32x4){0.f, 0.f, 0.f, 0.f};
            }
#pragma unroll 1
            for (int ct = 0; ct < ncb; ++ct) {
                tile_glds(Kc + (size_t)ct * 64 * 64, 64, VcT + ct * 64, 256, kvbuf, tid);
                __syncthreads();
                const char* buf = kvbuf;
#pragma unroll
                for (int kh = 0; kh < 2; ++kh) {
                    bf16x8 kf[2][2]; lds_kf(buf, kh, lane, kf);
                    if (pass == 0) {
#pragma unroll
                        for (int nt = 0; nt < 4; ++nt) {
                            f32x4 s0 = (f32x4){0.f, 0.f, 0.f, 0.f}, s1 = s0;
                            { const bf16x8 qa = *(const bf16x8*)(ql + nt * qstride + q0o), qb_ = *(const bf16x8*)(ql + nt * qstride + q1o);
                              s0 = mfma(kf[0][0], qa, s0); s1 = mfma(kf[1][0], qa, s1); s0 = mfma(kf[0][1], qb_, s0); s1 = mfma(kf[1][1], qb_, s1); }
                            float sv[8]; bool ok[8]; float mx = -1e30f;
#pragma unroll
                            for (int e = 0; e < 8; ++e) { sv[e] = (e < 4) ? s0[e & 3] : s1[e & 3]; const int n = ct * 64 + kh * 32 + (e >> 2) * 16 + quad * 4 + (e & 3);
                                ok[e] = (16 * n + 31 <= tq); if (ok[e]) mx = fmaxf(mx, sv[e]); }
                            mx = fmaxf(mx, __shfl_xor(mx, 16)); mx = fmaxf(mx, __shfl_xor(mx, 32));
                            const float mn = fmaxf(m[nt], mx), alpha = __builtin_amdgcn_exp2f(m[nt] - mn);
                            float rs = 0.f;
#pragma unroll
                            for (int e = 0; e < 8; ++e) rs += ok[e] ? __builtin_amdgcn_exp2f(sv[e] - mn) : 0.f;
                            rs += __shfl_xor(rs, 16); rs += __shfl_xor(rs, 32);
                            l[nt] = l[nt] * alpha + rs; m[nt] = mn;
                        }
                    } else {
                        bf16x8 vf[4]; lds_vf(buf, kh, lane, vf);
                        float As[2] = {0.f, 0.f}, p3[2] = {0.f, 0.f};
#pragma unroll
                        for (int nt = 0; nt < 4; ++nt) {
                            f32x4 s0 = (f32x4){0.f, 0.f, 0.f, 0.f}, s1 = s0;
                            { const bf16x8 qa = *(const bf16x8*)(ql + nt * qstride + q0o), qb_ = *(const bf16x8*)(ql + nt * qstride + q1o);
                              s0 = mfma(kf[0][0], qa, s0); s1 = mfma(kf[1][0], qa, s1); s0 = mfma(kf[0][1], qb_, s0); s1 = mfma(kf[1][1], qb_, s1); }
                            float pv[8];
#pragma unroll
                            for (int e = 0; e < 8; ++e) { const float s = (e < 4) ? s0[e & 3] : s1[e & 3]; const int n = ct * 64 + kh * 32 + (e >> 2) * 16 + quad * 4 + (e & 3);
                                pv[e] = (16 * n + 31 <= tq) ? __builtin_amdgcn_exp2f(s - m[nt]) * inv[nt] : 0.f; }
                            As[0] += (pv[0] + pv[1]) + (pv[2] + pv[3]); As[1] += (pv[4] + pv[5]) + (pv[6] + pv[7]); p3[0] += pv[3]; p3[1] += pv[7];
                            const bf16x8 P = mk8(pk2(pv[0], pv[1]), pk2(pv[2], pv[3]), pk2(pv[4], pv[5]), pk2(pv[6], pv[7]));
#pragma unroll
                            for (int dt = 0; dt < 4; ++dt) O[dt][nt] = mfma(vf[dt], P, O[dt][nt]);
                        }
                        const int qq = w * 16 + l15;
#pragma unroll
                        for (int t2 = 0; t2 < 2; ++t2) {
                            const float rr = __shfl(p3[t2], (lane + 48) & 63);
                            const float carry = (quad == 0) ? prevr : rr; prevr = rr;
                            const int jb = ct * 16 + kh * 8 + t2 * 4 + quad;
                            impL[jb * 64 + ((qq ^ jb) & 63)] = As[t2] + carry;
                        }
                    }
                }
                __syncthreads();
            }
        }
    }
    {
        const float4 gv = *(const float4*)(gates + token * 32 + 0 * 8 + g * 4);
        const float sc[4] = {gv.x, gv.y, gv.z, gv.w};
        attn_store2(mix, token0, 0, mixcol, 64, O, sc, lane, false);
    }
#pragma unroll 1
    for (int qi = 0; qi < 16; ++qi) {
        const int q = w * 16 + qi, jb = lane;
        float val = impL[jb * 64 + ((q ^ jb) & 63)];
        if (jb > blk) val = -1e30f;
        else if (jb == 0 || jb == blk || jb == blk - 1) val = 1e30f;
        int rank = 0;
        for (int jp = 0; jp < 64; ++jp) { const float vj = __shfl(val, jp); rank += ((vj > val) || (vj == val && jp < jb)) ? 1 : 0; }
        const bool sel = (rank < 16) && (val > -5e29f);
        const u64 mask = __ballot(sel);
        if (lane == 0) selm[q] = mask;
    }
    __syncthreads();
    u64 uni = 0;
    for (int q = 0; q < 64; ++q) uni |= selm[q];
    const u64 sm = selm[w * 16 + l15];
    {
#pragma unroll
        for (int nt = 0; nt < 4; ++nt) { m[nt] = -1e30f; l[nt] = 0.f; }
#pragma unroll
        for (int dt = 0; dt < 4; ++dt)
#pragma unroll
            for (int nt = 0; nt < 4; ++nt) O[dt][nt] = (f32x4){0.f, 0.f, 0.f, 0.f};
        const u64 tiles = uni & ((blk == 63) ? ~0ull : ((2ull << blk) - 1ull));
        attn_stream(tiles, proj + (size_t)b * 4096 * PJ_LD + 1792 + g * 64, PJ_LD, VT + ((size_t)((4 + g) * 8 + b) * 64) * 4096, 4096, kvbuf, 0, 63, ql, q0o, q1o, qstride, nullptr, O, m, l, tid, lane,
                    [&](int nt, float ckv, int key, int jb, float& s) { return (((sm >> jb) & 1ull) != 0) && (key <= tq); });
        const float4 gv = *(const float4*)(gates + token * 32 + 1 * 8 + g * 4);
        const float sc[4] = {gv.x / fmaxf(l[0], 1e-30f), gv.y / fmaxf(l[1], 1e-30f), gv.z / fmaxf(l[2], 1e-30f), gv.w / fmaxf(l[3], 1e-30f)};
        attn_store2(mix, token0, 0, mixcol, 64, O, sc, lane, true);
    }
    {
#pragma unroll
        for (int nt = 0; nt < 4; ++nt) { m[nt] = -1e30f; l[nt] = 0.f; }
#pragma unroll
        for (int dt = 0; dt < 4; ++dt)
#pragma unroll
            for (int nt = 0; nt < 4; ++nt) O[dt][nt] = (f32x4){0.f, 0.f, 0.f, 0.f};
        const int jlo = blk > 8 ? blk - 8 : 0;
        const u64 upto = (blk == 63) ? ~0ull : ((2ull << blk) - 1ull);
        const u64 tiles = upto & ~((1ull << jlo) - 1ull);
        attn_stream(tiles, proj + (size_t)b * 4096 * PJ_LD + 2048 + g * 64, PJ_LD, VT + ((size_t)((6 + g) * 8 + b) * 64) * 4096, 4096, kvbuf, 0, 63, ql, q0o, q1o, qstride, nullptr, O, m, l, tid, lane,
                    [&](int nt, float ckv, int key, int jb, float& s) { return (key <= tq) && (key + 512 > tq); });
        const float4 gv = *(const float4*)(gates + token * 32 + 2 * 8 + g * 4);
        const float sc[4] = {gv.x / fmaxf(l[0], 1e-30f), gv.y / fmaxf(l[1], 1e-30f), gv.z / fmaxf(l[2], 1e-30f), gv.w / fmaxf(l[3], 1e-30f)};
        attn_store2(mix, token0, 0, mixcol, 64, O, sc, lane, true);
    }
    __syncthreads();
}

__device__ void fox_unit(const Params& p, int L, int b, int h, int qb, char* lds) {
    const int tid = otid(), lane = tid & 63, w = tid >> 6, quad = lane >> 4, l15 = lane & 15;
    const bf16_t* proj = (const bf16_t*)(p.ws + OFF_BIG); const bf16_t* VT = (const bf16_t*)(p.ws + OFF_BIG + OFF_VT_IN_BIG);
    bf16_t* mix = (bf16_t*)(p.ws + OFF_ACT);
    const float* cc = (const float*)(p.ws + OFF_FOXC) + (size_t)(b * 4 + h) * 4096;
    const int q0 = qb * 256 + w * 64; const size_t token0 = (size_t)b * 4096 + q0;
    int tq[4]; float cq[4];
#pragma unroll
    for (int nt = 0; nt < 4; ++nt) { tq[nt] = q0 + nt * 16 + l15; cq[nt] = cc[tq[nt]]; }
    char* Qs = lds + 32768;
#pragma unroll
    for (int t = 0; t < 8; ++t) { const int idx = t * 64 + lane, rr = idx >> 3, c = idx & 7;
        const uint4 v = *(const uint4*)(proj + (token0 + rr) * PJ_LD + 2304 + h * 64 + c * 8);
        *(uint4*)(Qs + (w * 64 + rr) * 128 + ((c ^ (rr & 7)) << 4)) = v; }
    const char* ql = Qs + (w * 64 + l15) * 128; const int q0o = ((quad) ^ (l15 & 7)) << 4, q1o = ((4 + quad) ^ (l15 & 7)) << 4; const int qstride = 2048;
    __syncthreads();
    f32x4 O[4][4]; float m[4], l[4];
#pragma unroll
    for (int nt = 0; nt < 4; ++nt) { m[nt] = -1e30f; l[nt] = 0.f; }
#pragma unroll
    for (int dt = 0; dt < 4; ++dt)
#pragma unroll
        for (int nt = 0; nt < 4; ++nt) O[dt][nt] = (f32x4){0.f, 0.f, 0.f, 0.f};
    const int jmax = qb * 4 + 3;
    int jlo_w, jlo_b;
    { const float cq0 = cc[q0]; int lo = 0, hi = qb * 4 + w;
      while (lo < hi) { const int mid = (lo + hi) >> 1; if (cq0 - cc[mid * 64 + 63] >= -202.f) hi = mid; else lo = mid + 1; }
      jlo_w = lo; }
    { const float cq0 = cc[qb * 256]; int lo = 0, hi = qb * 4;
      while (lo < hi) { const int mid = (lo + hi) >> 1; if (cq0 - cc[mid * 64 + 63] >= -202.f) hi = mid; else lo = mid + 1; }
      jlo_b = lo; }
    const u64 tiles = ((jmax == 63) ? ~0ull : ((2ull << jmax) - 1ull)) & ~((1ull << jlo_b) - 1ull);
    attn_stream(tiles, proj + (size_t)b * 4096 * PJ_LD + 2560 + h * 64, PJ_LD, VT + ((size_t)((8 + h) * 8 + b) * 64) * 4096, 4096, lds, jlo_w, qb * 4 + w, ql, q0o, q1o, qstride, cc, O, m, l, tid, lane,
                [&](int nt, float ckv, int key, int jb, float& s) { s += cq[nt] - ckv; return key <= tq[nt]; });
    float sc[4];
#pragma unroll
    for (int nt = 0; nt < 4; ++nt) sc[nt] = 1.0f / fmaxf(l[nt], 1e-30f);
    attn_store2(mix, token0, 16, 768 + h * 64, 0, O, sc, lane, false);
}

__device__ void mixA_phase(const Params& p, int L, char* lds);
DEVI int next_unit(const Params& p, int idx, char* lds) {
    int* slot = (int*)(lds + LDS_BYTES - 16);
    const unsigned g = blockIdx.x & 7u;
    unsigned* ctr = (unsigned*)(p.ws + OFF_XBAR) + 10240 + (idx * 8 + (int)g) * 64;
    __syncthreads();
    if (otid() == 0) *slot = (int)(g + 8u * atomicAdd(ctr, 1u));
    __syncthreads();
    return *slot;
}
__device__ void mixA_phase(const Params& p, int L, char* lds) {
#pragma unroll 1
    for (;;) {
        const int job = next_unit(p, L * 4 + 3, lds); if (job >= 544 + 1024) break;
        if (job < 512) compress_unit(p, L, job, lds);
        else if (job < 544) foxc_job(p, L, job - 512, lds);
        else {
#pragma unroll 1
            for (int u = (job - 544) * 2; u < (job - 544) * 2 + 2; ++u) hgrn_a_unit(p, L, u, lds);
        }
    }
}
__device__ void mixB_phase(const Params& p, int L, char* lds) {
#pragma unroll 1
    for (;;) { const int f = next_unit(p, L * 4 + 0, lds); if (f >= 512) break; const int qb = 15 - (f >> 5), bh = f & 31; fox_unit(p, L, bh >> 2, bh & 3, qb, lds); }
#pragma unroll 1
    for (;;) { const int n = next_unit(p, L * 4 + 1, lds); if (n >= 1024) break; const int blk = 63 - (n >> 4), bg = n & 15; nsa_unit(p, L, bg >> 1, bg & 1, blk, lds); }
#pragma unroll 1
    for (;;) { const int c = next_unit(p, L * 4 + 2, lds); if (c >= 1024) break;
#pragma unroll 1
        for (int u = c * 2; u < c * 2 + 2; ++u) hgrn_c_unit(p, L, u, lds); }
}


#define XB_TMO      128
#define XB_XCNT(j)  (256  + 64 * (j))
#define XB_XSUB(j)  (1280 + 64 * (j))
#define XB_XGEN(j)  (2304 + 64 * (j))
#define XB_TOP      3328
#define XB_TOPGEN   3392
#define XCD_BAR_WORDS 3456
#define XB_SPIN_CAP (1u << 18)
#define LAS __attribute__((address_space(3)))
DEVI unsigned xb_ld(unsigned* p)              { return __hip_atomic_load(p, __ATOMIC_RELAXED, __HIP_MEMORY_SCOPE_AGENT); }
DEVI unsigned xb_add(unsigned* p, unsigned v) { return __hip_atomic_fetch_add(p, v, __ATOMIC_RELAXED, __HIP_MEMORY_SCOPE_AGENT); }
DEVI unsigned xb_xcc_id() { return (unsigned)__builtin_amdgcn_s_getreg((3 << 11) | 20) & 0xFu; }
#define XB_SPIN(cond, bar) do { unsigned _sp = 0; while (cond) { __builtin_amdgcn_s_sleep(1); \
    if ((++_sp & 255u) == 0u) { if (xb_ld(&(bar)[XB_TMO])) break; if (_sp > XB_SPIN_CAP) { atomicAdd(&(bar)[XB_TMO], 1u); break; } } } } while (0)
struct XcdBarrier { unsigned* bar; unsigned x; volatile LAS unsigned* st; };
DEVI XcdBarrier xcd_barrier_post(unsigned* bar, volatile LAS unsigned* st) {
    XcdBarrier b; b.bar = bar; b.x = xb_xcc_id(); b.st = st;
    if (threadIdx.x == 0) (void)xb_add(&bar[XB_XCNT(b.x)], 1u);
    return b;
}
DEVI void xcd_barrier_complete(unsigned* bar, unsigned x, unsigned& nloc, unsigned& nx) {
    const unsigned G = gridDim.x * gridDim.y * gridDim.z;
    unsigned sum, cnt, mine, sp = 0u;
    for (;;) {
        sum = 0u; cnt = 0u; mine = 0u;
#pragma unroll
        for (unsigned j = 0; j < 16; ++j) { const unsigned c = xb_ld(&bar[XB_XCNT(j)]); sum += c; cnt += (c > 0u) ? 1u : 0u; mine = (j == x) ? c : mine; }
        if (sum == G) break;
        __builtin_amdgcn_s_sleep(1);
        if ((++sp & 255u) == 0u) { if (xb_ld(&bar[XB_TMO])) break; if (sp > XB_SPIN_CAP) { atomicAdd(&bar[XB_TMO], 1u); break; } }
    }
    nloc = mine > 0u ? mine : 1u; nx = cnt > 0u ? cnt : 1u;
}
DEVI void xcd_barrier(const XcdBarrier& b) {
    __builtin_amdgcn_fence(__ATOMIC_RELEASE, "agent");
    asm volatile("s_waitcnt vmcnt(0)" ::: "memory");
    __syncthreads();
    if (threadIdx.x == 0) {
        unsigned* bar = b.bar;
        __builtin_amdgcn_s_waitcnt(0);
        unsigned nloc = b.st[0], nx = b.st[1];
        if (nloc == 0u) { xcd_barrier_complete(bar, b.x, nloc, nx); b.st[0] = nloc; b.st[1] = nx; }
        const unsigned old = xb_add(&bar[XB_XSUB(b.x)], 1u);
        const unsigned gen = old / nloc;
        if (old + 1u == (gen + 1u) * nloc) {
            __builtin_amdgcn_fence(__ATOMIC_RELEASE, "agent");
            asm volatile("s_waitcnt vmcnt(0)" ::: "memory");
            const unsigned og = xb_add(&bar[XB_TOP], 1u);
            const unsigned tg = og / nx;
            if (og + 1u == (tg + 1u) * nx) xb_add(&bar[XB_TOPGEN], 1u);
            else XB_SPIN(xb_ld(&bar[XB_TOPGEN]) == tg, bar);
            __builtin_amdgcn_fence(__ATOMIC_ACQUIRE, "agent");
            xb_add(&bar[XB_XGEN(b.x)], 1u);
            asm volatile("s_waitcnt vmcnt(0)" ::: "memory");
        } else {
            XB_SPIN(xb_ld(&bar[XB_XGEN(b.x)]) == gen, bar);
            __builtin_amdgcn_fence(__ATOMIC_ACQUIRE, "agent");
            asm volatile("s_waitcnt vmcnt(0)" ::: "memory");
        }
    }
    __syncthreads();
    __builtin_amdgcn_fence(__ATOMIC_ACQUIRE, "agent");
    asm volatile("s_waitcnt vmcnt(0)" ::: "memory");
}

__device__ void run_phase(const Params& p, int ph, char* lds) {
    if (ph == 0) { prep_phase(p, lds); return; }
    const int L = (ph - 1) / 7, s = (ph - 1) % 7;
    switch (s) {
        case 0: gemm_phase<EPI_PROJ>(p, L, lds); break;
        case 1: mixA_phase(p, L, lds); break;
        case 2: hgrn_scan_phase(p); break;
        case 3: mixB_phase(p, L, lds); break;
        case 4: gemm_phase<EPI_WO>(p, L, lds); break;
        case 5: gemm_phase<EPI_UP>(p, L, lds); break;
        default: gemm_phase<EPI_DOWN>(p, L, lds); break;
    }
}

__global__ void __launch_bounds__(256, 2) fwd_kernel(Params p, int ph_lo, int ph_hi) {
    __shared__ __attribute__((aligned(16))) char lds[LDS_BYTES];
    __shared__ uint4 xb_words;
    if (threadIdx.x == 0) xb_words = make_uint4(0u, 0u, 0u, 0u);
    __syncthreads();
    unsigned* bar = (unsigned*)(p.ws + OFF_XBAR);
    for (int ph = ph_lo; ph < ph_hi; ++ph) {
        run_phase(p, ph, lds);
        if (ph + 1 < ph_hi) {
            if (ph == ph_lo) cg::this_grid().sync();
            else {
                asm volatile("s_waitcnt vmcnt(0)" ::: "memory");
                __syncthreads();
                if (threadIdx.x == 0) {
                    unsigned* base = bar + ph * 640;
                    const unsigned g = blockIdx.x & 7u, G = gridDim.x;
                    const unsigned nper = (G >> 3) + ((g < (G & 7u)) ? 1u : 0u);
                    const unsigned ngrp = G < 8u ? G : 8u;
                    __builtin_amdgcn_fence(__ATOMIC_RELEASE, "agent");
                    asm volatile("s_waitcnt vmcnt(0)" ::: "memory");
                    if (__hip_atomic_fetch_add(base + g * 64, 1u, __ATOMIC_RELAXED, __HIP_MEMORY_SCOPE_AGENT) == nper - 1u) {
                        if (__hip_atomic_fetch_add(base + 8 * 64, 1u, __ATOMIC_RELAXED, __HIP_MEMORY_SCOPE_AGENT) == ngrp - 1u)
                            __hip_atomic_store(base + 9 * 64, 1u, __ATOMIC_RELAXED, __HIP_MEMORY_SCOPE_AGENT);
                    }
                    while (__hip_atomic_load(base + 9 * 64, __ATOMIC_RELAXED, __HIP_MEMORY_SCOPE_AGENT) == 0u) __builtin_amdgcn_s_sleep(1);
                    __builtin_amdgcn_fence(__ATOMIC_ACQUIRE, "agent");
                    asm volatile("s_waitcnt vmcnt(0)" ::: "memory");
                }
                __syncthreads();
            }
        }
    }
}

extern "C" void kernel_launch(void* const* d_in, const int* in_sizes, int n_in, void* d_out, int out_size, void* d_ws, size_t ws_size,
                              hipStream_t stream) {
    if (ws_size < WS_NEED) { fprintf(stderr, "workspace too small: %zu < %zu\n", ws_size, (size_t)WS_NEED); return; }
    Params p{};
    p.x = (const float*)d_in[0]; p.norm1_g = (const float*)d_in[1]; p.w_in = (const float*)d_in[2]; p.lb_logits = (const float*)d_in[3];
    p.onorm_g = (const float*)d_in[4]; p.nsa_qn_g = (const float*)d_in[5]; p.nsa_kn_g = (const float*)d_in[6]; p.cmp_pos = (const float*)d_in[7];
    p.cmp_w1 = (const float*)d_in[8]; p.cmp_w2 = (const float*)d_in[9]; p.fox_qn_g = (const float*)d_in[10]; p.fox_kn_g = (const float*)d_in[11];
    p.fox_fb = (const float*)d_in[12]; p.w_o = (const float*)d_in[13]; p.norm2_g = (const float*)d_in[14]; p.w_up = (const float*)d_in[15];
    p.w_down = (const float*)d_in[16];
    p.out = (float*)d_out; p.ws = (char*)d_ws;
#if MULTI_LAUNCH
    for (int ph = 0; ph < NPHASE; ++ph) hipLaunchKernelGGL(fwd_kernel, dim3(512), dim3(256), 0, stream, p, ph, ph + 1);
#else
    static int grid_blocks = 0;
    if (!grid_blocks) {
        int dev = 0, cus = 0, per_cu = 0;
        hipGetDevice(&dev);
        hipDeviceGetAttribute(&cus, hipDeviceAttributeMultiprocessorCount, dev);
        hipOccupancyMaxActiveBlocksPerMultiprocessor(&per_cu, fwd_kernel, 256, 0);
        per_cu = 2;
        grid_blocks = cus * per_cu;
        grid_blocks &= ~7;
    }
    int lo = 0, hi = NPHASE;
    void* args[] = {&p, &lo, &hi};
    hipError_t e = hipLaunchCooperativeKernel((void*)fwd_kernel, dim3(grid_blocks), dim3(256), args, 0, stream);
    if (e != hipSuccess) fprintf(stderr, "cooperative launch failed: %s (grid %d)\n", hipGetErrorString(e), grid_blocks);
#endif
}
```
